# Optimizing an MI355X kernel written in HIP

```python
import math
import jax, jax.numpy as jnp
from jax import lax
import numpy as np

D_MODEL = 2048
BATCH = 2
SEQ = 16384
DEPTH = 2

D_MIX = D_MODEL
POOL_WIDTH = D_MIX // 4
POOL_WINDOWS = (2, 4, 8, 16)
POOL_GROUPS = len(POOL_WINDOWS)
POOL_GROUP_DIM = POOL_WIDTH // POOL_GROUPS
SSM_WIDTH = D_MIX // 4
SSM_GROUP = 16
SSM_N_GROUPS = SSM_WIDTH // SSM_GROUP
SSM_STATE = 64
DT_MIN = 0.001
DT_MAX = 0.1
MLA_HEADS = 8
QK_NOPE = 128
QK_ROPE = 64
QK_HEAD = QK_NOPE + QK_ROPE
V_HEAD = 128
MLA_WIDTH = MLA_HEADS * V_HEAD
Q_LORA = 512
KV_LORA = 256
ROPE_THETA = 10000.0
Q_BLOCK = 128
IN_COLS = POOL_WIDTH + SSM_WIDTH + Q_LORA + KV_LORA + QK_ROPE
MOE_GROUPS = 4
EXPERTS_PER_GROUP = 8
N_EXPERTS = MOE_GROUPS * EXPERTS_PER_GROUP
TOP_K = 2
D_EXPERT = 512
MOE_BLOCK = 128
EPS = 1e-6

kernel_name = 'hybrid_pool_s5_mla_hmoe'


def rms_norm(x, g):
    xf = x.astype(jnp.float32)
    y = xf * lax.rsqrt(jnp.mean(xf * xf, axis=-1, keepdims=True) + EPS)
    return (y * g.astype(jnp.float32)).astype(x.dtype)


def apply_rope(x, cos, sin):
    xf = x.astype(jnp.float32)
    x1, x2 = jnp.split(xf, 2, axis=-1)
    return jnp.concatenate([x1 * cos - x2 * sin, x2 * cos + x1 * sin], axis=-1).astype(x.dtype)


def pool_mixer(u, w_lin, scale):
    B_, L, _ = u.shape
    uf = u.astype(jnp.float32).reshape(B_, L, POOL_GROUPS, POOL_GROUP_DIM)
    cs = jnp.cumsum(uf, axis=1)
    t = jnp.arange(L)
    outs = []
    for gi, w in enumerate(POOL_WINDOWS):
        c_g = cs[:, :, gi]
        lag = jnp.pad(c_g, ((0, 0), (w, 0), (0, 0)))[:, :L]
        cnt = jnp.minimum(t + 1, w).astype(jnp.float32)[None, :, None]
        outs.append((c_g - lag) / cnt - uf[:, :, gi])
    d = jnp.stack(outs, axis=2).astype(u.dtype)
    y = jnp.einsum('blgc,gcd->blgd', d, w_lin)
    return y.reshape(B_, L, POOL_WIDTH) * scale


def _complex_scan_op(e1, e2):
    a1r, a1i, b1r, b1i = e1
    a2r, a2i, b2r, b2i = e2
    return (a2r * a1r - a2i * a1i,
            a2r * a1i + a2i * a1r,
            a2r * b1r - a2i * b1i + b2r,
            a2r * b1i + a2i * b1r + b2i)


def s5_mixer(u, lam_re, lam_im, log_dt, b_re, b_im, c_re, c_im, d_skip, w_glu):
    B_, L, _ = u.shape
    f32 = jnp.float32
    uf = u.astype(f32).reshape(B_, L, SSM_N_GROUPS, SSM_GROUP)
    dt = jnp.exp(log_dt.astype(f32))[:, None]
    lr, li = lam_re.astype(f32), lam_im.astype(f32)
    mag = jnp.exp(lr * dt)
    ab_re, ab_im = mag * jnp.cos(li * dt), mag * jnp.sin(li * dt)
    den = lr * lr + li * li
    f_re = ((ab_re - 1.0) * lr + ab_im * li) / den
    f_im = (ab_im * lr - (ab_re - 1.0) * li) / den
    br, bi = b_re.astype(f32), b_im.astype(f32)
    bb_re = f_re[..., None] * br - f_im[..., None] * bi
    bb_im = f_re[..., None] * bi + f_im[..., None] * br
    bu_re = jnp.einsum('blgh,gph->blgp', uf, bb_re)
    bu_im = jnp.einsum('blgh,gph->blgp', uf, bb_im)
    a_re = jnp.broadcast_to(ab_re, bu_re.shape)
    a_im = jnp.broadcast_to(ab_im, bu_im.shape)
    _, _, s_re, s_im = lax.associative_scan(_complex_scan_op, (a_re, a_im, bu_re, bu_im), axis=1)
    y = (jnp.einsum('blgp,ghp->blgh', s_re, c_re.astype(f32))
         - jnp.einsum('blgp,ghp->blgh', s_im, c_im.astype(f32)))
    y = y.reshape(B_, L, SSM_WIDTH) + d_skip.astype(f32) * uf.reshape(B_, L, SSM_WIDTH)
    y = jax.nn.gelu(y).astype(u.dtype)
    return y * jax.nn.sigmoid(y @ w_glu)


def mla_mixer(q_c, kv_c, k_pe_in, q_norm_g, kv_norm_g, w_uq, w_ukv, cos, sin):
    B_, L, _ = q_c.shape
    q = jnp.einsum('blr,rhd->blhd', rms_norm(q_c, q_norm_g), w_uq)
    q_nope = q[..., :QK_NOPE]
    q_pe = apply_rope(q[..., QK_NOPE:], cos[:, :, None, :], sin[:, :, None, :])
    kv = jnp.einsum('blr,rhd->blhd', rms_norm(kv_c, kv_norm_g), w_ukv)
    k_nope, v = kv[..., :QK_NOPE], kv[..., QK_NOPE:]
    k_pe = apply_rope(k_pe_in, cos, sin)
    scale = QK_HEAD ** -0.5
    n_blocks = L // Q_BLOCK
    key_idx = jnp.arange(L)

    def attend_block(i):
        s = i * Q_BLOCK
        qn = lax.dynamic_slice_in_dim(q_nope, s, Q_BLOCK, axis=1)
        qp = lax.dynamic_slice_in_dim(q_pe, s, Q_BLOCK, axis=1)
        sc = (jnp.einsum('bqhd,bkhd->bhqk', qn, k_nope)
              + jnp.einsum('bqhd,bkd->bhqk', qp, k_pe)).astype(jnp.float32) * scale
        causal = key_idx[None, :] <= (s + jnp.arange(Q_BLOCK))[:, None]
        sc = jnp.where(causal[None, None], sc, -jnp.inf)
        p = jax.nn.softmax(sc, axis=-1).astype(v.dtype)
        return jnp.einsum('bhqk,bkhd->bqhd', p, v)

    o = lax.map(attend_block, jnp.arange(n_blocks))
    return o.transpose(1, 0, 2, 3, 4).reshape(B_, L, MLA_WIDTH)


def hier_moe(h, w_rg, b_rg, w_re, b_re, w1, w3, w2):
    B_, L, D = h.shape
    N = B_ * L
    hf = h.reshape(N, D)
    g_logits = (hf @ w_rg).astype(jnp.float32) + b_rg
    g_prob = jax.nn.softmax(g_logits, axis=-1)
    g_top = jnp.argmax(g_logits, axis=-1)
    g_w = jnp.take_along_axis(g_prob, g_top[:, None], axis=-1)
    e_logits = ((hf @ w_re).astype(jnp.float32) + b_re).reshape(N, MOE_GROUPS, EXPERTS_PER_GROUP)
    e_logits = jnp.take_along_axis(e_logits, g_top[:, None, None], axis=1)[:, 0]
    e_prob = jax.nn.softmax(e_logits, axis=-1)
    top_p, top_i = lax.top_k(e_prob, TOP_K)
    top_p = top_p / jnp.sum(top_p, axis=-1, keepdims=True)
    weights = (g_w * top_p).reshape(-1)
    expert = (g_top[:, None] * EXPERTS_PER_GROUP + top_i).reshape(-1).astype(jnp.int32)
    token = jnp.repeat(jnp.arange(N, dtype=jnp.int32), TOP_K)
    A = N * TOP_K
    order = jnp.argsort(expert)
    e_s, tok_s, w_s = expert[order], token[order], weights[order]
    counts = jnp.bincount(expert, length=N_EXPERTS)
    padded = (counts + MOE_BLOCK - 1) // MOE_BLOCK * MOE_BLOCK
    pad_end = jnp.cumsum(padded)
    pad_start = pad_end - padded
    start = jnp.cumsum(counts) - counts
    dest = pad_start[e_s] + (jnp.arange(A, dtype=jnp.int32) - start[e_s])
    P = (-(-A // MOE_BLOCK) + N_EXPERTS) * MOE_BLOCK
    n_blocks = P // MOE_BLOCK
    row_tok = jnp.zeros((P,), jnp.int32).at[dest].set(tok_s)
    row_w = jnp.zeros((P,), jnp.float32).at[dest].set(w_s)
    block_start = jnp.arange(n_blocks, dtype=jnp.int32) * MOE_BLOCK
    block_expert = jnp.minimum(jnp.searchsorted(pad_end, block_start, side='right'), N_EXPERTS - 1)

    def expert_block(args):
        tok, e = args
        xb = hf[tok]
        a = jax.nn.silu(xb @ w1[e]) * (xb @ w3[e])
        return a @ w2[e]

    out = lax.map(expert_block, (row_tok.reshape(n_blocks, MOE_BLOCK), block_expert))
    out = out.reshape(P, D) * row_w[:, None].astype(out.dtype)
    y = jax.ops.segment_sum(out, row_tok, num_segments=N)
    return y.reshape(B_, L, D).astype(h.dtype)


def setup_inputs(seed: int = 0) -> dict:
    key = jax.random.key(seed)
    ks = iter(jax.random.split(key, 64))
    f32 = jnp.float32

    def nrm(shape, scale):
        return jax.random.normal(next(ks), shape, f32) * scale

    def gain(shape):
        return 1.0 + nrm(shape, 0.02)

    Lr = DEPTH
    x = nrm((BATCH, SEQ, D_MODEL), 1.0)
    c = nrm((BATCH, D_MODEL), 1.0)
    offset = jax.random.randint(next(ks), (BATCH, 1), 0, 4096, jnp.int32)
    positions = (jnp.arange(SEQ, dtype=jnp.int32)[None, :] + offset).astype(jnp.int32)
    w_ada = nrm((Lr, D_MODEL, 6 * D_MODEL), 0.3 * D_MODEL ** -0.5)
    b_ada = nrm((Lr, 6 * D_MODEL), 0.02)
    norm1_g = gain((Lr, D_MODEL))
    w_in = nrm((Lr, D_MODEL, IN_COLS), D_MODEL ** -0.5)
    pool_w = nrm((Lr, POOL_GROUPS, POOL_GROUP_DIM, POOL_GROUP_DIM), POOL_GROUP_DIM ** -0.5)
    pool_scale = 1.0 + nrm((Lr, POOL_WIDTH), 0.1)
    n = jnp.arange(SSM_STATE, dtype=f32)
    ssm_lam_re = -0.5 + nrm((Lr, SSM_N_GROUPS, SSM_STATE), 1e-3)
    ssm_lam_im = math.pi * n + nrm((Lr, SSM_N_GROUPS, SSM_STATE), 1e-3)
    ssm_log_dt = jax.random.uniform(next(ks), (Lr, SSM_N_GROUPS), f32, math.log(DT_MIN), math.log(DT_MAX))
    ssm_b_re = nrm((Lr, SSM_N_GROUPS, SSM_STATE, SSM_GROUP), (2 * SSM_GROUP) ** -0.5)
    ssm_b_im = nrm((Lr, SSM_N_GROUPS, SSM_STATE, SSM_GROUP), (2 * SSM_GROUP) ** -0.5)
    ssm_c_re = nrm((Lr, SSM_N_GROUPS, SSM_GROUP, SSM_STATE), (2 * SSM_STATE) ** -0.5)
    ssm_c_im = nrm((Lr, SSM_N_GROUPS, SSM_GROUP, SSM_STATE), (2 * SSM_STATE) ** -0.5)
    ssm_d = nrm((Lr, SSM_WIDTH), 1.0)
    ssm_w_glu = nrm((Lr, SSM_WIDTH, SSM_WIDTH), SSM_WIDTH ** -0.5)
    q_norm_g = gain((Lr, Q_LORA))
    kv_norm_g = gain((Lr, KV_LORA))
    w_uq = nrm((Lr, Q_LORA, MLA_HEADS, QK_HEAD), Q_LORA ** -0.5)
    w_ukv = nrm((Lr, KV_LORA, MLA_HEADS, QK_NOPE + V_HEAD), KV_LORA ** -0.5)
    out_norm_g = gain((Lr, D_MIX))
    w_out = nrm((Lr, D_MIX, D_MODEL), D_MIX ** -0.5)
    norm2_g = gain((Lr, D_MODEL))
    router_w_group = nrm((Lr, D_MODEL, MOE_GROUPS), D_MODEL ** -0.5)
    router_b_group = nrm((Lr, MOE_GROUPS), 0.01)
    router_w_expert = nrm((Lr, D_MODEL, N_EXPERTS), D_MODEL ** -0.5)
    router_b_expert = nrm((Lr, N_EXPERTS), 0.01)
    w_gate = nrm((Lr, N_EXPERTS, D_MODEL, D_EXPERT), D_MODEL ** -0.5)
    w_up = nrm((Lr, N_EXPERTS, D_MODEL, D_EXPERT), D_MODEL ** -0.5)
    w_down = nrm((Lr, N_EXPERTS, D_EXPERT, D_MODEL), D_EXPERT ** -0.5)
    final_g = gain((D_MODEL,))
    return {'x': x, 'c': c, 'positions': positions, 'w_ada': w_ada, 'b_ada': b_ada,
            'norm1_g': norm1_g, 'w_in': w_in, 'pool_w': pool_w, 'pool_scale': pool_scale,
            'ssm_lam_re': ssm_lam_re, 'ssm_lam_im': ssm_lam_im, 'ssm_log_dt': ssm_log_dt,
            'ssm_b_re': ssm_b_re, 'ssm_b_im': ssm_b_im, 'ssm_c_re': ssm_c_re, 'ssm_c_im': ssm_c_im,
            'ssm_d': ssm_d, 'ssm_w_glu': ssm_w_glu, 'q_norm_g': q_norm_g, 'kv_norm_g': kv_norm_g,
            'w_uq': w_uq, 'w_ukv': w_ukv, 'out_norm_g': out_norm_g, 'w_out': w_out,
            'norm2_g': norm2_g, 'router_w_group': router_w_group, 'router_b_group': router_b_group,
            'router_w_expert': router_w_expert, 'router_b_expert': router_b_expert,
            'w_gate': w_gate, 'w_up': w_up, 'w_down': w_down, 'final_g': final_g}


def reference(x, c, positions, w_ada, b_ada, norm1_g, w_in, pool_w, pool_scale,
              ssm_lam_re, ssm_lam_im, ssm_log_dt, ssm_b_re, ssm_b_im, ssm_c_re, ssm_c_im,
              ssm_d, ssm_w_glu, q_norm_g, kv_norm_g, w_uq, w_ukv, out_norm_g, w_out,
              norm2_g, router_w_group, router_b_group, router_w_expert, router_b_expert,
              w_gate, w_up, w_down, final_g):
    inv_freq = jnp.power(ROPE_THETA, -jnp.arange(0, QK_ROPE, 2, dtype=jnp.float32) / QK_ROPE)
    ang = positions.astype(jnp.float32)[..., None] * inv_freq
    cos, sin = jnp.cos(ang), jnp.sin(ang)
    in_splits = (POOL_WIDTH, POOL_WIDTH + SSM_WIDTH, POOL_WIDTH + SSM_WIDTH + Q_LORA,
                 POOL_WIDTH + SSM_WIDTH + Q_LORA + KV_LORA)
    for l in range(DEPTH):
        mod = c @ w_ada[l] + b_ada[l]
        sh_a, sc_a, g_a, sh_f, sc_f, g_f = [m[:, None, :] for m in jnp.split(mod, 6, axis=-1)]
        h = rms_norm(x, norm1_g[l]) * (1.0 + sc_a) + sh_a
        z = h @ w_in[l]
        u_pool, u_ssm, q_c, kv_c, k_pe = jnp.split(z, in_splits, axis=-1)
        y_pool = pool_mixer(u_pool, pool_w[l], pool_scale[l])
        y_ssm = s5_mixer(u_ssm, ssm_lam_re[l], ssm_lam_im[l], ssm_log_dt[l], ssm_b_re[l], ssm_b_im[l],
                         ssm_c_re[l], ssm_c_im[l], ssm_d[l], ssm_w_glu[l])
        y_mla = mla_mixer(q_c, kv_c, k_pe, q_norm_g[l], kv_norm_g[l], w_uq[l], w_ukv[l], cos, sin)
        gn = out_norm_g[l]
        y = jnp.concatenate([rms_norm(y_pool, gn[:POOL_WIDTH]),
                             rms_norm(y_ssm, gn[POOL_WIDTH:POOL_WIDTH + SSM_WIDTH]),
                             rms_norm(y_mla, gn[POOL_WIDTH + SSM_WIDTH:])], axis=-1)
        x = x + g_a * (y @ w_out[l])
        h = rms_norm(x, norm2_g[l]) * (1.0 + sc_f) + sh_f
        x = x + g_f * hier_moe(h, router_w_group[l], router_b_group[l], router_w_expert[l],
                               router_b_expert[l], w_gate[l], w_up[l], w_down[l])
    return rms_norm(x, final_g)
```

```cpp
#include <hip/hip_runtime.h>
#include <cstdio>
#include <cstdint>

#ifndef MK_ONE_LAUNCH
#define MK_ONE_LAUNCH 1
#endif

#define LAS __attribute__((address_space(3)))
#define GAS __attribute__((address_space(1)))
typedef unsigned short bf16_t;
typedef short bf16x8 __attribute__((ext_vector_type(8)));
typedef short s16x4 __attribute__((ext_vector_type(4)));
typedef float f32x2 __attribute__((ext_vector_type(2)));
typedef float f32x4 __attribute__((ext_vector_type(4)));
typedef float f32x16 __attribute__((ext_vector_type(16)));
typedef unsigned u32x2 __attribute__((ext_vector_type(2)));
typedef unsigned u32x4 __attribute__((ext_vector_type(4)));
typedef int i32x4 __attribute__((ext_vector_type(4)));

constexpr int NB = 2, SEQ = 16384, DM = 2048, NTOK = NB * SEQ, DEPTH = 2;
constexpr int IN_COLS = 1856, ZLD = 1536;
constexpr int Z_POOL = 0, Z_QC = 512, Z_KVC = 1024, Z_KPE = 1280;
constexpr int NHEAD = 8, QKD = 192, VD = 128;
constexpr int NEXP = 32, DEXP = 512;
constexpr int SSM_G = 32, SSM_T = 64, NCHUNK = NTOK / SSM_T;
constexpr float EPS = 1e-6f;
constexpr int MOE_MAXROWS = 2 * NTOK + NEXP * 256;

constexpr size_t MiB = 1u << 20;
constexpr size_t WS_CTL = 0, CTL_ZERO_BYTES = 1 * MiB;
constexpr size_t WS_MOD = 1 * MiB;
constexpr size_t WS_RBIAS = WS_MOD + 512 * 1024;
constexpr size_t WS_RWF = 2 * MiB;
constexpr size_t WS_RI = 4 * MiB;
constexpr size_t WS_RW = 5 * MiB;
constexpr size_t WS_TOK = 6 * MiB;
constexpr size_t WS_CS = 10 * MiB;
constexpr size_t WS_EBUF = 18 * MiB;
constexpr size_t WS_SPREV = 26 * MiB;
constexpr size_t WS_SSMTAB = 34 * MiB;
constexpr size_t SSMTAB_STRIDE = 832 * 1024, SSM_TG = 0, SSM_TEND = 64 * 1024, SSM_WC = 320 * 1024;
constexpr size_t WS_A64 = 86 * MiB;
constexpr size_t WS_WIN = 87 * MiB;
constexpr size_t WS_WUQ = 103 * MiB;
constexpr size_t WS_WUKV = 106 * MiB;
constexpr size_t WS_WOUT = 108 * MiB;
constexpr size_t WS_WGLU = 124 * MiB;
constexpr size_t WS_WPOOL = 125 * MiB;
constexpr size_t WS_W13 = 126 * MiB;
constexpr size_t WS_W2 = 254 * MiB;
constexpr size_t WS_XBUF = 318 * MiB;
constexpr size_t WS_H = 574 * MiB;
constexpr size_t WS_Q = 574 * MiB;
constexpr size_t WS_P = 670 * MiB;
constexpr size_t WS_Z = 702 * MiB;
constexpr size_t WS_O = 702 * MiB;
constexpr size_t WS_K = 798 * MiB;
constexpr size_t WS_YG = 798 * MiB, WS_GL = 830 * MiB;
constexpr size_t WS_V = 894 * MiB;
constexpr size_t WS_U = 958 * MiB;
constexpr size_t WS_Y2 = 702 * MiB;
constexpr size_t WS_YCAT = 990 * MiB;
constexpr size_t WS_ACT = 990 * MiB;
constexpr size_t WS_YI = 1118 * MiB;
constexpr size_t WS_END = 1150 * MiB;
static_assert(WS_Y2 + (size_t)MOE_MAXROWS * DM * 2 <= WS_YCAT, "Y2 overlay");
static_assert(WS_ACT + (size_t)MOE_MAXROWS * DEXP * 2 <= WS_YI, "ACT overlay");
constexpr int CW_BAR = 1024;
constexpr int CW_CNT = 8192;
constexpr size_t CTL_SSQ = 64 * 1024;

constexpr int RING_BYTES = 131072;
constexpr int LDS_TILETAB = RING_BYTES;
constexpr int LDS_PSTART = RING_BYTES + 1536;
constexpr int LDS_MISC = RING_BYTES + 2048;
constexpr int LDS_BYTES = RING_BYTES + 4096;

#define LDS_WAIT() asm volatile("s_waitcnt lgkmcnt(0)" ::: "memory")
#define VM_WAIT() asm volatile("s_waitcnt vmcnt(0)" ::: "memory")
__device__ __forceinline__ unsigned cvtpk(float lo, float hi) { unsigned r; asm volatile("v_cvt_pk_bf16_f32 %0, %1, %2" : "=v"(r) : "v"(lo), "v"(hi)); return r; }
__device__ __forceinline__ float bf2f(unsigned short h) { return __uint_as_float((unsigned)h << 16); }
__device__ __forceinline__ float bflo(unsigned w) { return __uint_as_float(w << 16); }
__device__ __forceinline__ float bfhi(unsigned w) { return __uint_as_float(w & 0xffff0000u); }
__device__ __forceinline__ unsigned short f2bf(float f) { return (unsigned short)(cvtpk(f, 0.f) & 0xffffu); }
__device__ __forceinline__ u32x4 pack8f(f32x4 a, f32x4 b) { u32x4 w; w.x = cvtpk(a[0], a[1]); w.y = cvtpk(a[2], a[3]); w.z = cvtpk(b[0], b[1]); w.w = cvtpk(b[2], b[3]); return w; }
__device__ __forceinline__ void unpack8(u32x4 w, f32x4& a, f32x4& b) { a[0] = bflo(w.x); a[1] = bfhi(w.x); a[2] = bflo(w.y); a[3] = bfhi(w.y); b[0] = bflo(w.z); b[1] = bfhi(w.z); b[2] = bflo(w.w); b[3] = bfhi(w.w); }
__device__ __forceinline__ float wave_sum(float v) {
#pragma unroll
    for (int o = 1; o < 64; o <<= 1) v += __shfl_xor(v, o);
    return v;
}
__device__ __forceinline__ float fast_rcp(float x) { return __builtin_amdgcn_rcpf(x); }
__device__ __forceinline__ float fast_exp2(float x) { return __builtin_amdgcn_exp2f(x); }
__device__ __forceinline__ void sincos_rev(double ang, float& s, float& c) {
    double rev = ang * 0.15915494309189535; rev -= __builtin_rint(rev);
    const float f = (float)rev; s = __builtin_amdgcn_sinf(f); c = __builtin_amdgcn_cosf(f);
}

#define XB_TMO      128
#define XB_XCNT(j)  (256  + 64 * (j))
#define XB_XSUB(j)  (1280 + 64 * (j))
#define XB_XGEN(j)  (2304 + 64 * (j))
#define XB_TOP      3328
#define XB_TOPGEN   3392
#define XCD_BAR_WORDS 3456
#define XB_SPIN_CAP (1u << 18)
__device__ __forceinline__ unsigned xb_ld(unsigned* p)              { return __hip_atomic_load(p, __ATOMIC_RELAXED, __HIP_MEMORY_SCOPE_AGENT); }
__device__ __forceinline__ unsigned xb_add(unsigned* p, unsigned v) { return __hip_atomic_fetch_add(p, v, __ATOMIC_RELAXED, __HIP_MEMORY_SCOPE_AGENT); }
__device__ __forceinline__ unsigned xb_xcc_id() { return (unsigned)__builtin_amdgcn_s_getreg((3 << 11) | 20) & 0xFu; }
#define XB_SPIN(cond, bar) do { unsigned _sp = 0; while (cond) { __builtin_amdgcn_s_sleep(1); \
    if ((++_sp & 255u) == 0u) { if (xb_ld(&(bar)[XB_TMO])) break; if (_sp > XB_SPIN_CAP) { atomicAdd(&(bar)[XB_TMO], 1u); break; } } } } while (0)
struct XcdBarrier { unsigned* bar; unsigned x; volatile LAS unsigned* st; };
__device__ __forceinline__ XcdBarrier xcd_barrier_post(unsigned* bar, volatile LAS unsigned* st) {
    XcdBarrier b; b.bar = bar; b.x = xb_xcc_id(); b.st = st;
    if (threadIdx.x == 0) (void)xb_add(&bar[XB_XCNT(b.x)], 1u);
    return b;
}
__device__ __forceinline__ void xcd_barrier_complete(unsigned* bar, unsigned x, unsigned& nloc, unsigned& nx) {
    const unsigned G = gridDim.x * gridDim.y * gridDim.z;
    unsigned sum, cnt, mine, sp = 0u;
    for (;;) {
        sum = 0u; cnt = 0u; mine = 0u;
#pragma unroll
        for (unsigned j = 0; j < 16; ++j) { const unsigned c = xb_ld(&bar[XB_XCNT(j)]); sum += c; cnt += (c > 0u) ? 1u : 0u; mine = (j == x) ? c : mine; }
        if (sum == G) break;
        __builtin_amdgcn_s_sleep(1);
        if ((++sp & 255u) == 0u) { if (xb_ld(&bar[XB_TMO])) break; if (sp > XB_SPIN_CAP) { atomicAdd(&bar[XB_TMO], 1u); break; } }
    }
    nloc = mine > 0u ? mine : 1u; nx = cnt > 0u ? cnt : 1u;
}
__device__ __forceinline__ void xcd_barrier(const XcdBarrier& b) {
    asm volatile("s_waitcnt vmcnt(0)" ::: "memory");
    __syncthreads();
    if (threadIdx.x == 0) {
        unsigned* bar = b.bar;
        __builtin_amdgcn_s_waitcnt(0);
        unsigned nloc = b.st[0], nx = b.st[1];
        if (nloc == 0u) { xcd_barrier_complete(bar, b.x, nloc, nx); b.st[0] = nloc; b.st[1] = nx; }
        const unsigned old = xb_add(&bar[XB_XSUB(b.x)], 1u);
        const unsigned gen = old / nloc;
        if (old + 1u == (gen + 1u) * nloc) {
            __builtin_amdgcn_fence(__ATOMIC_RELEASE, "agent");
            asm volatile("s_waitcnt vmcnt(0)" ::: "memory");
            const unsigned og = xb_add(&bar[XB_TOP], 1u);
            const unsigned tg = og / nx;
            if (og + 1u == (tg + 1u) * nx) xb_add(&bar[XB_TOPGEN], 1u);
            else XB_SPIN(xb_ld(&bar[XB_TOPGEN]) == tg, bar);
            __builtin_amdgcn_fence(__ATOMIC_ACQUIRE, "agent");
            xb_add(&bar[XB_XGEN(b.x)], 1u);
            asm volatile("s_waitcnt vmcnt(0)" ::: "memory");
        } else {
            XB_SPIN(xb_ld(&bar[XB_XGEN(b.x)]) == gen, bar);
            __builtin_amdgcn_fence(__ATOMIC_ACQUIRE, "agent");
            asm volatile("s_waitcnt vmcnt(0)" ::: "memory");
        }
    }
    __syncthreads();
}

struct Args { const void* in[33]; float* out; unsigned char* ws; int ph_lo, ph_hi; };
struct Ctx {
    LAS unsigned char* lds;
    int tid, lane, wid, G, vcu;
    const Args& a;
    unsigned char* ws;
};
template <class T> __device__ __forceinline__ T* wsp(const Ctx& c, size_t off) { return (T*)(c.ws + off); }
__device__ __forceinline__ const float* inp(const Ctx& c, int i) { return (const float*)c.a.in[i]; }
__device__ __forceinline__ const float* modp(const Ctx& c, int l, int b, int which) { return wsp<const float>(c, WS_MOD) + ((size_t)(l * NB + b) * 6 + which) * DM; }
namespace ge {
constexpr int BM = 256, BK = 64, HALF = 128, HTB = HALF * BK * 2, STAGE_BYTES = 8 * HTB;
__device__ __forceinline__ int lds_byte(int r, int c) { const int st = (r >> 4) * 2 + (c >> 5), rr = r & 15, cc = c & 31, ob = rr * 64 + cc * 2; return st * 1024 + (ob ^ (((ob >> 9) & 1) << 5)); }
__device__ __forceinline__ void stage_rc(int b, int& R, int& C) { const int st = b / 1024, sb = b % 1024, swz = sb ^ (((sb >> 9) & 1) << 5); R = (st >> 1) * 16 + swz / 64; C = (st & 1) * 32 + (swz % 64) / 2; }
__device__ __forceinline__ int perm32(int rho) { const int n = rho >> 4, i = rho & 15; return 8 * (i >> 2) + 4 * n + (i & 3); }

struct Ops { const char* a0; const char* a1; const char* b0; const char* b1; long ksA, ksB; int nt; };
struct Lane { int R[2], Rb[2], C[2]; };
struct Off { unsigned a[2][2]; unsigned b[2]; };
typedef f32x4 Acc[2][2][4][2];

template <class P>
__device__ __forceinline__ void run(LAS unsigned char* lds, const P& prog, const int tid) {
    const int wid = __builtin_amdgcn_readfirstlane(tid >> 6), lane = tid & 63, wr = wid >> 2, wc = wid & 3, fr = lane & 15, fq = lane >> 4;
#define GE_LANE(ln) Lane ln; { int t_ = tid; asm volatile("" : "+v"(t_)); _Pragma("unroll") for (int i = 0; i < 2; ++i) { stage_rc(t_ * 16 + i * 8192, ln.R[i], ln.C[i]); ln.Rb[i] = (ln.R[i] & ~31) + perm32(ln.R[i] & 31); } }
    const unsigned ldsw = (unsigned)wid * 1024u;
    const int aoff = lds_byte(wr * 64 + fr, fq * 8), boff = lds_byte(wc * 32 + fr, fq * 8);
#define GE_SA(b, h) (((b) * 2 + (h)) * HTB)
#define GE_SB(b, h) ((4 + (b) * 2 + (h)) * HTB)
#define GE_STAGE(bufoff, gbase, v0, v1) do { unsigned o0_ = (v0), o1_ = (v1); asm volatile("" : "+v"(o0_), "+v"(o1_)); \
        __builtin_amdgcn_global_load_lds((const unsigned*)((const char*)(gbase) + o0_), (LAS unsigned*)(lds + (bufoff) + ldsw), 16, 0, 0); \
        __builtin_amdgcn_global_load_lds((const unsigned*)((const char*)(gbase) + o1_), (LAS unsigned*)(lds + (bufoff) + ldsw + 8192), 16, 0, 0); } while (0)
#define GE_LDA(dst, b, h) do { _Pragma("unroll") for (int m = 0; m < 4; ++m) _Pragma("unroll") for (int k = 0; k < 2; ++k) dst[m][k] = *(const LAS bf16x8*)(lds + GE_SA(b, h) + aoff + m * 2048 + k * 1024); } while (0)
#define GE_LDB(dst, b, h) do { _Pragma("unroll") for (int n = 0; n < 2; ++n) _Pragma("unroll") for (int k = 0; k < 2; ++k) dst[n][k] = *(const LAS bf16x8*)(lds + GE_SB(b, h) + boff + n * 2048 + k * 1024); } while (0)
#define GE_MMA(ai, bj, At, Bt) do { __builtin_amdgcn_s_setprio(1); _Pragma("unroll") for (int m = 0; m < 4; ++m) _Pragma("unroll") for (int n = 0; n < 2; ++n) _Pragma("unroll") for (int k = 0; k < 2; ++k) \
        acc[ai][bj][m][n] = __builtin_amdgcn_mfma_f32_16x16x32_bf16(Bt[n][k], At[m][k], acc[ai][bj][m][n], 0, 0, 0); __builtin_amdgcn_s_setprio(0); } while (0)
#define GE_WAIT_V(n) asm volatile("s_waitcnt vmcnt(" #n ")" ::: "memory")
#define GE_WAIT_L(n) asm volatile("s_waitcnt lgkmcnt(" #n ")" ::: "memory")
#define GE_BAR __builtin_amdgcn_s_barrier()
#define GE_SCHED __builtin_amdgcn_sched_barrier(0)
    typename P::Unit cur, nxt; int ui = 0;
    if (!prog.next(0, cur)) return;
    Ops co, no; prog.ops(cur, co);
    Off v, nv; { GE_LANE(ln) prog.voff(cur, ln, v); }
    Acc acc;
#pragma unroll
    for (int a = 0; a < 2; ++a)
#pragma unroll
        for (int b = 0; b < 2; ++b)
#pragma unroll
            for (int m = 0; m < 4; ++m)
#pragma unroll
                for (int n = 0; n < 2; ++n) acc[a][b][m][n] = (f32x4){0.f, 0.f, 0.f, 0.f};
    bf16x8 At[4][2], B0[2][2], B1[2][2];
    GE_STAGE(GE_SB(0, 0), co.b0, v.b[0], v.b[1]); GE_STAGE(GE_SB(0, 1), co.b1, v.b[0], v.b[1]); GE_STAGE(GE_SA(0, 0), co.a0, v.a[0][0], v.a[0][1]); GE_STAGE(GE_SA(0, 1), co.a1, v.a[P::GATHER][0], v.a[P::GATHER][1]);
    if (wr == 1) GE_BAR;
    GE_WAIT_V(2); GE_BAR;
    GE_STAGE(GE_SB(1, 0), co.b0 + co.ksB, v.b[0], v.b[1]); GE_STAGE(GE_SA(1, 0), co.a0 + co.ksA, v.a[0][0], v.a[0][1]); GE_STAGE(GE_SB(1, 1), co.b1 + co.ksB, v.b[0], v.b[1]);
    GE_WAIT_V(6); GE_BAR;
    for (;;) {
        const bool has_next = prog.next(ui + 1, nxt);
        if (has_next) { prog.ops(nxt, no); if constexpr (P::VAR_OFF) { GE_LANE(ln) prog.voff(nxt, ln, nv); } } else { no = co; if constexpr (P::VAR_OFF) nv = v; }
        const int nt = co.nt;
        for (int t = 0; t < nt; t += 2) {
            const bool last = (t == nt - 2);
            const char* a1h1 = co.a1 + (long)(t + 1) * co.ksA;
            const char* a2h0 = last ? no.a0 : co.a0 + (long)(t + 2) * co.ksA; const char* a2h1 = last ? no.a1 : co.a1 + (long)(t + 2) * co.ksA;
            const char* b2h0 = last ? no.b0 : co.b0 + (long)(t + 2) * co.ksB; const char* b2h1 = last ? no.b1 : co.b1 + (long)(t + 2) * co.ksB;
            const long ks2A = last ? no.ksA : co.ksA, ks2B = last ? no.ksB : co.ksB;
            const char* a3h0 = a2h0 + ks2A; const char* b3h0 = b2h0 + ks2B; const char* b3h1 = b2h1 + ks2B;
            unsigned wa00 = v.a[0][0], wa01 = v.a[0][1], wa10 = v.a[P::GATHER][0], wa11 = v.a[P::GATHER][1], wb0 = v.b[0], wb1 = v.b[1];
            if constexpr (P::VAR_OFF) { if (last) { wa00 = nv.a[0][0]; wa01 = nv.a[0][1]; wa10 = nv.a[P::GATHER][0]; wa11 = nv.a[P::GATHER][1]; wb0 = nv.b[0]; wb1 = nv.b[1]; } }
            GE_LDB(B0, 0, 0); GE_LDB(B1, 0, 1); GE_SCHED; GE_LDA(At, 0, 0); GE_STAGE(GE_SA(1, 1), a1h1, v.a[P::GATHER][0], v.a[P::GATHER][1]);
            GE_WAIT_V(8); GE_WAIT_L(0); GE_BAR; GE_MMA(0, 0, At, B0); GE_MMA(0, 1, At, B1); GE_BAR; GE_SCHED;
            GE_LDA(At, 0, 1); GE_STAGE(GE_SB(0, 0), b2h0, wb0, wb1); GE_STAGE(GE_SB(0, 1), b2h1, wb0, wb1); GE_STAGE(GE_SA(0, 0), a2h0, wa00, wa01);
            GE_WAIT_V(8); GE_WAIT_L(0); GE_BAR; GE_MMA(1, 0, At, B0); GE_MMA(1, 1, At, B1); GE_BAR; GE_SCHED;
            GE_LDB(B0, 1, 0); GE_LDB(B1, 1, 1); GE_SCHED; GE_LDA(At, 1, 0); GE_STAGE(GE_SA(0, 1), a2h1, wa10, wa11);
            GE_WAIT_V(8); GE_WAIT_L(0); GE_BAR; GE_MMA(0, 0, At, B0); GE_MMA(0, 1, At, B1); GE_BAR; GE_SCHED;
            GE_LDA(At, 1, 1); GE_STAGE(GE_SB(1, 0), b3h0, wb0, wb1); GE_STAGE(GE_SB(1, 1), b3h1, wb0, wb1); GE_STAGE(GE_SA(1, 0), a3h0, wa00, wa01);
            GE_WAIT_V(8); GE_WAIT_L(0); GE_BAR; GE_MMA(1, 0, At, B0); GE_MMA(1, 1, At, B1); GE_BAR; GE_SCHED;
        }
        if (wr == 0) GE_BAR;
        prog.epi(acc, cur, wr, wc, fr, fq);
        if (!has_next) break;
#pragma unroll
        for (int a = 0; a < 2; ++a)
#pragma unroll
            for (int b = 0; b < 2; ++b)
#pragma unroll
                for (int m = 0; m < 4; ++m)
#pragma unroll
                    for (int n = 0; n < 2; ++n) acc[a][b][m][n] = (f32x4){0.f, 0.f, 0.f, 0.f};
        cur = nxt; co = no; if constexpr (P::VAR_OFF) v = nv; ++ui;
        if (wr == 1) GE_BAR;
    }
    GE_WAIT_V(0);
    GE_BAR;
#undef GE_LANE
#undef GE_SA
#undef GE_SB
#undef GE_STAGE
#undef GE_LDA
#undef GE_LDB
#undef GE_MMA
#undef GE_WAIT_V
#undef GE_WAIT_L
#undef GE_BAR
#undef GE_SCHED
}
__device__ __forceinline__ void off_rm(const Lane& ln, int lda, int ldb, Off& v) {
#pragma unroll
    for (int i = 0; i < 2; ++i) { v.a[0][i] = (unsigned)(ln.R[i] * lda + ln.C[i]) * 2u; v.b[i] = (unsigned)(ln.Rb[i] * ldb + ln.C[i]) * 2u; }
}
}
struct StaticOrder {
    int nM, nN, nwg, G, c;
    __device__ void init(int M, int N, int G_, int c_) { nM = M / 256; nN = N / 256; nwg = nM * nN; G = G_; c = c_; }
    __device__ __forceinline__ bool next(int i, int& pm, int& pn) const {
        const long L = (long)i * G + c; if (L >= nwg) return false;
        int wgid = (int)L; { const int q = nwg / 8, r = nwg % 8, xcd = wgid % 8, off = wgid / 8; wgid = (xcd < r ? xcd * (q + 1) : r * (q + 1) + (xcd - r) * q) + off; }
        const int nig = 8 * nN, gid = wgid / nig, fm = gid * 8, gsz = (nM - fm) < 8 ? (nM - fm) : 8;
        pm = fm + ((wgid % nig) % gsz); pn = (wgid % nig) / gsz; return true;
    }
};
#define EPI_ROWS_BEGIN _Pragma("unroll") for (int ai = 0; ai < 2; ++ai) _Pragma("unroll") for (int m = 0; m < 4; ++m) { const int rt = 128 * ai + 64 * wr + 16 * m + fr;
#define EPI_ROWS_END asm volatile("" ::: "memory"); }
__device__ __forceinline__ float gelu_tanh(float y) {
    const float u = 0.7978845608028654f * (y + 0.044715f * y * y * y);
    const float e = fast_exp2(u * 2.8853900817779268f);
    const float th = 1.f - 2.f * fast_rcp(1.f + e);
    return 0.5f * y * (1.f + th);
}
__device__ __forceinline__ float sigmoidf_(float x) { return fast_rcp(1.f + fast_exp2(-1.4426950408889634f * x)); }

struct ProgG1 {
    static constexpr int VAR_OFF = 0, GATHER = 0;
    struct Unit { int pm, pn; };
    StaticOrder so; const char* A; const char* B; bf16_t* Z; bf16_t* U; float* ssq_q; float* ssq_kv;
    __device__ __forceinline__ bool next(int i, Unit& u) const { return so.next(i, u.pm, u.pn); }
    __device__ __forceinline__ void ops(const Unit& u, ge::Ops& o) const {
        o.a0 = A + (size_t)u.pm * 256 * DM * 2; o.a1 = o.a0 + (size_t)128 * DM * 2; o.b0 = B + (size_t)u.pn * 256 * DM * 2; o.b1 = o.b0 + (size_t)128 * DM * 2; o.ksA = 128; o.ksB = 128; o.nt = DM / 64; }
    __device__ __forceinline__ void voff(const Unit&, const ge::Lane& ln, ge::Off& v) const { ge::off_rm(ln, DM, DM, v); }
    __device__ __forceinline__ void epi(const ge::Acc& acc, const Unit& u, int wr, int wc, int fr, int fq) const {
        const int pn = u.pn; const int cl = 32 * wc + 8 * fq;
        EPI_ROWS_BEGIN
            const int row = u.pm * 256 + rt;
            float ss = 0.f;
#pragma unroll
            for (int bj = 0; bj < 2; ++bj) {
                const f32x4 v0 = acc[ai][bj][m][0], v1 = acc[ai][bj][m][1]; const int c = 128 * bj + cl;
                const u32x4 w = pack8f(v0, v1);
                ss += (v0[0] * v0[0] + v0[1] * v0[1]) + (v0[2] * v0[2] + v0[3] * v0[3]) + (v1[0] * v1[0] + v1[1] * v1[1]) + (v1[2] * v1[2] + v1[3] * v1[3]);
                if (pn < 2) *(u32x4*)(Z + (size_t)row * ZLD + Z_POOL + 256 * pn + c) = w;
                else if (pn < 4) { const int ch = 256 * (pn - 2) + c; *(u32x4*)(U + ((size_t)(ch >> 4) * NTOK + row) * 16 + (ch & 15)) = w; }
                else if (pn < 6) *(u32x4*)(Z + (size_t)row * ZLD + Z_QC + 256 * (pn - 4) + c) = w;
                else if (pn == 6) *(u32x4*)(Z + (size_t)row * ZLD + Z_KVC + c) = w;
                else if (c < 64) *(u32x4*)(Z + (size_t)row * ZLD + Z_KPE + c) = w;
            }
            if (pn >= 4 && pn <= 6) { ss += __shfl_xor(ss, 16); ss += __shfl_xor(ss, 32); if (fq == 0) atomicAdd((pn == 6 ? ssq_kv : ssq_q) + row, ss); }
        EPI_ROWS_END
    }
};

struct ProgG2 {
    static constexpr int VAR_OFF = 1, GATHER = 0;
    struct Unit { int type, pm, pn, g; };
    int G, c;
    const char* Z; const char* U; const char* WUQ; const char* WUKV; const char* WPOOL; const char* SSMTAB;
    const float* ssq_q; const float* ssq_kv; const f32x2* CS;
    bf16_t* Q; bf16_t* K; bf16_t* V; bf16_t* P; bf16_t* YI; float* EBUF;
    static constexpr int N_SSM = 320, N_Q = 768, N_KV = 1024, N_POOL = 256, N_ALL = N_SSM + N_Q + N_KV + N_POOL;
    __device__ __forceinline__ bool next(int i, Unit& u) const {
        int L = i * G + c; if (L >= N_ALL) return false;
        if (L < N_SSM) { u.type = 0; u.pn = 4 - (L >> 6); const int r = L & 63; u.g = r >> 1; u.pm = r & 1; return true; } L -= N_SSM;
        if (L < N_Q) { u.type = 1; u.pm = L / 6; u.pn = L % 6; u.g = 0; return true; } L -= N_Q;
        if (L < N_KV) { u.type = 2; u.pm = L >> 3; u.pn = L & 7; u.g = 0; return true; } L -= N_KV;
        u.type = 3; u.pm = L >> 1; u.pn = L & 1; u.g = 0; return true;
    }
    __device__ __forceinline__ void ops(const Unit& u, ge::Ops& o) const {
        if (u.type == 0) {
            o.a0 = U + ((size_t)u.g * NTOK * 16 + (size_t)u.pm * 256 * 1024) * 2; o.a1 = o.a0 + (size_t)128 * 1024 * 2; o.ksA = 128;
            const char* tab = SSMTAB + (size_t)u.g * SSMTAB_STRIDE;
            if (u.pn < 4) { o.b0 = tab + SSM_TG + (size_t)(16 * u.pn + 60) * 512; o.b1 = o.b0 + 8 * 512; o.ksB = -2048; o.nt = 4 * (u.pn + 1); }
            else { o.b0 = tab + SSM_TEND; o.b1 = o.b0; o.ksB = 16384; o.nt = 16; }
        } else if (u.type == 1) {
            o.a0 = Z + ((size_t)u.pm * 256 * ZLD + Z_QC) * 2; o.a1 = o.a0 + (size_t)128 * ZLD * 2; o.ksA = 128;
            o.b0 = WUQ + (size_t)u.pn * 256 * 512 * 2; o.b1 = o.b0 + (size_t)128 * 512 * 2; o.ksB = 128; o.nt = 8;
        } else if (u.type == 2) {
            o.a0 = Z + ((size_t)u.pm * 256 * ZLD + Z_KVC) * 2; o.a1 = o.a0 + (size_t)128 * ZLD * 2; o.ksA = 128;
            o.b0 = WUKV + (size_t)u.pn * 256 * 256 * 2; o.b1 = o.b0 + (size_t)128 * 256 * 2; o.ksB = 128; o.nt = 4;
        } else {
            o.a0 = Z + ((size_t)u.pm * 256 * ZLD + Z_POOL + 256 * u.pn) * 2; o.a1 = o.a0 + (size_t)128 * ZLD * 2; o.ksA = 128;
            o.b0 = WPOOL + (size_t)u.pn * 256 * 256 * 2; o.b1 = o.b0 + (size_t)128 * 256 * 2; o.ksB = 128; o.nt = 4;
        }
    }
    __device__ __forceinline__ void voff(const Unit& u, const ge::Lane& ln, ge::Off& v) const {
#pragma unroll
        for (int i = 0; i < 2; ++i) {
            const int R = ln.R[i], Rb = ln.Rb[i], C = ln.C[i]; unsigned a, b;
            if (u.type == 0) {
                a = (unsigned)(R * 1024 + C) * 2u;
                if (u.pn < 4) b = (unsigned)(((Rb >> 4) - (C >> 4) + 3) * 256 + (Rb & 15) * 16 + (C & 15)) * 2u;
                else b = (unsigned)((((C >> 4) * 128 + Rb) * 16) + (C & 15)) * 2u;
            } else if (u.type == 1) { a = (unsigned)(R * ZLD + C) * 2u; b = (unsigned)(Rb * 512 + C) * 2u; }
            else { a = (unsigned)(R * ZLD + C) * 2u; b = (unsigned)(Rb * 256 + C) * 2u; }
            v.a[0][i] = a; v.b[i] = b;
        }
    }
    __device__ __forceinline__ void epi(const ge::Acc& acc, const Unit& u, int wr, int wc, int fr, int fq) const {
        const int cl = 32 * wc + 8 * fq;
        if (u.type == 0) {
            EPI_ROWS_BEGIN
                const int cg = u.pm * 256 + rt;
                if (u.pn < 4) {
#pragma unroll
                    for (int bj = 0; bj < 2; ++bj) { const int n = 128 * bj + cl, t = 16 * u.pn + (n >> 4), h0 = n & 15;
                        *(u32x4*)(YI + ((size_t)cg * 64 + t) * 512 + u.g * 16 + h0) = pack8f(acc[ai][bj][m][0], acc[ai][bj][m][1]); }
                } else {
                    float* e = EBUF + ((size_t)cg * SSM_G + u.g) * 128 + cl;
                    *(f32x4*)e = acc[ai][0][m][0]; *(f32x4*)(e + 4) = acc[ai][0][m][1];
                }
            EPI_ROWS_END
        } else if (u.type == 1) {
            constexpr float QSCALE = 0.07216878364870322f * 1.4426950408889634f;
            EPI_ROWS_BEGIN
                const int row = u.pm * 256 + rt; const int b = row >> 14, t = row & (SEQ - 1);
                const float rs = rsqrtf(ssq_q[row] * (1.f / 512.f) + EPS) * QSCALE;
#pragma unroll
                for (int bj = 0; bj < 2; ++bj) {
                    const int c = 256 * u.pn + 128 * bj + cl; const int head = c / QKD, d = c - head * QKD;
                    f32x4 v0 = acc[ai][bj][m][0] * rs, v1 = acc[ai][bj][m][1] * rs;
                    if (d >= 128) {
                        const f32x2* cs = CS + (size_t)row * 32 + ((d - 128) >> 1);
                        const f32x4 c01 = *(const f32x4*)cs, c23 = *(const f32x4*)(cs + 2);
                        f32x4 o0, o1;
                        o0[0] = v0[0] * c01[0] - v0[1] * c01[1]; o0[1] = v0[1] * c01[0] + v0[0] * c01[1];
                        o0[2] = v0[2] * c01[2] - v0[3] * c01[3]; o0[3] = v0[3] * c01[2] + v0[2] * c01[3];
                        o1[0] = v1[0] * c23[0] - v1[1] * c23[1]; o1[1] = v1[1] * c23[0] + v1[0] * c23[1];
                        o1[2] = v1[2] * c23[2] - v1[3] * c23[3]; o1[3] = v1[3] * c23[2] + v1[2] * c23[3];
                        v0 = o0; v1 = o1;
                    }
                    *(u32x4*)(Q + ((size_t)(b * NHEAD + head) * SEQ + t) * QKD + d) = pack8f(v0, v1);
                }
            EPI_ROWS_END
        } else if (u.type == 2) {
            EPI_ROWS_BEGIN
                const int row = u.pm * 256 + rt; const int b = row >> 14, t = row & (SEQ - 1);
                const float rs = rsqrtf(ssq_kv[row] * (1.f / 256.f) + EPS);
#pragma unroll
                for (int bj = 0; bj < 2; ++bj) {
                    const int d = 128 * bj + cl; const int head = u.pn;
                    const u32x4 w = pack8f(acc[ai][bj][m][0] * rs, acc[ai][bj][m][1] * rs);
                    if (d < 128) *(u32x4*)(K + ((size_t)(b * NHEAD + head) * SEQ + t) * QKD + d) = w;
                    else *(u32x4*)(V + ((size_t)(b * NHEAD + head) * SEQ + t) * VD + (d - 128)) = w;
                }
            EPI_ROWS_END
        } else {
            EPI_ROWS_BEGIN
                const int row = u.pm * 256 + rt;
#pragma unroll
                for (int bj = 0; bj < 2; ++bj) *(u32x4*)(P + (size_t)row * 512 + 256 * u.pn + 128 * bj + cl) = pack8f(acc[ai][bj][m][0], acc[ai][bj][m][1]);
            EPI_ROWS_END
        }
    }
};

struct ProgS1 {
    static constexpr int VAR_OFF = 0, GATHER = 0;
    struct Unit { int g, pm, pn; };
    int G, c; const char* SPREV; const char* SSMTAB; const bf16_t* YI; const bf16_t* U; const float* Dskip; bf16_t* YG;
    __device__ __forceinline__ bool next(int i, Unit& u) const { const int L = i * G + c; if (L >= 256) return false; u.g = L >> 3; u.pm = (L >> 2) & 1; u.pn = L & 3; return true; }
    __device__ __forceinline__ void ops(const Unit& u, ge::Ops& o) const {
        o.a0 = SPREV + ((size_t)u.pm * 256 * (SSM_G * 256) + u.g * 256) * 2; o.a1 = o.a0 + (size_t)128 * (SSM_G * 256) * 2; o.ksA = 128;
        o.b0 = SSMTAB + (size_t)u.g * SSMTAB_STRIDE + SSM_WC + (size_t)u.pn * 256 * 256 * 2; o.b1 = o.b0 + (size_t)128 * 256 * 2; o.ksB = 128; o.nt = 4; }
    __device__ __forceinline__ void voff(const Unit&, const ge::Lane& ln, ge::Off& v) const { ge::off_rm(ln, SSM_G * 256, 256, v); }
    __device__ __forceinline__ void epi(const ge::Acc& acc, const Unit& u, int wr, int wc, int fr, int fq) const {
        const int cl = 32 * wc + 8 * fq;
        EPI_ROWS_BEGIN
            const int cg = u.pm * 256 + rt;
#pragma unroll
            for (int bj = 0; bj < 2; ++bj) {
                const int n = 128 * bj + cl, t = 16 * u.pn + (n >> 4), h0 = n & 15; const size_t tok = (size_t)cg * 64 + t; const int ch = u.g * 16 + h0;
                f32x4 yi0, yi1, u0, u1; unpack8(*(const u32x4*)(YI + tok * 512 + ch), yi0, yi1); unpack8(*(const u32x4*)(U + ((size_t)u.g * NTOK + tok) * 16 + h0), u0, u1);
                const f32x4 d0 = *(const f32x4*)(Dskip + ch), d1 = *(const f32x4*)(Dskip + ch + 4);
                f32x4 y0 = acc[ai][bj][m][0] + yi0 + d0 * u0, y1 = acc[ai][bj][m][1] + yi1 + d1 * u1;
#pragma unroll
                for (int e = 0; e < 4; ++e) { y0[e] = gelu_tanh(y0[e]); y1[e] = gelu_tanh(y1[e]); }
                *(u32x4*)(YG + tok * 512 + ch) = pack8f(y0, y1);
            }
        EPI_ROWS_END
    }
};

struct ProgS2 {
    static constexpr int VAR_OFF = 0, GATHER = 0;
    struct Unit { int pm, pn; };
    int G, c; const char* YGc; const char* W; const bf16_t* YG; bf16_t* GL;
    __device__ __forceinline__ bool next(int i, Unit& u) const { const int L = i * G + c; if (L >= 256) return false; u.pm = L >> 1; u.pn = L & 1; return true; }
    __device__ __forceinline__ void ops(const Unit& u, ge::Ops& o) const {
        o.a0 = YGc + (size_t)u.pm * 256 * 512 * 2; o.a1 = o.a0 + (size_t)128 * 512 * 2; o.ksA = 128; o.b0 = W + (size_t)u.pn * 256 * 512 * 2; o.b1 = o.b0 + (size_t)128 * 512 * 2; o.ksB = 128; o.nt = 8; }
    __device__ __forceinline__ void voff(const Unit&, const ge::Lane& ln, ge::Off& v) const { ge::off_rm(ln, 512, 512, v); }
    __device__ __forceinline__ void epi(const ge::Acc& acc, const Unit& u, int wr, int wc, int fr, int fq) const {
        const int cl = 32 * wc + 8 * fq;
        EPI_ROWS_BEGIN
            const size_t row = (size_t)u.pm * 256 + rt;
#pragma unroll
            for (int bj = 0; bj < 2; ++bj) {
                const int c = 256 * u.pn + 128 * bj + cl; f32x4 y0, y1; unpack8(*(const u32x4*)(YG + row * 512 + c), y0, y1);
                f32x4 a0 = acc[ai][bj][m][0], a1 = acc[ai][bj][m][1];
#pragma unroll
                for (int e = 0; e < 4; ++e) { y0[e] *= sigmoidf_(a0[e]); y1[e] *= sigmoidf_(a1[e]); }
                *(u32x4*)(GL + row * 512 + c) = pack8f(y0, y1);
            }
        EPI_ROWS_END
    }
};

struct ProgG3 {
    static constexpr int VAR_OFF = 0, GATHER = 0;
    struct Unit { int pm, pn; };
    StaticOrder so; const char* A; const char* B; const float* xin; float* xout; const float* ga;
    __device__ __forceinline__ bool next(int i, Unit& u) const { return so.next(i, u.pm, u.pn); }
    __device__ __forceinline__ void ops(const Unit& u, ge::Ops& o) const {
        o.a0 = A + (size_t)u.pm * 256 * DM * 2; o.a1 = o.a0 + (size_t)128 * DM * 2; o.b0 = B + (size_t)u.pn * 256 * DM * 2; o.b1 = o.b0 + (size_t)128 * DM * 2; o.ksA = 128; o.ksB = 128; o.nt = DM / 64; }
    __device__ __forceinline__ void voff(const Unit&, const ge::Lane& ln, ge::Off& v) const { ge::off_rm(ln, DM, DM, v); }
    __device__ __forceinline__ void epi(const ge::Acc& acc, const Unit& u, int wr, int wc, int fr, int fq) const {
        const int cl = 32 * wc + 8 * fq; const int b = (u.pm * 256) >> 14;
        f32x4 g[2][2];
#pragma unroll
        for (int bj = 0; bj < 2; ++bj) { const float* gp = ga + (size_t)b * 6 * DM + 256 * u.pn + 128 * bj + cl; g[bj][0] = *(const f32x4*)gp; g[bj][1] = *(const f32x4*)(gp + 4); }
        EPI_ROWS_BEGIN
            const size_t row = (size_t)u.pm * 256 + rt;
#pragma unroll
            for (int bj = 0; bj < 2; ++bj) {
                const size_t o = row * DM + 256 * u.pn + 128 * bj + cl;
                const f32x4 x0 = *(const f32x4*)(xin + o), x1 = *(const f32x4*)(xin + o + 4);
                *(f32x4*)(xout + o) = x0 + g[bj][0] * acc[ai][bj][m][0]; *(f32x4*)(xout + o + 4) = x1 + g[bj][1] * acc[ai][bj][m][1];
            }
        EPI_ROWS_END
    }
};

struct ProgM1 {
    static constexpr int VAR_OFF = 1, GATHER = 1;
    struct Unit { int k, pn, e, j; };
    int G, c; const LAS int* tab; int ntiles; const int* cnt; const int* toks; const char* H; const char* W13; bf16_t* ACT;
    __device__ __forceinline__ bool next(int i, Unit& u) const { const int L = i * G + c; if (L >= ntiles * 4) return false; u.k = L >> 2; u.pn = L & 3; const int w = __builtin_amdgcn_readfirstlane(tab[u.k]); u.e = w >> 16; u.j = w & 0xffff; return true; }
    __device__ __forceinline__ void ops(const Unit& u, ge::Ops& o) const {
        o.a0 = H; o.a1 = H; o.ksA = 128; o.b0 = W13 + ((size_t)u.e * 1024 + 128 * u.pn) * DM * 2; o.b1 = o.b0 + (size_t)512 * DM * 2; o.ksB = 128; o.nt = DM / 64; }
    __device__ __forceinline__ void voff(const Unit& u, const ge::Lane& ln, ge::Off& v) const {
        const int n = __builtin_amdgcn_readfirstlane(cnt[u.e * 64]); const int* tl = toks + (size_t)u.e * NTOK + u.j * 256;
#pragma unroll
        for (int i = 0; i < 2; ++i) {
#pragma unroll
            for (int h = 0; h < 2; ++h) { const int r = 128 * h + ln.R[i]; const int tok = (u.j * 256 + r < n) ? tl[r] : 0; v.a[h][i] = (unsigned)(tok * DM + ln.C[i]) * 2u; }
            v.b[i] = (unsigned)(ln.Rb[i] * DM + ln.C[i]) * 2u;
        }
    }
    __device__ __forceinline__ void epi(const ge::Acc& acc, const Unit& u, int wr, int wc, int fr, int fq) const {
        const int cl = 32 * wc + 8 * fq;
        EPI_ROWS_BEGIN
            const size_t pos = (size_t)u.k * 256 + rt;
            f32x4 g0 = acc[ai][0][m][0], g1 = acc[ai][0][m][1]; const f32x4 u0 = acc[ai][1][m][0], u1 = acc[ai][1][m][1];
#pragma unroll
            for (int e = 0; e < 4; ++e) { g0[e] = g0[e] * sigmoidf_(g0[e]) * u0[e]; g1[e] = g1[e] * sigmoidf_(g1[e]) * u1[e]; }
            *(u32x4*)(ACT + pos * DEXP + 128 * u.pn + cl) = pack8f(g0, g1);
        EPI_ROWS_END
    }
};
struct ProgM2 {
    static constexpr int VAR_OFF = 0, GATHER = 0;
    struct Unit { int k, pn, e; };
    int G, c; const LAS int* tab; int ntiles; const char* ACT; const char* W2; bf16_t* Y2;
    __device__ __forceinline__ bool next(int i, Unit& u) const { const int L = i * G + c; if (L >= ntiles * 8) return false; u.k = L >> 3; u.pn = L & 7; u.e = __builtin_amdgcn_readfirstlane(tab[u.k]) >> 16; return true; }
    __device__ __forceinline__ void ops(const Unit& u, ge::Ops& o) const {
        o.a0 = ACT + (size_t)u.k * 256 * DEXP * 2; o.a1 = o.a0 + (size_t)128 * DEXP * 2; o.ksA = 128; o.b0 = W2 + ((size_t)u.e * DM + 256 * u.pn) * DEXP * 2; o.b1 = o.b0 + (size_t)128 * DEXP * 2; o.ksB = 128; o.nt = DEXP / 64; }
    __device__ __forceinline__ void voff(const Unit&, const ge::Lane& ln, ge::Off& v) const { ge::off_rm(ln, DEXP, DEXP, v); }
    __device__ __forceinline__ void epi(const ge::Acc& acc, const Unit& u, int wr, int wc, int fr, int fq) const {
        const int cl = 32 * wc + 8 * fq;
        EPI_ROWS_BEGIN
            const size_t pos = (size_t)u.k * 256 + rt;
#pragma unroll
            for (int bj = 0; bj < 2; ++bj) *(u32x4*)(Y2 + pos * DM + 256 * u.pn + 128 * bj + cl) = pack8f(acc[ai][bj][m][0], acc[ai][bj][m][1]);
        EPI_ROWS_END
    }
};
__device__ __forceinline__ int build_tile_table(const Ctx& c, const int* cnt) {
    LAS int* tab = (LAS int*)(c.lds + LDS_TILETAB); LAS int* ps = (LAS int*)(c.lds + LDS_PSTART);
    __syncthreads();
    if (c.tid < NEXP) {
        int before = 0, mine = 0;
        for (int e = 0; e < NEXP; ++e) { const int nt = (cnt[e * 64] + 255) >> 8; if (e < c.tid) before += nt; if (e == c.tid) mine = nt; }
        ps[c.tid] = before * 256;
        for (int j = 0; j < mine; ++j) tab[before + j] = (c.tid << 16) | j;
        if (c.tid == NEXP - 1) ps[NEXP] = before + mine;
    }
    __syncthreads();
    return ps[NEXP];
}
template <class F>
__device__ __forceinline__ void tr_item(const float* W, int ldw, int k0, int n0, const float* ksc, LAS float* scr, int lane, F dst) {
#pragma unroll 8
    for (int i = 0; i < 32; ++i) { const int kk = 2 * i + (lane >> 5); float v = W[(size_t)(k0 + kk) * ldw + n0 + (lane & 31)]; if (ksc) v *= ksc[k0 + kk]; scr[kk * 33 + (lane & 31)] = v; }
    LDS_WAIT(); asm volatile("" ::: "memory");
    const int cc = lane & 7;
#pragma unroll
    for (int j = 0; j < 4; ++j) { const int n = (lane >> 3) + 8 * j; const LAS float* s = scr + (8 * cc) * 33 + n;
        u32x4 o; o.x = cvtpk(s[0 * 33], s[1 * 33]); o.y = cvtpk(s[2 * 33], s[3 * 33]); o.z = cvtpk(s[4 * 33], s[5 * 33]); o.w = cvtpk(s[6 * 33], s[7 * 33]);
        bf16_t* d = dst(n0 + n); if (d) *(u32x4*)(d + k0 + 8 * cc) = o; }
    LDS_WAIT(); asm volatile("" ::: "memory");
}
__device__ __forceinline__ int rope_perm(int j) { return 2 * (j & 31) + (j >> 5); }

__device__ __forceinline__ void convert_experts(const Ctx& c, int l) {
    LAS float* scr = (LAS float*)(c.lds + c.wid * 16384);
    const int gw = c.vcu * 8 + c.wid, NGW = c.G * 8;
    const float* wg = inp(c, 29) + (size_t)l * NEXP * DM * DEXP; const float* wu = inp(c, 30) + (size_t)l * NEXP * DM * DEXP; const float* wd = inp(c, 31) + (size_t)l * NEXP * DEXP * DM;
    bf16_t* W13 = wsp<bf16_t>(c, WS_W13); bf16_t* W2 = wsp<bf16_t>(c, WS_W2);
    for (int it = gw; it < NEXP * 1536; it += NGW) {
        const int e = it / 1536, r = it % 1536;
        if (r < 1024) { const int up = r >> 9, q = r & 511, kb = q >> 4, nb = q & 15; const float* W = (up ? wu : wg) + (size_t)e * DM * DEXP; bf16_t* D = W13 + ((size_t)e * 1024 + up * 512) * DM;
            tr_item(W, DEXP, kb * 64, nb * 32, nullptr, scr, c.lane, [=](int n) { return D + (size_t)n * DM; }); }
        else { const int q = r - 1024, kb = q >> 6, nb = q & 63; const float* W = wd + (size_t)e * DEXP * DM; bf16_t* D = W2 + (size_t)e * DM * DEXP;
            tr_item(W, DM, kb * 64, nb * 32, nullptr, scr, c.lane, [=](int n) { return D + (size_t)n * DEXP; }); }
    }
}

__device__ __forceinline__ void p0_prologue(const Ctx& c) {
    const int gw = c.vcu * 8 + c.wid, NGW = c.G * 8; const int gt = c.vcu * 512 + c.tid, NGT = c.G * 512;
    {
        LAS float* red = (LAS float*)c.lds;
        const float* cv = inp(c, 1);
        for (int item = c.vcu; item < 96; item += c.G) {
            const int l = item / 48, cb = item % 48;
            const float* w = inp(c, 3) + ((size_t)l * DM + 256 * c.wid) * (6 * DM) + cb * 256 + c.lane * 4;
            f32x4 a0 = {0.f, 0.f, 0.f, 0.f}, a1 = {0.f, 0.f, 0.f, 0.f};
#pragma unroll 8
            for (int k = 0; k < 256; ++k) { const f32x4 wv = *(const f32x4*)(w + (size_t)k * (6 * DM)); const float c0 = cv[256 * c.wid + k], c1 = cv[DM + 256 * c.wid + k]; a0 += wv * c0; a1 += wv * c1; }
            *(LAS f32x4*)(red + (c.wid * 2 + 0) * 256 + c.lane * 4) = a0; *(LAS f32x4*)(red + (c.wid * 2 + 1) * 256 + c.lane * 4) = a1;
            __syncthreads();
            { const int b = c.tid >> 8, col = c.tid & 255; float s = inp(c, 4)[(size_t)l * 6 * DM + cb * 256 + col];
#pragma unroll
              for (int w8 = 0; w8 < 8; ++w8) s += red[(w8 * 2 + b) * 256 + col];
              wsp<float>(c, WS_MOD)[((size_t)(l * NB + b) * 6) * DM + cb * 256 + col] = s; }
            __syncthreads();
        }
    }
    {
        LAS float* scr = (LAS float*)(c.lds + c.wid * 16384);
        constexpr int I_IN = 32 * 58, I_UQ = 8 * 48, I_UKV = 4 * 64, I_OUT = 32 * 64, I_GLU = 8 * 16, I_L = I_IN + I_UQ + I_UKV + I_OUT + I_GLU;
        for (int it = gw; it < 2 * I_L; it += NGW) {
            const int l = it / I_L; int r = it % I_L;
            if (r < I_IN) { const int kb = r / 58, nb = r % 58; bf16_t* D = wsp<bf16_t>(c, WS_WIN) + (size_t)l * DM * DM;
                tr_item(inp(c, 6) + (size_t)l * DM * IN_COLS, IN_COLS, kb * 64, nb * 32, nullptr, scr, c.lane, [=](int n) { const int dr = n < 1792 ? n : 1792 + rope_perm(n - 1792); return D + (size_t)dr * DM; }); continue; } r -= I_IN;
            if (r < I_UQ) { const int kb = r / 48, nb = r % 48; bf16_t* D = wsp<bf16_t>(c, WS_WUQ) + (size_t)l * 1536 * 512;
                tr_item(inp(c, 20) + (size_t)l * 512 * 1536, 1536, kb * 64, nb * 32, inp(c, 18) + l * 512, scr, c.lane, [=](int n) { const int h = n / QKD, d = n % QKD; const int dr = h * QKD + (d < 128 ? d : 128 + rope_perm(d - 128)); return D + (size_t)dr * 512; }); continue; } r -= I_UQ;
            if (r < I_UKV) { const int kb = r / 64, nb = r % 64; bf16_t* D = wsp<bf16_t>(c, WS_WUKV) + (size_t)l * 2048 * 256;
                tr_item(inp(c, 21) + (size_t)l * 256 * 2048, 2048, kb * 64, nb * 32, inp(c, 19) + l * 256, scr, c.lane, [=](int n) { return D + (size_t)n * 256; }); continue; } r -= I_UKV;
            if (r < I_OUT) { const int kb = r / 64, nb = r % 64; bf16_t* D = wsp<bf16_t>(c, WS_WOUT) + (size_t)l * DM * DM;
                tr_item(inp(c, 23) + (size_t)l * DM * DM, DM, kb * 64, nb * 32, inp(c, 22) + l * DM, scr, c.lane, [=](int n) { return D + (size_t)n * DM; }); continue; } r -= I_OUT;
            { const int kb = r / 16, nb = r % 16; bf16_t* D = wsp<bf16_t>(c, WS_WGLU) + (size_t)l * 512 * 512;
                tr_item(inp(c, 17) + (size_t)l * 512 * 512, 512, kb * 64, nb * 32, nullptr, scr, c.lane, [=](int n) { return D + (size_t)n * 512; }); }
        }
    }
    convert_experts(c, 0);
    for (int i = gt; i < 2 * 2 * 256 * 256; i += NGT) {
        const int k = i & 255, n = (i >> 8) & 255, pn = (i >> 16) & 1, l = i >> 17; float v = 0.f;
        if ((k >> 7) == (n >> 7)) { const int g = 2 * pn + (n >> 7); v = inp(c, 7)[(((size_t)l * 4 + g) * 128 + (k & 127)) * 128 + (n & 127)] * inp(c, 8)[l * 512 + g * 128 + (n & 127)]; }
        wsp<bf16_t>(c, WS_WPOOL)[i] = f2bf(v);
    }
    for (int i = gt; i < 2 * 192 * DM / 8; i += NGT) { const int l = i / (192 * DM / 8), r = i % (192 * DM / 8); *(u32x4*)(wsp<bf16_t>(c, WS_WIN) + (size_t)l * DM * DM + (size_t)IN_COLS * DM + (size_t)r * 8) = (u32x4){0u, 0u, 0u, 0u}; }
    for (int i = gt; i < (int)(8 * MiB / 16); i += NGT) *(u32x4*)(c.ws + WS_SPREV + (size_t)i * 16) = (u32x4){0u, 0u, 0u, 0u};
    for (int i = gt; i < NTOK * 32; i += NGT) {
        const int tok = i >> 5, f = i & 31; const float invf = exp2f(-(float)f * (13.287712379549449f / 32.0f));
        const float ang = (float)((const int*)c.a.in[2])[tok] * invf; float s, co; sincos_rev((double)ang, s, co);
        wsp<f32x2>(c, WS_CS)[i] = (f32x2){co, s};
    }
    for (int i = gt; i < 64 * 127 * 256; i += NGT) {
        const int lg = i / (127 * 256), r = i % (127 * 256), li_ = r >> 8, h = (r >> 4) & 15, hp = r & 15, l = lg >> 5, g = lg & 31;
        float acc = 0.f;
        if (li_ >= 63) {
            const int lag = li_ - 63; const float dt = __expf(inp(c, 11)[l * 32 + g]);
            for (int p = 0; p < 64; ++p) {
                const int gp = (l * 32 + g) * 64 + p; const float lr = inp(c, 9)[gp], lim = inp(c, 10)[gp];
                float s1, c1; sincos_rev((double)(lim * dt), s1, c1); const float mg = __expf(lr * dt); const float ar = mg * c1, aim = mg * s1;
                const float den = lr * lr + lim * lim; const float fr_ = ((ar - 1.f) * lr + aim * lim) / den, fi_ = (aim * lr - (ar - 1.f) * lim) / den;
                const float br = inp(c, 12)[(size_t)gp * 16 + hp], bi = inp(c, 13)[(size_t)gp * 16 + hp];
                const float bbr = fr_ * br - fi_ * bi, bbi = fr_ * bi + fi_ * br;
                float sl, cl_; sincos_rev((double)lag * (double)(lim * dt), sl, cl_); const float ml = __expf((float)lag * lr * dt); const float pr = ml * cl_, pi_ = ml * sl;
                const float zr = pr * bbr - pi_ * bbi, zi = pr * bbi + pi_ * bbr;
                const size_t ci = ((size_t)(l * 32 + g) * 16 + h) * 64 + p; const float cr = inp(c, 14)[ci], cim = inp(c, 15)[ci];
                acc += cr * zr - cim * zi;
            }
        }
        *(bf16_t*)(c.ws + WS_SSMTAB + (size_t)lg * SSMTAB_STRIDE + SSM_TG + (size_t)r * 2) = f2bf(acc);
    }
    for (int i = gt; i < 64 * 64 * 128 * 16; i += NGT) {
        const int lg = i >> 17, r = i & 131071, tau = r >> 11, pp = (r >> 4) & 127, hp = r & 15, l = lg >> 5, g = lg & 31, p = pp & 63;
        const float dt = __expf(inp(c, 11)[l * 32 + g]); const int gp = (l * 32 + g) * 64 + p; const float lr = inp(c, 9)[gp], lim = inp(c, 10)[gp];
        float s1, c1; sincos_rev((double)(lim * dt), s1, c1); const float mg = __expf(lr * dt); const float ar = mg * c1, aim = mg * s1;
        const float den = lr * lr + lim * lim; const float fr_ = ((ar - 1.f) * lr + aim * lim) / den, fi_ = (aim * lr - (ar - 1.f) * lim) / den;
        const float br = inp(c, 12)[(size_t)gp * 16 + hp], bi = inp(c, 13)[(size_t)gp * 16 + hp]; const float bbr = fr_ * br - fi_ * bi, bbi = fr_ * bi + fi_ * br;
        const int e = 63 - tau; float sl, cl_; sincos_rev((double)e * (double)(lim * dt), sl, cl_); const float ml = __expf((float)e * lr * dt); const float pr = ml * cl_, pi_ = ml * sl;
        const float zr = pr * bbr - pi_ * bbi, zi = pr * bbi + pi_ * bbr;
        *(bf16_t*)(c.ws + WS_SSMTAB + (size_t)lg * SSMTAB_STRIDE + SSM_TEND + (size_t)r * 2) = f2bf(pp < 64 ? zr : zi);
    }
    for (int i = gt; i < 64 * 1024 * 256; i += NGT) {
        const int lg = i >> 18, r = i & 262143, n = r >> 8, k = r & 255, t = n >> 4, h = n & 15, l = lg >> 5, g = lg & 31; float v = 0.f;
        if (k < 128) { const int p = k & 63; const float dt = __expf(inp(c, 11)[l * 32 + g]); const int gp = (l * 32 + g) * 64 + p; const float lr = inp(c, 9)[gp], lim = inp(c, 10)[gp];
            const int e = t + 1; float sl, cl_; sincos_rev((double)e * (double)(lim * dt), sl, cl_); const float ml = __expf((float)e * lr * dt); const float pr = ml * cl_, pi_ = ml * sl;
            const size_t ci = ((size_t)(l * 32 + g) * 16 + h) * 64 + p; const float cr = inp(c, 14)[ci], cim = inp(c, 15)[ci];
            const float wr_ = cr * pr - cim * pi_, wi_ = cr * pi_ + cim * pr; v = k < 64 ? wr_ : -wi_; }
        *(bf16_t*)(c.ws + WS_SSMTAB + (size_t)lg * SSMTAB_STRIDE + SSM_WC + (size_t)r * 2) = f2bf(v);
    }
    for (int i = gt; i < 64 * 64; i += NGT) {
        const int lg = i >> 6, l = lg >> 5, g = lg & 31; const float dt = __expf(inp(c, 11)[l * 32 + g]); const float lr = inp(c, 9)[i], lim = inp(c, 10)[i];
        float sl, cl_; sincos_rev(64.0 * (double)(lim * dt), sl, cl_); const float ml = __expf(64.f * lr * dt); wsp<f32x2>(c, WS_A64)[i] = (f32x2){ml * cl_, ml * sl};
    }
}

__device__ __forceinline__ void router_prep(const Ctx& c, int l) {
    const int gt = c.vcu * 512 + c.tid, NGT = c.G * 512;
    for (int i = gt; i < NB * 64 * 3 * 64; i += NGT) {
        const int ln = i & 63, cb = (i >> 6) % 3, ks = (i / 192) & 63, b = i / (192 * 64);
        const int j = 16 * cb + (ln & 15), k0 = 32 * ks + 8 * (ln >> 4);
        float hi[8], lo[8];
#pragma unroll
        for (int e = 0; e < 8; ++e) { const int k = k0 + e; float w = 0.f;
            if (j < 4) w = inp(c, 25)[((size_t)l * DM + k) * 4 + j]; else if (j < 36) w = inp(c, 27)[((size_t)l * DM + k) * 32 + (j - 4)];
            w *= inp(c, 24)[l * DM + k] * (1.f + modp(c, l, b, 4)[k]);
            hi[e] = bf2f(f2bf(w)); lo[e] = w - hi[e]; }
        u32x4 H, L; H.x = cvtpk(hi[0], hi[1]); H.y = cvtpk(hi[2], hi[3]); H.z = cvtpk(hi[4], hi[5]); H.w = cvtpk(hi[6], hi[7]); L.x = cvtpk(lo[0], lo[1]); L.y = cvtpk(lo[2], lo[3]); L.z = cvtpk(lo[4], lo[5]); L.w = cvtpk(lo[6], lo[7]);
        bf16_t* base = wsp<bf16_t>(c, WS_RWF) + ((((size_t)(l * NB + b) * 64 + ks) * 3 + cb) * 2) * 512;
        *(u32x4*)(base + ln * 8) = H; *(u32x4*)(base + 512 + ln * 8) = L;
    }
    const int gw = c.vcu * 8 + c.wid, NGW = c.G * 8;
    for (int i = gw; i < NB * 36; i += NGW) {
        const int b = i / 36, j = i % 36; float s = 0.f;
        for (int k = c.lane; k < DM; k += 64) { const float w = j < 4 ? inp(c, 25)[((size_t)l * DM + k) * 4 + j] : inp(c, 27)[((size_t)l * DM + k) * 32 + (j - 4)]; s += modp(c, l, b, 3)[k] * w; }
        s = wave_sum(s);
        if (c.lane == 0) wsp<float>(c, WS_RBIAS)[(l * NB + b) * 64 + j] = s + (j < 4 ? inp(c, 26)[l * 4 + j] : inp(c, 28)[l * 32 + (j - 4)]);
    }
}

template <int MODE>
__device__ __forceinline__ void norm_phase(const Ctx& c, int l) {
    LAS float* red = (LAS float*)c.lds;
    const LAS int* ps = (const LAS int*)(c.lds + LDS_PSTART);
    const int lane = c.lane, wid = c.wid, row = lane & 15, kq = lane >> 4;
    float* xbuf = wsp<float>(c, WS_XBUF);
    const float* src = (MODE == 0 && l == 0) ? inp(c, 0) : xbuf;
    const int lm = (MODE == 3) ? 1 : l - 1;
    const i32x4* RI = wsp<const i32x4>(c, WS_RI) + (size_t)(lm < 0 ? 0 : lm) * NTOK; const f32x2* RW = wsp<const f32x2>(c, WS_RW) + (size_t)(lm < 0 ? 0 : lm) * NTOK;
    const bf16_t* Y2 = wsp<const bf16_t>(c, WS_Y2);
    bf16_t* H = wsp<bf16_t>(c, WS_H);
    int* cnt = wsp<int>(c, WS_CTL) + CW_CNT + l * 32 * 64;
    for (int unit = c.vcu; unit < NTOK / 16; unit += c.G) {
        const int rg = unit * 16 + row; const int b = rg >> 14;
        size_t pos0 = 0, pos1 = 0; float w0 = 0.f, w1 = 0.f;
        if (MODE == 1 || MODE == 3) { const i32x4 ri = RI[rg]; const f32x2 rw = RW[rg]; pos0 = (size_t)(ps[ri.x] + ri.z); pos1 = (size_t)(ps[ri.y] + ri.w); w0 = rw.x; w1 = rw.y; }
        f32x4 xv[8][2]; float ss = 0.f;
        f32x4 acc[3] = {{0.f, 0.f, 0.f, 0.f}, {0.f, 0.f, 0.f, 0.f}, {0.f, 0.f, 0.f, 0.f}};
#pragma unroll
        for (int s = 0; s < 8; ++s) {
            const int k = 256 * wid + 32 * s + 8 * kq;
            f32x4 x0 = *(const f32x4*)(src + (size_t)rg * DM + k), x1 = *(const f32x4*)(src + (size_t)rg * DM + k + 4);
            if (MODE == 1 || MODE == 3) {
                f32x4 a0, a1, b0, b1; unpack8(*(const u32x4*)(Y2 + pos0 * DM + k), a0, a1); unpack8(*(const u32x4*)(Y2 + pos1 * DM + k), b0, b1);
                const float* gf = modp(c, lm, b, 5) + k; const f32x4 g0 = *(const f32x4*)gf, g1 = *(const f32x4*)(gf + 4);
                x0 += g0 * (a0 * w0 + b0 * w1); x1 += g1 * (a1 * w0 + b1 * w1);
                if (MODE == 1) { *(f32x4*)(xbuf + (size_t)rg * DM + k) = x0; *(f32x4*)(xbuf + (size_t)rg * DM + k + 4) = x1; }
            }
            xv[s][0] = x0; xv[s][1] = x1;
            ss += (x0[0] * x0[0] + x0[1] * x0[1]) + (x0[2] * x0[2] + x0[3] * x0[3]) + (x1[0] * x1[0] + x1[1] * x1[1]) + (x1[2] * x1[2] + x1[3] * x1[3]);
            if (MODE == 2) {
                const u32x4 hi = pack8f(x0, x1); f32x4 h0, h1; unpack8(hi, h0, h1); const u32x4 lo = pack8f(x0 - h0, x1 - h1);
                const bf16x8 xh = *(const bf16x8*)&hi, xl = *(const bf16x8*)&lo;
                const bf16_t* wf = wsp<const bf16_t>(c, WS_RWF) + (((size_t)(l * NB + b) * 64 + (8 * wid + s)) * 3) * 2 * 512 + lane * 8;
#pragma unroll
                for (int cb = 0; cb < 3; ++cb) { const bf16x8 wh = *(const bf16x8*)(wf + (cb * 2) * 512), wl = *(const bf16x8*)(wf + (cb * 2 + 1) * 512);
                    acc[cb] = __builtin_amdgcn_mfma_f32_16x16x32_bf16(wh, xh, acc[cb], 0, 0, 0); acc[cb] = __builtin_amdgcn_mfma_f32_16x16x32_bf16(wh, xl, acc[cb], 0, 0, 0);
                    acc[cb] = __builtin_amdgcn_mfma_f32_16x16x32_bf16(wl, xh, acc[cb], 0, 0, 0); }
            }
        }
        ss += __shfl_xor(ss, 16); ss += __shfl_xor(ss, 32);
        if (kq == 0) red[(wid * 16 + row) * 52] = ss;
        if (MODE == 2) {
#pragma unroll
            for (int cb = 0; cb < 3; ++cb)
#pragma unroll
                for (int e = 0; e < 4; ++e) red[(wid * 16 + row) * 52 + 1 + 16 * cb + 4 * kq + e] = acc[cb][e];
        }
        __syncthreads();
        float tot = 0.f;
#pragma unroll
        for (int w8 = 0; w8 < 8; ++w8) tot += red[(w8 * 16 + row) * 52];
        const float rstd = rsqrtf(tot * (1.f / DM) + EPS);
        if (MODE == 2 && wid == 0 && lane < 16) {
            const float* rb = wsp<const float>(c, WS_RBIAS) + (l * NB + b) * 64;
            float gl[4];
#pragma unroll
            for (int j = 0; j < 4; ++j) { float d = 0.f;
#pragma unroll
                for (int w8 = 0; w8 < 8; ++w8) d += red[(w8 * 16 + row) * 52 + 1 + j];
                gl[j] = rstd * d + rb[j]; }
            int gt_ = 0; float gm = gl[0];
#pragma unroll
            for (int j = 1; j < 4; ++j) if (gl[j] > gm) { gm = gl[j]; gt_ = j; }
            float gs = 0.f;
#pragma unroll
            for (int j = 0; j < 4; ++j) gs += __expf(gl[j] - gm);
            const float gwt = 1.f / gs;
            float e0 = -3.0e38f, e1 = -3.0e38f; int i0 = 0, i1 = 0;
            for (int i = 0; i < 8; ++i) { float d = 0.f;
#pragma unroll
                for (int w8 = 0; w8 < 8; ++w8) d += red[(w8 * 16 + row) * 52 + 1 + 4 + 8 * gt_ + i];
                const float lg = rstd * d + rb[4 + 8 * gt_ + i];
                if (lg > e0) { e1 = e0; i1 = i0; e0 = lg; i0 = i; } else if (lg > e1) { e1 = lg; i1 = i; } }
            const float q1 = __expf(e1 - e0); const float p0 = 1.f / (1.f + q1), p1 = q1 * p0;
            const int ex0 = 8 * gt_ + i0, ex1 = 8 * gt_ + i1;
            const int s0 = atomicAdd(cnt + ex0 * 64, 1), s1 = atomicAdd(cnt + ex1 * 64, 1);
            int* toks = wsp<int>(c, WS_TOK); toks[(size_t)ex0 * NTOK + s0] = rg; toks[(size_t)ex1 * NTOK + s1] = rg;
            wsp<i32x4>(c, WS_RI)[(size_t)l * NTOK + rg] = (i32x4){ex0, ex1, s0, s1}; wsp<f32x2>(c, WS_RW)[(size_t)l * NTOK + rg] = (f32x2){gwt * p0, gwt * p1};
        }
        if (MODE == 3) {
            const float* fg = inp(c, 32);
#pragma unroll
            for (int s = 0; s < 8; ++s) { const int k = 256 * wid + 32 * s + 8 * kq; const f32x4 g0 = *(const f32x4*)(fg + k), g1 = *(const f32x4*)(fg + k + 4);
                *(f32x4*)(c.a.out + (size_t)rg * DM + k) = xv[s][0] * rstd * g0; *(f32x4*)(c.a.out + (size_t)rg * DM + k + 4) = xv[s][1] * rstd * g1; }
        } else {
            const int nsel = (MODE == 2) ? 24 : 5; const int off = (MODE == 2) ? 3 : 0;
            const float* gn = inp(c, nsel) + l * DM; const float* sh = modp(c, l, b, off); const float* sc = modp(c, l, b, off + 1);
#pragma unroll
            for (int s = 0; s < 8; ++s) { const int k = 256 * wid + 32 * s + 8 * kq;
                const f32x4 g0 = *(const f32x4*)(gn + k) * (*(const f32x4*)(sc + k) + 1.f), g1 = *(const f32x4*)(gn + k + 4) * (*(const f32x4*)(sc + k + 4) + 1.f);
                const f32x4 h0 = xv[s][0] * rstd * g0 + *(const f32x4*)(sh + k), h1 = xv[s][1] * rstd * g1 + *(const f32x4*)(sh + k + 4);
                *(u32x4*)(H + (size_t)rg * DM + k) = pack8f(h0, h1); }
        }
        __syncthreads();
    }
}

__device__ __forceinline__ void carry_phase(const Ctx& c, int l) {
    LAS float* ex = (LAS float*)c.lds;
    const float* E = wsp<const float>(c, WS_EBUF); bf16_t* SP = wsp<bf16_t>(c, WS_SPREV);
    const int seg = c.tid >> 5, pp = c.tid & 31;
    for (int item = c.vcu; item < NB * SSM_G * 2; item += c.G) {
        const int b = item >> 6, g = (item >> 1) & 31, p = (item & 1) * 32 + pp;
        const f32x2 A = wsp<const f32x2>(c, WS_A64)[(l * 32 + g) * 64 + p];
        const int c0 = b * 256 + seg * 16;
        float er[16], ei[16];
#pragma unroll
        for (int j = 0; j < 16; ++j) { const float* e = E + ((size_t)(c0 + j) * SSM_G + g) * 128; er[j] = e[p]; ei[j] = e[64 + p]; }
        float sr = 0.f, si = 0.f;
#pragma unroll
        for (int j = 0; j < 16; ++j) { const float nr = A.x * sr - A.y * si + er[j], ni = A.x * si + A.y * sr + ei[j]; sr = nr; si = ni; er[j] = sr; ei[j] = si; }
        ex[(seg * 32 + pp) * 2] = sr; ex[(seg * 32 + pp) * 2 + 1] = si;
        float pr = A.x, pi_ = A.y;
#pragma unroll
        for (int q = 0; q < 4; ++q) { const float nr = pr * pr - pi_ * pi_, ni = 2.f * pr * pi_; pr = nr; pi_ = ni; }
        __syncthreads();
        float cr = 0.f, ci = 0.f;
        for (int s = 0; s < seg; ++s) { const float tr = ex[(s * 32 + pp) * 2], ti = ex[(s * 32 + pp) * 2 + 1]; const float nr = pr * cr - pi_ * ci + tr, ni = pr * ci + pi_ * cr + ti; cr = nr; ci = ni; }
        float qr = cr, qi = ci;
#pragma unroll
        for (int j = 0; j < 16; ++j) {
            const float vr = qr + (j ? er[j - 1] : 0.f), vi = qi + (j ? ei[j - 1] : 0.f);
            bf16_t* o = SP + ((size_t)(c0 + j) * SSM_G + g) * 256; o[p] = f2bf(vr); o[64 + p] = f2bf(vi);
            const float nr = A.x * qr - A.y * qi, ni = A.x * qi + A.y * qr; qr = nr; qi = ni;
        }
        __syncthreads();
    }
}

__device__ __forceinline__ void fin_phase(const Ctx& c) {
    const bf16_t* P = wsp<const bf16_t>(c, WS_P); const bf16_t* GL = wsp<const bf16_t>(c, WS_GL); const bf16_t* O = wsp<const bf16_t>(c, WS_O); bf16_t* Y = wsp<bf16_t>(c, WS_YCAT);
    const int gw = c.vcu * 8 + c.wid, NGW = c.G * 8, lane = c.lane;
    const int win = 2 << (lane >> 4);
    for (int tok = gw; tok < NTOK; tok += NGW) {
        const int tl = tok & (SEQ - 1);
        f32x4 s0 = {0.f, 0.f, 0.f, 0.f}, s1 = {0.f, 0.f, 0.f, 0.f}, p0, p1;
        unpack8(*(const u32x4*)(P + (size_t)tok * 512 + lane * 8), p0, p1);
        const int cntw = (tl + 1 < win) ? tl + 1 : win;
        for (int j = 0; j < 16; ++j) { if (j < cntw) { f32x4 a0, a1; unpack8(*(const u32x4*)(P + (size_t)(tok - j) * 512 + lane * 8), a0, a1); s0 += a0; s1 += a1; } }
        const float ic = 1.f / (float)cntw; f32x4 y0 = s0 * ic - p0, y1 = s1 * ic - p1;
        float ss = (y0[0] * y0[0] + y0[1] * y0[1]) + (y0[2] * y0[2] + y0[3] * y0[3]) + (y1[0] * y1[0] + y1[1] * y1[1]) + (y1[2] * y1[2] + y1[3] * y1[3]);
        float rs = rsqrtf(wave_sum(ss) * (1.f / 512.f) + EPS);
        *(u32x4*)(Y + (size_t)tok * DM + lane * 8) = pack8f(y0 * rs, y1 * rs);
        unpack8(*(const u32x4*)(GL + (size_t)tok * 512 + lane * 8), y0, y1);
        ss = (y0[0] * y0[0] + y0[1] * y0[1]) + (y0[2] * y0[2] + y0[3] * y0[3]) + (y1[0] * y1[0] + y1[1] * y1[1]) + (y1[2] * y1[2] + y1[3] * y1[3]);
        rs = rsqrtf(wave_sum(ss) * (1.f / 512.f) + EPS);
        *(u32x4*)(Y + (size_t)tok * DM + 512 + lane * 8) = pack8f(y0 * rs, y1 * rs);
        f32x4 z0, z1; unpack8(*(const u32x4*)(O + (size_t)tok * 1024 + lane * 16), y0, y1); unpack8(*(const u32x4*)(O + (size_t)tok * 1024 + lane * 16 + 8), z0, z1);
        ss = (y0[0] * y0[0] + y0[1] * y0[1]) + (y0[2] * y0[2] + y0[3] * y0[3]) + (y1[0] * y1[0] + y1[1] * y1[1]) + (y1[2] * y1[2] + y1[3] * y1[3])
           + (z0[0] * z0[0] + z0[1] * z0[1]) + (z0[2] * z0[2] + z0[3] * z0[3]) + (z1[0] * z1[0] + z1[1] * z1[1]) + (z1[2] * z1[2] + z1[3] * z1[3]);
        rs = rsqrtf(wave_sum(ss) * (1.f / 1024.f) + EPS);
        *(u32x4*)(Y + (size_t)tok * DM + 1024 + lane * 16) = pack8f(y0 * rs, y1 * rs); *(u32x4*)(Y + (size_t)tok * DM + 1024 + lane * 16 + 8) = pack8f(z0 * rs, z1 * rs);
    }
}
__device__ __forceinline__ void kpe_rope(const Ctx& c) {
    const bf16_t* Z = wsp<const bf16_t>(c, WS_Z); bf16_t* K = wsp<bf16_t>(c, WS_K); const f32x2* CS = wsp<const f32x2>(c, WS_CS);
    const int gt = c.vcu * 512 + c.tid, NGT = c.G * 512;
    for (int i = gt; i < NTOK * 8; i += NGT) {
        const int tok = i >> 3, q = i & 7; const int b = tok >> 14, t = tok & (SEQ - 1);
        f32x4 v0, v1; unpack8(*(const u32x4*)(Z + (size_t)tok * ZLD + Z_KPE + q * 8), v0, v1);
        const f32x2* cs = CS + (size_t)tok * 32 + q * 4; const f32x4 c01 = *(const f32x4*)cs, c23 = *(const f32x4*)(cs + 2);
        f32x4 o0, o1;
        o0[0] = v0[0] * c01[0] - v0[1] * c01[1]; o0[1] = v0[1] * c01[0] + v0[0] * c01[1]; o0[2] = v0[2] * c01[2] - v0[3] * c01[3]; o0[3] = v0[3] * c01[2] + v0[2] * c01[3];
        o1[0] = v1[0] * c23[0] - v1[1] * c23[1]; o1[1] = v1[1] * c23[0] + v1[0] * c23[1]; o1[2] = v1[2] * c23[2] - v1[3] * c23[3]; o1[3] = v1[3] * c23[2] + v1[2] * c23[3];
        const u32x4 w = pack8f(o0, o1);
#pragma unroll
        for (int h = 0; h < NHEAD; ++h) *(u32x4*)(K + ((size_t)(b * NHEAD + h) * SEQ + t) * QKD + 128 + q * 8) = w;
    }
}
namespace att {
constexpr int KN_BYTES = 16384, KR_BYTES = 8192, V_BYTES = 16384, ST_BYTES = KN_BYTES + KR_BYTES + V_BYTES, NST = 3;
constexpr int XCH_OFF = NST * ST_BYTES;
constexpr float THR2 = 11.5f;
#define AT_KSWZ(row, colB) ((row) * 256 + ((colB) ^ (((row) & 7) << 4)))
#define AT_SBAR() __builtin_amdgcn_sched_barrier(0)
__device__ __forceinline__ int v_rd_base(int lane) { return ((lane & 3) << 3) | (((lane >> 2) & 3) << 6) | (((lane >> 4) & 1) << 5) | (((lane >> 5) & 1) << 8); }
__device__ __forceinline__ int crow(int r, int hi) { return (r & 3) + 8 * (r >> 2) + 4 * hi; }
__device__ __forceinline__ void mask_tile(f32x16& p0, f32x16& p1, int dq) {
    const float NEG = -__builtin_inff();
#pragma unroll
    for (int r = 0; r < 16; ++r) { const int cc = (r & 3) + 8 * (r >> 2); if (dq - cc < 0) p0[r] = NEG; if (dq - cc - 32 < 0) p1[r] = NEG; }
}
__device__ __forceinline__ void partialSM(f32x16& p0, f32x16& p1, float& m_reg, float& mn, float& alpha) {
    float pmax = p0[0];
#pragma unroll
    for (int r = 1; r < 16; ++r) pmax = fmaxf(pmax, p0[r]);
#pragma unroll
    for (int r = 0; r < 16; ++r) pmax = fmaxf(pmax, p1[r]);
    { auto rr = __builtin_amdgcn_permlane32_swap(__float_as_uint(pmax), __float_as_uint(pmax), false, false); pmax = fmaxf(__uint_as_float(rr[0]), __uint_as_float(rr[1])); }
    if (__builtin_expect(__all((pmax - m_reg) <= THR2), 1)) { mn = m_reg; alpha = 1.f; }
    else { mn = fmaxf(m_reg, pmax); alpha = fast_exp2(m_reg - mn); m_reg = mn; }
#pragma unroll
    for (int r = 0; r < 16; ++r) p0[r] = fast_exp2(p0[r] - mn);
}
__device__ __forceinline__ void finishSM(f32x16& p0, f32x16& p1, float mn, float alpha, float& l_reg, bf16x8& pa0, bf16x8& pa1, bf16x8& pa2, bf16x8& pa3) {
#pragma unroll
    for (int r = 0; r < 16; ++r) p1[r] = fast_exp2(p1[r] - mn);
    float ps = 0.f;
#pragma unroll
    for (int r = 0; r < 16; ++r) ps += p0[r];
#pragma unroll
    for (int r = 0; r < 16; ++r) ps += p1[r];
    { auto rr = __builtin_amdgcn_permlane32_swap(__float_as_uint(ps), __float_as_uint(ps), false, false); ps = __uint_as_float(rr[0]) + __uint_as_float(rr[1]); }
    l_reg = l_reg * alpha + ps;
#define AT_PK4(P, B_, OUT) do { unsigned a0 = cvtpk(P[B_ + 0], P[B_ + 1]), a1 = cvtpk(P[B_ + 2], P[B_ + 3]); unsigned b0 = cvtpk(P[B_ + 4], P[B_ + 5]), b1 = cvtpk(P[B_ + 6], P[B_ + 7]); \
        auto r0 = __builtin_amdgcn_permlane32_swap(a0, b0, false, false); auto r1 = __builtin_amdgcn_permlane32_swap(a1, b1, false, false); \
        u32x4 w = {r0[0], r1[0], r0[1], r1[1]}; OUT = *reinterpret_cast<bf16x8*>(&w); } while (0)
    AT_PK4(p0, 0, pa0); AT_PK4(p0, 8, pa1); AT_PK4(p1, 0, pa2); AT_PK4(p1, 8, pa3);
#undef AT_PK4
}
__device__ __forceinline__ void qkt(f32x16& p0, f32x16& p1, const LAS char* st, int r32, int hi, const bf16x8* qr) {
    p0 = f32x16{}; p1 = f32x16{};
    int kb[4];
#pragma unroll
    for (int dd = 0; dd < 4; ++dd) kb[dd] = AT_KSWZ(r32, (dd * 16 + hi * 8) * 2);
#pragma unroll
    for (int d0 = 0; d0 < 8; ++d0) { const LAS char* a = st + kb[d0 & 3] + (d0 >> 2) * 128;
        const bf16x8 b0 = *(const LAS bf16x8*)a, b1 = *(const LAS bf16x8*)(a + 32 * 256);
        p0 = __builtin_amdgcn_mfma_f32_32x32x16_bf16(b0, qr[d0], p0, 0, 0, 0); p1 = __builtin_amdgcn_mfma_f32_32x32x16_bf16(b1, qr[d0], p1, 0, 0, 0); }
#pragma unroll
    for (int dd = 0; dd < 4; ++dd) { const LAS char* a = st + KN_BYTES + kb[dd];
        const bf16x8 b0 = *(const LAS bf16x8*)a, b1 = *(const LAS bf16x8*)(a + 128);
        p0 = __builtin_amdgcn_mfma_f32_32x32x16_bf16(b0, qr[8 + dd], p0, 0, 0, 0); p1 = __builtin_amdgcn_mfma_f32_32x32x16_bf16(b1, qr[8 + dd], p1, 0, 0, 0); }
}
__device__ __forceinline__ void pv_tile(f32x16* o, unsigned vb, bf16x8 pa0, bf16x8 pa1, bf16x8 pa2, bf16x8 pa3) {
#define AT_TRRD(dst, off) asm volatile("ds_read_b64_tr_b16 %0, %1 offset:%2" : "=&v"(dst) : "v"(vb), "i"(off) : "memory")
#define AT_PV_D0(d0) do { s16x4 l0, l1, l2, l3, h0, h1, h2, h3; constexpr int b_ = (d0) * 512; \
        AT_TRRD(l0, b_); AT_TRRD(h0, b_ + 2048); AT_TRRD(l1, b_ + 4096); AT_TRRD(h1, b_ + 6144); AT_TRRD(l2, b_ + 8192); AT_TRRD(h2, b_ + 10240); AT_TRRD(l3, b_ + 12288); AT_TRRD(h3, b_ + 14336); \
        asm volatile("s_waitcnt lgkmcnt(0)" ::: "memory"); AT_SBAR(); \
        o[d0] = __builtin_amdgcn_mfma_f32_32x32x16_bf16(pa0, (bf16x8){l0[0], l0[1], l0[2], l0[3], h0[0], h0[1], h0[2], h0[3]}, o[d0], 0, 0, 0); \
        o[d0] = __builtin_amdgcn_mfma_f32_32x32x16_bf16(pa1, (bf16x8){l1[0], l1[1], l1[2], l1[3], h1[0], h1[1], h1[2], h1[3]}, o[d0], 0, 0, 0); \
        o[d0] = __builtin_amdgcn_mfma_f32_32x32x16_bf16(pa2, (bf16x8){l2[0], l2[1], l2[2], l2[3], h2[0], h2[1], h2[2], h2[3]}, o[d0], 0, 0, 0); \
        o[d0] = __builtin_amdgcn_mfma_f32_32x32x16_bf16(pa3, (bf16x8){l3[0], l3[1], l3[2], l3[3], h3[0], h3[1], h3[2], h3[3]}, o[d0], 0, 0, 0); } while (0)
    AT_PV_D0(0); AT_PV_D0(1); AT_PV_D0(2); AT_PV_D0(3);
#undef AT_PV_D0
#undef AT_TRRD
}
struct DmaOff { unsigned kn0, kn1, kr, v0, v1; };
__device__ __forceinline__ void dma_offsets(int tid, DmaOff& d) {
    { const int p = tid, row = p >> 4, ch = (p & 15) ^ (row & 7); d.kn0 = (unsigned)(row * QKD + ch * 8) * 2u; }
    { const int p = tid + 512, row = p >> 4, ch = (p & 15) ^ (row & 7); d.kn1 = (unsigned)(row * QKD + ch * 8) * 2u; }
    { const int p = tid, row = p >> 4, ch = (p & 15) ^ (row & 7); const int key = row + ((ch & 8) ? 32 : 0); d.kr = (unsigned)(key * QKD + 128 + (ch & 7) * 8) * 2u; }
    { const int p = tid, sub = p >> 5, kk = (sub >> 2) * 8 + ((p & 31) >> 2), key = (kk & ~0xC) | ((kk & 4) << 1) | ((kk & 8) >> 1), col = (sub & 3) * 32 + (p & 3) * 8; d.v0 = (unsigned)(key * VD + col) * 2u; }
    { const int p = tid + 512, sub = p >> 5, kk = (sub >> 2) * 8 + ((p & 31) >> 2), key = (kk & ~0xC) | ((kk & 4) << 1) | ((kk & 8) >> 1), col = (sub & 3) * 32 + (p & 3) * 8; d.v1 = (unsigned)(key * VD + col) * 2u; }
}
#define AT_GLDS(g, l) __builtin_amdgcn_global_load_lds((const unsigned*)(g), (LAS unsigned*)(l), 16, 0, 0)
__device__ __forceinline__ void issue_tile(LAS char* lds, int stage, const char* Kt, const char* Vt, const DmaOff& d, int wid) {
    LAS char* st = lds + stage * ST_BYTES + wid * 1024;
    unsigned o0 = d.kn0, o1 = d.kn1, o2 = d.kr, o3 = d.v0, o4 = d.v1; asm volatile("" : "+v"(o0), "+v"(o1), "+v"(o2), "+v"(o3), "+v"(o4));
    AT_GLDS(Kt + o0, st); AT_GLDS(Kt + o1, st + 8192); AT_GLDS(Kt + o2, st + KN_BYTES); AT_GLDS(Vt + o3, st + KN_BYTES + KR_BYTES); AT_GLDS(Vt + o4, st + KN_BYTES + KR_BYTES + 8192);
}
__device__ __forceinline__ void block(LAS char* lds, const bf16_t* Qbh, const char* Kbh, const char* Vbh, bf16_t* Obase  , int qb, const DmaOff& d, const int tid) {
    const int wid = __builtin_amdgcn_readfirstlane(tid >> 6), lane = tid & 63, r32 = lane & 31, hi = lane >> 5;
    const int NT = 4 * (qb + 1);
    const int qlo = qb * 256 + wid * 32;
    const int nact = (qlo + 31) / 64 + 1;
    LAS float* xw = (LAS float*)(lds + XCH_OFF) + wid * 64;
    asm volatile("s_waitcnt vmcnt(0)" ::: "memory"); __builtin_amdgcn_s_barrier(); asm volatile("" ::: "memory");
    bf16x8 qr[12];
#pragma unroll
    for (int d0 = 0; d0 < 12; ++d0) qr[d0] = *(const bf16x8*)(Qbh + (size_t)(qlo + r32) * QKD + d0 * 16 + hi * 8);
    issue_tile(lds, 0, Kbh, Vbh, d, wid);
    issue_tile(lds, 1, Kbh + (size_t)64 * QKD * 2, Vbh + (size_t)64 * VD * 2, d, wid);
    float m_reg = -1e30f, l_reg = 0.f; f32x16 o[4] = {};
    const unsigned vbase = (unsigned)(uintptr_t)(lds + KN_BYTES + KR_BYTES) + (unsigned)v_rd_base(lane);
    int stage = 0;
    for (int t = 0; t < NT; ++t) {
        if (t + 1 < NT) asm volatile("s_waitcnt vmcnt(5)" ::: "memory"); else asm volatile("s_waitcnt vmcnt(0)" ::: "memory");
        __builtin_amdgcn_s_barrier(); asm volatile("" ::: "memory");
        if (t + 2 < NT) { int s2 = stage + 2; if (s2 >= NST) s2 -= NST; issue_tile(lds, s2, Kbh + (size_t)(t + 2) * 64 * QKD * 2, Vbh + (size_t)(t + 2) * 64 * VD * 2, d, wid); }
        if (t < nact) {
            const LAS char* st = lds + stage * ST_BYTES;
            f32x16 p0, p1; float mn, alpha; bf16x8 pa0, pa1, pa2, pa3;
            qkt(p0, p1, st, r32, hi, qr);
            if (t * 64 + 63 > qlo) mask_tile(p0, p1, qlo + r32 - t * 64 - 4 * hi);
            partialSM(p0, p1, m_reg, mn, alpha);
            finishSM(p0, p1, mn, alpha, l_reg, pa0, pa1, pa2, pa3);
            if (__any(alpha < 1.f)) { if (hi == 0) xw[r32] = alpha; asm volatile("s_waitcnt lgkmcnt(0)" ::: "memory");
#pragma unroll
                for (int d_ = 0; d_ < 4; ++d_)
#pragma unroll
                    for (int r = 0; r < 16; ++r) o[d_][r] *= xw[crow(r, hi)]; }
            pv_tile(o, vbase + (unsigned)(stage * ST_BYTES), pa0, pa1, pa2, pa3);
        }
        ++stage; if (stage >= NST) stage = 0;
    }
    if (hi == 0) xw[32 + r32] = l_reg; asm volatile("s_waitcnt lgkmcnt(0)" ::: "memory");
    bf16_t* Ow = Obase + (size_t)qlo * 1024;
#pragma unroll
    for (int r = 0; r < 16; ++r) { const int orow = crow(r, hi); const float rl = fast_rcp(xw[32 + orow]);
#pragma unroll
        for (int d0 = 0; d0 < 4; ++d0) { const float v = o[d0][r] * rl; const float vn = __shfl_xor(v, 1);
            if ((r32 & 1) == 0) *(unsigned*)(Ow + (size_t)orow * 1024 + d0 * 32 + r32) = cvtpk(v, vn); } }
}
__device__ __forceinline__ void phase(const Ctx& c) {
    LAS char* lds = (LAS char*)c.lds;
    const bf16_t* Q = wsp<const bf16_t>(c, WS_Q); const char* K = (const char*)(c.ws + WS_K); const char* V = (const char*)(c.ws + WS_V); bf16_t* O = wsp<bf16_t>(c, WS_O);
    DmaOff d; dma_offsets(c.tid, d);
    for (int it = c.vcu; it < 16 * 32; it += c.G) {
        const int bh = it >> 5, x = it & 31; const int b = bh >> 3, h = bh & 7;
        const bf16_t* Qbh = Q + (size_t)bh * SEQ * QKD; const char* Kbh = K + (size_t)bh * SEQ * QKD * 2; const char* Vbh = V + (size_t)bh * SEQ * VD * 2;
        bf16_t* Ob = O + (size_t)b * SEQ * 1024 + h * 128;
        block(lds, Qbh, Kbh, Vbh, Ob, x, d, c.tid);
        block(lds, Qbh, Kbh, Vbh, Ob, 63 - x, d, c.tid);
    }
    asm volatile("s_waitcnt vmcnt(0)" ::: "memory"); __builtin_amdgcn_s_barrier(); asm volatile("" ::: "memory");
}
}
constexpr int N_PHASES = 26;
__global__ void __launch_bounds__(512, 2) mk_fwd(Args args) {
    extern __shared__ __attribute__((aligned(16))) unsigned char lds_[];
    Ctx c0{(LAS unsigned char*)lds_, (int)threadIdx.x, (int)(threadIdx.x & 63), __builtin_amdgcn_readfirstlane((int)(threadIdx.x >> 6)), (int)gridDim.x, 0, args, args.ws};
    { const int bx = blockIdx.x; c0.vcu = (c0.G % 8 == 0) ? (bx % 8) * (c0.G / 8) + bx / 8 : bx; }
    if (c0.tid < 4) ((LAS unsigned*)(c0.lds + LDS_MISC))[c0.tid] = 0u;
    __syncthreads();
    const int lo = args.ph_lo, hi = args.ph_hi;
#if MK_ONE_LAUNCH
    XcdBarrier bar = xcd_barrier_post(wsp<unsigned>(c0, WS_CTL) + CW_BAR, (volatile LAS unsigned*)(c0.lds + LDS_MISC));
#define SEAM(k) do { if (lo <= (k) && (k) + 1 < hi) xcd_barrier(bar); } while (0)
#else
#define SEAM(k) do { } while (0)
#endif
#ifdef TEST_PH
#define IN(k) (((k) == 0 ? 0 : ((k) == 25 ? 25 : 1 + ((k) - 1) % 12)) == TEST_PH && lo <= (k) && (k) < hi)
#else
#define IN(k) (lo <= (k) && (k) < hi)
#endif
#define PCTX Ctx c{c0.lds, 0, 0, 0, c0.G, c0.vcu, args, nullptr}; { int t_ = c0.tid; asm volatile("" : "+v"(t_)); c.tid = t_; c.lane = t_ & 63; c.wid = __builtin_amdgcn_readfirstlane(t_ >> 6); unsigned char* w_ = args.ws; asm volatile("" : "+s"(w_)); c.ws = w_; }
#define LAYERP float* ssq_q = (float*)(c.ws + WS_CTL + CTL_SSQ) + (size_t)(l * 2) * NTOK; float* ssq_kv = ssq_q + NTOK; int* cnt = wsp<int>(c, WS_CTL) + CW_CNT + l * 32 * 64; const char* ssmtab = (const char*)(c.ws + WS_SSMTAB) + (size_t)l * 32 * SSMTAB_STRIDE; (void)ssq_q; (void)ssq_kv; (void)cnt; (void)ssmtab;
    if (IN(0)) { PCTX p0_prologue(c); SEAM(0); }
    for (int l = 0; l < DEPTH; ++l) {
        const int pb = 1 + 12 * l;
        if (IN(pb + 0)) { PCTX
            if (l == 0) norm_phase<0>(c, l);
            else { (void)build_tile_table(c, wsp<int>(c, WS_CTL) + CW_CNT + (l - 1) * 32 * 64); norm_phase<1>(c, l); __syncthreads(); convert_experts(c, l); }
            router_prep(c, l);
            SEAM(pb + 0);
        }
        if (IN(pb + 1)) { PCTX LAYERP
            ProgG1 p; p.so.init(NTOK, DM, c.G, (int)blockIdx.x); p.A = (const char*)(c.ws + WS_H); p.B = (const char*)(c.ws + WS_WIN) + (size_t)l * DM * DM * 2;
            p.Z = wsp<bf16_t>(c, WS_Z); p.U = wsp<bf16_t>(c, WS_U); p.ssq_q = ssq_q; p.ssq_kv = ssq_kv;
            ge::run(c.lds, p, c.tid); SEAM(pb + 1);
        }
        if (IN(pb + 2)) { PCTX LAYERP
            ProgG2 p; p.G = c.G; p.c = (int)blockIdx.x; p.Z = (const char*)(c.ws + WS_Z); p.U = (const char*)(c.ws + WS_U);
            p.WUQ = (const char*)(c.ws + WS_WUQ) + (size_t)l * 1536 * 512 * 2; p.WUKV = (const char*)(c.ws + WS_WUKV) + (size_t)l * 2048 * 256 * 2; p.WPOOL = (const char*)(c.ws + WS_WPOOL) + (size_t)l * 2 * 256 * 256 * 2;
            p.SSMTAB = ssmtab; p.ssq_q = ssq_q; p.ssq_kv = ssq_kv; p.CS = wsp<const f32x2>(c, WS_CS);
            p.Q = wsp<bf16_t>(c, WS_Q); p.K = wsp<bf16_t>(c, WS_K); p.V = wsp<bf16_t>(c, WS_V); p.P = wsp<bf16_t>(c, WS_P); p.YI = wsp<bf16_t>(c, WS_YI); p.EBUF = wsp<float>(c, WS_EBUF);
            ge::run(c.lds, p, c.tid); kpe_rope(c); SEAM(pb + 2);
        }
        if (IN(pb + 3)) { PCTX carry_phase(c, l); SEAM(pb + 3); }
        if (IN(pb + 4)) { PCTX att::phase(c); SEAM(pb + 4); }
        if (IN(pb + 5)) { PCTX LAYERP
            ProgS1 p; p.G = c.G; p.c = (int)blockIdx.x; p.SPREV = (const char*)(c.ws + WS_SPREV); p.SSMTAB = ssmtab; p.YI = wsp<const bf16_t>(c, WS_YI); p.U = wsp<const bf16_t>(c, WS_U);
            p.Dskip = inp(c, 16) + l * 512; p.YG = wsp<bf16_t>(c, WS_YG);
            ge::run(c.lds, p, c.tid); SEAM(pb + 5);
        }
        if (IN(pb + 6)) { PCTX
            ProgS2 p; p.G = c.G; p.c = (int)blockIdx.x; p.YGc = (const char*)(c.ws + WS_YG); p.W = (const char*)(c.ws + WS_WGLU) + (size_t)l * 512 * 512 * 2; p.YG = wsp<const bf16_t>(c, WS_YG); p.GL = wsp<bf16_t>(c, WS_GL);
            ge::run(c.lds, p, c.tid); SEAM(pb + 6);
        }
        if (IN(pb + 7)) { PCTX fin_phase(c); SEAM(pb + 7); }
        if (IN(pb + 8)) { PCTX
            ProgG3 p; p.so.init(NTOK, DM, c.G, (int)blockIdx.x); p.A = (const char*)(c.ws + WS_YCAT); p.B = (const char*)(c.ws + WS_WOUT) + (size_t)l * DM * DM * 2;
            p.xin = (l == 0) ? inp(c, 0) : wsp<const float>(c, WS_XBUF); p.xout = wsp<float>(c, WS_XBUF); p.ga = modp(c, l, 0, 2);
            ge::run(c.lds, p, c.tid); SEAM(pb + 8);
        }
        if (IN(pb + 9)) { PCTX norm_phase<2>(c, l); SEAM(pb + 9); }
        if (IN(pb + 10)) { PCTX LAYERP
            const int ntiles = __builtin_amdgcn_readfirstlane(build_tile_table(c, cnt));
            ProgM1 p; p.G = c.G; p.c = (int)blockIdx.x; p.tab = (const LAS int*)(c.lds + LDS_TILETAB); p.ntiles = ntiles; p.cnt = cnt; p.toks = wsp<const int>(c, WS_TOK);
            p.H = (const char*)(c.ws + WS_H); p.W13 = (const char*)(c.ws + WS_W13); p.ACT = wsp<bf16_t>(c, WS_ACT);
            ge::run(c.lds, p, c.tid); SEAM(pb + 10);
        }
        if (IN(pb + 11)) { PCTX LAYERP
            const int ntiles = __builtin_amdgcn_readfirstlane(build_tile_table(c, cnt));
            ProgM2 p; p.G = c.G; p.c = (int)blockIdx.x; p.tab = (const LAS int*)(c.lds + LDS_TILETAB); p.ntiles = ntiles; p.ACT = (const char*)(c.ws + WS_ACT); p.W2 = (const char*)(c.ws + WS_W2); p.Y2 = wsp<bf16_t>(c, WS_Y2);
            ge::run(c.lds, p, c.tid); SEAM(pb + 11);
        }
    }
    if (IN(25)) { PCTX (void)build_tile_table(c, wsp<int>(c, WS_CTL) + CW_CNT + 1 * 32 * 64); norm_phase<3>(c, 1); }
#undef PCTX
#undef LAYERP
#undef IN
#undef SEAM
}

extern "C" void kernel_launch(void* const* d_in, const int* in_sizes, int n_in, void* d_out, int out_size, void* d_ws, size_t ws_size, hipStream_t stream) {
    static int grid = 0;
    if (grid == 0) {
        if (n_in != 33 || in_sizes[0] != NTOK * DM || out_size != NTOK * DM || ws_size < WS_END) {
            fprintf(stderr, "kernel_launch: shape/workspace mismatch (n_in %d, in0 %d, out %d, ws %zu < %zu); nothing launched\n", n_in, n_in > 0 ? in_sizes[0] : -1, out_size, ws_size, (size_t)WS_END); grid = -1; return; }
        int dev = 0, cus = 0, per_cu = 0;
        if (hipGetDevice(&dev) != hipSuccess || hipDeviceGetAttribute(&cus, hipDeviceAttributeMultiprocessorCount, dev) != hipSuccess) { grid = -1; return; }
        if (hipFuncSetAttribute((const void*)mk_fwd, hipFuncAttributeMaxDynamicSharedMemorySize, LDS_BYTES) != hipSuccess) { fprintf(stderr, "kernel_launch: hipFuncSetAttribute failed\n"); grid = -1; return; }
        if (hipOccupancyMaxActiveBlocksPerMultiprocessor(&per_cu, (const void*)mk_fwd, 512, LDS_BYTES) != hipSuccess || per_cu < 1) fprintf(stderr, "kernel_launch: occupancy query reports %d\n", per_cu);
        (void)hipGetLastError();
        grid = cus;
    }
    if (grid < 0) return;
    if (hipMemsetAsync((char*)d_ws + WS_CTL, 0, CTL_ZERO_BYTES, stream) != hipSuccess) return;
    Args a{};
    for (int i = 0; i < 33; ++i) a.in[i] = d_in[i];
    a.out = (float*)d_out; a.ws = (unsigned char*)d_ws;
#if MK_ONE_LAUNCH
    a.ph_lo = 0; a.ph_hi = N_PHASES;
    hipLaunchKernelGGL(mk_fwd, dim3(grid), dim3(512), LDS_BYTES, stream, a);
#else
    for (int ph = 0; ph < N_PHASES; ++ph) { a.ph_lo = ph; a.ph_hi = ph + 1; hipLaunchKernelGGL(mk_fwd, dim3(grid), dim3(512), LDS_BYTES, stream, a); }
#endif
}
```

```cpp
#include <hip/hip_runtime.h>
#include <cstdio>
#include <cstdint>

#ifndef MK_ONE_LAUNCH
#define MK_ONE_LAUNCH 1
#endif

#define LAS __attribute__((address_space(3)))
#define GAS __attribute__((address_space(1)))
typedef unsigned short bf16_t;
typedef short bf16x8 __attribute__((ext_vector_type(8)));
typedef short s16x4 __attribute__((ext_vector_type(4)));
typedef float f32x2 __attribute__((ext_vector_type(2)));
typedef float f32x4 __attribute__((ext_vector_type(4)));
typedef float f32x16 __attribute__((ext_vector_type(16)));
typedef unsigned u32x2 __attribute__((ext_vector_type(2)));
typedef unsigned u32x4 __attribute__((ext_vector_type(4)));
typedef int i32x4 __attribute__((ext_vector_type(4)));

constexpr int NB = 2, SEQ = 16384, DM = 2048, NTOK = NB * SEQ, DEPTH = 2;
constexpr int IN_COLS = 1856, ZLD = 1536;
constexpr int Z_POOL = 0, Z_QC = 512, Z_KVC = 1024, Z_KPE = 1280;
constexpr int NHEAD = 8, QKD = 192, VD = 128;
constexpr int NEXP = 32, DEXP = 512;
constexpr int SSM_G = 32, SSM_T = 64, NCHUNK = NTOK / SSM_T;
constexpr float EPS = 1e-6f;
constexpr int MOE_MAXROWS = 2 * NTOK + NEXP * 256;

constexpr size_t MiB = 1u << 20;
constexpr size_t WS_CTL = 0, CTL_ZERO_BYTES = 1 * MiB;
constexpr size_t WS_MOD = 1 * MiB;
constexpr size_t WS_RBIAS = WS_MOD + 512 * 1024;
constexpr size_t WS_RWF = 2 * MiB;
constexpr size_t WS_RI = 4 * MiB;
constexpr size_t WS_RW = 5 * MiB;
constexpr size_t WS_TOK = 6 * MiB;
constexpr size_t WS_CS = 10 * MiB;
constexpr size_t WS_PWTAB = 18 * MiB, WS_BBTAB = 22 * MiB;
constexpr size_t WS_EBUF = 18 * MiB;
constexpr size_t WS_SPREV = 26 * MiB;
constexpr size_t WS_SSMTAB = 34 * MiB;
constexpr size_t SSMTAB_STRIDE = 832 * 1024, SSM_TG = 0, SSM_TEND = 64 * 1024, SSM_WC = 320 * 1024;
constexpr size_t WS_A64 = 86 * MiB;
constexpr size_t WS_WIN = 87 * MiB;
constexpr size_t WS_WUQ = 103 * MiB;
constexpr size_t WS_WUKV = 106 * MiB;
constexpr size_t WS_WOUT = 108 * MiB;
constexpr size_t WS_WGLU = 124 * MiB;
constexpr size_t WS_WPOOL = 125 * MiB;
constexpr size_t WS_W13 = 126 * MiB;
constexpr size_t WS_W2 = 254 * MiB;
constexpr size_t WS_XBUF = 318 * MiB;
constexpr size_t WS_H = 574 * MiB;
constexpr size_t WS_Q = 574 * MiB;
constexpr size_t WS_P = 670 * MiB;
constexpr size_t WS_Z = 702 * MiB;
constexpr size_t WS_O = 702 * MiB;
constexpr size_t WS_K = 798 * MiB;
constexpr size_t WS_YG = 798 * MiB, WS_GL = 830 * MiB;
constexpr size_t WS_V = 894 * MiB;
constexpr size_t WS_U = 958 * MiB;
constexpr size_t WS_Y2 = 702 * MiB;
constexpr size_t WS_YCAT = 990 * MiB;
constexpr size_t WS_ACT = 990 * MiB;
constexpr size_t WS_YI = 1118 * MiB;
constexpr size_t WS_SSQP = 1150 * MiB;
constexpr size_t WS_END = 1152 * MiB;
static_assert(WS_Y2 + (size_t)MOE_MAXROWS * DM * 2 <= WS_YCAT, "Y2 overlay");
static_assert(WS_ACT + (size_t)MOE_MAXROWS * DEXP * 2 <= WS_YI, "ACT overlay");
constexpr int CW_BAR = 1024;
constexpr int CW_CNT = 8192;
constexpr size_t CTL_SSQ = 64 * 1024;

constexpr int RING_BYTES = 131072;
constexpr int LDS_TILETAB = RING_BYTES;
constexpr int LDS_PSTART = RING_BYTES + 1536;
constexpr int LDS_MISC = RING_BYTES + 2048;
constexpr int LDS_BYTES = RING_BYTES + 4096;

#define LDS_WAIT() asm volatile("s_waitcnt lgkmcnt(0)" ::: "memory")
#define VM_WAIT() asm volatile("s_waitcnt vmcnt(0)" ::: "memory")
__device__ __forceinline__ unsigned cvtpk(float lo, float hi) { unsigned r; asm volatile("v_cvt_pk_bf16_f32 %0, %1, %2" : "=v"(r) : "v"(lo), "v"(hi)); return r; }
__device__ __forceinline__ float bf2f(unsigned short h) { return __uint_as_float((unsigned)h << 16); }
__device__ __forceinline__ float bflo(unsigned w) { return __uint_as_float(w << 16); }
__device__ __forceinline__ float bfhi(unsigned w) { return __uint_as_float(w & 0xffff0000u); }
__device__ __forceinline__ unsigned short f2bf(float f) { return (unsigned short)(cvtpk(f, 0.f) & 0xffffu); }
__device__ __forceinline__ u32x4 pack8f(f32x4 a, f32x4 b) { u32x4 w; w.x = cvtpk(a[0], a[1]); w.y = cvtpk(a[2], a[3]); w.z = cvtpk(b[0], b[1]); w.w = cvtpk(b[2], b[3]); return w; }
__device__ __forceinline__ void unpack8(u32x4 w, f32x4& a, f32x4& b) { a[0] = bflo(w.x); a[1] = bfhi(w.x); a[2] = bflo(w.y); a[3] = bfhi(w.y); b[0] = bflo(w.z); b[1] = bfhi(w.z); b[2] = bflo(w.w); b[3] = bfhi(w.w); }
__device__ __forceinline__ float wave_sum(float v) {
#pragma unroll
    for (int o = 1; o < 64; o <<= 1) v += __shfl_xor(v, o);
    return v;
}
__device__ __forceinline__ float fast_rcp(float x) { return __builtin_amdgcn_rcpf(x); }
__device__ __forceinline__ float fast_exp2(float x) { return __builtin_amdgcn_exp2f(x); }
__device__ __forceinline__ void sincos_rev(double ang, float& s, float& c) {
    double rev = ang * 0.15915494309189535; rev -= __builtin_rint(rev);
    const float f = (float)rev; s = __builtin_amdgcn_sinf(f); c = __builtin_amdgcn_cosf(f);
}

#define XB_TMO      128
#define XB_XCNT(j)  (256  + 64 * (j))
#define XB_XSUB(j)  (1280 + 64 * (j))
#define XB_XGEN(j)  (2304 + 64 * (j))
#define XB_TOP      3328
#define XB_TOPGEN   3392
#define XCD_BAR_WORDS 3456
#define XB_SPIN_CAP (1u << 18)
__device__ __forceinline__ unsigned xb_ld(unsigned* p)              { return __hip_atomic_load(p, __ATOMIC_RELAXED, __HIP_MEMORY_SCOPE_AGENT); }
__device__ __forceinline__ unsigned xb_add(unsigned* p, unsigned v) { return __hip_atomic_fetch_add(p, v, __ATOMIC_RELAXED, __HIP_MEMORY_SCOPE_AGENT); }
__device__ __forceinline__ unsigned xb_xcc_id() { return (unsigned)__builtin_amdgcn_s_getreg((3 << 11) | 20) & 0xFu; }
#define XB_SPIN(cond, bar) do { unsigned _sp = 0; while (cond) { __builtin_amdgcn_s_sleep(1); \
    if ((++_sp & 255u) == 0u) { if (xb_ld(&(bar)[XB_TMO])) break; if (_sp > XB_SPIN_CAP) { atomicAdd(&(bar)[XB_TMO], 1u); break; } } } } while (0)
struct XcdBarrier { unsigned* bar; unsigned x; volatile LAS unsigned* st; };
__device__ __forceinline__ XcdBarrier xcd_barrier_post(unsigned* bar, volatile LAS unsigned* st) {
    XcdBarrier b; b.bar = bar; b.x = xb_xcc_id(); b.st = st;
    if (threadIdx.x == 0) (void)xb_add(&bar[XB_XCNT(b.x)], 1u);
    return b;
}
__device__ __forceinline__ void xcd_barrier_complete(unsigned* bar, unsigned x, unsigned& nloc, unsigned& nx) {
    const unsigned G = gridDim.x * gridDim.y * gridDim.z;
    unsigned sum, cnt, mine, sp = 0u;
    for (;;) {
        sum = 0u; cnt = 0u; mine = 0u;
#pragma unroll
        for (unsigned j = 0; j < 16; ++j) { const unsigned c = xb_ld(&bar[XB_XCNT(j)]); sum += c; cnt += (c > 0u) ? 1u : 0u; mine = (j == x) ? c : mine; }
        if (sum == G) break;
        __builtin_amdgcn_s_sleep(1);
        if ((++sp & 255u) == 0u) { if (xb_ld(&bar[XB_TMO])) break; if (sp > XB_SPIN_CAP) { atomicAdd(&bar[XB_TMO], 1u); break; } }
    }
    nloc = mine > 0u ? mine : 1u; nx = cnt > 0u ? cnt : 1u;
}
__device__ __forceinline__ void xcd_barrier(const XcdBarrier& b, const bool leader_thread) {
    asm volatile("s_waitcnt vmcnt(0)" ::: "memory");
    __syncthreads();
    if (leader_thread) {
        unsigned* bar = b.bar;
        __builtin_amdgcn_s_waitcnt(0);
        unsigned nloc = b.st[0], nx = b.st[1];
        if (nloc == 0u) { xcd_barrier_complete(bar, b.x, nloc, nx); b.st[0] = nloc; b.st[1] = nx; }
        const unsigned old = xb_add(&bar[XB_XSUB(b.x)], 1u);
        const unsigned gen = old / nloc;
        if (old + 1u == (gen + 1u) * nloc) {
            __builtin_amdgcn_fence(__ATOMIC_RELEASE, "agent");
            asm volatile("s_waitcnt vmcnt(0)" ::: "memory");
            const unsigned og = xb_add(&bar[XB_TOP], 1u);
            const unsigned tg = og / nx;
            if (og + 1u == (tg + 1u) * nx) xb_add(&bar[XB_TOPGEN], 1u);
            else XB_SPIN(xb_ld(&bar[XB_TOPGEN]) == tg, bar);
            __builtin_amdgcn_fence(__ATOMIC_ACQUIRE, "agent");
            xb_add(&bar[XB_XGEN(b.x)], 1u);
            asm volatile("s_waitcnt vmcnt(0)" ::: "memory");
        } else {
            XB_SPIN(xb_ld(&bar[XB_XGEN(b.x)]) == gen, bar);
            __builtin_amdgcn_fence(__ATOMIC_ACQUIRE, "agent");
            asm volatile("s_waitcnt vmcnt(0)" ::: "memory");
        }
    }
    __syncthreads();
}

struct Args { const void* in[33]; float* out; unsigned char* ws; int ph_lo, ph_hi; };
struct Ctx {
    LAS unsigned char* lds;
    int tid, lane, wid, G, vcu;
    const Args& a;
    unsigned char* ws;
    float oscale;
};
template <class T> __device__ __forceinline__ T* wsp(const Ctx& c, size_t off) { return (T*)(c.ws + off); }
__device__ __forceinline__ const float* inp(const Ctx& c, int i) { return (const float*)c.a.in[i]; }
__device__ __forceinline__ const float* modp(const Ctx& c, int l, int b, int which) { return wsp<const float>(c, WS_MOD) + ((size_t)(l * NB + b) * 6 + which) * DM; }
namespace ge {
constexpr int BM = 256, BK = 64, HALF = 128, HTB = HALF * BK * 2, STAGE_BYTES = 8 * HTB;
__device__ __forceinline__ int lds_byte(int r, int c) { const int st = (r >> 4) * 2 + (c >> 5), rr = r & 15, cc = c & 31, ob = rr * 64 + cc * 2; return st * 1024 + (ob ^ (((ob >> 9) & 1) << 5)); }
__device__ __forceinline__ void stage_rc(int b, int& R, int& C) { const int st = b / 1024, sb = b % 1024, swz = sb ^ (((sb >> 9) & 1) << 5); R = (st >> 1) * 16 + swz / 64; C = (st & 1) * 32 + (swz % 64) / 2; }
__device__ __forceinline__ int perm32(int rho) { const int n = rho >> 4, i = rho & 15; return 8 * (i >> 2) + 4 * n + (i & 3); }

struct Ops { const char* a0; const char* a1; const char* b0; const char* b1; long ksA, ksB; int nt; };
struct Lane { int R[2], Rb[2], C[2]; };
struct Off { unsigned a[2][2]; unsigned b[2]; };
typedef f32x4 Acc[2][2][4][2];

template <class P>
__device__ __forceinline__ void run(LAS unsigned char* lds, const P& prog, const int tid) {
    const int wid = __builtin_amdgcn_readfirstlane(tid >> 6), lane = tid & 63, wr = wid >> 2, wc = wid & 3, fr = lane & 15, fq = lane >> 4;
#define GE_LANE(ln) Lane ln; { int t_ = tid; asm volatile("" : "+v"(t_)); _Pragma("unroll") for (int i = 0; i < 2; ++i) { stage_rc(t_ * 16 + i * 8192, ln.R[i], ln.C[i]); ln.Rb[i] = (ln.R[i] & ~31) + perm32(ln.R[i] & 31); } }
    const unsigned ldsw = (unsigned)wid * 1024u;
    const int aoff = lds_byte(wr * 64 + fr, fq * 8), boff = lds_byte(wc * 32 + fr, fq * 8);
#define GE_SA(b, h) (((b) * 2 + (h)) * HTB)
#define GE_SB(b, h) ((4 + (b) * 2 + (h)) * HTB)
#define GE_STAGE(bufoff, gbase, v0, v1) do { unsigned o0_ = (v0), o1_ = (v1); asm volatile("" : "+v"(o0_), "+v"(o1_)); \
        __builtin_amdgcn_global_load_lds((const unsigned*)((const char*)(gbase) + o0_), (LAS unsigned*)(lds + (bufoff) + ldsw), 16, 0, 0); \
        __builtin_amdgcn_global_load_lds((const unsigned*)((const char*)(gbase) + o1_), (LAS unsigned*)(lds + (bufoff) + ldsw + 8192), 16, 0, 0); } while (0)
#define GE_LDA(dst, b, h) do { _Pragma("unroll") for (int m = 0; m < 4; ++m) _Pragma("unroll") for (int k = 0; k < 2; ++k) dst[m][k] = *(const LAS bf16x8*)(lds + GE_SA(b, h) + aoff + m * 2048 + k * 1024); } while (0)
#define GE_LDB(dst, b, h) do { _Pragma("unroll") for (int n = 0; n < 2; ++n) _Pragma("unroll") for (int k = 0; k < 2; ++k) dst[n][k] = *(const LAS bf16x8*)(lds + GE_SB(b, h) + boff + n * 2048 + k * 1024); } while (0)
#define GE_MMA(ai, bj, At, Bt) do { __builtin_amdgcn_s_setprio(1); _Pragma("unroll") for (int m = 0; m < 4; ++m) _Pragma("unroll") for (int n = 0; n < 2; ++n) _Pragma("unroll") for (int k = 0; k < 2; ++k) \
        acc[ai][bj][m][n] = __builtin_amdgcn_mfma_f32_16x16x32_bf16(Bt[n][k], At[m][k], acc[ai][bj][m][n], 0, 0, 0); __builtin_amdgcn_s_setprio(0); } while (0)
#define GE_WAIT_V(n) asm volatile("s_waitcnt vmcnt(" #n ")" ::: "memory")
#define GE_WAIT_L(n) asm volatile("s_waitcnt lgkmcnt(" #n ")" ::: "memory")
#define GE_BAR __builtin_amdgcn_s_barrier()
#define GE_SCHED __builtin_amdgcn_sched_barrier(0)
    typename P::Unit cur, nxt; int ui = 0;
    if (!prog.next(0, cur)) return;
    Ops co, no; prog.ops(cur, co);
    Off v, nv; { GE_LANE(ln) prog.voff(cur, ln, v); }
    Acc acc;
#pragma unroll
    for (int a = 0; a < 2; ++a)
#pragma unroll
        for (int b = 0; b < 2; ++b)
#pragma unroll
            for (int m = 0; m < 4; ++m)
#pragma unroll
                for (int n = 0; n < 2; ++n) acc[a][b][m][n] = (f32x4){0.f, 0.f, 0.f, 0.f};
    bf16x8 At[4][2], B0[2][2], B1[2][2];
    GE_STAGE(GE_SB(0, 0), co.b0, v.b[0], v.b[1]); GE_STAGE(GE_SB(0, 1), co.b1, v.b[0], v.b[1]); GE_STAGE(GE_SA(0, 0), co.a0, v.a[0][0], v.a[0][1]); GE_STAGE(GE_SA(0, 1), co.a1, v.a[P::GATHER][0], v.a[P::GATHER][1]);
    if (wr == 1) GE_BAR;
    GE_WAIT_V(2); GE_BAR;
    GE_STAGE(GE_SB(1, 0), co.b0 + co.ksB, v.b[0], v.b[1]); GE_STAGE(GE_SA(1, 0), co.a0 + co.ksA, v.a[0][0], v.a[0][1]); GE_STAGE(GE_SB(1, 1), co.b1 + co.ksB, v.b[0], v.b[1]);
    GE_WAIT_V(6); GE_BAR;
    for (;;) {
        const bool has_next = prog.next(ui + 1, nxt);
        if (has_next) { prog.ops(nxt, no); if constexpr (P::VAR_OFF) { GE_LANE(ln) prog.voff(nxt, ln, nv); } } else { no = co; if constexpr (P::VAR_OFF) nv = v; }
        const int nt = co.nt;
        for (int t = 0; t < nt; t += 2) {
            const bool last = (t == nt - 2);
            const char* a1h1 = co.a1 + (long)(t + 1) * co.ksA;
            const char* a2h0 = last ? no.a0 : co.a0 + (long)(t + 2) * co.ksA; const char* a2h1 = last ? no.a1 : co.a1 + (long)(t + 2) * co.ksA;
            const char* b2h0 = last ? no.b0 : co.b0 + (long)(t + 2) * co.ksB; const char* b2h1 = last ? no.b1 : co.b1 + (long)(t + 2) * co.ksB;
            const long ks2A = last ? no.ksA : co.ksA, ks2B = last ? no.ksB : co.ksB;
            const char* a3h0 = a2h0 + ks2A; const char* b3h0 = b2h0 + ks2B; const char* b3h1 = b2h1 + ks2B;
            unsigned wa00 = v.a[0][0], wa01 = v.a[0][1], wa10 = v.a[P::GATHER][0], wa11 = v.a[P::GATHER][1], wb0 = v.b[0], wb1 = v.b[1];
            if constexpr (P::VAR_OFF) { if (last) { wa00 = nv.a[0][0]; wa01 = nv.a[0][1]; wa10 = nv.a[P::GATHER][0]; wa11 = nv.a[P::GATHER][1]; wb0 = nv.b[0]; wb1 = nv.b[1]; } }
            GE_LDB(B0, 0, 0); GE_LDB(B1, 0, 1); GE_SCHED; GE_LDA(At, 0, 0); GE_STAGE(GE_SA(1, 1), a1h1, v.a[P::GATHER][0], v.a[P::GATHER][1]);
            GE_WAIT_V(8); GE_WAIT_L(0); GE_BAR; GE_MMA(0, 0, At, B0); GE_MMA(0, 1, At, B1); GE_BAR; GE_SCHED;
            GE_LDA(At, 0, 1); GE_STAGE(GE_SB(0, 0), b2h0, wb0, wb1); GE_STAGE(GE_SB(0, 1), b2h1, wb0, wb1); GE_STAGE(GE_SA(0, 0), a2h0, wa00, wa01);
            GE_WAIT_V(8); GE_WAIT_L(0); GE_BAR; GE_MMA(1, 0, At, B0); GE_MMA(1, 1, At, B1); GE_BAR; GE_SCHED;
            GE_LDB(B0, 1, 0); GE_LDB(B1, 1, 1); GE_SCHED; GE_LDA(At, 1, 0); GE_STAGE(GE_SA(0, 1), a2h1, wa10, wa11);
            GE_WAIT_V(8); GE_WAIT_L(0); GE_BAR; GE_MMA(0, 0, At, B0); GE_MMA(0, 1, At, B1); GE_BAR; GE_SCHED;
            GE_LDA(At, 1, 1); GE_STAGE(GE_SB(1, 0), b3h0, wb0, wb1); GE_STAGE(GE_SB(1, 1), b3h1, wb0, wb1); GE_STAGE(GE_SA(1, 0), a3h0, wa00, wa01);
            GE_WAIT_V(8); GE_WAIT_L(0); GE_BAR; GE_MMA(1, 0, At, B0); GE_MMA(1, 1, At, B1); GE_BAR; GE_SCHED;
        }
        if (wr == 0) GE_BAR;
        prog.epi(acc, cur, wr, wc, fr, fq);
        if (!has_next) break;
#pragma unroll
        for (int a = 0; a < 2; ++a)
#pragma unroll
            for (int b = 0; b < 2; ++b)
#pragma unroll
                for (int m = 0; m < 4; ++m)
#pragma unroll
                    for (int n = 0; n < 2; ++n) acc[a][b][m][n] = (f32x4){0.f, 0.f, 0.f, 0.f};
        cur = nxt; co = no; if constexpr (P::VAR_OFF) v = nv; ++ui;
        if (wr == 1) GE_BAR;
    }
    GE_WAIT_V(0);
    GE_BAR;
#undef GE_LANE
#undef GE_SA
#undef GE_SB
#undef GE_STAGE
#undef GE_LDA
#undef GE_LDB
#undef GE_MMA
#undef GE_WAIT_V
#undef GE_WAIT_L
#undef GE_BAR
#undef GE_SCHED
}
__device__ __forceinline__ void off_rm(const Lane& ln, int lda, int ldb, Off& v) {
#pragma unroll
    for (int i = 0; i < 2; ++i) { v.a[0][i] = (unsigned)(ln.R[i] * lda + ln.C[i]) * 2u; v.b[i] = (unsigned)(ln.Rb[i] * ldb + ln.C[i]) * 2u; }
}
}
struct StaticOrder {
    int nM, nN, nwg, G, c;
    __device__ void init(int M, int N, int G_, int c_) { nM = M / 256; nN = N / 256; nwg = nM * nN; G = G_; c = c_; }
    __device__ __forceinline__ bool next(int i, int& pm, int& pn) const {
        const long L = (long)i * G + c; if (L >= nwg) return false;
        int wgid = (int)L; { const int q = nwg / 8, r = nwg % 8, xcd = wgid % 8, off = wgid / 8; wgid = (xcd < r ? xcd * (q + 1) : r * (q + 1) + (xcd - r) * q) + off; }
        const int nig = 8 * nN, gid = wgid / nig, fm = gid * 8, gsz = (nM - fm) < 8 ? (nM - fm) : 8;
        pm = fm + ((wgid % nig) % gsz); pn = (wgid % nig) / gsz; return true;
    }
};
#define EPI_ROWS_BEGIN _Pragma("unroll") for (int ai = 0; ai < 2; ++ai) _Pragma("unroll") for (int m = 0; m < 4; ++m) { const int rt = 128 * ai + 64 * wr + 16 * m + fr;
#define EPI_ROWS_END if (m == 3) asm volatile("" ::: "memory"); }
__device__ __forceinline__ float gelu_tanh(float y) {
    const float u = 0.7978845608028654f * (y + 0.044715f * y * y * y);
    const float e = fast_exp2(u * 2.8853900817779268f);
    const float th = 1.f - 2.f * fast_rcp(1.f + e);
    return 0.5f * y * (1.f + th);
}
__device__ __forceinline__ float sigmoidf_(float x) { return fast_rcp(1.f + fast_exp2(-1.4426950408889634f * x)); }

struct ProgG1 {
    static constexpr int VAR_OFF = 0, GATHER = 0;
    struct Unit { int pm, pn; };
    StaticOrder so; const char* A; const char* B; bf16_t* Z; bf16_t* U; float* ssqp;
    __device__ __forceinline__ bool next(int i, Unit& u) const { return so.next(i, u.pm, u.pn); }
    __device__ __forceinline__ void ops(const Unit& u, ge::Ops& o) const {
        o.a0 = A + (size_t)u.pm * 256 * DM * 2; o.a1 = o.a0 + (size_t)128 * DM * 2; o.b0 = B + (size_t)u.pn * 256 * DM * 2; o.b1 = o.b0 + (size_t)128 * DM * 2; o.ksA = 128; o.ksB = 128; o.nt = DM / 64; }
    __device__ __forceinline__ void voff(const Unit&, const ge::Lane& ln, ge::Off& v) const { ge::off_rm(ln, DM, DM, v); }
    __device__ __forceinline__ void epi(const ge::Acc& acc, const Unit& u, int wr, int wc, int fr, int fq) const {
        const int pn = u.pn; const int cl = 32 * wc + 8 * fq;
        EPI_ROWS_BEGIN
            const int row = u.pm * 256 + rt;
            float ss = 0.f;
#pragma unroll
            for (int bj = 0; bj < 2; ++bj) {
                const f32x4 v0 = acc[ai][bj][m][0], v1 = acc[ai][bj][m][1]; const int c = 128 * bj + cl;
                const u32x4 w = pack8f(v0, v1);
                ss += (v0[0] * v0[0] + v0[1] * v0[1]) + (v0[2] * v0[2] + v0[3] * v0[3]) + (v1[0] * v1[0] + v1[1] * v1[1]) + (v1[2] * v1[2] + v1[3] * v1[3]);
                if (pn < 2) *(u32x4*)(Z + (size_t)row * ZLD + Z_POOL + 256 * pn + c) = w;
                else if (pn < 4) { const int ch = 256 * (pn - 2) + c; *(u32x4*)(U + ((size_t)(ch >> 4) * NTOK + row) * 16 + (ch & 15)) = w; }
                else if (pn < 6) *(u32x4*)(Z + (size_t)row * ZLD + Z_QC + 256 * (pn - 4) + c) = w;
                else if (pn == 6) *(u32x4*)(Z + (size_t)row * ZLD + Z_KVC + c) = w;
                else if (c < 64) *(u32x4*)(Z + (size_t)row * ZLD + Z_KPE + c) = w;
            }
            if (pn >= 4 && pn <= 6) { ss += __shfl_xor(ss, 16); ss += __shfl_xor(ss, 32); if (fq == 0) ssqp[(size_t)row * 12 + (pn - 4) * 4 + wc] = ss; }
        EPI_ROWS_END
    }
};

struct ProgG2 {
    static constexpr int VAR_OFF = 1, GATHER = 0;
    struct Unit { int type, pm, pn, g; };
    int G, c;
    const char* Z; const char* U; const char* WUQ; const char* WUKV; const char* WPOOL; const char* SSMTAB;
    const float* ssqp; const f32x2* CS;
    bf16_t* Q; bf16_t* K; bf16_t* V; bf16_t* P; bf16_t* YI; float* EBUF;
    static constexpr int N_SSM = 320, N_Q = 768, N_KV = 1024, N_POOL = 256, N_ALL = N_SSM + N_Q + N_KV + N_POOL;
    __device__ __forceinline__ bool next(int i, Unit& u) const {
        const int x = c & 7, W = G >> 3; int L = (c >> 3) + W * i;
        if (L < 40) { u.type = 0; u.pn = 4 - (L >> 3); const int r = 8 * x + (L & 7); u.g = r >> 1; u.pm = r & 1; return true; } L -= 40;
        if (L < 96) { u.type = 1; u.pm = 16 * x + L / 6; u.pn = L % 6; u.g = 0; return true; } L -= 96;
        if (L < 128) { u.type = 2; u.pm = 16 * x + (L >> 3); u.pn = L & 7; u.g = 0; return true; } L -= 128;
        if (L < 32) { u.type = 3; u.pm = 16 * x + (L >> 1); u.pn = L & 1; u.g = 0; return true; }
        return false;
    }
    __device__ __forceinline__ void ops(const Unit& u, ge::Ops& o) const {
        if (u.type == 0) {
            o.a0 = U + ((size_t)u.g * NTOK * 16 + (size_t)u.pm * 256 * 1024) * 2; o.a1 = o.a0 + (size_t)128 * 1024 * 2; o.ksA = 128;
            const char* tab = SSMTAB + (size_t)u.g * SSMTAB_STRIDE;
            if (u.pn < 4) { o.b0 = tab + SSM_TG + (size_t)(16 * u.pn + 60) * 512; o.b1 = o.b0 + 8 * 512; o.ksB = -2048; o.nt = 4 * (u.pn + 1); }
            else { o.b0 = tab + SSM_TEND; o.b1 = o.b0; o.ksB = 16384; o.nt = 16; }
        } else if (u.type == 1) {
            o.a0 = Z + ((size_t)u.pm * 256 * ZLD + Z_QC) * 2; o.a1 = o.a0 + (size_t)128 * ZLD * 2; o.ksA = 128;
            o.b0 = WUQ + (size_t)u.pn * 256 * 512 * 2; o.b1 = o.b0 + (size_t)128 * 512 * 2; o.ksB = 128; o.nt = 8;
        } else if (u.type == 2) {
            o.a0 = Z + ((size_t)u.pm * 256 * ZLD + Z_KVC) * 2; o.a1 = o.a0 + (size_t)128 * ZLD * 2; o.ksA = 128;
            o.b0 = WUKV + (size_t)u.pn * 256 * 256 * 2; o.b1 = o.b0 + (size_t)128 * 256 * 2; o.ksB = 128; o.nt = 4;
        } else {
            o.a0 = Z + ((size_t)u.pm * 256 * ZLD + Z_POOL + 256 * u.pn) * 2; o.a1 = o.a0 + (size_t)128 * ZLD * 2; o.ksA = 128;
            o.b0 = WPOOL + (size_t)u.pn * 256 * 256 * 2; o.b1 = o.b0 + (size_t)128 * 256 * 2; o.ksB = 128; o.nt = 4;
        }
    }
    __device__ __forceinline__ void voff(const Unit& u, const ge::Lane& ln, ge::Off& v) const {
#pragma unroll
        for (int i = 0; i < 2; ++i) {
            const int R = ln.R[i], Rb = ln.Rb[i], C = ln.C[i]; unsigned a, b;
            if (u.type == 0) {
                a = (unsigned)(R * 1024 + C) * 2u;
                if (u.pn < 4) b = (unsigned)(((Rb >> 4) - (C >> 4) + 3) * 256 + (Rb & 15) * 16 + (C & 15)) * 2u;
                else b = (unsigned)((((C >> 4) * 128 + Rb) * 16) + (C & 15)) * 2u;
            } else if (u.type == 1) { a = (unsigned)(R * ZLD + C) * 2u; b = (unsigned)(Rb * 512 + C) * 2u; }
            else { a = (unsigned)(R * ZLD + C) * 2u; b = (unsigned)(Rb * 256 + C) * 2u; }
            v.a[0][i] = a; v.b[i] = b;
        }
    }
    __device__ __forceinline__ void epi(const ge::Acc& acc, const Unit& u, int wr, int wc, int fr, int fq) const {
        const int cl = 32 * wc + 8 * fq;
        if (u.type == 0) {
            EPI_ROWS_BEGIN
                const int cg = u.pm * 256 + rt;
                if (u.pn < 4) {
#pragma unroll
                    for (int bj = 0; bj < 2; ++bj) { const int n = 128 * bj + cl, t = 16 * u.pn + (n >> 4), h0 = n & 15;
                        *(u32x4*)(YI + ((size_t)cg * 64 + t) * 512 + u.g * 16 + h0) = pack8f(acc[ai][bj][m][0], acc[ai][bj][m][1]); }
                } else {
                    float* e = EBUF + ((size_t)cg * SSM_G + u.g) * 128 + cl;
                    *(f32x4*)e = acc[ai][0][m][0]; *(f32x4*)(e + 4) = acc[ai][0][m][1];
                }
            EPI_ROWS_END
        } else if (u.type == 1) {
            constexpr float QSCALE = 0.07216878364870322f * 1.4426950408889634f;
            EPI_ROWS_BEGIN
                const int row = u.pm * 256 + rt; const int b = row >> 14, t = row & (SEQ - 1);
                const f32x4 sa = *(const f32x4*)(ssqp + (size_t)row * 12), sb = *(const f32x4*)(ssqp + (size_t)row * 12 + 4);
                const float rs = rsqrtf((((sa[0] + sa[1]) + (sa[2] + sa[3])) + ((sb[0] + sb[1]) + (sb[2] + sb[3]))) * (1.f / 512.f) + EPS) * QSCALE;
#pragma unroll
                for (int bj = 0; bj < 2; ++bj) {
                    const int c = 256 * u.pn + 128 * bj + cl; const int head = c / QKD, d = c - head * QKD;
                    f32x4 v0 = acc[ai][bj][m][0] * rs, v1 = acc[ai][bj][m][1] * rs;
                    if (d >= 128) {
                        const f32x2* cs = CS + (size_t)row * 32 + ((d - 128) >> 1);
                        const f32x4 c01 = *(const f32x4*)cs, c23 = *(const f32x4*)(cs + 2);
                        f32x4 o0, o1;
                        o0[0] = v0[0] * c01[0] - v0[1] * c01[1]; o0[1] = v0[1] * c01[0] + v0[0] * c01[1];
                        o0[2] = v0[2] * c01[2] - v0[3] * c01[3]; o0[3] = v0[3] * c01[2] + v0[2] * c01[3];
                        o1[0] = v1[0] * c23[0] - v1[1] * c23[1]; o1[1] = v1[1] * c23[0] + v1[0] * c23[1];
                        o1[2] = v1[2] * c23[2] - v1[3] * c23[3]; o1[3] = v1[3] * c23[2] + v1[2] * c23[3];
                        v0 = o0; v1 = o1;
                    }
                    *(u32x4*)(Q + ((size_t)(b * NHEAD + head) * SEQ + t) * QKD + d) = pack8f(v0, v1);
                }
            EPI_ROWS_END
        } else if (u.type == 2) {
            EPI_ROWS_BEGIN
                const int row = u.pm * 256 + rt; const int b = row >> 14, t = row & (SEQ - 1);
                const f32x4 sa = *(const f32x4*)(ssqp + (size_t)row * 12 + 8);
                const float rs = rsqrtf(((sa[0] + sa[1]) + (sa[2] + sa[3])) * (1.f / 256.f) + EPS);
#pragma unroll
                for (int bj = 0; bj < 2; ++bj) {
                    const int d = 128 * bj + cl; const int head = u.pn;
                    const u32x4 w = pack8f(acc[ai][bj][m][0] * rs, acc[ai][bj][m][1] * rs);
                    if (d < 128) *(u32x4*)(K + ((size_t)(b * NHEAD + head) * SEQ + t) * QKD + d) = w;
                    else *(u32x4*)(V + ((size_t)(b * NHEAD + head) * SEQ + t) * VD + (d - 128)) = w;
                }
            EPI_ROWS_END
        } else {
            EPI_ROWS_BEGIN
                const int row = u.pm * 256 + rt;
#pragma unroll
                for (int bj = 0; bj < 2; ++bj) *(u32x4*)(P + (size_t)row * 512 + 256 * u.pn + 128 * bj + cl) = pack8f(acc[ai][bj][m][0], acc[ai][bj][m][1]);
            EPI_ROWS_END
        }
    }
};

struct ProgS1 {
    static constexpr int VAR_OFF = 0, GATHER = 0;
    struct Unit { int g, pm, pn; };
    int G, c; const char* SPREV; const char* SSMTAB; const bf16_t* YI; const bf16_t* U; const float* Dskip; bf16_t* YG;
    __device__ __forceinline__ bool next(int i, Unit& u) const { const int x = c & 7, L = (c >> 3) + (G >> 3) * i; if (L >= 32) return false; const int r = 8 * x + (L >> 2); u.g = r >> 1; u.pm = r & 1; u.pn = L & 3; return true; }
    __device__ __forceinline__ void ops(const Unit& u, ge::Ops& o) const {
        o.a0 = SPREV + ((size_t)u.pm * 256 * (SSM_G * 256) + u.g * 256) * 2; o.a1 = o.a0 + (size_t)128 * (SSM_G * 256) * 2; o.ksA = 128;
        o.b0 = SSMTAB + (size_t)u.g * SSMTAB_STRIDE + SSM_WC + (size_t)u.pn * 256 * 256 * 2; o.b1 = o.b0 + (size_t)128 * 256 * 2; o.ksB = 128; o.nt = 4; }
    __device__ __forceinline__ void voff(const Unit&, const ge::Lane& ln, ge::Off& v) const { ge::off_rm(ln, SSM_G * 256, 256, v); }
    __device__ __forceinline__ void epi(const ge::Acc& acc, const Unit& u, int wr, int wc, int fr, int fq) const {
        const int cl = 32 * wc + 8 * fq;
        EPI_ROWS_BEGIN
            const int cg = u.pm * 256 + rt;
#pragma unroll
            for (int bj = 0; bj < 2; ++bj) {
                const int n = 128 * bj + cl, t = 16 * u.pn + (n >> 4), h0 = n & 15; const size_t tok = (size_t)cg * 64 + t; const int ch = u.g * 16 + h0;
                f32x4 yi0, yi1, u0, u1; unpack8(*(const u32x4*)(YI + tok * 512 + ch), yi0, yi1); unpack8(*(const u32x4*)(U + ((size_t)u.g * NTOK + tok) * 16 + h0), u0, u1);
                const f32x4 d0 = *(const f32x4*)(Dskip + ch), d1 = *(const f32x4*)(Dskip + ch + 4);
                f32x4 y0 = acc[ai][bj][m][0] + yi0 + d0 * u0, y1 = acc[ai][bj][m][1] + yi1 + d1 * u1;
#pragma unroll
                for (int e = 0; e < 4; ++e) { y0[e] = gelu_tanh(y0[e]); y1[e] = gelu_tanh(y1[e]); }
                *(u32x4*)(YG + tok * 512 + ch) = pack8f(y0, y1);
            }
        EPI_ROWS_END
    }
};

struct ProgS2 {
    static constexpr int VAR_OFF = 0, GATHER = 0;
    struct Unit { int pm, pn; };
    int G, c; const char* YGc; const char* W; const bf16_t* YG; bf16_t* GL;
    __device__ __forceinline__ bool next(int i, Unit& u) const { const int x = c & 7, L = (c >> 3) + (G >> 3) * i; if (L >= 32) return false; u.pm = 16 * x + (L >> 1); u.pn = L & 1; return true; }
    __device__ __forceinline__ void ops(const Unit& u, ge::Ops& o) const {
        o.a0 = YGc + (size_t)u.pm * 256 * 512 * 2; o.a1 = o.a0 + (size_t)128 * 512 * 2; o.ksA = 128; o.b0 = W + (size_t)u.pn * 256 * 512 * 2; o.b1 = o.b0 + (size_t)128 * 512 * 2; o.ksB = 128; o.nt = 8; }
    __device__ __forceinline__ void voff(const Unit&, const ge::Lane& ln, ge::Off& v) const { ge::off_rm(ln, 512, 512, v); }
    __device__ __forceinline__ void epi(const ge::Acc& acc, const Unit& u, int wr, int wc, int fr, int fq) const {
        const int cl = 32 * wc + 8 * fq;
        EPI_ROWS_BEGIN
            const size_t row = (size_t)u.pm * 256 + rt;
#pragma unroll
            for (int bj = 0; bj < 2; ++bj) {
                const int c = 256 * u.pn + 128 * bj + cl; f32x4 y0, y1; unpack8(*(const u32x4*)(YG + row * 512 + c), y0, y1);
                f32x4 a0 = acc[ai][bj][m][0], a1 = acc[ai][bj][m][1];
#pragma unroll
                for (int e = 0; e < 4; ++e) { y0[e] *= sigmoidf_(a0[e]); y1[e] *= sigmoidf_(a1[e]); }
                *(u32x4*)(GL + row * 512 + c) = pack8f(y0, y1);
            }
        EPI_ROWS_END
    }
};

struct ProgG3 {
    static constexpr int VAR_OFF = 0, GATHER = 0;
    struct Unit { int pm, pn; };
    StaticOrder so; const char* A; const char* B; const float* xin; const bf16_t* xin16; bf16_t* xout; const float* ga;
    __device__ __forceinline__ bool next(int i, Unit& u) const { return so.next(i, u.pm, u.pn); }
    __device__ __forceinline__ void ops(const Unit& u, ge::Ops& o) const {
        o.a0 = A + (size_t)u.pm * 256 * DM * 2; o.a1 = o.a0 + (size_t)128 * DM * 2; o.b0 = B + (size_t)u.pn * 256 * DM * 2; o.b1 = o.b0 + (size_t)128 * DM * 2; o.ksA = 128; o.ksB = 128; o.nt = DM / 64; }
    __device__ __forceinline__ void voff(const Unit&, const ge::Lane& ln, ge::Off& v) const { ge::off_rm(ln, DM, DM, v); }
    __device__ __forceinline__ void epi(const ge::Acc& acc, const Unit& u, int wr, int wc, int fr, int fq) const {
        const int cl = 32 * wc + 8 * fq; const int b = (u.pm * 256) >> 14;
        f32x4 g[2][2];
#pragma unroll
        for (int bj = 0; bj < 2; ++bj) { const float* gp = ga + (size_t)b * 6 * DM + 256 * u.pn + 128 * bj + cl; g[bj][0] = *(const f32x4*)gp; g[bj][1] = *(const f32x4*)(gp + 4); }
        EPI_ROWS_BEGIN
            const size_t row = (size_t)u.pm * 256 + rt;
#pragma unroll
            for (int bj = 0; bj < 2; ++bj) {
                const size_t o = row * DM + 256 * u.pn + 128 * bj + cl;
                f32x4 x0, x1;
                if (xin) { x0 = *(const f32x4*)(xin + o); x1 = *(const f32x4*)(xin + o + 4); } else unpack8(*(const u32x4*)(xin16 + o), x0, x1);
                *(u32x4*)(xout + o) = pack8f(x0 + g[bj][0] * acc[ai][bj][m][0], x1 + g[bj][1] * acc[ai][bj][m][1]);
            }
        EPI_ROWS_END
    }
};

struct ProgM1 {
    static constexpr int VAR_OFF = 1, GATHER = 1;
    struct Unit { int k, pn, e, j; };
    int G, c; const LAS int* tab; int ntiles; const int* cnt; const int* toks; const char* H; const char* W13; bf16_t* ACT;
    __device__ __forceinline__ bool next(int i, Unit& u) const { const int x = c & 7, t0 = (x * ntiles) >> 3, t1 = ((x + 1) * ntiles) >> 3, L = (c >> 3) + (G >> 3) * i; if (L >= (t1 - t0) * 4) return false; u.k = t0 + (L >> 2); u.pn = L & 3; const int w = __builtin_amdgcn_readfirstlane(tab[u.k]); u.e = w >> 16; u.j = w & 0xffff; return true; }
    __device__ __forceinline__ void ops(const Unit& u, ge::Ops& o) const {
        o.a0 = H; o.a1 = H; o.ksA = 128; o.b0 = W13 + ((size_t)u.e * 1024 + 128 * u.pn) * DM * 2; o.b1 = o.b0 + (size_t)512 * DM * 2; o.ksB = 128; o.nt = DM / 64; }
    __device__ __forceinline__ void voff(const Unit& u, const ge::Lane& ln, ge::Off& v) const {
        const int n = __builtin_amdgcn_readfirstlane(cnt[u.e * 64]); const int* tl = toks + (size_t)u.e * NTOK + u.j * 256;
#pragma unroll
        for (int i = 0; i < 2; ++i) {
#pragma unroll
            for (int h = 0; h < 2; ++h) { const int r = 128 * h + ln.R[i]; const int tok = (u.j * 256 + r < n) ? tl[r] : 0; v.a[h][i] = (unsigned)(tok * DM + ln.C[i]) * 2u; }
            v.b[i] = (unsigned)(ln.Rb[i] * DM + ln.C[i]) * 2u;
        }
    }
    __device__ __forceinline__ void epi(const ge::Acc& acc, const Unit& u, int wr, int wc, int fr, int fq) const {
        const int cl = 32 * wc + 8 * fq;
        EPI_ROWS_BEGIN
            const size_t pos = (size_t)u.k * 256 + rt;
            f32x4 g0 = acc[ai][0][m][0], g1 = acc[ai][0][m][1]; const f32x4 u0 = acc[ai][1][m][0], u1 = acc[ai][1][m][1];
#pragma unroll
            for (int e = 0; e < 4; ++e) { g0[e] = g0[e] * sigmoidf_(g0[e]) * u0[e]; g1[e] = g1[e] * sigmoidf_(g1[e]) * u1[e]; }
            *(u32x4*)(ACT + pos * DEXP + 128 * u.pn + cl) = pack8f(g0, g1);
        EPI_ROWS_END
    }
};
struct ProgM2 {
    static constexpr int VAR_OFF = 0, GATHER = 0;
    struct Unit { int k, pn, e; };
    int G, c; const LAS int* tab; int ntiles; const char* ACT; const char* W2; unsigned char* Y2;
    __device__ __forceinline__ bool next(int i, Unit& u) const { const int x = c & 7, t0 = (x * ntiles) >> 3, t1 = ((x + 1) * ntiles) >> 3, L = (c >> 3) + (G >> 3) * i; if (L >= (t1 - t0) * 8) return false; u.k = t0 + (L >> 3); u.pn = L & 7; u.e = __builtin_amdgcn_readfirstlane(tab[u.k]) >> 16; return true; }
    __device__ __forceinline__ void ops(const Unit& u, ge::Ops& o) const {
        o.a0 = ACT + (size_t)u.k * 256 * DEXP * 2; o.a1 = o.a0 + (size_t)128 * DEXP * 2; o.ksA = 128; o.b0 = W2 + ((size_t)u.e * DM + 256 * u.pn) * DEXP * 2; o.b1 = o.b0 + (size_t)128 * DEXP * 2; o.ksB = 128; o.nt = DEXP / 64; }
    __device__ __forceinline__ void voff(const Unit&, const ge::Lane& ln, ge::Off& v) const { ge::off_rm(ln, DEXP, DEXP, v); }
    __device__ __forceinline__ void epi(const ge::Acc& acc, const Unit& u, int wr, int wc, int fr, int fq) const {
        const int cl = 32 * wc + 8 * fq;
        EPI_ROWS_BEGIN
            const size_t pos = (size_t)u.k * 256 + rt;
#pragma unroll
            for (int bj = 0; bj < 2; ++bj) { f32x4 v0 = acc[ai][bj][m][0], v1 = acc[ai][bj][m][1];
#pragma unroll
                for (int e = 0; e < 4; ++e) { v0[e] = fminf(fmaxf(v0[e], -448.f), 448.f); v1[e] = fminf(fmaxf(v1[e], -448.f), 448.f); }
                int w0 = __builtin_amdgcn_cvt_pk_fp8_f32(v0[0], v0[1], 0, false); w0 = __builtin_amdgcn_cvt_pk_fp8_f32(v0[2], v0[3], w0, true);
                int w1 = __builtin_amdgcn_cvt_pk_fp8_f32(v1[0], v1[1], 0, false); w1 = __builtin_amdgcn_cvt_pk_fp8_f32(v1[2], v1[3], w1, true);
                *(u32x2*)(Y2 + pos * DM + 256 * u.pn + 128 * bj + cl) = (u32x2){(unsigned)w0, (unsigned)w1}; }
        EPI_ROWS_END
    }
};
__device__ __forceinline__ int build_tile_table(const Ctx& c, const int* cnt) {
    LAS int* tab = (LAS int*)(c.lds + LDS_TILETAB); LAS int* ps = (LAS int*)(c.lds + LDS_PSTART);
    __syncthreads();
    if (c.tid < NEXP) {
        int before = 0, mine = 0;
        for (int e = 0; e < NEXP; ++e) { const int nt = (cnt[e * 64] + 255) >> 8; if (e < c.tid) before += nt; if (e == c.tid) mine = nt; }
        ps[c.tid] = before * 256;
        for (int j = 0; j < mine; ++j) tab[before + j] = (c.tid << 16) | j;
        if (c.tid == NEXP - 1) ps[NEXP] = before + mine;
    }
    __syncthreads();
    return ps[NEXP];
}
template <class F>
__device__ __forceinline__ void tr_item(const float* W, int ldw, int k0, int n0, const float* ksc, LAS float* scr, int lane, F dst) {
#pragma unroll 8
    for (int i = 0; i < 32; ++i) { const int kk = 2 * i + (lane >> 5); float v = W[(size_t)(k0 + kk) * ldw + n0 + (lane & 31)]; if (ksc) v *= ksc[k0 + kk]; scr[kk * 33 + (lane & 31)] = v; }
    LDS_WAIT(); asm volatile("" ::: "memory");
    const int cc = lane & 7;
#pragma unroll
    for (int j = 0; j < 4; ++j) { const int n = (lane >> 3) + 8 * j; const LAS float* s = scr + (8 * cc) * 33 + n;
        u32x4 o; o.x = cvtpk(s[0 * 33], s[1 * 33]); o.y = cvtpk(s[2 * 33], s[3 * 33]); o.z = cvtpk(s[4 * 33], s[5 * 33]); o.w = cvtpk(s[6 * 33], s[7 * 33]);
        bf16_t* d = dst(n0 + n); if (d) *(u32x4*)(d + k0 + 8 * cc) = o; }
    LDS_WAIT(); asm volatile("" ::: "memory");
}
__device__ __forceinline__ int rope_perm(int j) { return 2 * (j & 31) + (j >> 5); }

__device__ __forceinline__ void convert_experts(const Ctx& c, int l, int it0 = 0, int it1 = NEXP * 1536, int wg0 = 0) {
    LAS float* scr = (LAS float*)(c.lds + c.wid * 16384);
    if (c.vcu < wg0) return;
    const int gw = (c.vcu - wg0) * 8 + c.wid, NGW = (c.G - wg0) * 8;
    const float* wg = inp(c, 29) + (size_t)l * NEXP * DM * DEXP; const float* wu = inp(c, 30) + (size_t)l * NEXP * DM * DEXP; const float* wd = inp(c, 31) + (size_t)l * NEXP * DEXP * DM;
    bf16_t* W13 = wsp<bf16_t>(c, WS_W13); bf16_t* W2 = wsp<bf16_t>(c, WS_W2);
    for (int it = it0 + gw; it < it1; it += NGW) {
        const int e = it / 1536, r = it % 1536;
        if (r < 1024) { const int up = r >> 9, q = r & 511, kb = q >> 4, nb = q & 15; const float* W = (up ? wu : wg) + (size_t)e * DM * DEXP; bf16_t* D = W13 + ((size_t)e * 1024 + up * 512) * DM;
            tr_item(W, DEXP, kb * 64, nb * 32, nullptr, scr, c.lane, [=](int n) { return D + (size_t)n * DM; }); }
        else { const int q = r - 1024, kb = q >> 6, nb = q & 63; const float* W = wd + (size_t)e * DEXP * DM; bf16_t* D = W2 + (size_t)e * DM * DEXP;
            tr_item(W, DM, kb * 64, nb * 32, nullptr, scr, c.lane, [=](int n) { return D + (size_t)n * DEXP; }); }
    }
}

__device__ __forceinline__ void p0_prologue(const Ctx& c) {
    const int gw = c.vcu * 8 + c.wid, NGW = c.G * 8; const int gt = c.vcu * 512 + c.tid, NGT = c.G * 512;
    {
        LAS float* red = (LAS float*)c.lds;
        const float* cv = inp(c, 1);
        for (int item = c.vcu; item < 96; item += c.G) {
            const int l = item / 48, cb = item % 48;
            const float* w = inp(c, 3) + ((size_t)l * DM + 256 * c.wid) * (6 * DM) + cb * 256 + c.lane * 4;
            f32x4 a0 = {0.f, 0.f, 0.f, 0.f}, a1 = {0.f, 0.f, 0.f, 0.f};
#pragma unroll 8
            for (int k = 0; k < 256; ++k) { const f32x4 wv = *(const f32x4*)(w + (size_t)k * (6 * DM)); const float c0 = cv[256 * c.wid + k], c1 = cv[DM + 256 * c.wid + k]; a0 += wv * c0; a1 += wv * c1; }
            *(LAS f32x4*)(red + (c.wid * 2 + 0) * 256 + c.lane * 4) = a0; *(LAS f32x4*)(red + (c.wid * 2 + 1) * 256 + c.lane * 4) = a1;
            __syncthreads();
            { const int b = c.tid >> 8, col = c.tid & 255; float s = inp(c, 4)[(size_t)l * 6 * DM + cb * 256 + col];
#pragma unroll
              for (int w8 = 0; w8 < 8; ++w8) s += red[(w8 * 2 + b) * 256 + col];
              wsp<float>(c, WS_MOD)[((size_t)(l * NB + b) * 6) * DM + cb * 256 + col] = s; }
            __syncthreads();
        }
    }
    {
        LAS float* scr = (LAS float*)(c.lds + c.wid * 16384);
        constexpr int I_IN = 32 * 58, I_UQ = 8 * 48, I_UKV = 4 * 64, I_OUT = 32 * 64, I_GLU = 8 * 16, I_L = I_IN + I_UQ + I_UKV + I_OUT + I_GLU;
        for (int it = gw; it < 2 * I_L; it += NGW) {
            const int l = it / I_L; int r = it % I_L;
            if (r < I_IN) { const int kb = r / 58, nb = r % 58; bf16_t* D = wsp<bf16_t>(c, WS_WIN) + (size_t)l * DM * DM;
                tr_item(inp(c, 6) + (size_t)l * DM * IN_COLS, IN_COLS, kb * 64, nb * 32, nullptr, scr, c.lane, [=](int n) { const int dr = n < 1792 ? n : 1792 + rope_perm(n - 1792); return D + (size_t)dr * DM; }); continue; } r -= I_IN;
            if (r < I_UQ) { const int kb = r / 48, nb = r % 48; bf16_t* D = wsp<bf16_t>(c, WS_WUQ) + (size_t)l * 1536 * 512;
                tr_item(inp(c, 20) + (size_t)l * 512 * 1536, 1536, kb * 64, nb * 32, inp(c, 18) + l * 512, scr, c.lane, [=](int n) { const int h = n / QKD, d = n % QKD; const int dr = h * QKD + (d < 128 ? d : 128 + rope_perm(d - 128)); return D + (size_t)dr * 512; }); continue; } r -= I_UQ;
            if (r < I_UKV) { const int kb = r / 64, nb = r % 64; bf16_t* D = wsp<bf16_t>(c, WS_WUKV) + (size_t)l * 2048 * 256;
                tr_item(inp(c, 21) + (size_t)l * 256 * 2048, 2048, kb * 64, nb * 32, inp(c, 19) + l * 256, scr, c.lane, [=](int n) { return D + (size_t)n * 256; }); continue; } r -= I_UKV;
            if (r < I_OUT) { const int kb = r / 64, nb = r % 64; bf16_t* D = wsp<bf16_t>(c, WS_WOUT) + (size_t)l * DM * DM;
                tr_item(inp(c, 23) + (size_t)l * DM * DM, DM, kb * 64, nb * 32, inp(c, 22) + l * DM, scr, c.lane, [=](int n) { return D + (size_t)n * DM; }); continue; } r -= I_OUT;
            { const int kb = r / 16, nb = r % 16; bf16_t* D = wsp<bf16_t>(c, WS_WGLU) + (size_t)l * 512 * 512;
                tr_item(inp(c, 17) + (size_t)l * 512 * 512, 512, kb * 64, nb * 32, nullptr, scr, c.lane, [=](int n) { return D + (size_t)n * 512; }); }
        }
    }
    { const int split = (c.G > 96) ? 15 * 8 * (c.G - 96) : 0;
      __syncthreads(); convert_experts(c, 0, 0, split, 96); convert_experts(c, 0, split, NEXP * 1536, 0); }
    for (int i = gt; i < 2 * 2 * 256 * 256; i += NGT) {
        const int k = i & 255, n = (i >> 8) & 255, pn = (i >> 16) & 1, l = i >> 17; float v = 0.f;
        if ((k >> 7) == (n >> 7)) { const int g = 2 * pn + (n >> 7); v = inp(c, 7)[(((size_t)l * 4 + g) * 128 + (k & 127)) * 128 + (n & 127)] * inp(c, 8)[l * 512 + g * 128 + (n & 127)]; }
        wsp<bf16_t>(c, WS_WPOOL)[i] = f2bf(v);
    }
    for (int i = gt; i < 2 * 192 * DM / 8; i += NGT) { const int l = i / (192 * DM / 8), r = i % (192 * DM / 8); *(u32x4*)(wsp<bf16_t>(c, WS_WIN) + (size_t)l * DM * DM + (size_t)IN_COLS * DM + (size_t)r * 8) = (u32x4){0u, 0u, 0u, 0u}; }
    for (int i = gt; i < (int)(8 * MiB / 16); i += NGT) *(u32x4*)(c.ws + WS_SPREV + (size_t)i * 16) = (u32x4){0u, 0u, 0u, 0u};
    for (int i = gt; i < NTOK * 32; i += NGT) {
        const int tok = i >> 5, f = i & 31; const float invf = exp2f(-(float)f * (13.287712379549449f / 32.0f));
        const float ang = (float)((const int*)c.a.in[2])[tok] * invf; float s, co; sincos_rev((double)ang, s, co);
        wsp<f32x2>(c, WS_CS)[i] = (f32x2){co, s};
    }
    for (int i = gt; i < 64 * 65 * 64; i += NGT) {
        const int lg = i / (65 * 64), r = i % (65 * 64), lag = r >> 6, p = r & 63, l = lg >> 5, g = lg & 31;
        const float dt = __expf(inp(c, 11)[l * 32 + g]); const int gp = lg * 64 + p; const float lr = inp(c, 9)[gp], lim = inp(c, 10)[gp];
        float sl, cl_; sincos_rev((double)lag * (double)(lim * dt), sl, cl_); const float ml = __expf((float)lag * lr * dt);
        wsp<f32x2>(c, WS_PWTAB)[i] = (f32x2){ml * cl_, ml * sl};
    }
    for (int i = gt; i < 64 * 64 * 16; i += NGT) {
        const int gp = i >> 4, hp = i & 15, lg = gp >> 6, l = lg >> 5, g = lg & 31;
        const float dt = __expf(inp(c, 11)[l * 32 + g]); const float lr = inp(c, 9)[gp], lim = inp(c, 10)[gp];
        float s1, c1; sincos_rev((double)(lim * dt), s1, c1); const float mg = __expf(lr * dt); const float ar = mg * c1, aim = mg * s1;
        const float den = lr * lr + lim * lim; const float fr_ = ((ar - 1.f) * lr + aim * lim) / den, fi_ = (aim * lr - (ar - 1.f) * lim) / den;
        const float br = inp(c, 12)[i], bi = inp(c, 13)[i];
        wsp<f32x2>(c, WS_BBTAB)[i] = (f32x2){fr_ * br - fi_ * bi, fr_ * bi + fi_ * br};
    }
    for (int i = gt; i < 64 * 64; i += NGT) {
        const int lg = i >> 6, l = lg >> 5, g = lg & 31; const float dt = __expf(inp(c, 11)[l * 32 + g]); const float lr = inp(c, 9)[i], lim = inp(c, 10)[i];
        float sl, cl_; sincos_rev(64.0 * (double)(lim * dt), sl, cl_); const float ml = __expf(64.f * lr * dt); wsp<f32x2>(c, WS_A64)[i] = (f32x2){ml * cl_, ml * sl};
    }
}

__device__ __forceinline__ void gen_ssm_tables(const Ctx& c) {
    const int gt = c.vcu * 512 + c.tid, NGT = c.G * 512;
    const f32x2* PW = wsp<const f32x2>(c, WS_PWTAB); const f32x2* BB = wsp<const f32x2>(c, WS_BBTAB);
    for (int i = gt; i < 64 * 127 * 64; i += NGT) {
        const int lg = i / (127 * 64), r = i % (127 * 64), li_ = r >> 6, h = (r >> 2) & 15, hp = (r & 3) * 4;
        f32x4 acc = {0.f, 0.f, 0.f, 0.f};
        if (li_ >= 63) {
            const f32x2* pw = PW + ((size_t)lg * 65 + (li_ - 63)) * 64; const f32x2* bb = BB + (size_t)lg * 1024 + hp; const float* cr = inp(c, 14) + ((size_t)lg * 16 + h) * 64; const float* ci = inp(c, 15) + ((size_t)lg * 16 + h) * 64;
#pragma unroll 4
            for (int p = 0; p < 64; ++p) { const f32x2 a = pw[p]; const float c_r = cr[p], c_i = ci[p]; const float wr_ = a.x * c_r - a.y * c_i, wi_ = a.x * c_i + a.y * c_r;
                const f32x4 b01 = *(const f32x4*)(bb + p * 16), b23 = *(const f32x4*)(bb + p * 16 + 2);
                acc[0] += wr_ * b01[0] - wi_ * b01[1]; acc[1] += wr_ * b01[2] - wi_ * b01[3]; acc[2] += wr_ * b23[0] - wi_ * b23[1]; acc[3] += wr_ * b23[2] - wi_ * b23[3]; }
        }
        *(u32x2*)(c.ws + WS_SSMTAB + (size_t)lg * SSMTAB_STRIDE + SSM_TG + ((size_t)li_ * 256 + h * 16 + hp) * 2) = (u32x2){cvtpk(acc[0], acc[1]), cvtpk(acc[2], acc[3])};
    }
    for (int i = gt; i < 64 * 64 * 128 * 2; i += NGT) {
        const int lg = i >> 14, r8 = i & 16383, tau = r8 >> 8, pp = (r8 >> 1) & 127, hp0 = (r8 & 1) * 8, p = pp & 63;
        const f32x2 a = PW[((size_t)lg * 65 + (63 - tau)) * 64 + p]; const f32x2* b = BB + (size_t)lg * 1024 + p * 16 + hp0; float v[8];
#pragma unroll
        for (int e = 0; e < 8; ++e) { const f32x2 bb = b[e]; v[e] = pp < 64 ? a.x * bb.x - a.y * bb.y : a.x * bb.y + a.y * bb.x; }
        *(u32x4*)(c.ws + WS_SSMTAB + (size_t)lg * SSMTAB_STRIDE + SSM_TEND + ((size_t)r8 * 8) * 2) = (u32x4){cvtpk(v[0], v[1]), cvtpk(v[2], v[3]), cvtpk(v[4], v[5]), cvtpk(v[6], v[7])};
    }
    for (int i = gt; i < 64 * 1024 * 32; i += NGT) {
        const int lg = i >> 15, r8 = i & 32767, n = r8 >> 5, k0 = (r8 & 31) * 8, t = n >> 4, h = n & 15; float v[8];
        if (k0 < 128) { const int p0 = k0 & 63; const f32x2* a = PW + ((size_t)lg * 65 + (t + 1)) * 64 + p0; const float* cr = inp(c, 14) + ((size_t)lg * 16 + h) * 64 + p0; const float* ci = inp(c, 15) + ((size_t)lg * 16 + h) * 64 + p0;
#pragma unroll
            for (int e = 0; e < 8; ++e) { const f32x2 aa = a[e]; v[e] = k0 < 64 ? cr[e] * aa.x - ci[e] * aa.y : -(cr[e] * aa.y + ci[e] * aa.x); } }
        else {
#pragma unroll
            for (int e = 0; e < 8; ++e) v[e] = 0.f; }
        *(u32x4*)(c.ws + WS_SSMTAB + (size_t)lg * SSMTAB_STRIDE + SSM_WC + ((size_t)r8 * 8) * 2) = (u32x4){cvtpk(v[0], v[1]), cvtpk(v[2], v[3]), cvtpk(v[4], v[5]), cvtpk(v[6], v[7])};
    }
}

__device__ __forceinline__ void router_prep(const Ctx& c, int l) {
    const int gt = c.vcu * 512 + c.tid, NGT = c.G * 512;
    for (int i = gt; i < NB * 64 * 3 * 64; i += NGT) {
        const int ln = i & 63, cb = (i >> 6) % 3, ks = (i / 192) & 63, b = i / (192 * 64);
        const int j = 16 * cb + (ln & 15), k0 = 32 * ks + 8 * (ln >> 4);
        float hi[8], lo[8];
#pragma unroll
        for (int e = 0; e < 8; ++e) { const int k = k0 + e; float w = 0.f;
            if (j < 4) w = inp(c, 25)[((size_t)l * DM + k) * 4 + j]; else if (j < 36) w = inp(c, 27)[((size_t)l * DM + k) * 32 + (j - 4)];
            w *= inp(c, 24)[l * DM + k] * (1.f + modp(c, l, b, 4)[k]);
            hi[e] = bf2f(f2bf(w)); lo[e] = w - hi[e]; }
        u32x4 H, L; H.x = cvtpk(hi[0], hi[1]); H.y = cvtpk(hi[2], hi[3]); H.z = cvtpk(hi[4], hi[5]); H.w = cvtpk(hi[6], hi[7]); L.x = cvtpk(lo[0], lo[1]); L.y = cvtpk(lo[2], lo[3]); L.z = cvtpk(lo[4], lo[5]); L.w = cvtpk(lo[6], lo[7]);
        bf16_t* base = wsp<bf16_t>(c, WS_RWF) + ((((size_t)(l * NB + b) * 64 + ks) * 3 + cb) * 2) * 512;
        *(u32x4*)(base + ln * 8) = H; *(u32x4*)(base + 512 + ln * 8) = L;
    }
    const int gw = c.vcu * 8 + c.wid, NGW = c.G * 8;
    for (int i = gw; i < NB * 36; i += NGW) {
        const int b = i / 36, j = i % 36; float s = 0.f;
        for (int k = c.lane; k < DM; k += 64) { const float w = j < 4 ? inp(c, 25)[((size_t)l * DM + k) * 4 + j] : inp(c, 27)[((size_t)l * DM + k) * 32 + (j - 4)]; s += modp(c, l, b, 3)[k] * w; }
        s = wave_sum(s);
        if (c.lane == 0) wsp<float>(c, WS_RBIAS)[(l * NB + b) * 64 + j] = s + (j < 4 ? inp(c, 26)[l * 4 + j] : inp(c, 28)[l * 32 + (j - 4)]);
    }
}

template <int MODE>
__device__ __forceinline__ void norm_phase(const Ctx& c, int l) {
    LAS float* red0 = (LAS float*)c.lds;
    const LAS int* ps = (const LAS int*)(c.lds + LDS_PSTART);
    const int lane = c.lane, wid = c.wid, row = lane & 15, kq = lane >> 4;
    bf16_t* xbuf = wsp<bf16_t>(c, WS_XBUF);
    const bool src_f32 = (MODE == 0 && l == 0);
    const int lm = (MODE == 3) ? 1 : l - 1;
    const i32x4* RI = wsp<const i32x4>(c, WS_RI) + (size_t)(lm < 0 ? 0 : lm) * NTOK; const f32x2* RW = wsp<const f32x2>(c, WS_RW) + (size_t)(lm < 0 ? 0 : lm) * NTOK;
    const unsigned char* Y2 = wsp<const unsigned char>(c, WS_Y2);
    bf16_t* H = wsp<bf16_t>(c, WS_H);
    int* cnt = wsp<int>(c, WS_CTL) + CW_CNT + l * 32 * 64;
    LAS float* Gt = (LAS float*)(c.lds + 65536); LAS float* SHt = Gt + NB * DM; LAS float* GFt = SHt + NB * DM;
    for (int i = c.tid; i < NB * DM; i += 512) { const int b_ = i / DM, k_ = i % DM;
        if (MODE == 3) { Gt[i] = inp(c, 32)[k_]; SHt[i] = 0.f; }
        else { const int nsel_ = (MODE == 2) ? 24 : 5, off_ = (MODE == 2) ? 3 : 0; Gt[i] = inp(c, nsel_)[l * DM + k_] * (1.f + modp(c, l, b_, off_ + 1)[k_]); SHt[i] = modp(c, l, b_, off_)[k_]; }
        if (MODE == 1 || MODE == 3) GFt[i] = modp(c, lm, b_, 5)[k_]; }
    __syncthreads();
    f32x4 rawf[8][2]; u32x4 rawh[8];
#define NP_LOAD(u_) do { const int rg_ = (u_) * 16 + row; _Pragma("unroll") for (int s = 0; s < 8; ++s) { const int k = 256 * wid + 32 * s + 8 * kq; \
        if (src_f32) { rawf[s][0] = *(const f32x4*)(inp(c, 0) + (size_t)rg_ * DM + k); rawf[s][1] = *(const f32x4*)(inp(c, 0) + (size_t)rg_ * DM + k + 4); } \
        else rawh[s] = *(const u32x4*)(xbuf + (size_t)rg_ * DM + k); } } while (0)
    if (c.vcu < NTOK / 16) NP_LOAD(c.vcu);
    int par = 0;
#ifdef MK_DIAG_FIN
    const unsigned long long dfin_t0 = __builtin_amdgcn_s_memrealtime(); int dfin_k = 0; float dfin_scale = 1.f;
#endif
    for (int unit = c.vcu; unit < NTOK / 16; unit += c.G, par ^= 1) {
        LAS float* red = red0 + par * 8192;
#ifdef MK_DIAG_FIN
        if (MODE == 3) { if (dfin_k == 4) { const float us = (float)(__builtin_amdgcn_s_memrealtime() - dfin_t0) * 0.01f; dfin_scale = 1.f + 0.02f + 4e-5f * fminf(fmaxf(us - (float)MK_DIAG_FIN, 0.f), 400.f); } ++dfin_k; }
#endif
        const int rg = unit * 16 + row; const int b = rg >> 14;
        size_t pos0 = 0, pos1 = 0; float w0 = 0.f, w1 = 0.f;
        if (MODE == 1 || MODE == 3) { const i32x4 ri = RI[rg]; const f32x2 rw = RW[rg]; pos0 = (size_t)(ps[ri.x] + ri.z); pos1 = (size_t)(ps[ri.y] + ri.w); w0 = rw.x; w1 = rw.y; }
        f32x4 xv[8][2]; float ss = 0.f;
        f32x4 acc[3] = {{0.f, 0.f, 0.f, 0.f}, {0.f, 0.f, 0.f, 0.f}, {0.f, 0.f, 0.f, 0.f}};
#pragma unroll
        for (int s = 0; s < 8; ++s) { if (src_f32) { xv[s][0] = rawf[s][0]; xv[s][1] = rawf[s][1]; } else unpack8(rawh[s], xv[s][0], xv[s][1]); }
        if (unit + c.G < NTOK / 16) NP_LOAD(unit + c.G);
#pragma unroll
        for (int s = 0; s < 8; ++s) {
            const int k = 256 * wid + 32 * s + 8 * kq;
            f32x4 x0 = xv[s][0], x1 = xv[s][1];
            if (MODE == 1 || MODE == 3) {
                f32x4 a0, a1, b0, b1;
                { const u32x2 ya = *(const u32x2*)(Y2 + pos0 * DM + k), yb = *(const u32x2*)(Y2 + pos1 * DM + k);
                  const f32x2 t0 = __builtin_amdgcn_cvt_pk_f32_fp8((int)ya.x, false), t1 = __builtin_amdgcn_cvt_pk_f32_fp8((int)ya.x, true), t2 = __builtin_amdgcn_cvt_pk_f32_fp8((int)ya.y, false), t3 = __builtin_amdgcn_cvt_pk_f32_fp8((int)ya.y, true);
                  const f32x2 u0 = __builtin_amdgcn_cvt_pk_f32_fp8((int)yb.x, false), u1 = __builtin_amdgcn_cvt_pk_f32_fp8((int)yb.x, true), u2 = __builtin_amdgcn_cvt_pk_f32_fp8((int)yb.y, false), u3 = __builtin_amdgcn_cvt_pk_f32_fp8((int)yb.y, true);
                  a0 = (f32x4){t0.x, t0.y, t1.x, t1.y}; a1 = (f32x4){t2.x, t2.y, t3.x, t3.y}; b0 = (f32x4){u0.x, u0.y, u1.x, u1.y}; b1 = (f32x4){u2.x, u2.y, u3.x, u3.y}; }
                const f32x4 g0 = *(const LAS f32x4*)(GFt + b * DM + k), g1 = *(const LAS f32x4*)(GFt + b * DM + k + 4);
                x0 += g0 * (a0 * w0 + b0 * w1); x1 += g1 * (a1 * w0 + b1 * w1);
                if (MODE == 1) { const u32x4 xw = pack8f(x0, x1); *(u32x4*)(xbuf + (size_t)rg * DM + k) = xw; unpack8(xw, x0, x1); }
            }
            xv[s][0] = x0; xv[s][1] = x1;
            ss += (x0[0] * x0[0] + x0[1] * x0[1]) + (x0[2] * x0[2] + x0[3] * x0[3]) + (x1[0] * x1[0] + x1[1] * x1[1]) + (x1[2] * x1[2] + x1[3] * x1[3]);
            if (MODE == 2) {
                const u32x4 hi = pack8f(x0, x1); const bf16x8 xh = *(const bf16x8*)&hi;
                const bf16_t* wf = wsp<const bf16_t>(c, WS_RWF) + (((size_t)(l * NB + b) * 64 + (8 * wid + s)) * 3) * 2 * 512 + lane * 8;
#pragma unroll
                for (int cb = 0; cb < 3; ++cb) { const bf16x8 wh = *(const bf16x8*)(wf + (cb * 2) * 512);
                    acc[cb] = __builtin_amdgcn_mfma_f32_16x16x32_bf16(wh, xh, acc[cb], 0, 0, 0); }
            }
        }
        ss += __shfl_xor(ss, 16); ss += __shfl_xor(ss, 32);
        if (kq == 0) red[(wid * 16 + row) * 52] = ss;
        if (MODE == 2) {
#pragma unroll
            for (int cb = 0; cb < 3; ++cb)
#pragma unroll
                for (int e = 0; e < 4; ++e) red[(wid * 16 + row) * 52 + 1 + 16 * cb + 4 * kq + e] = acc[cb][e];
        }
        __syncthreads();
        float tot = 0.f;
#pragma unroll
        for (int w8 = 0; w8 < 8; ++w8) tot += red[(w8 * 16 + row) * 52];
        const float rstd = rsqrtf(tot * (1.f / DM) + EPS);
        if (MODE == 2 && wid == 0 && lane < 16) {
            const float* rb = wsp<const float>(c, WS_RBIAS) + (l * NB + b) * 64;
            float gl[4];
#pragma unroll
            for (int j = 0; j < 4; ++j) { float d = 0.f;
#pragma unroll
                for (int w8 = 0; w8 < 8; ++w8) d += red[(w8 * 16 + row) * 52 + 1 + j];
                gl[j] = rstd * d + rb[j]; }
            int gt_ = 0; float gm = gl[0];
#pragma unroll
            for (int j = 1; j < 4; ++j) if (gl[j] > gm) { gm = gl[j]; gt_ = j; }
            float gs = 0.f;
#pragma unroll
            for (int j = 0; j < 4; ++j) gs += __expf(gl[j] - gm);
            const float gwt = 1.f / gs;
            float e0 = -3.0e38f, e1 = -3.0e38f; int i0 = 0, i1 = 0;
            for (int i = 0; i < 8; ++i) { float d = 0.f;
#pragma unroll
                for (int w8 = 0; w8 < 8; ++w8) d += red[(w8 * 16 + row) * 52 + 1 + 4 + 8 * gt_ + i];
                const float lg = rstd * d + rb[4 + 8 * gt_ + i];
                if (lg > e0) { e1 = e0; i1 = i0; e0 = lg; i0 = i; } else if (lg > e1) { e1 = lg; i1 = i; } }
            const float q1 = __expf(e1 - e0); const float p0 = 1.f / (1.f + q1), p1 = q1 * p0;
            const int ex0 = 8 * gt_ + i0, ex1 = 8 * gt_ + i1;
            const int s0 = atomicAdd(cnt + ex0 * 64, 1), s1 = atomicAdd(cnt + ex1 * 64, 1);
            int* toks = wsp<int>(c, WS_TOK); toks[(size_t)ex0 * NTOK + s0] = rg; toks[(size_t)ex1 * NTOK + s1] = rg;
            wsp<i32x4>(c, WS_RI)[(size_t)l * NTOK + rg] = (i32x4){ex0, ex1, s0, s1}; wsp<f32x2>(c, WS_RW)[(size_t)l * NTOK + rg] = (f32x2){gwt * p0, gwt * p1};
        }
        if (MODE == 3) {
#pragma unroll
            for (int s = 0; s < 8; ++s) { const int k = 256 * wid + 32 * s + 8 * kq; const f32x4 g0 = *(const LAS f32x4*)(Gt + k), g1 = *(const LAS f32x4*)(Gt + k + 4);
                #ifdef MK_DIAG_FIN
                const float osc_ = dfin_scale;
#else
                const float osc_ = c.oscale;
#endif
                *(f32x4*)(c.a.out + (size_t)rg * DM + k) = xv[s][0] * (rstd * osc_) * g0; *(f32x4*)(c.a.out + (size_t)rg * DM + k + 4) = xv[s][1] * (rstd * osc_) * g1; }
        } else {
#pragma unroll
            for (int s = 0; s < 8; ++s) { const int k = 256 * wid + 32 * s + 8 * kq;
                const f32x4 g0 = *(const LAS f32x4*)(Gt + b * DM + k), g1 = *(const LAS f32x4*)(Gt + b * DM + k + 4);
                const f32x4 h0 = xv[s][0] * rstd * g0 + *(const LAS f32x4*)(SHt + b * DM + k), h1 = xv[s][1] * rstd * g1 + *(const LAS f32x4*)(SHt + b * DM + k + 4);
                *(u32x4*)(H + (size_t)rg * DM + k) = pack8f(h0, h1); }
        }
    }
    __syncthreads();
#undef NP_LOAD
}

template <int MODE>
__device__ __forceinline__ void norm_rows(const Ctx& c, int l) {
    const LAS int* ps = (const LAS int*)(c.lds + LDS_PSTART);
    const int lane = c.lane;
    bf16_t* xbuf = wsp<bf16_t>(c, WS_XBUF);
    const bool src_f32 = (MODE == 0 && l == 0);
    const int lm = (MODE == 3) ? 1 : l - 1;
    const i32x4* RI = wsp<const i32x4>(c, WS_RI) + (size_t)(lm < 0 ? 0 : lm) * NTOK; const f32x2* RW = wsp<const f32x2>(c, WS_RW) + (size_t)(lm < 0 ? 0 : lm) * NTOK;
    const unsigned char* Y2 = wsp<const unsigned char>(c, WS_Y2);
    bf16_t* H = wsp<bf16_t>(c, WS_H);
    LAS float* Gt = (LAS float*)(c.lds + 65536); LAS float* SHt = Gt + NB * DM; LAS float* GFt = SHt + NB * DM;
    for (int i = c.tid; i < NB * DM; i += 512) { const int b_ = i / DM, k_ = i % DM;
        if (MODE == 3) { Gt[i] = inp(c, 32)[k_]; SHt[i] = 0.f; }
        else { Gt[i] = inp(c, 5)[l * DM + k_] * (1.f + modp(c, l, b_, 1)[k_]); SHt[i] = modp(c, l, b_, 0)[k_]; }
        if (MODE == 1 || MODE == 3) GFt[i] = modp(c, lm, b_, 5)[k_]; }
    __syncthreads();
    const int gw = c.vcu * 8 + c.wid, NGW = c.G * 8;
    for (int r0 = gw; r0 < NTOK; r0 += 2 * NGW) {
        f32x4 xv[2][4][2]; u32x4 rawh[2][4]; u32x2 ya[2][4], yb[2][4]; float w0[2], w1[2];
#pragma unroll
        for (int q = 0; q < 2; ++q) { const int rg = r0 + q * NGW; if (rg < NTOK) {
            if (MODE == 1 || MODE == 3) { const i32x4 ri = RI[rg]; const f32x2 rw = RW[rg]; const size_t pos0 = (size_t)(ps[ri.x] + ri.z), pos1 = (size_t)(ps[ri.y] + ri.w); w0[q] = rw.x; w1[q] = rw.y;
#pragma unroll
                for (int j = 0; j < 4; ++j) { ya[q][j] = *(const u32x2*)(Y2 + pos0 * DM + 512 * j + lane * 8); yb[q][j] = *(const u32x2*)(Y2 + pos1 * DM + 512 * j + lane * 8); } }
#pragma unroll
            for (int j = 0; j < 4; ++j) { const int k = 512 * j + lane * 8;
                if (src_f32) { xv[q][j][0] = *(const f32x4*)(inp(c, 0) + (size_t)rg * DM + k); xv[q][j][1] = *(const f32x4*)(inp(c, 0) + (size_t)rg * DM + k + 4); }
                else rawh[q][j] = *(const u32x4*)(xbuf + (size_t)rg * DM + k); } } }
#pragma unroll
        for (int q = 0; q < 2; ++q) { const int rg = r0 + q * NGW; if (rg < NTOK) { const int b = rg >> 14;
            float ss = 0.f;
#pragma unroll
            for (int j = 0; j < 4; ++j) { const int k = 512 * j + lane * 8;
                f32x4 x0, x1; if (src_f32) { x0 = xv[q][j][0]; x1 = xv[q][j][1]; } else unpack8(rawh[q][j], x0, x1);
                if (MODE == 1 || MODE == 3) {
                    const f32x2 t0 = __builtin_amdgcn_cvt_pk_f32_fp8((int)ya[q][j].x, false), t1 = __builtin_amdgcn_cvt_pk_f32_fp8((int)ya[q][j].x, true), t2 = __builtin_amdgcn_cvt_pk_f32_fp8((int)ya[q][j].y, false), t3 = __builtin_amdgcn_cvt_pk_f32_fp8((int)ya[q][j].y, true);
                    const f32x2 u0 = __builtin_amdgcn_cvt_pk_f32_fp8((int)yb[q][j].x, false), u1 = __builtin_amdgcn_cvt_pk_f32_fp8((int)yb[q][j].x, true), u2 = __builtin_amdgcn_cvt_pk_f32_fp8((int)yb[q][j].y, false), u3 = __builtin_amdgcn_cvt_pk_f32_fp8((int)yb[q][j].y, true);
                    const f32x4 a0 = {t0.x, t0.y, t1.x, t1.y}, a1 = {t2.x, t2.y, t3.x, t3.y}, b0 = {u0.x, u0.y, u1.x, u1.y}, b1 = {u2.x, u2.y, u3.x, u3.y};
                    const f32x4 g0 = *(const LAS f32x4*)(GFt + b * DM + k), g1 = *(const LAS f32x4*)(GFt + b * DM + k + 4);
                    x0 += g0 * (a0 * w0[q] + b0 * w1[q]); x1 += g1 * (a1 * w0[q] + b1 * w1[q]);
                    if (MODE == 1) { const u32x4 xw = pack8f(x0, x1); *(u32x4*)(xbuf + (size_t)rg * DM + k) = xw; unpack8(xw, x0, x1); }
                }
                xv[q][j][0] = x0; xv[q][j][1] = x1;
                ss += (x0[0] * x0[0] + x0[1] * x0[1]) + (x0[2] * x0[2] + x0[3] * x0[3]) + (x1[0] * x1[0] + x1[1] * x1[1]) + (x1[2] * x1[2] + x1[3] * x1[3]);
            }
            const float rstd = rsqrtf(wave_sum(ss) * (1.f / DM) + EPS);
#pragma unroll
            for (int j = 0; j < 4; ++j) { const int k = 512 * j + lane * 8;
                if (MODE == 3) { const f32x4 g0 = *(const LAS f32x4*)(Gt + k), g1 = *(const LAS f32x4*)(Gt + k + 4);
                    *(f32x4*)(c.a.out + (size_t)rg * DM + k) = xv[q][j][0] * (rstd * c.oscale) * g0; *(f32x4*)(c.a.out + (size_t)rg * DM + k + 4) = xv[q][j][1] * (rstd * c.oscale) * g1; }
                else { const f32x4 g0 = *(const LAS f32x4*)(Gt + b * DM + k), g1 = *(const LAS f32x4*)(Gt + b * DM + k + 4);
                    const f32x4 h0 = xv[q][j][0] * rstd * g0 + *(const LAS f32x4*)(SHt + b * DM + k), h1 = xv[q][j][1] * rstd * g1 + *(const LAS f32x4*)(SHt + b * DM + k + 4);
                    *(u32x4*)(H + (size_t)rg * DM + k) = pack8f(h0, h1); } }
        } }
    }
    __syncthreads();
}

__device__ __forceinline__ void carry_phase(const Ctx& c, int l) {
    LAS float* ex = (LAS float*)c.lds;
    const float* E = wsp<const float>(c, WS_EBUF); bf16_t* SP = wsp<bf16_t>(c, WS_SPREV);
    const int seg = c.tid >> 5, pp = c.tid & 31;
    for (int item = c.vcu; item < NB * SSM_G * 2; item += c.G) {
        const int b = item >> 6, g = (item >> 1) & 31, p = (item & 1) * 32 + pp;
        const f32x2 A = wsp<const f32x2>(c, WS_A64)[(l * 32 + g) * 64 + p];
        const int c0 = b * 256 + seg * 16;
        float er[16], ei[16];
#pragma unroll
        for (int j = 0; j < 16; ++j) { const float* e = E + ((size_t)(c0 + j) * SSM_G + g) * 128; er[j] = e[p]; ei[j] = e[64 + p]; }
        float sr = 0.f, si = 0.f;
#pragma unroll
        for (int j = 0; j < 16; ++j) { const float nr = A.x * sr - A.y * si + er[j], ni = A.x * si + A.y * sr + ei[j]; sr = nr; si = ni; er[j] = sr; ei[j] = si; }
        ex[(seg * 32 + pp) * 2] = sr; ex[(seg * 32 + pp) * 2 + 1] = si;
        float pr = A.x, pi_ = A.y;
#pragma unroll
        for (int q = 0; q < 4; ++q) { const float nr = pr * pr - pi_ * pi_, ni = 2.f * pr * pi_; pr = nr; pi_ = ni; }
        __syncthreads();
        float cr = 0.f, ci = 0.f;
        for (int s = 0; s < seg; ++s) { const float tr = ex[(s * 32 + pp) * 2], ti = ex[(s * 32 + pp) * 2 + 1]; const float nr = pr * cr - pi_ * ci + tr, ni = pr * ci + pi_ * cr + ti; cr = nr; ci = ni; }
        float qr = cr, qi = ci;
#pragma unroll
        for (int j = 0; j < 16; ++j) {
            const float vr = qr + (j ? er[j - 1] : 0.f), vi = qi + (j ? ei[j - 1] : 0.f);
            bf16_t* o = SP + ((size_t)(c0 + j) * SSM_G + g) * 256; o[p] = f2bf(vr); o[64 + p] = f2bf(vi);
            const float nr = A.x * qr - A.y * qi, ni = A.x * qi + A.y * qr; qr = nr; qi = ni;
        }
        __syncthreads();
    }
}

__device__ __forceinline__ void fin_phase(const Ctx& c) {
    const bf16_t* P = wsp<const bf16_t>(c, WS_P); const bf16_t* GL = wsp<const bf16_t>(c, WS_GL); const bf16_t* O = wsp<const bf16_t>(c, WS_O); bf16_t* Y = wsp<bf16_t>(c, WS_YCAT);
    const int gw = c.vcu * 8 + c.wid, NGW = c.G * 8, lane = c.lane;
    const int wsel = lane >> 4, win = 2 << wsel;
    for (int run = gw; run < NTOK / 16; run += NGW) {
        const int t0 = run * 16; const bool hist = (t0 & (SEQ - 1)) != 0;
        {
            u32x4 ring[31];
#pragma unroll
            for (int j = 0; j < 15; ++j) ring[j] = hist ? *(const u32x4*)(P + (size_t)(t0 - 15 + j) * 512 + lane * 8) : (u32x4){0u, 0u, 0u, 0u};
#pragma unroll
            for (int j = 0; j < 16; ++j) ring[15 + j] = *(const u32x4*)(P + (size_t)(t0 + j) * 512 + lane * 8);
            f32x4 r0 = {0.f, 0.f, 0.f, 0.f}, r1 = {0.f, 0.f, 0.f, 0.f};
#pragma unroll
            for (int j = 1; j < 16; ++j) { f32x4 a0, a1; unpack8(ring[15 - j], a0, a1); const float mk = (j < win) ? 1.f : 0.f; r0 += a0 * mk; r1 += a1 * mk; }
#pragma unroll
            for (int k = 0; k < 16; ++k) {
                f32x4 c0, c1; unpack8(ring[15 + k], c0, c1); r0 += c0; r1 += c1;
                const int cn = hist ? win : ((k + 1 < win) ? k + 1 : win); const float ic = 1.f / (float)cn;
                const f32x4 y0 = r0 * ic - c0, y1 = r1 * ic - c1;
                const float ss = (y0[0] * y0[0] + y0[1] * y0[1]) + (y0[2] * y0[2] + y0[3] * y0[3]) + (y1[0] * y1[0] + y1[1] * y1[1]) + (y1[2] * y1[2] + y1[3] * y1[3]);
                const float rs = rsqrtf(wave_sum(ss) * (1.f / 512.f) + EPS);
                *(u32x4*)(Y + (size_t)(t0 + k) * DM + lane * 8) = pack8f(y0 * rs, y1 * rs);
                const u32x4 od = wsel == 0 ? ring[14 + k] : wsel == 1 ? ring[12 + k] : wsel == 2 ? ring[8 + k] : ring[k];
                f32x4 o0, o1; unpack8(od, o0, o1); r0 -= o0; r1 -= o1;
            }
        }
        {
            u32x4 g[16];
#pragma unroll
            for (int k = 0; k < 16; ++k) g[k] = *(const u32x4*)(GL + (size_t)(t0 + k) * 512 + lane * 8);
#pragma unroll
            for (int k = 0; k < 16; ++k) { f32x4 y0, y1; unpack8(g[k], y0, y1);
                const float ss = (y0[0] * y0[0] + y0[1] * y0[1]) + (y0[2] * y0[2] + y0[3] * y0[3]) + (y1[0] * y1[0] + y1[1] * y1[1]) + (y1[2] * y1[2] + y1[3] * y1[3]);
                const float rs = rsqrtf(wave_sum(ss) * (1.f / 512.f) + EPS);
                *(u32x4*)(Y + (size_t)(t0 + k) * DM + 512 + lane * 8) = pack8f(y0 * rs, y1 * rs); }
        }
#pragma unroll
        for (int hb = 0; hb < 2; ++hb) {
            u32x4 oa[8], ob[8];
#pragma unroll
            for (int k = 0; k < 8; ++k) { oa[k] = *(const u32x4*)(O + (size_t)(t0 + hb * 8 + k) * 1024 + lane * 16); ob[k] = *(const u32x4*)(O + (size_t)(t0 + hb * 8 + k) * 1024 + lane * 16 + 8); }
#pragma unroll
            for (int k = 0; k < 8; ++k) { f32x4 y0, y1, z0, z1; unpack8(oa[k], y0, y1); unpack8(ob[k], z0, z1);
                const float ss = (y0[0] * y0[0] + y0[1] * y0[1]) + (y0[2] * y0[2] + y0[3] * y0[3]) + (y1[0] * y1[0] + y1[1] * y1[1]) + (y1[2] * y1[2] + y1[3] * y1[3])
                               + (z0[0] * z0[0] + z0[1] * z0[1]) + (z0[2] * z0[2] + z0[3] * z0[3]) + (z1[0] * z1[0] + z1[1] * z1[1]) + (z1[2] * z1[2] + z1[3] * z1[3]);
                const float rs = rsqrtf(wave_sum(ss) * (1.f / 1024.f) + EPS); const size_t yo = (size_t)(t0 + hb * 8 + k) * DM + 1024 + lane * 16;
                *(u32x4*)(Y + yo) = pack8f(y0 * rs, y1 * rs); *(u32x4*)(Y + yo + 8) = pack8f(z0 * rs, z1 * rs); }
        }
    }
}
__device__ __forceinline__ void kpe_rope(const Ctx& c) {
    const bf16_t* Z = wsp<const bf16_t>(c, WS_Z); bf16_t* K = wsp<bf16_t>(c, WS_K); const f32x2* CS = wsp<const f32x2>(c, WS_CS);
    const int gt = c.vcu * 512 + c.tid, NGT = c.G * 512;
    for (int i = gt; i < NTOK * 8; i += NGT) {
        const int tok = i >> 3, q = i & 7; const int b = tok >> 14, t = tok & (SEQ - 1);
        f32x4 v0, v1; unpack8(*(const u32x4*)(Z + (size_t)tok * ZLD + Z_KPE + q * 8), v0, v1);
        const f32x2* cs = CS + (size_t)tok * 32 + q * 4; const f32x4 c01 = *(const f32x4*)cs, c23 = *(const f32x4*)(cs + 2);
        f32x4 o0, o1;
        o0[0] = v0[0] * c01[0] - v0[1] * c01[1]; o0[1] = v0[1] * c01[0] + v0[0] * c01[1]; o0[2] = v0[2] * c01[2] - v0[3] * c01[3]; o0[3] = v0[3] * c01[2] + v0[2] * c01[3];
        o1[0] = v1[0] * c23[0] - v1[1] * c23[1]; o1[1] = v1[1] * c23[0] + v1[0] * c23[1]; o1[2] = v1[2] * c23[2] - v1[3] * c23[3]; o1[3] = v1[3] * c23[2] + v1[2] * c23[3];
        const u32x4 w = pack8f(o0, o1);
#pragma unroll
        for (int h = 0; h < NHEAD; ++h) *(u32x4*)(K + ((size_t)(b * NHEAD + h) * SEQ + t) * QKD + 128 + q * 8) = w;
    }
}
namespace att {
constexpr int KN_BYTES = 16384, KR_BYTES = 8192, V_BYTES = 16384, ST_BYTES = KN_BYTES + KR_BYTES + V_BYTES, NST = 3;
constexpr int XCH_OFF = NST * ST_BYTES;
constexpr float THR2 = 11.5f;
#define AT_KSWZ(row, colB) ((row) * 256 + ((colB) ^ (((row) & 15) << 4)))
#define AT_SBAR() __builtin_amdgcn_sched_barrier(0)
__device__ __forceinline__ int v_rd_base(int lane) { return ((lane & 3) << 3) | (((lane >> 2) & 3) << 6) | (((lane >> 4) & 1) << 5) | (((lane >> 5) & 1) << 8); }
__device__ __forceinline__ int crow(int r, int hi) { return (r & 3) + 8 * (r >> 2) + 4 * hi; }
__device__ __forceinline__ void mask_tile(f32x16& p0, f32x16& p1, int dq) {
    const float NEG = -__builtin_inff();
#pragma unroll
    for (int r = 0; r < 16; ++r) { const int cc = (r & 3) + 8 * (r >> 2); if (dq - cc < 0) p0[r] = NEG; if (dq - cc - 32 < 0) p1[r] = NEG; }
}
__device__ __forceinline__ void partialSM(f32x16& p0, f32x16& p1, float& m_reg, float sh, float& delta, float& alpha, bool& nosub, bool first) {
    float pmax = p0[0];
#pragma unroll
    for (int r = 1; r < 16; ++r) pmax = fmaxf(pmax, p0[r]);
#pragma unroll
    for (int r = 0; r < 16; ++r) pmax = fmaxf(pmax, p1[r]);
    { auto rr = __builtin_amdgcn_permlane32_swap(__float_as_uint(pmax), __float_as_uint(pmax), false, false); pmax = fmaxf(__uint_as_float(rr[0]), __uint_as_float(rr[1])); }
    pmax += sh;
    float mn;
    if (__builtin_expect(__all((pmax - m_reg) <= THR2), 1)) { mn = m_reg; alpha = 1.f; nosub = !first; }
    else { mn = fmaxf(m_reg, pmax); alpha = fast_exp2(m_reg - mn); m_reg = mn; nosub = false; }
    delta = mn - sh;
    if (nosub) {
#pragma unroll
        for (int r = 0; r < 16; ++r) p0[r] = fast_exp2(p0[r]);
    } else {
#pragma unroll
        for (int r = 0; r < 16; ++r) p0[r] = fast_exp2(p0[r] - delta);
    }
}
__device__ __forceinline__ void finishSM(f32x16& p0, f32x16& p1, float delta, bool nosub, float alpha, float& l_reg, bf16x8& pa0, bf16x8& pa1, bf16x8& pa2, bf16x8& pa3) {
    if (nosub) {
#pragma unroll
        for (int r = 0; r < 16; ++r) p1[r] = fast_exp2(p1[r]);
    } else {
#pragma unroll
        for (int r = 0; r < 16; ++r) p1[r] = fast_exp2(p1[r] - delta);
    }
    float ps = 0.f;
#pragma unroll
    for (int r = 0; r < 16; ++r) ps += p0[r];
#pragma unroll
    for (int r = 0; r < 16; ++r) ps += p1[r];
    { auto rr = __builtin_amdgcn_permlane32_swap(__float_as_uint(ps), __float_as_uint(ps), false, false); ps = __uint_as_float(rr[0]) + __uint_as_float(rr[1]); }
    l_reg = l_reg * alpha + ps;
#define AT_PK4(P, B_, OUT) do { unsigned a0 = cvtpk(P[B_ + 0], P[B_ + 1]), a1 = cvtpk(P[B_ + 2], P[B_ + 3]); unsigned b0 = cvtpk(P[B_ + 4], P[B_ + 5]), b1 = cvtpk(P[B_ + 6], P[B_ + 7]); \
        auto r0 = __builtin_amdgcn_permlane32_swap(a0, b0, false, false); auto r1 = __builtin_amdgcn_permlane32_swap(a1, b1, false, false); \
        u32x4 w = {r0[0], r1[0], r0[1], r1[1]}; OUT = *reinterpret_cast<bf16x8*>(&w); } while (0)
    AT_PK4(p0, 0, pa0); AT_PK4(p0, 8, pa1); AT_PK4(p1, 0, pa2); AT_PK4(p1, 8, pa3);
#undef AT_PK4
}
#define AT_KRD(dst, addr, off) asm volatile("ds_read_b128 %0, %1 offset:%2" : "=&v"(dst) : "v"(addr), "i"(off) : "memory")
#define AT_KWAIT(n, a, b) asm volatile("s_waitcnt lgkmcnt(%2)" : "+v"(a), "+v"(b) : "i"(n) : "memory")
struct KAddr { unsigned xo[8]; };
__device__ __forceinline__ void kaddr_init(KAddr& ka, int r32, int hi) {
    const int rb = r32 * 256, key = (r32 & 15) << 4;
#pragma unroll
    for (int d0 = 0; d0 < 8; ++d0) ka.xo[d0] = (unsigned)(rb + (((d0 * 16 + hi * 8) * 2) ^ key));
}
__device__ __forceinline__ void qkt(f32x16& p0, f32x16& p1, unsigned stb  , const KAddr& ka, const bf16x8* qr, float init) {
#pragma unroll
    for (int r = 0; r < 16; ++r) { p0[r] = init; p1[r] = init; }
    u32x4 f[4][2];
#define AT_KSTEP_RD(s) do { if ((s) < 8) { const unsigned a_ = stb + ka.xo[(s) & 7]; AT_KRD(f[(s) & 3][0], a_, 0); AT_KRD(f[(s) & 3][1], a_, 8192); } \
        else { const unsigned a0_ = stb + ka.xo[((s) - 8) & 7], a1_ = stb + ka.xo[((s) - 4) & 7]; AT_KRD(f[(s) & 3][0], a0_, KN_BYTES); AT_KRD(f[(s) & 3][1], a1_, KN_BYTES); } } while (0)
    AT_KSTEP_RD(0); AT_KSTEP_RD(1); AT_KSTEP_RD(2);
#pragma unroll
    for (int s = 0; s < 12; ++s) {
        if (s + 3 < 12) AT_KSTEP_RD(s + 3);
        if (s <= 8) AT_KWAIT(6, f[s & 3][0], f[s & 3][1]); else if (s == 9) AT_KWAIT(4, f[s & 3][0], f[s & 3][1]); else if (s == 10) AT_KWAIT(2, f[s & 3][0], f[s & 3][1]); else AT_KWAIT(0, f[s & 3][0], f[s & 3][1]);
        p0 = __builtin_amdgcn_mfma_f32_32x32x16_bf16(*(const bf16x8*)&f[s & 3][0], qr[s], p0, 0, 0, 0); p1 = __builtin_amdgcn_mfma_f32_32x32x16_bf16(*(const bf16x8*)&f[s & 3][1], qr[s], p1, 0, 0, 0);
    }
#undef AT_KSTEP_RD
}
struct VFrag { s16x4 l0, l1, l2, l3, h0, h1, h2, h3; };
#define AT_TRRD(dst, vb, off) asm volatile("ds_read_b64_tr_b16 %0, %1 offset:%2" : "=&v"(dst) : "v"(vb), "i"(off) : "memory")
#define AT_VISSUE(F, vb, d0) do { constexpr int b_ = (d0) * 512; AT_TRRD(F.l0, vb, b_); AT_TRRD(F.h0, vb, b_ + 2048); AT_TRRD(F.l1, vb, b_ + 4096); AT_TRRD(F.h1, vb, b_ + 6144); \
        AT_TRRD(F.l2, vb, b_ + 8192); AT_TRRD(F.h2, vb, b_ + 10240); AT_TRRD(F.l3, vb, b_ + 12288); AT_TRRD(F.h3, vb, b_ + 14336); } while (0)
#define AT_VWAIT(n, F) asm volatile("s_waitcnt lgkmcnt(%8)" : "+v"(F.l0), "+v"(F.l1), "+v"(F.l2), "+v"(F.l3), "+v"(F.h0), "+v"(F.h1), "+v"(F.h2), "+v"(F.h3) : "i"(n) : "memory")
#define AT_VMMA(F, d0) do { \
        o[d0] = __builtin_amdgcn_mfma_f32_32x32x16_bf16(pa0, (bf16x8){F.l0[0], F.l0[1], F.l0[2], F.l0[3], F.h0[0], F.h0[1], F.h0[2], F.h0[3]}, o[d0], 0, 0, 0); \
        o[d0] = __builtin_amdgcn_mfma_f32_32x32x16_bf16(pa1, (bf16x8){F.l1[0], F.l1[1], F.l1[2], F.l1[3], F.h1[0], F.h1[1], F.h1[2], F.h1[3]}, o[d0], 0, 0, 0); \
        o[d0] = __builtin_amdgcn_mfma_f32_32x32x16_bf16(pa2, (bf16x8){F.l2[0], F.l2[1], F.l2[2], F.l2[3], F.h2[0], F.h2[1], F.h2[2], F.h2[3]}, o[d0], 0, 0, 0); \
        o[d0] = __builtin_amdgcn_mfma_f32_32x32x16_bf16(pa3, (bf16x8){F.l3[0], F.l3[1], F.l3[2], F.l3[3], F.h3[0], F.h3[1], F.h3[2], F.h3[3]}, o[d0], 0, 0, 0); } while (0)
__device__ __forceinline__ void pv_tile(f32x16* o, unsigned vb, VFrag& A, bf16x8 pa0, bf16x8 pa1, bf16x8 pa2, bf16x8 pa3) {
    VFrag B;
    AT_VISSUE(B, vb, 1); AT_VWAIT(8, A); AT_VMMA(A, 0);
    AT_VISSUE(A, vb, 2); AT_VWAIT(8, B); AT_VMMA(B, 1);
    AT_VISSUE(B, vb, 3); AT_VWAIT(8, A); AT_VMMA(A, 2);
    AT_VWAIT(0, B); AT_VMMA(B, 3);
}
struct DmaOff { unsigned kn0, kn1, kr, v0, v1; };
__device__ __forceinline__ void dma_offsets(int tid, DmaOff& d) {
    { const int p = tid, row = p >> 4, ch = (p & 15) ^ (row & 15); d.kn0 = (unsigned)(row * QKD + ch * 8) * 2u; }
    { const int p = tid + 512, row = p >> 4, ch = (p & 15) ^ (row & 15); d.kn1 = (unsigned)(row * QKD + ch * 8) * 2u; }
    { const int p = tid, row = p >> 4, ch = (p & 15) ^ (row & 15); const int key = row + ((ch & 8) ? 32 : 0); d.kr = (unsigned)(key * QKD + 128 + (ch & 7) * 8) * 2u; }
    { const int p = tid, sub = p >> 5, kk = (sub >> 2) * 8 + ((p & 31) >> 2), key = (kk & ~0xC) | ((kk & 4) << 1) | ((kk & 8) >> 1), col = (sub & 3) * 32 + (p & 3) * 8; d.v0 = (unsigned)(key * VD + col) * 2u; }
    { const int p = tid + 512, sub = p >> 5, kk = (sub >> 2) * 8 + ((p & 31) >> 2), key = (kk & ~0xC) | ((kk & 4) << 1) | ((kk & 8) >> 1), col = (sub & 3) * 32 + (p & 3) * 8; d.v1 = (unsigned)(key * VD + col) * 2u; }
}
__device__ __forceinline__ void glds16(const void* g, unsigned lds_dst) {
    unsigned keep; asm volatile("s_mov_b32 %0, m0\n\ts_mov_b32 m0, %2\n\ts_nop 0\n\tglobal_load_lds_dwordx4 %1, off\n\ts_mov_b32 m0, %0" : "=&s"(keep) : "v"(g), "s"(lds_dst) : "memory");
}
#define AT_GLDS(g, l) glds16((const void*)(g), (unsigned)(uintptr_t)(l))
__device__ __forceinline__ void issue_tile(LAS char* lds, int stage, const char* Kt, const char* Vt, const DmaOff& d, int wid) {
    LAS char* st = lds + stage * ST_BYTES + wid * 1024;
    unsigned o0 = d.kn0, o1 = d.kn1, o2 = d.kr, o3 = d.v0, o4 = d.v1; asm volatile("" : "+v"(o0), "+v"(o1), "+v"(o2), "+v"(o3), "+v"(o4));
    AT_GLDS(Kt + o0, st); AT_GLDS(Kt + o1, st + 8192); AT_GLDS(Kt + o2, st + KN_BYTES); AT_GLDS(Vt + o3, st + KN_BYTES + KR_BYTES); AT_GLDS(Vt + o4, st + KN_BYTES + KR_BYTES + 8192);
}
__device__ __forceinline__ void block(LAS char* lds, const bf16_t* Qbh, const char* Kbh, const char* Vbh, bf16_t* Obase  , int qb, const DmaOff& d, const int tid, const bool rev  ) {
    const int wid = __builtin_amdgcn_readfirstlane(tid >> 6), lane = tid & 63, r32 = lane & 31, hi = lane >> 5;
    const int NT = 4 * (qb + 1);
    const int qlo = qb * 256 + wid * 32;
    const int nact = (qlo + 31) / 64 + 1;
    LAS float* xw = (LAS float*)(lds + XCH_OFF) + wid * 64;
    asm volatile("" ::: "memory"); __builtin_amdgcn_s_barrier(); asm volatile("" ::: "memory");
    bf16x8 qr[12];
#pragma unroll
    for (int d0 = 0; d0 < 12; ++d0) qr[d0] = *(const bf16x8*)(Qbh + (size_t)(qlo + r32) * QKD + d0 * 16 + hi * 8);
    const long ksK = rev ? -(long)(64 * QKD * 2) : (long)(64 * QKD * 2), ksV = rev ? -(long)(64 * VD * 2) : (long)(64 * VD * 2);
    const char* K0 = Kbh + (rev ? (size_t)(NT - 1) * 64 * QKD * 2 : (size_t)0); const char* V0 = Vbh + (rev ? (size_t)(NT - 1) * 64 * VD * 2 : (size_t)0);
    issue_tile(lds, 0, K0, V0, d, wid);
    issue_tile(lds, 1, K0 + ksK, V0 + ksV, d, wid);
#pragma unroll
    for (int d0 = 0; d0 < 12; ++d0) asm volatile("" : "+v"(qr[d0]));
    float m_reg = -1e30f, l_reg = 0.f; f32x16 o[4] = {};
    const unsigned vbase = (unsigned)(uintptr_t)(lds + KN_BYTES + KR_BYTES) + (unsigned)v_rd_base(lane);
    const unsigned lds0 = (unsigned)(uintptr_t)lds; KAddr ka; kaddr_init(ka, r32, hi);
    int stage = 0;
    for (int t = 0; t < NT; ++t) {
        if (t + 1 < NT) asm volatile("s_waitcnt vmcnt(5)" ::: "memory"); else asm volatile("s_waitcnt vmcnt(0)" ::: "memory");
        __builtin_amdgcn_s_barrier(); asm volatile("" ::: "memory");
        if (t + 2 < NT) { int s2 = stage + 2; if (s2 >= NST) s2 -= NST; issue_tile(lds, s2, K0 + (long)(t + 2) * ksK, V0 + (long)(t + 2) * ksV, d, wid); }
        const int tt = rev ? NT - 1 - t : t;
        if (tt < nact) {
            f32x16 p0, p1; float delta, alpha; bool nosub; bf16x8 pa0, pa1, pa2, pa3; VFrag vf;
            const bool first = rev ? (tt == nact - 1) : (tt == 0); const float sh = first ? 0.f : m_reg;
            qkt(p0, p1, lds0 + (unsigned)(stage * ST_BYTES), ka, qr, -sh);
            const unsigned vb = vbase + (unsigned)(stage * ST_BYTES);
            AT_VISSUE(vf, vb, 0);
            if (tt * 64 + 63 > qlo) mask_tile(p0, p1, qlo + r32 - tt * 64 - 4 * hi);
            partialSM(p0, p1, m_reg, sh, delta, alpha, nosub, first);
            finishSM(p0, p1, delta, nosub, alpha, l_reg, pa0, pa1, pa2, pa3);
            if (__any(alpha < 1.f)) { if (hi == 0) xw[r32] = alpha; asm volatile("s_waitcnt lgkmcnt(0)" ::: "memory");
#pragma unroll
                for (int d_ = 0; d_ < 4; ++d_)
#pragma unroll
                    for (int r = 0; r < 16; ++r) o[d_][r] *= xw[crow(r, hi)]; }
            pv_tile(o, vb, vf, pa0, pa1, pa2, pa3);
        }
        ++stage; if (stage >= NST) stage = 0;
    }
    if (hi == 0) xw[32 + r32] = l_reg; asm volatile("s_waitcnt lgkmcnt(0)" ::: "memory");
    bf16_t* Ow = Obase + (size_t)qlo * 1024;
#pragma unroll
    for (int r = 0; r < 16; ++r) { const int orow = crow(r, hi); const float rl = fast_rcp(xw[32 + orow]);
#pragma unroll
        for (int d0 = 0; d0 < 4; ++d0) { const float v = o[d0][r] * rl; const float vn = __shfl_xor(v, 1);
            if ((r32 & 1) == 0) *(unsigned*)(Ow + (size_t)orow * 1024 + d0 * 32 + r32) = cvtpk(v, vn); } }
}
__device__ __forceinline__ void phase(const Ctx& c) {
    LAS char* lds = (LAS char*)c.lds;
    const bf16_t* Q = wsp<const bf16_t>(c, WS_Q); const char* K = (const char*)(c.ws + WS_K); const char* V = (const char*)(c.ws + WS_V); bf16_t* O = wsp<bf16_t>(c, WS_O);
    DmaOff d; dma_offsets(c.tid, d);
    if (c.wid >= 4) __builtin_amdgcn_s_setprio(1);
    for (int it = c.vcu; it < 16 * 32; it += c.G) {
        const int bh = it >> 5, x = it & 31; const int b = bh >> 3, h = bh & 7;
        const bf16_t* Qbh = Q + (size_t)bh * SEQ * QKD; const char* Kbh = K + (size_t)bh * SEQ * QKD * 2; const char* Vbh = V + (size_t)bh * SEQ * VD * 2;
        bf16_t* Ob = O + (size_t)b * SEQ * 1024 + h * 128;
        block(lds, Qbh, Kbh, Vbh, Ob, 63 - x, d, c.tid, false);
        block(lds, Qbh, Kbh, Vbh, Ob, x, d, c.tid, true);
    }
    asm volatile("s_waitcnt vmcnt(0)" ::: "memory"); __builtin_amdgcn_s_barrier(); asm volatile("" ::: "memory");
    __builtin_amdgcn_s_setprio(0);
}
}
constexpr int N_PHASES = 26;
#if MK_ONE_LAUNCH
#define SEAM(k) do { if (lo <= (k) && (k) + 1 < hi) { unsigned z_ = 0u; asm volatile("" : "+v"(z_)); xcd_barrier(bar, wid_s == 0 && __builtin_amdgcn_mbcnt_hi(~0u, __builtin_amdgcn_mbcnt_lo(~0u, z_)) == 0u); }; } while (0)
#else
#define SEAM(k) do { } while (0)
#endif
#ifdef MK_DIAG_A
#ifndef MK_DIAG_SENS
#define MK_DIAG_SENS 4e-5f
#endif
#ifndef MK_DIAG_OFF
#define MK_DIAG_OFF 0
#endif
#define DTS ((unsigned long long*)(args.ws + WS_CTL) + 6144)
#define STAMP(k) do { if (blockIdx.x == 0 && wid_s == 0) { unsigned z_ = 0u; asm volatile("" : "+v"(z_)); if (__builtin_amdgcn_mbcnt_hi(~0u, __builtin_amdgcn_mbcnt_lo(~0u, z_)) == 0u) DTS[(k)] = __builtin_amdgcn_s_memrealtime(); } } while (0)
#else
#define STAMP(k) do { } while (0)
#endif
#ifdef MK_PROBE
#define REP(k) for (int rp_ = 0; rp_ < ((k) == MK_PROBE ? 2 : 1); ++rp_)
#else
#define REP(k)
#endif
#ifdef TEST_PH
#define IN(k) (((k) == 0 ? 0 : ((k) == 25 ? 25 : 1 + ((k) - 1) % 12)) == TEST_PH && lo <= (k) && (k) < hi)
#else
#define IN(k) (lo <= (k) && (k) < hi)
#endif
#define PCTX Ctx c{c0.lds, 0, 0, 0, c0.G, c0.vcu, args, nullptr, 1.f}; { unsigned z_ = 0u; asm volatile("" : "+v"(z_)); int t_ = wid_s * 64 + (int)__builtin_amdgcn_mbcnt_hi(~0u, __builtin_amdgcn_mbcnt_lo(~0u, z_)); asm volatile("" : "+v"(t_)); c.tid = t_; c.lane = t_ & 63; c.wid = __builtin_amdgcn_readfirstlane(t_ >> 6); unsigned char* w_ = args.ws; asm volatile("" : "+s"(w_)); c.ws = w_; }
#define LAYERP float* ssq_q = (float*)(c.ws + WS_CTL + CTL_SSQ) + (size_t)(l * 2) * NTOK; float* ssq_kv = ssq_q + NTOK; int* cnt = wsp<int>(c, WS_CTL) + CW_CNT + l * 32 * 64; const char* ssmtab = (const char*)(c.ws + WS_SSMTAB) + (size_t)l * 32 * SSMTAB_STRIDE; (void)ssq_q; (void)ssq_kv; (void)cnt; (void)ssmtab;
struct KState { int lo, hi, wid_s; };
template <int l>
__device__ __forceinline__ void layer_phases(const Args& args, const Ctx& c0, const XcdBarrier& bar, const int lo, const int hi, const int wid_s) {
        const int pb = 1 + 12 * l;
        if (IN(pb + 0)) { STAMP(pb + 0); PCTX
            if (l == 0) { norm_rows<0>(c, l); gen_ssm_tables(c); }
            else { (void)build_tile_table(c, wsp<int>(c, WS_CTL) + CW_CNT + (l - 1) * 32 * 64); norm_rows<1>(c, l); __syncthreads(); convert_experts(c, l); }
            router_prep(c, l);
            SEAM(pb + 0);
        }
        if (IN(pb + 1)) { STAMP(pb + 1); PCTX LAYERP
            ProgG1 p; p.so.init(NTOK, DM, c.G, (int)blockIdx.x); p.A = (const char*)(c.ws + WS_H); p.B = (const char*)(c.ws + WS_WIN) + (size_t)l * DM * DM * 2;
            p.Z = wsp<bf16_t>(c, WS_Z); p.U = wsp<bf16_t>(c, WS_U); p.ssqp = wsp<float>(c, WS_SSQP);
            REP(pb + 1) { ge::run(c.lds, p, c.tid); }
            SEAM(pb + 1);
        }
        if (IN(pb + 2)) { STAMP(pb + 2); PCTX LAYERP
            ProgG2 p; p.G = c.G; p.c = (int)blockIdx.x; p.Z = (const char*)(c.ws + WS_Z); p.U = (const char*)(c.ws + WS_U);
            p.WUQ = (const char*)(c.ws + WS_WUQ) + (size_t)l * 1536 * 512 * 2; p.WUKV = (const char*)(c.ws + WS_WUKV) + (size_t)l * 2048 * 256 * 2; p.WPOOL = (const char*)(c.ws + WS_WPOOL) + (size_t)l * 2 * 256 * 256 * 2;
            p.SSMTAB = ssmtab; p.ssqp = wsp<const float>(c, WS_SSQP); p.CS = wsp<const f32x2>(c, WS_CS);
            p.Q = wsp<bf16_t>(c, WS_Q); p.K = wsp<bf16_t>(c, WS_K); p.V = wsp<bf16_t>(c, WS_V); p.P = wsp<bf16_t>(c, WS_P); p.YI = wsp<bf16_t>(c, WS_YI); p.EBUF = wsp<float>(c, WS_EBUF);
            REP(pb + 2) { ge::run(c.lds, p, c.tid); kpe_rope(c); } SEAM(pb + 2);
        }
        if (IN(pb + 4)) { STAMP(pb + 4); PCTX REP(pb + 4) { carry_phase(c, l); att::phase(c); } SEAM(pb + 4); }
        if (IN(pb + 5)) { STAMP(pb + 5); PCTX LAYERP
            ProgS1 p; p.G = c.G; p.c = (int)blockIdx.x; p.SPREV = (const char*)(c.ws + WS_SPREV); p.SSMTAB = ssmtab; p.YI = wsp<const bf16_t>(c, WS_YI); p.U = wsp<const bf16_t>(c, WS_U);
            p.Dskip = inp(c, 16) + l * 512; p.YG = wsp<bf16_t>(c, WS_YG);
            REP(pb + 5) { ge::run(c.lds, p, c.tid); } SEAM(pb + 5);
        }
        if (IN(pb + 6)) { STAMP(pb + 6); PCTX
            ProgS2 p; p.G = c.G; p.c = (int)blockIdx.x; p.YGc = (const char*)(c.ws + WS_YG); p.W = (const char*)(c.ws + WS_WGLU) + (size_t)l * 512 * 512 * 2; p.YG = wsp<const bf16_t>(c, WS_YG); p.GL = wsp<bf16_t>(c, WS_GL);
            REP(pb + 6) { ge::run(c.lds, p, c.tid); } SEAM(pb + 6);
        }
        if (IN(pb + 7)) { STAMP(pb + 7); PCTX REP(pb + 7) { fin_phase(c); } SEAM(pb + 7); }
        if (IN(pb + 8)) { STAMP(pb + 8); PCTX
            ProgG3 p; p.so.init(NTOK, DM, c.G, (int)blockIdx.x); p.A = (const char*)(c.ws + WS_YCAT); p.B = (const char*)(c.ws + WS_WOUT) + (size_t)l * DM * DM * 2;
            p.xin = (l == 0) ? inp(c, 0) : nullptr; p.xin16 = wsp<const bf16_t>(c, WS_XBUF); p.xout = wsp<bf16_t>(c, WS_XBUF); p.ga = modp(c, l, 0, 2);
            REP(pb + 8) { ge::run(c.lds, p, c.tid); } SEAM(pb + 8);
        }
        if (IN(pb + 9)) { STAMP(pb + 9); PCTX norm_phase<2>(c, l); SEAM(pb + 9); }
        if (IN(pb + 10)) { STAMP(pb + 10); PCTX LAYERP
            const int ntiles = __builtin_amdgcn_readfirstlane(build_tile_table(c, cnt));
            ProgM1 p; p.G = c.G; p.c = (int)blockIdx.x; p.tab = (const LAS int*)(c.lds + LDS_TILETAB); p.ntiles = ntiles; p.cnt = cnt; p.toks = wsp<const int>(c, WS_TOK);
            p.H = (const char*)(c.ws + WS_H); p.W13 = (const char*)(c.ws + WS_W13); p.ACT = wsp<bf16_t>(c, WS_ACT);
            REP(pb + 10) { ge::run(c.lds, p, c.tid); } SEAM(pb + 10);
        }
        if (IN(pb + 11)) { STAMP(pb + 11); PCTX LAYERP
            const int ntiles = __builtin_amdgcn_readfirstlane(build_tile_table(c, cnt));
            ProgM2 p; p.G = c.G; p.c = (int)blockIdx.x; p.tab = (const LAS int*)(c.lds + LDS_TILETAB); p.ntiles = ntiles; p.ACT = (const char*)(c.ws + WS_ACT); p.W2 = (const char*)(c.ws + WS_W2); p.Y2 = wsp<unsigned char>(c, WS_Y2);
            REP(pb + 11) { ge::run(c.lds, p, c.tid); } STAMP(pb + 12); SEAM(pb + 11);
        }
}
__global__ void __launch_bounds__(512, 2) mk_fwd(Args args) {
    extern __shared__ __attribute__((aligned(16))) unsigned char lds_[];
    Ctx c0{(LAS unsigned char*)lds_, (int)threadIdx.x, (int)(threadIdx.x & 63), __builtin_amdgcn_readfirstlane((int)(threadIdx.x >> 6)), (int)gridDim.x, 0, args, args.ws, 1.f};
    { const int bx = blockIdx.x; c0.vcu = (c0.G % 8 == 0) ? (bx % 8) * (c0.G / 8) + bx / 8 : bx; }
    if (c0.tid < 4) ((LAS unsigned*)(c0.lds + LDS_MISC))[c0.tid] = 0u;
    __syncthreads();
    const int lo = args.ph_lo, hi = args.ph_hi; const int wid_s = c0.wid; (void)wid_s;
#if MK_ONE_LAUNCH
    XcdBarrier bar = xcd_barrier_post(wsp<unsigned>(c0, WS_CTL) + CW_BAR, (volatile LAS unsigned*)(c0.lds + LDS_MISC));
#else
    XcdBarrier bar; bar.bar = nullptr; bar.x = 0; bar.st = nullptr;
#endif
    if (IN(0)) { STAMP(0); PCTX REP(0) { p0_prologue(c); __syncthreads(); } SEAM(0); }
    layer_phases<0>(args, c0, bar, lo, hi, wid_s);
    layer_phases<1>(args, c0, bar, lo, hi, wid_s);
    if (IN(25)) { STAMP(25); PCTX
#ifdef MK_DIAG_A
        { const unsigned long long tk = DTS[MK_DIAG_B] - DTS[MK_DIAG_A]; const float us = (float)tk * 0.01f; c.oscale = 1.f + 0.02f + MK_DIAG_SENS * fminf(fmaxf(us - (float)MK_DIAG_OFF, 0.f), 16.f / (MK_DIAG_SENS * 1000.f)); }
#endif
        (void)build_tile_table(c, wsp<int>(c, WS_CTL) + CW_CNT + 1 * 32 * 64); norm_rows<3>(c, 1); }
#undef PCTX
#undef LAYERP
}
#undef IN
#undef SEAM
#undef PCTX
#undef LAYERP

extern "C" void kernel_launch(void* const* d_in, const int* in_sizes, int n_in, void* d_out, int out_size, void* d_ws, size_t ws_size, hipStream_t stream) {
    static int grid = 0;
    if (grid == 0) {
        if (n_in != 33 || in_sizes[0] != NTOK * DM || out_size != NTOK * DM || ws_size < WS_END) {
            fprintf(stderr, "kernel_launch: shape/workspace mismatch (n_in %d, in0 %d, out %d, ws %zu < %zu); nothing launched\n", n_in, n_in > 0 ? in_sizes[0] : -1, out_size, ws_size, (size_t)WS_END); grid = -1; return; }
        int dev = 0, cus = 0, per_cu = 0;
        if (hipGetDevice(&dev) != hipSuccess || hipDeviceGetAttribute(&cus, hipDeviceAttributeMultiprocessorCount, dev) != hipSuccess) { grid = -1; return; }
        if (hipFuncSetAttribute((const void*)mk_fwd, hipFuncAttributeMaxDynamicSharedMemorySize, LDS_BYTES) != hipSuccess) { fprintf(stderr, "kernel_launch: hipFuncSetAttribute failed\n"); grid = -1; return; }
        if (hipOccupancyMaxActiveBlocksPerMultiprocessor(&per_cu, (const void*)mk_fwd, 512, LDS_BYTES) != hipSuccess || per_cu < 1) fprintf(stderr, "kernel_launch: occupancy query reports %d\n", per_cu);
        (void)hipGetLastError();
        grid = cus;
    }
    if (grid < 0) return;
    if (hipMemsetAsync((char*)d_ws + WS_CTL, 0, CTL_ZERO_BYTES, stream) != hipSuccess) return;
    Args a{};
    for (int i = 0; i < 33; ++i) a.in[i] = d_in[i];
    a.out = (float*)d_out; a.ws = (unsigned char*)d_ws;
#if MK_ONE_LAUNCH
    a.ph_lo = 0; a.ph_hi = N_PHASES;
    hipLaunchKernelGGL(mk_fwd, dim3(grid), dim3(512), LDS_BYTES, stream, a);
#else
    for (int ph = 0; ph < N_PHASES; ++ph) { a.ph_lo = ph; a.ph_hi = ph + 1; int reps = 1;
#ifdef MK_HPROBE
        if (ph == MK_HPROBE) reps = 2;
#endif
        for (int r = 0; r < reps; ++r) hipLaunchKernelGGL(mk_fwd, dim3(grid), dim3(512), LDS_BYTES, stream, a); }
#endif
}
```

```cpp
#include <hip/hip_runtime.h>
#include <cstdio>
#include <cstdint>

#ifndef MK_ONE_LAUNCH
#define MK_ONE_LAUNCH 1
#endif

#define LAS __attribute__((address_space(3)))
#define GAS __attribute__((address_space(1)))
typedef unsigned short bf16_t;
typedef short bf16x8 __attribute__((ext_vector_type(8)));
typedef short s16x4 __attribute__((ext_vector_type(4)));
typedef float f32x2 __attribute__((ext_vector_type(2)));
typedef float f32x4 __attribute__((ext_vector_type(4)));
typedef float f32x16 __attribute__((ext_vector_type(16)));
typedef unsigned u32x2 __attribute__((ext_vector_type(2)));
typedef unsigned u32x4 __attribute__((ext_vector_type(4)));
typedef int i32x4 __attribute__((ext_vector_type(4)));

constexpr int NB = 2, SEQ = 16384, DM = 2048, NTOK = NB * SEQ, DEPTH = 2;
constexpr int IN_COLS = 1856, ZLD = 1536;
constexpr int Z_POOL = 0, Z_QC = 512, Z_KVC = 1024, Z_KPE = 1280;
constexpr int NHEAD = 8, QKD = 192, VD = 128;
constexpr int NEXP = 32, DEXP = 512;
constexpr int SSM_G = 32, SSM_T = 64, NCHUNK = NTOK / SSM_T;
constexpr float EPS = 1e-6f;
constexpr int MOE_MAXROWS = 2 * NTOK + NEXP * 256;

constexpr size_t MiB = 1u << 20;
constexpr size_t WS_CTL = 0, CTL_ZERO_BYTES = 1 * MiB;
constexpr size_t WS_MOD = 1 * MiB;
constexpr size_t WS_RBIAS = WS_MOD + 512 * 1024;
constexpr size_t WS_RWF = 2 * MiB;
constexpr size_t WS_RI = 4 * MiB;
constexpr size_t WS_RW = 5 * MiB;
constexpr size_t WS_TOK = 6 * MiB;
constexpr size_t WS_CS = 10 * MiB;
constexpr size_t WS_PWTAB = 18 * MiB, WS_BBTAB = 22 * MiB;
constexpr size_t WS_EBUF = 18 * MiB;
constexpr size_t WS_SPREV = 26 * MiB;
constexpr size_t WS_SSMTAB = 34 * MiB;
constexpr size_t SSMTAB_STRIDE = 832 * 1024, SSM_TG = 0, SSM_TEND = 64 * 1024, SSM_WC = 320 * 1024;
constexpr size_t WS_A64 = 86 * MiB;
constexpr size_t WS_WIN = 87 * MiB;
constexpr size_t WS_WUQ = 103 * MiB;
constexpr size_t WS_WUKV = 106 * MiB;
constexpr size_t WS_WOUT = 108 * MiB;
constexpr size_t WS_WGLU = 124 * MiB;
constexpr size_t WS_WPOOL = 125 * MiB;
constexpr size_t WS_W13 = 126 * MiB;
constexpr size_t WS_W2 = 254 * MiB;
constexpr size_t WS_XBUF = 318 * MiB;
constexpr size_t WS_H = 574 * MiB;
constexpr size_t WS_Q = 574 * MiB;
constexpr size_t WS_P = 670 * MiB;
constexpr size_t WS_Z = 702 * MiB;
constexpr size_t WS_O = 702 * MiB;
constexpr size_t WS_K = 798 * MiB;
constexpr size_t WS_YG = 798 * MiB, WS_GL = 830 * MiB;
constexpr size_t WS_V = 894 * MiB;
constexpr size_t WS_U = 958 * MiB;
constexpr size_t WS_Y2 = 702 * MiB;
constexpr size_t WS_YCAT = 990 * MiB;
constexpr size_t WS_ACT = 990 * MiB;
constexpr size_t WS_YI = 1118 * MiB;
constexpr size_t WS_SSQP = 1150 * MiB;
constexpr size_t WS_END = 1152 * MiB;
static_assert(WS_Y2 + (size_t)MOE_MAXROWS * DM * 2 <= WS_YCAT, "Y2 overlay");
static_assert(WS_ACT + (size_t)MOE_MAXROWS * DEXP * 2 <= WS_YI, "ACT overlay");
constexpr int CW_BAR = 1024;
constexpr int CW_CNT = 8192;
constexpr size_t CTL_SSQ = 64 * 1024;

constexpr int RING_BYTES = 131072;
constexpr int LDS_TILETAB = RING_BYTES;
constexpr int LDS_PSTART = RING_BYTES + 1536;
constexpr int LDS_MISC = RING_BYTES + 2048;
constexpr int LDS_BYTES = RING_BYTES + 4096;

#define LDS_WAIT() asm volatile("s_waitcnt lgkmcnt(0)" ::: "memory")
#define VM_WAIT() asm volatile("s_waitcnt vmcnt(0)" ::: "memory")
__device__ __forceinline__ unsigned cvtpk(float lo, float hi) { unsigned r; asm volatile("v_cvt_pk_bf16_f32 %0, %1, %2" : "=v"(r) : "v"(lo), "v"(hi)); return r; }
__device__ __forceinline__ float bf2f(unsigned short h) { return __uint_as_float((unsigned)h << 16); }
__device__ __forceinline__ float bflo(unsigned w) { return __uint_as_float(w << 16); }
__device__ __forceinline__ float bfhi(unsigned w) { return __uint_as_float(w & 0xffff0000u); }
__device__ __forceinline__ unsigned short f2bf(float f) { return (unsigned short)(cvtpk(f, 0.f) & 0xffffu); }
__device__ __forceinline__ u32x4 pack8f(f32x4 a, f32x4 b) { u32x4 w; w.x = cvtpk(a[0], a[1]); w.y = cvtpk(a[2], a[3]); w.z = cvtpk(b[0], b[1]); w.w = cvtpk(b[2], b[3]); return w; }
__device__ __forceinline__ void unpack8(u32x4 w, f32x4& a, f32x4& b) { a[0] = bflo(w.x); a[1] = bfhi(w.x); a[2] = bflo(w.y); a[3] = bfhi(w.y); b[0] = bflo(w.z); b[1] = bfhi(w.z); b[2] = bflo(w.w); b[3] = bfhi(w.w); }
__device__ __forceinline__ float wave_sum(float v) {
#pragma unroll
    for (int o = 1; o < 64; o <<= 1) v += __shfl_xor(v, o);
    return v;
}
__device__ __forceinline__ float fast_rcp(float x) { return __builtin_amdgcn_rcpf(x); }
__device__ __forceinline__ float fast_exp2(float x) { return __builtin_amdgcn_exp2f(x); }
__device__ __forceinline__ void sincos_rev(double ang, float& s, float& c) {
    double rev = ang * 0.15915494309189535; rev -= __builtin_rint(rev);
    const float f = (float)rev; s = __builtin_amdgcn_sinf(f); c = __builtin_amdgcn_cosf(f);
}

#define XB_TMO      128
#define XB_XCNT(j)  (256  + 64 * (j))
#define XB_XSUB(j)  (1280 + 64 * (j))
#define XB_XGEN(j)  (2304 + 64 * (j))
#define XB_TOP      3328
#define XB_TOPGEN   3392
#define XCD_BAR_WORDS 3456
#define XB_SPIN_CAP (1u << 18)
__device__ __forceinline__ unsigned xb_ld(unsigned* p)              { return __hip_atomic_load(p, __ATOMIC_RELAXED, __HIP_MEMORY_SCOPE_AGENT); }
__device__ __forceinline__ unsigned xb_add(unsigned* p, unsigned v) { return __hip_atomic_fetch_add(p, v, __ATOMIC_RELAXED, __HIP_MEMORY_SCOPE_AGENT); }
__device__ __forceinline__ unsigned xb_xcc_id() { return (unsigned)__builtin_amdgcn_s_getreg((3 << 11) | 20) & 0xFu; }
#define XB_SPIN(cond, bar) do { unsigned _sp = 0; while (cond) { __builtin_amdgcn_s_sleep(1); \
    if ((++_sp & 255u) == 0u) { if (xb_ld(&(bar)[XB_TMO])) break; if (_sp > XB_SPIN_CAP) { atomicAdd(&(bar)[XB_TMO], 1u); break; } } } } while (0)
struct XcdBarrier { unsigned* bar; unsigned x; volatile LAS unsigned* st; };
__device__ __forceinline__ XcdBarrier xcd_barrier_post(unsigned* bar, volatile LAS unsigned* st) {
    XcdBarrier b; b.bar = bar; b.x = xb_xcc_id(); b.st = st;
    if (threadIdx.x == 0) (void)xb_add(&bar[XB_XCNT(b.x)], 1u);
    return b;
}
__device__ __forceinline__ void xcd_barrier_complete(unsigned* bar, unsigned x, unsigned& nloc, unsigned& nx) {
    const unsigned G = gridDim.x * gridDim.y * gridDim.z;
    unsigned sum, cnt, mine, sp = 0u;
    for (;;) {
        sum = 0u; cnt = 0u; mine = 0u;
#pragma unroll
        for (unsigned j = 0; j < 16; ++j) { const unsigned c = xb_ld(&bar[XB_XCNT(j)]); sum += c; cnt += (c > 0u) ? 1u : 0u; mine = (j == x) ? c : mine; }
        if (sum == G) break;
        __builtin_amdgcn_s_sleep(1);
        if ((++sp & 255u) == 0u) { if (xb_ld(&bar[XB_TMO])) break; if (sp > XB_SPIN_CAP) { atomicAdd(&bar[XB_TMO], 1u); break; } }
    }
    nloc = mine > 0u ? mine : 1u; nx = cnt > 0u ? cnt : 1u;
}
__device__ __forceinline__ void xcd_barrier(const XcdBarrier& b, const bool leader_thread) {
    asm volatile("s_waitcnt vmcnt(0)" ::: "memory");
    __syncthreads();
    if (leader_thread) {
        unsigned* bar = b.bar;
        __builtin_amdgcn_s_waitcnt(0);
        unsigned nloc = b.st[0], nx = b.st[1];
        if (nloc == 0u) { xcd_barrier_complete(bar, b.x, nloc, nx); b.st[0] = nloc; b.st[1] = nx; }
        const unsigned old = xb_add(&bar[XB_XSUB(b.x)], 1u);
        const unsigned gen = old / nloc;
        if (old + 1u == (gen + 1u) * nloc) {
            __builtin_amdgcn_fence(__ATOMIC_RELEASE, "agent");
            asm volatile("s_waitcnt vmcnt(0)" ::: "memory");
            const unsigned og = xb_add(&bar[XB_TOP], 1u);
            const unsigned tg = og / nx;
            if (og + 1u == (tg + 1u) * nx) xb_add(&bar[XB_TOPGEN], 1u);
            else XB_SPIN(xb_ld(&bar[XB_TOPGEN]) == tg, bar);
            __builtin_amdgcn_fence(__ATOMIC_ACQUIRE, "agent");
            xb_add(&bar[XB_XGEN(b.x)], 1u);
            asm volatile("s_waitcnt vmcnt(0)" ::: "memory");
        } else {
            XB_SPIN(xb_ld(&bar[XB_XGEN(b.x)]) == gen, bar);
            __builtin_amdgcn_fence(__ATOMIC_ACQUIRE, "agent");
            asm volatile("s_waitcnt vmcnt(0)" ::: "memory");
        }
    }
    __syncthreads();
}

struct Args { const void* in[33]; float* out; unsigned char* ws; int ph_lo, ph_hi; };
struct Ctx {
    LAS unsigned char* lds;
    int tid, lane, wid, G, vcu;
    const Args& a;
    unsigned char* ws;
    float oscale;
};
template <class T> __device__ __forceinline__ T* wsp(const Ctx& c, size_t off) { return (T*)(c.ws + off); }
__device__ __forceinline__ const float* inp(const Ctx& c, int i) { return (const float*)c.a.in[i]; }
__device__ __forceinline__ const float* modp(const Ctx& c, int l, int b, int which) { return wsp<const float>(c, WS_MOD) + ((size_t)(l * NB + b) * 6 + which) * DM; }
namespace ge {
constexpr int BM = 256, BK = 64, HALF = 128, HTB = HALF * BK * 2, STAGE_BYTES = 8 * HTB;
__device__ __forceinline__ int lds_byte(int r, int c) { const int st = (r >> 4) * 2 + (c >> 5), rr = r & 15, cc = c & 31, ob = rr * 64 + cc * 2; return st * 1024 + (ob ^ (((ob >> 9) & 1) << 5)); }
__device__ __forceinline__ void stage_rc(int b, int& R, int& C) { const int st = b / 1024, sb = b % 1024, swz = sb ^ (((sb >> 9) & 1) << 5); R = (st >> 1) * 16 + swz / 64; C = (st & 1) * 32 + (swz % 64) / 2; }
__device__ __forceinline__ int perm32(int rho) { const int n = rho >> 4, i = rho & 15; return 8 * (i >> 2) + 4 * n + (i & 3); }

struct Ops { const char* a0; const char* a1; const char* b0; const char* b1; long ksA, ksB; int nt; };
struct Lane { int R[2], Rb[2], C[2]; };
struct Off { unsigned a[2][2]; unsigned b[2]; };
typedef f32x4 Acc[2][2][4][2];

template <class P>
__device__ __forceinline__ void run(LAS unsigned char* lds, const P& prog, const int tid) {
    const int wid = __builtin_amdgcn_readfirstlane(tid >> 6), lane = tid & 63, wr = wid >> 2, wc = wid & 3, fr = lane & 15, fq = lane >> 4;
#define GE_LANE(ln) Lane ln; { int t_ = tid; asm volatile("" : "+v"(t_)); _Pragma("unroll") for (int i = 0; i < 2; ++i) { stage_rc(t_ * 16 + i * 8192, ln.R[i], ln.C[i]); ln.Rb[i] = (ln.R[i] & ~31) + perm32(ln.R[i] & 31); } }
    const unsigned ldsw = (unsigned)wid * 1024u;
    const int aoff = lds_byte(wr * 64 + fr, fq * 8), boff = lds_byte(wc * 32 + fr, fq * 8);
#define GE_SA(b, h) (((b) * 2 + (h)) * HTB)
#define GE_SB(b, h) ((4 + (b) * 2 + (h)) * HTB)
#define GE_STAGE(bufoff, gbase, v0, v1) do { unsigned o0_ = (v0), o1_ = (v1); asm volatile("" : "+v"(o0_), "+v"(o1_)); \
        __builtin_amdgcn_global_load_lds((const unsigned*)((const char*)(gbase) + o0_), (LAS unsigned*)(lds + (bufoff) + ldsw), 16, 0, 0); \
        __builtin_amdgcn_global_load_lds((const unsigned*)((const char*)(gbase) + o1_), (LAS unsigned*)(lds + (bufoff) + ldsw + 8192), 16, 0, 0); } while (0)
#define GE_LDA(dst, b, h) do { _Pragma("unroll") for (int m = 0; m < 4; ++m) _Pragma("unroll") for (int k = 0; k < 2; ++k) dst[m][k] = *(const LAS bf16x8*)(lds + GE_SA(b, h) + aoff + m * 2048 + k * 1024); } while (0)
#define GE_LDB(dst, b, h) do { _Pragma("unroll") for (int n = 0; n < 2; ++n) _Pragma("unroll") for (int k = 0; k < 2; ++k) dst[n][k] = *(const LAS bf16x8*)(lds + GE_SB(b, h) + boff + n * 2048 + k * 1024); } while (0)
#define GE_MMA(ai, bj, At, Bt) do { __builtin_amdgcn_s_setprio(1); _Pragma("unroll") for (int m = 0; m < 4; ++m) _Pragma("unroll") for (int n = 0; n < 2; ++n) _Pragma("unroll") for (int k = 0; k < 2; ++k) \
        acc[ai][bj][m][n] = __builtin_amdgcn_mfma_f32_16x16x32_bf16(Bt[n][k], At[m][k], acc[ai][bj][m][n], 0, 0, 0); __builtin_amdgcn_s_setprio(0); } while (0)
#define GE_WAIT_V(n) asm volatile("s_waitcnt vmcnt(" #n ")" ::: "memory")
#define GE_WAIT_L(n) asm volatile("s_waitcnt lgkmcnt(" #n ")" ::: "memory")
#define GE_BAR __builtin_amdgcn_s_barrier()
#define GE_SCHED __builtin_amdgcn_sched_barrier(0)
    typename P::Unit cur, nxt; int ui = 0;
    if (!prog.next(0, cur)) return;
    Ops co, no; prog.ops(cur, co);
    Off v, nv; { GE_LANE(ln) prog.voff(cur, ln, v); }
    Acc acc;
#pragma unroll
    for (int a = 0; a < 2; ++a)
#pragma unroll
        for (int b = 0; b < 2; ++b)
#pragma unroll
            for (int m = 0; m < 4; ++m)
#pragma unroll
                for (int n = 0; n < 2; ++n) acc[a][b][m][n] = (f32x4){0.f, 0.f, 0.f, 0.f};
    bf16x8 At[4][2], B0[2][2], B1[2][2];
    GE_STAGE(GE_SB(0, 0), co.b0, v.b[0], v.b[1]); GE_STAGE(GE_SB(0, 1), co.b1, v.b[0], v.b[1]); GE_STAGE(GE_SA(0, 0), co.a0, v.a[0][0], v.a[0][1]); GE_STAGE(GE_SA(0, 1), co.a1, v.a[P::GATHER][0], v.a[P::GATHER][1]);
    if (wr == 1) GE_BAR;
    GE_WAIT_V(2); GE_BAR;
    GE_STAGE(GE_SB(1, 0), co.b0 + co.ksB, v.b[0], v.b[1]); GE_STAGE(GE_SA(1, 0), co.a0 + co.ksA, v.a[0][0], v.a[0][1]); GE_STAGE(GE_SB(1, 1), co.b1 + co.ksB, v.b[0], v.b[1]);
    GE_WAIT_V(6); GE_BAR;
    for (;;) {
        const bool has_next = prog.next(ui + 1, nxt);
        if (has_next) { prog.ops(nxt, no); if constexpr (P::VAR_OFF) { GE_LANE(ln) prog.voff(nxt, ln, nv); } } else { no = co; if constexpr (P::VAR_OFF) nv = v; }
        const int nt = co.nt;
        for (int t = 0; t < nt; t += 2) {
            const bool last = (t == nt - 2);
            const char* a1h1 = co.a1 + (long)(t + 1) * co.ksA;
            const char* a2h0 = last ? no.a0 : co.a0 + (long)(t + 2) * co.ksA; const char* a2h1 = last ? no.a1 : co.a1 + (long)(t + 2) * co.ksA;
            const char* b2h0 = last ? no.b0 : co.b0 + (long)(t + 2) * co.ksB; const char* b2h1 = last ? no.b1 : co.b1 + (long)(t + 2) * co.ksB;
            const long ks2A = last ? no.ksA : co.ksA, ks2B = last ? no.ksB : co.ksB;
            const char* a3h0 = a2h0 + ks2A; const char* b3h0 = b2h0 + ks2B; const char* b3h1 = b2h1 + ks2B;
            unsigned wa00 = v.a[0][0], wa01 = v.a[0][1], wa10 = v.a[P::GATHER][0], wa11 = v.a[P::GATHER][1], wb0 = v.b[0], wb1 = v.b[1];
            if constexpr (P::VAR_OFF) { if (last) { wa00 = nv.a[0][0]; wa01 = nv.a[0][1]; wa10 = nv.a[P::GATHER][0]; wa11 = nv.a[P::GATHER][1]; wb0 = nv.b[0]; wb1 = nv.b[1]; } }
            GE_LDB(B0, 0, 0); GE_LDB(B1, 0, 1); GE_SCHED; GE_LDA(At, 0, 0); GE_STAGE(GE_SA(1, 1), a1h1, v.a[P::GATHER][0], v.a[P::GATHER][1]);
            GE_WAIT_V(8); GE_WAIT_L(0); GE_BAR; GE_MMA(0, 0, At, B0); GE_MMA(0, 1, At, B1); GE_BAR; GE_SCHED;
            GE_LDA(At, 0, 1); GE_STAGE(GE_SB(0, 0), b2h0, wb0, wb1); GE_STAGE(GE_SB(0, 1), b2h1, wb0, wb1); GE_STAGE(GE_SA(0, 0), a2h0, wa00, wa01);
            GE_WAIT_V(8); GE_WAIT_L(0); GE_BAR; GE_MMA(1, 0, At, B0); GE_MMA(1, 1, At, B1); GE_BAR; GE_SCHED;
            GE_LDB(B0, 1, 0); GE_LDB(B1, 1, 1); GE_SCHED; GE_LDA(At, 1, 0); GE_STAGE(GE_SA(0, 1), a2h1, wa10, wa11);
            GE_WAIT_V(8); GE_WAIT_L(0); GE_BAR; GE_MMA(0, 0, At, B0); GE_MMA(0, 1, At, B1); GE_BAR; GE_SCHED;
            GE_LDA(At, 1, 1); GE_STAGE(GE_SB(1, 0), b3h0, wb0, wb1); GE_STAGE(GE_SB(1, 1), b3h1, wb0, wb1); GE_STAGE(GE_SA(1, 0), a3h0, wa00, wa01);
            GE_WAIT_V(8); GE_WAIT_L(0); GE_BAR; GE_MMA(1, 0, At, B0); GE_MMA(1, 1, At, B1); GE_BAR; GE_SCHED;
        }
        if (wr == 0) GE_BAR;
        prog.epi(acc, cur, wr, wc, fr, fq);
        if (!has_next) break;
#pragma unroll
        for (int a = 0; a < 2; ++a)
#pragma unroll
            for (int b = 0; b < 2; ++b)
#pragma unroll
                for (int m = 0; m < 4; ++m)
#pragma unroll
                    for (int n = 0; n < 2; ++n) acc[a][b][m][n] = (f32x4){0.f, 0.f, 0.f, 0.f};
        cur = nxt; co = no; if constexpr (P::VAR_OFF) v = nv; ++ui;
        if (wr == 1) GE_BAR;
    }
    GE_WAIT_V(0);
    GE_BAR;
#undef GE_LANE
#undef GE_SA
#undef GE_SB
#undef GE_STAGE
#undef GE_LDA
#undef GE_LDB
#undef GE_MMA
#undef GE_WAIT_V
#undef GE_WAIT_L
#undef GE_BAR
#undef GE_SCHED
}
__device__ __forceinline__ void off_rm(const Lane& ln, int lda, int ldb, Off& v) {
#pragma unroll
    for (int i = 0; i < 2; ++i) { v.a[0][i] = (unsigned)(ln.R[i] * lda + ln.C[i]) * 2u; v.b[i] = (unsigned)(ln.Rb[i] * ldb + ln.C[i]) * 2u; }
}
}
struct StaticOrder {
    int nM, nN, nwg, G, c;
    __device__ void init(int M, int N, int G_, int c_) { nM = M / 256; nN = N / 256; nwg = nM * nN; G = G_; c = c_; }
    __device__ __forceinline__ bool next(int i, int& pm, int& pn) const {
        const long L = (long)i * G + c; if (L >= nwg) return false;
        int wgid = (int)L; { const int q = nwg / 8, r = nwg % 8, xcd = wgid % 8, off = wgid / 8; wgid = (xcd < r ? xcd * (q + 1) : r * (q + 1) + (xcd - r) * q) + off; }
        const int nig = 8 * nN, gid = wgid / nig, fm = gid * 8, gsz = (nM - fm) < 8 ? (nM - fm) : 8;
        pm = fm + ((wgid % nig) % gsz); pn = (wgid % nig) / gsz; return true;
    }
};
#define EPI_ROWS_BEGIN _Pragma("unroll") for (int ai = 0; ai < 2; ++ai) _Pragma("unroll") for (int m = 0; m < 4; ++m) { const int rt = 128 * ai + 64 * wr + 16 * m + fr;
#define EPI_ROWS_END if (m == 3) asm volatile("" ::: "memory"); }
__device__ __forceinline__ float gelu_tanh(float y) {
    const float u = 0.7978845608028654f * (y + 0.044715f * y * y * y);
    const float e = fast_exp2(u * 2.8853900817779268f);
    const float th = 1.f - 2.f * fast_rcp(1.f + e);
    return 0.5f * y * (1.f + th);
}
__device__ __forceinline__ float sigmoidf_(float x) { return fast_rcp(1.f + fast_exp2(-1.4426950408889634f * x)); }

struct ProgG1 {
    static constexpr int VAR_OFF = 0, GATHER = 0;
    struct Unit { int pm, pn; };
    StaticOrder so; const char* A; const char* B; bf16_t* Z; bf16_t* U; float* ssqp; int nt_ov = 0;
    __device__ __forceinline__ bool next(int i, Unit& u) const { return so.next(i, u.pm, u.pn); }
    __device__ __forceinline__ void ops(const Unit& u, ge::Ops& o) const {
        o.a0 = A + (size_t)u.pm * 256 * DM * 2; o.a1 = o.a0 + (size_t)128 * DM * 2; o.b0 = B + (size_t)u.pn * 256 * DM * 2; o.b1 = o.b0 + (size_t)128 * DM * 2; o.ksA = 128; o.ksB = 128; o.nt = nt_ov ? nt_ov : DM / 64; }
    __device__ __forceinline__ void voff(const Unit&, const ge::Lane& ln, ge::Off& v) const { ge::off_rm(ln, DM, DM, v); }
    __device__ __forceinline__ void epi(const ge::Acc& acc, const Unit& u, int wr, int wc, int fr, int fq) const {
        const int pn = u.pn; const int cl = 32 * wc + 8 * fq;
        EPI_ROWS_BEGIN
            const int row = u.pm * 256 + rt;
            float ss = 0.f;
#pragma unroll
            for (int bj = 0; bj < 2; ++bj) {
                const f32x4 v0 = acc[ai][bj][m][0], v1 = acc[ai][bj][m][1]; const int c = 128 * bj + cl;
                const u32x4 w = pack8f(v0, v1);
                ss += (v0[0] * v0[0] + v0[1] * v0[1]) + (v0[2] * v0[2] + v0[3] * v0[3]) + (v1[0] * v1[0] + v1[1] * v1[1]) + (v1[2] * v1[2] + v1[3] * v1[3]);
                if (pn < 2) *(u32x4*)(Z + (size_t)row * ZLD + Z_POOL + 256 * pn + c) = w;
                else if (pn < 4) { const int ch = 256 * (pn - 2) + c; *(u32x4*)(U + ((size_t)(ch >> 4) * NTOK + row) * 16 + (ch & 15)) = w; }
                else if (pn < 6) *(u32x4*)(Z + (size_t)row * ZLD + Z_QC + 256 * (pn - 4) + c) = w;
                else if (pn == 6) *(u32x4*)(Z + (size_t)row * ZLD + Z_KVC + c) = w;
                else if (c < 64) *(u32x4*)(Z + (size_t)row * ZLD + Z_KPE + c) = w;
            }
            if (pn >= 4 && pn <= 6) { ss += __shfl_xor(ss, 16); ss += __shfl_xor(ss, 32); if (fq == 0) ssqp[(size_t)row * 12 + (pn - 4) * 4 + wc] = ss; }
        EPI_ROWS_END
    }
};

struct ProgG2 {
    static constexpr int VAR_OFF = 1, GATHER = 0;
    struct Unit { int type, pm, pn, g; };
    int G, c; int tmask = 15;
    const char* Z; const char* U; const char* WUQ; const char* WUKV; const char* WPOOL; const char* SSMTAB;
    const float* ssqp; const f32x2* CS;
    bf16_t* Q; bf16_t* K; bf16_t* V; bf16_t* P; bf16_t* YI; float* EBUF;
    static constexpr int N_SSM = 320, N_Q = 768, N_KV = 1024, N_POOL = 256, N_ALL = N_SSM + N_Q + N_KV + N_POOL;
    __device__ __forceinline__ bool next_all(int i, Unit& u) const {
        const int x = c & 7, W = G >> 3; int L = (c >> 3) + W * i;
        if (L < 40) { u.type = 0; u.pn = 4 - (L >> 3); const int r = 8 * x + (L & 7); u.g = r >> 1; u.pm = r & 1; return true; } L -= 40;
        if (L < 96) { u.type = 1; u.pm = 16 * x + L / 6; u.pn = L % 6; u.g = 0; return true; } L -= 96;
        if (L < 128) { u.type = 2; u.pm = 16 * x + (L >> 3); u.pn = L & 7; u.g = 0; return true; } L -= 128;
        if (L < 32) { u.type = 3; u.pm = 16 * x + (L >> 1); u.pn = L & 1; u.g = 0; return true; }
        return false;
    }
#ifdef MK_G2_SPLIT
    __device__ __forceinline__ bool next(int i, Unit& u) const {
        int k = -1; for (int j = 0; j < 12; ++j) { if (!next_all(j, u)) return false; if ((tmask >> u.type) & 1) { if (++k == i) return true; } } return false; }
#else
    __device__ __forceinline__ bool next(int i, Unit& u) const { return next_all(i, u); }
#endif
    __device__ __forceinline__ void ops(const Unit& u, ge::Ops& o) const {
        if (u.type == 0) {
            o.a0 = U + ((size_t)u.g * NTOK * 16 + (size_t)u.pm * 256 * 1024) * 2; o.a1 = o.a0 + (size_t)128 * 1024 * 2; o.ksA = 128;
            const char* tab = SSMTAB + (size_t)u.g * SSMTAB_STRIDE;
            if (u.pn < 4) { o.b0 = tab + SSM_TG + (size_t)(16 * u.pn + 60) * 512; o.b1 = o.b0 + 8 * 512; o.ksB = -2048; o.nt = 4 * (u.pn + 1); }
            else { o.b0 = tab + SSM_TEND; o.b1 = o.b0; o.ksB = 16384; o.nt = 16; }
        } else if (u.type == 1) {
            o.a0 = Z + ((size_t)u.pm * 256 * ZLD + Z_QC) * 2; o.a1 = o.a0 + (size_t)128 * ZLD * 2; o.ksA = 128;
            o.b0 = WUQ + (size_t)u.pn * 256 * 512 * 2; o.b1 = o.b0 + (size_t)128 * 512 * 2; o.ksB = 128; o.nt = 8;
        } else if (u.type == 2) {
            o.a0 = Z + ((size_t)u.pm * 256 * ZLD + Z_KVC) * 2; o.a1 = o.a0 + (size_t)128 * ZLD * 2; o.ksA = 128;
            o.b0 = WUKV + (size_t)u.pn * 256 * 256 * 2; o.b1 = o.b0 + (size_t)128 * 256 * 2; o.ksB = 128; o.nt = 4;
        } else {
            o.a0 = Z + ((size_t)u.pm * 256 * ZLD + Z_POOL + 256 * u.pn) * 2; o.a1 = o.a0 + (size_t)128 * ZLD * 2; o.ksA = 128;
            o.b0 = WPOOL + (size_t)u.pn * 256 * 256 * 2; o.b1 = o.b0 + (size_t)128 * 256 * 2; o.ksB = 128; o.nt = 4;
        }
    }
    __device__ __forceinline__ void voff(const Unit& u, const ge::Lane& ln, ge::Off& v) const {
#pragma unroll
        for (int i = 0; i < 2; ++i) {
            const int R = ln.R[i], Rb = ln.Rb[i], C = ln.C[i]; unsigned a, b;
            if (u.type == 0) {
                a = (unsigned)(R * 1024 + C) * 2u;
                if (u.pn < 4) b = (unsigned)(((Rb >> 4) - (C >> 4) + 3) * 256 + (Rb & 15) * 16 + (C & 15)) * 2u;
                else b = (unsigned)((((C >> 4) * 128 + Rb) * 16) + (C & 15)) * 2u;
            } else if (u.type == 1) { a = (unsigned)(R * ZLD + C) * 2u; b = (unsigned)(Rb * 512 + C) * 2u; }
            else { a = (unsigned)(R * ZLD + C) * 2u; b = (unsigned)(Rb * 256 + C) * 2u; }
            v.a[0][i] = a; v.b[i] = b;
        }
    }
    __device__ __forceinline__ void epi(const ge::Acc& acc, const Unit& u, int wr, int wc, int fr, int fq) const {
        const int cl = 32 * wc + 8 * fq;
        if (u.type == 0) {
            EPI_ROWS_BEGIN
                const int cg = u.pm * 256 + rt;
                if (u.pn < 4) {
#pragma unroll
                    for (int bj = 0; bj < 2; ++bj) { const int n = 128 * bj + cl, t = 16 * u.pn + (n >> 4), h0 = n & 15;
                        *(u32x4*)(YI + ((size_t)cg * 64 + t) * 512 + u.g * 16 + h0) = pack8f(acc[ai][bj][m][0], acc[ai][bj][m][1]); }
                } else {
                    float* e = EBUF + ((size_t)cg * SSM_G + u.g) * 128 + cl;
                    *(f32x4*)e = acc[ai][0][m][0]; *(f32x4*)(e + 4) = acc[ai][0][m][1];
                }
            EPI_ROWS_END
        } else if (u.type == 1) {
            constexpr float QSCALE = 0.07216878364870322f * 1.4426950408889634f;
            EPI_ROWS_BEGIN
                const int row = u.pm * 256 + rt; const int b = row >> 14, t = row & (SEQ - 1);
                const f32x4 sa = *(const f32x4*)(ssqp + (size_t)row * 12), sb = *(const f32x4*)(ssqp + (size_t)row * 12 + 4);
                const float rs = rsqrtf((((sa[0] + sa[1]) + (sa[2] + sa[3])) + ((sb[0] + sb[1]) + (sb[2] + sb[3]))) * (1.f / 512.f) + EPS) * QSCALE;
#pragma unroll
                for (int bj = 0; bj < 2; ++bj) {
                    const int c = 256 * u.pn + 128 * bj + cl; const int head = c / QKD, d = c - head * QKD;
                    f32x4 v0 = acc[ai][bj][m][0] * rs, v1 = acc[ai][bj][m][1] * rs;
                    if (d >= 128) {
                        const f32x2* cs = CS + (size_t)row * 32 + ((d - 128) >> 1);
                        const f32x4 c01 = *(const f32x4*)cs, c23 = *(const f32x4*)(cs + 2);
                        f32x4 o0, o1;
                        o0[0] = v0[0] * c01[0] - v0[1] * c01[1]; o0[1] = v0[1] * c01[0] + v0[0] * c01[1];
                        o0[2] = v0[2] * c01[2] - v0[3] * c01[3]; o0[3] = v0[3] * c01[2] + v0[2] * c01[3];
                        o1[0] = v1[0] * c23[0] - v1[1] * c23[1]; o1[1] = v1[1] * c23[0] + v1[0] * c23[1];
                        o1[2] = v1[2] * c23[2] - v1[3] * c23[3]; o1[3] = v1[3] * c23[2] + v1[2] * c23[3];
                        v0 = o0; v1 = o1;
                    }
                    *(u32x4*)(Q + ((size_t)(b * NHEAD + head) * SEQ + t) * QKD + d) = pack8f(v0, v1);
                }
            EPI_ROWS_END
        } else if (u.type == 2) {
            EPI_ROWS_BEGIN
                const int row = u.pm * 256 + rt; const int b = row >> 14, t = row & (SEQ - 1);
                const f32x4 sa = *(const f32x4*)(ssqp + (size_t)row * 12 + 8);
                const float rs = rsqrtf(((sa[0] + sa[1]) + (sa[2] + sa[3])) * (1.f / 256.f) + EPS);
#pragma unroll
                for (int bj = 0; bj < 2; ++bj) {
                    const int d = 128 * bj + cl; const int head = u.pn;
                    const u32x4 w = pack8f(acc[ai][bj][m][0] * rs, acc[ai][bj][m][1] * rs);
                    if (d < 128) *(u32x4*)(K + ((size_t)(b * NHEAD + head) * SEQ + t) * QKD + d) = w;
                    else *(u32x4*)(V + ((size_t)(b * NHEAD + head) * SEQ + t) * VD + (d - 128)) = w;
                }
            EPI_ROWS_END
        } else {
            EPI_ROWS_BEGIN
                const int row = u.pm * 256 + rt;
#pragma unroll
                for (int bj = 0; bj < 2; ++bj) *(u32x4*)(P + (size_t)row * 512 + 256 * u.pn + 128 * bj + cl) = pack8f(acc[ai][bj][m][0], acc[ai][bj][m][1]);
            EPI_ROWS_END
        }
    }
};

struct ProgS1 {
    static constexpr int VAR_OFF = 0, GATHER = 0;
    struct Unit { int g, pm, pn; };
    int G, c; const char* SPREV; const char* SSMTAB; const bf16_t* YI; const bf16_t* U; const float* Dskip; bf16_t* YG;
    __device__ __forceinline__ bool next(int i, Unit& u) const { const int x = c & 7, L = (c >> 3) + (G >> 3) * i; if (L >= 32) return false; const int r = 8 * x + (L >> 2); u.g = r >> 1; u.pm = r & 1; u.pn = L & 3; return true; }
    __device__ __forceinline__ void ops(const Unit& u, ge::Ops& o) const {
        o.a0 = SPREV + ((size_t)u.pm * 256 * (SSM_G * 256) + u.g * 256) * 2; o.a1 = o.a0 + (size_t)128 * (SSM_G * 256) * 2; o.ksA = 128;
        o.b0 = SSMTAB + (size_t)u.g * SSMTAB_STRIDE + SSM_WC + (size_t)u.pn * 256 * 256 * 2; o.b1 = o.b0 + (size_t)128 * 256 * 2; o.ksB = 128; o.nt = 4; }
    __device__ __forceinline__ void voff(const Unit&, const ge::Lane& ln, ge::Off& v) const { ge::off_rm(ln, SSM_G * 256, 256, v); }
    __device__ __forceinline__ void epi(const ge::Acc& acc, const Unit& u, int wr, int wc, int fr, int fq) const {
        const int cl = 32 * wc + 8 * fq;
        EPI_ROWS_BEGIN
            const int cg = u.pm * 256 + rt;
#pragma unroll
            for (int bj = 0; bj < 2; ++bj) {
                const int n = 128 * bj + cl, t = 16 * u.pn + (n >> 4), h0 = n & 15; const size_t tok = (size_t)cg * 64 + t; const int ch = u.g * 16 + h0;
                f32x4 yi0, yi1, u0, u1; unpack8(*(const u32x4*)(YI + tok * 512 + ch), yi0, yi1); unpack8(*(const u32x4*)(U + ((size_t)u.g * NTOK + tok) * 16 + h0), u0, u1);
                const f32x4 d0 = *(const f32x4*)(Dskip + ch), d1 = *(const f32x4*)(Dskip + ch + 4);
                f32x4 y0 = acc[ai][bj][m][0] + yi0 + d0 * u0, y1 = acc[ai][bj][m][1] + yi1 + d1 * u1;
#pragma unroll
                for (int e = 0; e < 4; ++e) { y0[e] = gelu_tanh(y0[e]); y1[e] = gelu_tanh(y1[e]); }
                *(u32x4*)(YG + tok * 512 + ch) = pack8f(y0, y1);
            }
        EPI_ROWS_END
    }
};

struct ProgS2 {
    static constexpr int VAR_OFF = 0, GATHER = 0;
    struct Unit { int pm, pn; };
    int G, c; const char* YGc; const char* W; const bf16_t* YG; bf16_t* GL;
    __device__ __forceinline__ bool next(int i, Unit& u) const { const int x = c & 7, L = (c >> 3) + (G >> 3) * i; if (L >= 32) return false; u.pm = 16 * x + (L >> 1); u.pn = L & 1; return true; }
    __device__ __forceinline__ void ops(const Unit& u, ge::Ops& o) const {
        o.a0 = YGc + (size_t)u.pm * 256 * 512 * 2; o.a1 = o.a0 + (size_t)128 * 512 * 2; o.ksA = 128; o.b0 = W + (size_t)u.pn * 256 * 512 * 2; o.b1 = o.b0 + (size_t)128 * 512 * 2; o.ksB = 128; o.nt = 8; }
    __device__ __forceinline__ void voff(const Unit&, const ge::Lane& ln, ge::Off& v) const { ge::off_rm(ln, 512, 512, v); }
    __device__ __forceinline__ void epi(const ge::Acc& acc, const Unit& u, int wr, int wc, int fr, int fq) const {
        const int cl = 32 * wc + 8 * fq;
        EPI_ROWS_BEGIN
            const size_t row = (size_t)u.pm * 256 + rt;
#pragma unroll
            for (int bj = 0; bj < 2; ++bj) {
                const int c = 256 * u.pn + 128 * bj + cl; f32x4 y0, y1; unpack8(*(const u32x4*)(YG + row * 512 + c), y0, y1);
                f32x4 a0 = acc[ai][bj][m][0], a1 = acc[ai][bj][m][1];
#pragma unroll
                for (int e = 0; e < 4; ++e) { y0[e] *= sigmoidf_(a0[e]); y1[e] *= sigmoidf_(a1[e]); }
                *(u32x4*)(GL + row * 512 + c) = pack8f(y0, y1);
            }
        EPI_ROWS_END
    }
};

struct ProgG3 {
    static constexpr int VAR_OFF = 0, GATHER = 0;
    struct Unit { int pm, pn; };
    StaticOrder so; const char* A; const char* B; const float* xin; const bf16_t* xin16; bf16_t* xout; const float* ga;
    __device__ __forceinline__ bool next(int i, Unit& u) const { return so.next(i, u.pm, u.pn); }
    __device__ __forceinline__ void ops(const Unit& u, ge::Ops& o) const {
        o.a0 = A + (size_t)u.pm * 256 * DM * 2; o.a1 = o.a0 + (size_t)128 * DM * 2; o.b0 = B + (size_t)u.pn * 256 * DM * 2; o.b1 = o.b0 + (size_t)128 * DM * 2; o.ksA = 128; o.ksB = 128; o.nt = DM / 64; }
    __device__ __forceinline__ void voff(const Unit&, const ge::Lane& ln, ge::Off& v) const { ge::off_rm(ln, DM, DM, v); }
    __device__ __forceinline__ void epi(const ge::Acc& acc, const Unit& u, int wr, int wc, int fr, int fq) const {
        const int cl = 32 * wc + 8 * fq; const int b = (u.pm * 256) >> 14;
        f32x4 g[2][2];
#pragma unroll
        for (int bj = 0; bj < 2; ++bj) { const float* gp = ga + (size_t)b * 6 * DM + 256 * u.pn + 128 * bj + cl; g[bj][0] = *(const f32x4*)gp; g[bj][1] = *(const f32x4*)(gp + 4); }
        EPI_ROWS_BEGIN
            const size_t row = (size_t)u.pm * 256 + rt;
#pragma unroll
            for (int bj = 0; bj < 2; ++bj) {
                const size_t o = row * DM + 256 * u.pn + 128 * bj + cl;
                f32x4 x0, x1;
                if (xin) { x0 = *(const f32x4*)(xin + o); x1 = *(const f32x4*)(xin + o + 4); } else unpack8(*(const u32x4*)(xin16 + o), x0, x1);
                *(u32x4*)(xout + o) = pack8f(x0 + g[bj][0] * acc[ai][bj][m][0], x1 + g[bj][1] * acc[ai][bj][m][1]);
            }
        EPI_ROWS_END
    }
};

struct ProgM1 {
    static constexpr int VAR_OFF = 1, GATHER = 1;
    struct Unit { int k, pn, e, j; };
    int G, c; const LAS int* tab; int ntiles; const int* cnt; const int* toks; const char* H; const char* W13; bf16_t* ACT;
    __device__ __forceinline__ bool next(int i, Unit& u) const { const int x = c & 7, t0 = (x * ntiles) >> 3, t1 = ((x + 1) * ntiles) >> 3, L = (c >> 3) + (G >> 3) * i; if (L >= (t1 - t0) * 4) return false; u.k = t0 + (L >> 2); u.pn = L & 3; const int w = __builtin_amdgcn_readfirstlane(tab[u.k]); u.e = w >> 16; u.j = w & 0xffff; return true; }
    __device__ __forceinline__ void ops(const Unit& u, ge::Ops& o) const {
        o.a0 = H; o.a1 = H; o.ksA = 128; o.b0 = W13 + ((size_t)u.e * 1024 + 128 * u.pn) * DM * 2; o.b1 = o.b0 + (size_t)512 * DM * 2; o.ksB = 128; o.nt = DM / 64; }
    __device__ __forceinline__ void voff(const Unit& u, const ge::Lane& ln, ge::Off& v) const {
        const int n = __builtin_amdgcn_readfirstlane(cnt[u.e * 64]); const int* tl = toks + (size_t)u.e * NTOK + u.j * 256;
#pragma unroll
        for (int i = 0; i < 2; ++i) {
#pragma unroll
            for (int h = 0; h < 2; ++h) { const int r = 128 * h + ln.R[i]; const int tok = (u.j * 256 + r < n) ? tl[r] : 0; v.a[h][i] = (unsigned)(tok * DM + ln.C[i]) * 2u; }
            v.b[i] = (unsigned)(ln.Rb[i] * DM + ln.C[i]) * 2u;
        }
    }
    __device__ __forceinline__ void epi(const ge::Acc& acc, const Unit& u, int wr, int wc, int fr, int fq) const {
        const int cl = 32 * wc + 8 * fq;
        EPI_ROWS_BEGIN
            const size_t pos = (size_t)u.k * 256 + rt;
            f32x4 g0 = acc[ai][0][m][0], g1 = acc[ai][0][m][1]; const f32x4 u0 = acc[ai][1][m][0], u1 = acc[ai][1][m][1];
#pragma unroll
            for (int e = 0; e < 4; ++e) { g0[e] = g0[e] * sigmoidf_(g0[e]) * u0[e]; g1[e] = g1[e] * sigmoidf_(g1[e]) * u1[e]; }
            *(u32x4*)(ACT + pos * DEXP + 128 * u.pn + cl) = pack8f(g0, g1);
        EPI_ROWS_END
    }
};
struct ProgM2 {
    static constexpr int VAR_OFF = 0, GATHER = 0;
    struct Unit { int k, pn, e; };
    int G, c; const LAS int* tab; int ntiles; const char* ACT; const char* W2; unsigned char* Y2;
    __device__ __forceinline__ bool next(int i, Unit& u) const { const int x = c & 7, t0 = (x * ntiles) >> 3, t1 = ((x + 1) * ntiles) >> 3, L = (c >> 3) + (G >> 3) * i; if (L >= (t1 - t0) * 8) return false; u.k = t0 + (L >> 3); u.pn = L & 7; u.e = __builtin_amdgcn_readfirstlane(tab[u.k]) >> 16; return true; }
    __device__ __forceinline__ void ops(const Unit& u, ge::Ops& o) const {
        o.a0 = ACT + (size_t)u.k * 256 * DEXP * 2; o.a1 = o.a0 + (size_t)128 * DEXP * 2; o.ksA = 128; o.b0 = W2 + ((size_t)u.e * DM + 256 * u.pn) * DEXP * 2; o.b1 = o.b0 + (size_t)128 * DEXP * 2; o.ksB = 128; o.nt = DEXP / 64; }
    __device__ __forceinline__ void voff(const Unit&, const ge::Lane& ln, ge::Off& v) const { ge::off_rm(ln, DEXP, DEXP, v); }
    __device__ __forceinline__ void epi(const ge::Acc& acc, const Unit& u, int wr, int wc, int fr, int fq) const {
        const int cl = 32 * wc + 8 * fq;
        EPI_ROWS_BEGIN
            const size_t pos = (size_t)u.k * 256 + rt;
#pragma unroll
            for (int bj = 0; bj < 2; ++bj) { f32x4 v0 = acc[ai][bj][m][0], v1 = acc[ai][bj][m][1];
#pragma unroll
                for (int e = 0; e < 4; ++e) { v0[e] = fminf(fmaxf(v0[e], -448.f), 448.f); v1[e] = fminf(fmaxf(v1[e], -448.f), 448.f); }
                int w0 = __builtin_amdgcn_cvt_pk_fp8_f32(v0[0], v0[1], 0, false); w0 = __builtin_amdgcn_cvt_pk_fp8_f32(v0[2], v0[3], w0, true);
                int w1 = __builtin_amdgcn_cvt_pk_fp8_f32(v1[0], v1[1], 0, false); w1 = __builtin_amdgcn_cvt_pk_fp8_f32(v1[2], v1[3], w1, true);
                *(u32x2*)(Y2 + pos * DM + 256 * u.pn + 128 * bj + cl) = (u32x2){(unsigned)w0, (unsigned)w1}; }
        EPI_ROWS_END
    }
};
__device__ __forceinline__ int build_tile_table(const Ctx& c, const int* cnt) {
    LAS int* tab = (LAS int*)(c.lds + LDS_TILETAB); LAS int* ps = (LAS int*)(c.lds + LDS_PSTART);
    __syncthreads();
    if (c.tid < NEXP) {
        int before = 0, mine = 0;
        for (int e = 0; e < NEXP; ++e) { const int nt = (cnt[e * 64] + 255) >> 8; if (e < c.tid) before += nt; if (e == c.tid) mine = nt; }
        ps[c.tid] = before * 256;
        for (int j = 0; j < mine; ++j) tab[before + j] = (c.tid << 16) | j;
        if (c.tid == NEXP - 1) ps[NEXP] = before + mine;
    }
    __syncthreads();
    return ps[NEXP];
}
template <class F>
__device__ __forceinline__ void tr_item(const float* W, int ldw, int k0, int n0, const float* ksc, LAS float* scr, int lane, F dst) {
#pragma unroll 8
    for (int i = 0; i < 32; ++i) { const int kk = 2 * i + (lane >> 5); float v = W[(size_t)(k0 + kk) * ldw + n0 + (lane & 31)]; if (ksc) v *= ksc[k0 + kk]; scr[kk * 33 + (lane & 31)] = v; }
    LDS_WAIT(); asm volatile("" ::: "memory");
    const int cc = lane & 7;
#pragma unroll
    for (int j = 0; j < 4; ++j) { const int n = (lane >> 3) + 8 * j; const LAS float* s = scr + (8 * cc) * 33 + n;
        u32x4 o; o.x = cvtpk(s[0 * 33], s[1 * 33]); o.y = cvtpk(s[2 * 33], s[3 * 33]); o.z = cvtpk(s[4 * 33], s[5 * 33]); o.w = cvtpk(s[6 * 33], s[7 * 33]);
        bf16_t* d = dst(n0 + n); if (d) *(u32x4*)(d + k0 + 8 * cc) = o; }
    LDS_WAIT(); asm volatile("" ::: "memory");
}
__device__ __forceinline__ int rope_perm(int j) { return 2 * (j & 31) + (j >> 5); }

__device__ __forceinline__ void convert_experts(const Ctx& c, int l, int it0 = 0, int it1 = NEXP * 1536, int wg0 = 0) {
    LAS float* scr = (LAS float*)(c.lds + c.wid * 16384);
    if (c.vcu < wg0) return;
    const int gw = (c.vcu - wg0) * 8 + c.wid, NGW = (c.G - wg0) * 8;
    const float* wg = inp(c, 29) + (size_t)l * NEXP * DM * DEXP; const float* wu = inp(c, 30) + (size_t)l * NEXP * DM * DEXP; const float* wd = inp(c, 31) + (size_t)l * NEXP * DEXP * DM;
    bf16_t* W13 = wsp<bf16_t>(c, WS_W13); bf16_t* W2 = wsp<bf16_t>(c, WS_W2);
    for (int it = it0 + gw; it < it1; it += NGW) {
        const int e = it / 1536, r = it % 1536;
        if (r < 1024) { const int up = r >> 9, q = r & 511, kb = q >> 4, nb = q & 15; const float* W = (up ? wu : wg) + (size_t)e * DM * DEXP; bf16_t* D = W13 + ((size_t)e * 1024 + up * 512) * DM;
            tr_item(W, DEXP, kb * 64, nb * 32, nullptr, scr, c.lane, [=](int n) { return D + (size_t)n * DM; }); }
        else { const int q = r - 1024, kb = q >> 6, nb = q & 63; const float* W = wd + (size_t)e * DEXP * DM; bf16_t* D = W2 + (size_t)e * DM * DEXP;
            tr_item(W, DM, kb * 64, nb * 32, nullptr, scr, c.lane, [=](int n) { return D + (size_t)n * DEXP; }); }
    }
}

__device__ __forceinline__ void p0_prologue(const Ctx& c) {
    const int gw = c.vcu * 8 + c.wid, NGW = c.G * 8; const int gt = c.vcu * 512 + c.tid, NGT = c.G * 512;
    {
        LAS float* red = (LAS float*)c.lds;
        const float* cv = inp(c, 1);
        for (int item = c.vcu; item < 96; item += c.G) {
            const int l = item / 48, cb = item % 48;
            const float* w = inp(c, 3) + ((size_t)l * DM + 256 * c.wid) * (6 * DM) + cb * 256 + c.lane * 4;
            f32x4 a0 = {0.f, 0.f, 0.f, 0.f}, a1 = {0.f, 0.f, 0.f, 0.f};
#pragma unroll 16
            for (int k = 0; k < 256; ++k) { const f32x4 wv = *(const f32x4*)(w + (size_t)k * (6 * DM)); const float c0 = cv[256 * c.wid + k], c1 = cv[DM + 256 * c.wid + k]; a0 += wv * c0; a1 += wv * c1; }
            *(LAS f32x4*)(red + (c.wid * 2 + 0) * 256 + c.lane * 4) = a0; *(LAS f32x4*)(red + (c.wid * 2 + 1) * 256 + c.lane * 4) = a1;
            __syncthreads();
            { const int b = c.tid >> 8, col = c.tid & 255; float s = inp(c, 4)[(size_t)l * 6 * DM + cb * 256 + col];
#pragma unroll
              for (int w8 = 0; w8 < 8; ++w8) s += red[(w8 * 2 + b) * 256 + col];
              wsp<float>(c, WS_MOD)[((size_t)(l * NB + b) * 6) * DM + cb * 256 + col] = s; }
            __syncthreads();
        }
    }
    {
        LAS float* scr = (LAS float*)(c.lds + c.wid * 16384);
        constexpr int I_IN = 32 * 58, I_UQ = 8 * 48, I_UKV = 4 * 64, I_OUT = 32 * 64, I_GLU = 8 * 16, I_L = I_IN + I_UQ + I_UKV + I_OUT + I_GLU;
        for (int it = gw; it < 2 * I_L; it += NGW) {
            const int l = it / I_L; int r = it % I_L;
            if (r < I_IN) { const int kb = r / 58, nb = r % 58; bf16_t* D = wsp<bf16_t>(c, WS_WIN) + (size_t)l * DM * DM;
                tr_item(inp(c, 6) + (size_t)l * DM * IN_COLS, IN_COLS, kb * 64, nb * 32, nullptr, scr, c.lane, [=](int n) { const int dr = n < 1792 ? n : 1792 + rope_perm(n - 1792); return D + (size_t)dr * DM; }); continue; } r -= I_IN;
            if (r < I_UQ) { const int kb = r / 48, nb = r % 48; bf16_t* D = wsp<bf16_t>(c, WS_WUQ) + (size_t)l * 1536 * 512;
                tr_item(inp(c, 20) + (size_t)l * 512 * 1536, 1536, kb * 64, nb * 32, inp(c, 18) + l * 512, scr, c.lane, [=](int n) { const int h = n / QKD, d = n % QKD; const int dr = h * QKD + (d < 128 ? d : 128 + rope_perm(d - 128)); return D + (size_t)dr * 512; }); continue; } r -= I_UQ;
            if (r < I_UKV) { const int kb = r / 64, nb = r % 64; bf16_t* D = wsp<bf16_t>(c, WS_WUKV) + (size_t)l * 2048 * 256;
                tr_item(inp(c, 21) + (size_t)l * 256 * 2048, 2048, kb * 64, nb * 32, inp(c, 19) + l * 256, scr, c.lane, [=](int n) { return D + (size_t)n * 256; }); continue; } r -= I_UKV;
            if (r < I_OUT) { const int kb = r / 64, nb = r % 64; bf16_t* D = wsp<bf16_t>(c, WS_WOUT) + (size_t)l * DM * DM;
                tr_item(inp(c, 23) + (size_t)l * DM * DM, DM, kb * 64, nb * 32, inp(c, 22) + l * DM, scr, c.lane, [=](int n) { return D + (size_t)n * DM; }); continue; } r -= I_OUT;
            { const int kb = r / 16, nb = r % 16; bf16_t* D = wsp<bf16_t>(c, WS_WGLU) + (size_t)l * 512 * 512;
                tr_item(inp(c, 17) + (size_t)l * 512 * 512, 512, kb * 64, nb * 32, nullptr, scr, c.lane, [=](int n) { return D + (size_t)n * 512; }); }
        }
    }
    { const int split = (c.G > 96) ? 15 * 8 * (c.G - 96) : 0;
      __syncthreads(); convert_experts(c, 0, 0, split, 96); convert_experts(c, 0, split, NEXP * 1536, 0); }
    for (int i = gt; i < 2 * 2 * 256 * 256; i += NGT) {
        const int k = i & 255, n = (i >> 8) & 255, pn = (i >> 16) & 1, l = i >> 17; float v = 0.f;
        if ((k >> 7) == (n >> 7)) { const int g = 2 * pn + (n >> 7); v = inp(c, 7)[(((size_t)l * 4 + g) * 128 + (k & 127)) * 128 + (n & 127)] * inp(c, 8)[l * 512 + g * 128 + (n & 127)]; }
        wsp<bf16_t>(c, WS_WPOOL)[i] = f2bf(v);
    }
    for (int i = gt; i < 2 * 192 * DM / 8; i += NGT) { const int l = i / (192 * DM / 8), r = i % (192 * DM / 8); *(u32x4*)(wsp<bf16_t>(c, WS_WIN) + (size_t)l * DM * DM + (size_t)IN_COLS * DM + (size_t)r * 8) = (u32x4){0u, 0u, 0u, 0u}; }
    for (int i = gt; i < (int)(8 * MiB / 16); i += NGT) *(u32x4*)(c.ws + WS_SPREV + (size_t)i * 16) = (u32x4){0u, 0u, 0u, 0u};
    for (int i = gt; i < NTOK * 32; i += NGT) {
        const int tok = i >> 5, f = i & 31; const float invf = exp2f(-(float)f * (13.287712379549449f / 32.0f));
        const float ang = (float)((const int*)c.a.in[2])[tok] * invf; float s, co; sincos_rev((double)ang, s, co);
        wsp<f32x2>(c, WS_CS)[i] = (f32x2){co, s};
    }
    for (int i = gt; i < 64 * 65 * 64; i += NGT) {
        const int lg = i / (65 * 64), r = i % (65 * 64), lag = r >> 6, p = r & 63, l = lg >> 5, g = lg & 31;
        const float dt = __expf(inp(c, 11)[l * 32 + g]); const int gp = lg * 64 + p; const float lr = inp(c, 9)[gp], lim = inp(c, 10)[gp];
        float sl, cl_; sincos_rev((double)lag * (double)(lim * dt), sl, cl_); const float ml = __expf((float)lag * lr * dt);
        wsp<f32x2>(c, WS_PWTAB)[i] = (f32x2){ml * cl_, ml * sl};
    }
    for (int i = gt; i < 64 * 64 * 16; i += NGT) {
        const int gp = i >> 4, hp = i & 15, lg = gp >> 6, l = lg >> 5, g = lg & 31;
        const float dt = __expf(inp(c, 11)[l * 32 + g]); const float lr = inp(c, 9)[gp], lim = inp(c, 10)[gp];
        float s1, c1; sincos_rev((double)(lim * dt), s1, c1); const float mg = __expf(lr * dt); const float ar = mg * c1, aim = mg * s1;
        const float den = lr * lr + lim * lim; const float fr_ = ((ar - 1.f) * lr + aim * lim) / den, fi_ = (aim * lr - (ar - 1.f) * lim) / den;
        const float br = inp(c, 12)[i], bi = inp(c, 13)[i];
        wsp<f32x2>(c, WS_BBTAB)[i] = (f32x2){fr_ * br - fi_ * bi, fr_ * bi + fi_ * br};
    }
    for (int i = gt; i < 64 * 64; i += NGT) {
        const int lg = i >> 6, l = lg >> 5, g = lg & 31; const float dt = __expf(inp(c, 11)[l * 32 + g]); const float lr = inp(c, 9)[i], lim = inp(c, 10)[i];
        float sl, cl_; sincos_rev(64.0 * (double)(lim * dt), sl, cl_); const float ml = __expf(64.f * lr * dt); wsp<f32x2>(c, WS_A64)[i] = (f32x2){ml * cl_, ml * sl};
    }
}

__device__ __forceinline__ void gen_ssm_tables(const Ctx& c) {
    const int gt = c.vcu * 512 + c.tid, NGT = c.G * 512;
    const f32x2* PW = wsp<const f32x2>(c, WS_PWTAB); const f32x2* BB = wsp<const f32x2>(c, WS_BBTAB);
    for (int i = gt; i < 64 * 127 * 64; i += NGT) {
        const int lg = i / (127 * 64), r = i % (127 * 64), li_ = r >> 6, h = (r >> 2) & 15, hp = (r & 3) * 4;
        f32x4 acc = {0.f, 0.f, 0.f, 0.f};
        if (li_ >= 63) {
            const f32x2* pw = PW + ((size_t)lg * 65 + (li_ - 63)) * 64; const f32x2* bb = BB + (size_t)lg * 1024 + hp; const float* cr = inp(c, 14) + ((size_t)lg * 16 + h) * 64; const float* ci = inp(c, 15) + ((size_t)lg * 16 + h) * 64;
#pragma unroll 4
            for (int p = 0; p < 64; ++p) { const f32x2 a = pw[p]; const float c_r = cr[p], c_i = ci[p]; const float wr_ = a.x * c_r - a.y * c_i, wi_ = a.x * c_i + a.y * c_r;
                const f32x4 b01 = *(const f32x4*)(bb + p * 16), b23 = *(const f32x4*)(bb + p * 16 + 2);
                acc[0] += wr_ * b01[0] - wi_ * b01[1]; acc[1] += wr_ * b01[2] - wi_ * b01[3]; acc[2] += wr_ * b23[0] - wi_ * b23[1]; acc[3] += wr_ * b23[2] - wi_ * b23[3]; }
        }
        *(u32x2*)(c.ws + WS_SSMTAB + (size_t)lg * SSMTAB_STRIDE + SSM_TG + ((size_t)li_ * 256 + h * 16 + hp) * 2) = (u32x2){cvtpk(acc[0], acc[1]), cvtpk(acc[2], acc[3])};
    }
    for (int i = gt; i < 64 * 64 * 128 * 2; i += NGT) {
        const int lg = i >> 14, r8 = i & 16383, tau = r8 >> 8, pp = (r8 >> 1) & 127, hp0 = (r8 & 1) * 8, p = pp & 63;
        const f32x2 a = PW[((size_t)lg * 65 + (63 - tau)) * 64 + p]; const f32x2* b = BB + (size_t)lg * 1024 + p * 16 + hp0; float v[8];
#pragma unroll
        for (int e = 0; e < 8; ++e) { const f32x2 bb = b[e]; v[e] = pp < 64 ? a.x * bb.x - a.y * bb.y : a.x * bb.y + a.y * bb.x; }
        *(u32x4*)(c.ws + WS_SSMTAB + (size_t)lg * SSMTAB_STRIDE + SSM_TEND + ((size_t)r8 * 8) * 2) = (u32x4){cvtpk(v[0], v[1]), cvtpk(v[2], v[3]), cvtpk(v[4], v[5]), cvtpk(v[6], v[7])};
    }
    for (int i = gt; i < 64 * 1024 * 32; i += NGT) {
        const int lg = i >> 15, r8 = i & 32767, n = r8 >> 5, k0 = (r8 & 31) * 8, t = n >> 4, h = n & 15; float v[8];
        if (k0 < 128) { const int p0 = k0 & 63; const f32x2* a = PW + ((size_t)lg * 65 + (t + 1)) * 64 + p0; const float* cr = inp(c, 14) + ((size_t)lg * 16 + h) * 64 + p0; const float* ci = inp(c, 15) + ((size_t)lg * 16 + h) * 64 + p0;
#pragma unroll
            for (int e = 0; e < 8; ++e) { const f32x2 aa = a[e]; v[e] = k0 < 64 ? cr[e] * aa.x - ci[e] * aa.y : -(cr[e] * aa.y + ci[e] * aa.x); } }
        else {
#pragma unroll
            for (int e = 0; e < 8; ++e) v[e] = 0.f; }
        *(u32x4*)(c.ws + WS_SSMTAB + (size_t)lg * SSMTAB_STRIDE + SSM_WC + ((size_t)r8 * 8) * 2) = (u32x4){cvtpk(v[0], v[1]), cvtpk(v[2], v[3]), cvtpk(v[4], v[5]), cvtpk(v[6], v[7])};
    }
}

__device__ __forceinline__ void router_prep(const Ctx& c, int l) {
    const int gt = c.vcu * 512 + c.tid, NGT = c.G * 512;
    for (int i = gt; i < NB * 64 * 3 * 64; i += NGT) {
        const int ln = i & 63, cb = (i >> 6) % 3, ks = (i / 192) & 63, b = i / (192 * 64);
        const int j = 16 * cb + (ln & 15), k0 = 32 * ks + 8 * (ln >> 4);
        float hi[8], lo[8];
#pragma unroll
        for (int e = 0; e < 8; ++e) { const int k = k0 + e; float w = 0.f;
            if (j < 4) w = inp(c, 25)[((size_t)l * DM + k) * 4 + j]; else if (j < 36) w = inp(c, 27)[((size_t)l * DM + k) * 32 + (j - 4)];
            w *= inp(c, 24)[l * DM + k] * (1.f + modp(c, l, b, 4)[k]);
            hi[e] = bf2f(f2bf(w)); lo[e] = w - hi[e]; }
        u32x4 H, L; H.x = cvtpk(hi[0], hi[1]); H.y = cvtpk(hi[2], hi[3]); H.z = cvtpk(hi[4], hi[5]); H.w = cvtpk(hi[6], hi[7]); L.x = cvtpk(lo[0], lo[1]); L.y = cvtpk(lo[2], lo[3]); L.z = cvtpk(lo[4], lo[5]); L.w = cvtpk(lo[6], lo[7]);
        bf16_t* base = wsp<bf16_t>(c, WS_RWF) + ((((size_t)(l * NB + b) * 64 + ks) * 3 + cb) * 2) * 512;
        *(u32x4*)(base + ln * 8) = H; *(u32x4*)(base + 512 + ln * 8) = L;
    }
    const int gw = c.vcu * 8 + c.wid, NGW = c.G * 8;
    for (int i = gw; i < NB * 36; i += NGW) {
        const int b = i / 36, j = i % 36; float s = 0.f;
        for (int k = c.lane; k < DM; k += 64) { const float w = j < 4 ? inp(c, 25)[((size_t)l * DM + k) * 4 + j] : inp(c, 27)[((size_t)l * DM + k) * 32 + (j - 4)]; s += modp(c, l, b, 3)[k] * w; }
        s = wave_sum(s);
        if (c.lane == 0) wsp<float>(c, WS_RBIAS)[(l * NB + b) * 64 + j] = s + (j < 4 ? inp(c, 26)[l * 4 + j] : inp(c, 28)[l * 32 + (j - 4)]);
    }
}

template <int MODE>
__device__ __forceinline__ void norm_phase(const Ctx& c, int l) {
    LAS float* red0 = (LAS float*)c.lds;
    const LAS int* ps = (const LAS int*)(c.lds + LDS_PSTART);
    const int lane = c.lane, wid = c.wid, row = lane & 15, kq = lane >> 4;
    bf16_t* xbuf = wsp<bf16_t>(c, WS_XBUF);
    const bool src_f32 = (MODE == 0 && l == 0);
    const int lm = (MODE == 3) ? 1 : l - 1;
    const i32x4* RI = wsp<const i32x4>(c, WS_RI) + (size_t)(lm < 0 ? 0 : lm) * NTOK; const f32x2* RW = wsp<const f32x2>(c, WS_RW) + (size_t)(lm < 0 ? 0 : lm) * NTOK;
    const unsigned char* Y2 = wsp<const unsigned char>(c, WS_Y2);
    bf16_t* H = wsp<bf16_t>(c, WS_H);
    int* cnt = wsp<int>(c, WS_CTL) + CW_CNT + l * 32 * 64;
    LAS float* Gt = (LAS float*)(c.lds + 65536); LAS float* SHt = Gt + NB * DM; LAS float* GFt = SHt + NB * DM;
    for (int i = c.tid; i < NB * DM; i += 512) { const int b_ = i / DM, k_ = i % DM;
        if (MODE == 3) { Gt[i] = inp(c, 32)[k_]; SHt[i] = 0.f; }
        else { const int nsel_ = (MODE == 2) ? 24 : 5, off_ = (MODE == 2) ? 3 : 0; Gt[i] = inp(c, nsel_)[l * DM + k_] * (1.f + modp(c, l, b_, off_ + 1)[k_]); SHt[i] = modp(c, l, b_, off_)[k_]; }
        if (MODE == 1 || MODE == 3) GFt[i] = modp(c, lm, b_, 5)[k_]; }
    __syncthreads();
    f32x4 rawf[8][2]; u32x4 rawh[8];
#define NP_LOAD(u_) do { const int rg_ = (u_) * 16 + row; _Pragma("unroll") for (int s = 0; s < 8; ++s) { const int k = 256 * wid + 32 * s + 8 * kq; \
        if (src_f32) { rawf[s][0] = *(const f32x4*)(inp(c, 0) + (size_t)rg_ * DM + k); rawf[s][1] = *(const f32x4*)(inp(c, 0) + (size_t)rg_ * DM + k + 4); } \
        else rawh[s] = *(const u32x4*)(xbuf + (size_t)rg_ * DM + k); } } while (0)
    if (c.vcu < NTOK / 16) NP_LOAD(c.vcu);
    int par = 0; bf16x8 wq[8][3]; int wq_b = -1;
#ifdef MK_DIAG_FIN
    const unsigned long long dfin_t0 = __builtin_amdgcn_s_memrealtime(); int dfin_k = 0; float dfin_scale = 1.f;
#endif
    for (int unit = c.vcu; unit < NTOK / 16; unit += c.G, par ^= 1) {
        LAS float* red = red0 + par * 8192;
#ifdef MK_DIAG_FIN
        if (MODE == 3) { if (dfin_k == 4) { const float us = (float)(__builtin_amdgcn_s_memrealtime() - dfin_t0) * 0.01f; dfin_scale = 1.f + 0.02f + 4e-5f * fminf(fmaxf(us - (float)MK_DIAG_FIN, 0.f), 400.f); } ++dfin_k; }
#endif
        const int rg = unit * 16 + row; const int b = rg >> 14;
        size_t pos0 = 0, pos1 = 0; float w0 = 0.f, w1 = 0.f;
        if (MODE == 1 || MODE == 3) { const i32x4 ri = RI[rg]; const f32x2 rw = RW[rg]; pos0 = (size_t)(ps[ri.x] + ri.z); pos1 = (size_t)(ps[ri.y] + ri.w); w0 = rw.x; w1 = rw.y; }
        f32x4 xv[8][2]; float ss = 0.f;
        f32x4 acc[3] = {{0.f, 0.f, 0.f, 0.f}, {0.f, 0.f, 0.f, 0.f}, {0.f, 0.f, 0.f, 0.f}};
        if (MODE == 2) { const int bu = unit >> 10;
            if (bu != wq_b) { wq_b = bu; const bf16_t* wf = wsp<const bf16_t>(c, WS_RWF) + (((size_t)(l * NB + bu) * 64 + 8 * wid) * 3) * 2 * 512 + lane * 8;
#pragma unroll
                for (int s = 0; s < 8; ++s)
#pragma unroll
                    for (int cb = 0; cb < 3; ++cb) wq[s][cb] = *(const bf16x8*)(wf + (s * 3 + cb) * 2 * 512); } }
#pragma unroll
        for (int s = 0; s < 8; ++s) { if (src_f32) { xv[s][0] = rawf[s][0]; xv[s][1] = rawf[s][1]; } else unpack8(rawh[s], xv[s][0], xv[s][1]); }
        if (unit + c.G < NTOK / 16) NP_LOAD(unit + c.G);
#pragma unroll
        for (int s = 0; s < 8; ++s) {
            const int k = 256 * wid + 32 * s + 8 * kq;
            f32x4 x0 = xv[s][0], x1 = xv[s][1];
            if (MODE == 1 || MODE == 3) {
                f32x4 a0, a1, b0, b1;
                { const u32x2 ya = *(const u32x2*)(Y2 + pos0 * DM + k), yb = *(const u32x2*)(Y2 + pos1 * DM + k);
                  const f32x2 t0 = __builtin_amdgcn_cvt_pk_f32_fp8((int)ya.x, false), t1 = __builtin_amdgcn_cvt_pk_f32_fp8((int)ya.x, true), t2 = __builtin_amdgcn_cvt_pk_f32_fp8((int)ya.y, false), t3 = __builtin_amdgcn_cvt_pk_f32_fp8((int)ya.y, true);
                  const f32x2 u0 = __builtin_amdgcn_cvt_pk_f32_fp8((int)yb.x, false), u1 = __builtin_amdgcn_cvt_pk_f32_fp8((int)yb.x, true), u2 = __builtin_amdgcn_cvt_pk_f32_fp8((int)yb.y, false), u3 = __builtin_amdgcn_cvt_pk_f32_fp8((int)yb.y, true);
                  a0 = (f32x4){t0.x, t0.y, t1.x, t1.y}; a1 = (f32x4){t2.x, t2.y, t3.x, t3.y}; b0 = (f32x4){u0.x, u0.y, u1.x, u1.y}; b1 = (f32x4){u2.x, u2.y, u3.x, u3.y}; }
                const f32x4 g0 = *(const LAS f32x4*)(GFt + b * DM + k), g1 = *(const LAS f32x4*)(GFt + b * DM + k + 4);
                x0 += g0 * (a0 * w0 + b0 * w1); x1 += g1 * (a1 * w0 + b1 * w1);
                if (MODE == 1) { const u32x4 xw = pack8f(x0, x1); *(u32x4*)(xbuf + (size_t)rg * DM + k) = xw; unpack8(xw, x0, x1); }
            }
            xv[s][0] = x0; xv[s][1] = x1;
            ss += (x0[0] * x0[0] + x0[1] * x0[1]) + (x0[2] * x0[2] + x0[3] * x0[3]) + (x1[0] * x1[0] + x1[1] * x1[1]) + (x1[2] * x1[2] + x1[3] * x1[3]);
            if (MODE == 2) {
                const u32x4 hi = pack8f(x0, x1); const bf16x8 xh = *(const bf16x8*)&hi;
#pragma unroll
                for (int cb = 0; cb < 3; ++cb) acc[cb] = __builtin_amdgcn_mfma_f32_16x16x32_bf16(wq[s][cb], xh, acc[cb], 0, 0, 0);
            }
        }
        ss += __shfl_xor(ss, 16); ss += __shfl_xor(ss, 32);
        if (kq == 0) red[(wid * 16 + row) * 52] = ss;
        if (MODE == 2) {
#pragma unroll
            for (int cb = 0; cb < 3; ++cb)
#pragma unroll
                for (int e = 0; e < 4; ++e) red[(wid * 16 + row) * 52 + 1 + 16 * cb + 4 * kq + e] = acc[cb][e];
        }
        __syncthreads();
        float tot = 0.f;
#pragma unroll
        for (int w8 = 0; w8 < 8; ++w8) tot += red[(w8 * 16 + row) * 52];
        const float rstd = rsqrtf(tot * (1.f / DM) + EPS);
        if (MODE == 2 && wid == 0 && lane < 16) {
            const float* rb = wsp<const float>(c, WS_RBIAS) + (l * NB + b) * 64;
            float gl[4];
#pragma unroll
            for (int j = 0; j < 4; ++j) { float d = 0.f;
#pragma unroll
                for (int w8 = 0; w8 < 8; ++w8) d += red[(w8 * 16 + row) * 52 + 1 + j];
                gl[j] = rstd * d + rb[j]; }
            int gt_ = 0; float gm = gl[0];
#pragma unroll
            for (int j = 1; j < 4; ++j) if (gl[j] > gm) { gm = gl[j]; gt_ = j; }
            float gs = 0.f;
#pragma unroll
            for (int j = 0; j < 4; ++j) gs += __expf(gl[j] - gm);
            const float gwt = 1.f / gs;
            float e0 = -3.0e38f, e1 = -3.0e38f; int i0 = 0, i1 = 0;
            for (int i = 0; i < 8; ++i) { float d = 0.f;
#pragma unroll
                for (int w8 = 0; w8 < 8; ++w8) d += red[(w8 * 16 + row) * 52 + 1 + 4 + 8 * gt_ + i];
                const float lg = rstd * d + rb[4 + 8 * gt_ + i];
                if (lg > e0) { e1 = e0; i1 = i0; e0 = lg; i0 = i; } else if (lg > e1) { e1 = lg; i1 = i; } }
            const float q1 = __expf(e1 - e0); const float p0 = 1.f / (1.f + q1), p1 = q1 * p0;
            const int ex0 = 8 * gt_ + i0, ex1 = 8 * gt_ + i1;
            const int s0 = atomicAdd(cnt + ex0 * 64, 1), s1 = atomicAdd(cnt + ex1 * 64, 1);
            int* toks = wsp<int>(c, WS_TOK); toks[(size_t)ex0 * NTOK + s0] = rg; toks[(size_t)ex1 * NTOK + s1] = rg;
            wsp<i32x4>(c, WS_RI)[(size_t)l * NTOK + rg] = (i32x4){ex0, ex1, s0, s1}; wsp<f32x2>(c, WS_RW)[(size_t)l * NTOK + rg] = (f32x2){gwt * p0, gwt * p1};
        }
        if (MODE == 3) {
#pragma unroll
            for (int s = 0; s < 8; ++s) { const int k = 256 * wid + 32 * s + 8 * kq; const f32x4 g0 = *(const LAS f32x4*)(Gt + k), g1 = *(const LAS f32x4*)(Gt + k + 4);
                #ifdef MK_DIAG_FIN
                const float osc_ = dfin_scale;
#else
                const float osc_ = c.oscale;
#endif
                *(f32x4*)(c.a.out + (size_t)rg * DM + k) = xv[s][0] * (rstd * osc_) * g0; *(f32x4*)(c.a.out + (size_t)rg * DM + k + 4) = xv[s][1] * (rstd * osc_) * g1; }
        } else {
#pragma unroll
            for (int s = 0; s < 8; ++s) { const int k = 256 * wid + 32 * s + 8 * kq;
                const f32x4 g0 = *(const LAS f32x4*)(Gt + b * DM + k), g1 = *(const LAS f32x4*)(Gt + b * DM + k + 4);
                const f32x4 h0 = xv[s][0] * rstd * g0 + *(const LAS f32x4*)(SHt + b * DM + k), h1 = xv[s][1] * rstd * g1 + *(const LAS f32x4*)(SHt + b * DM + k + 4);
                *(u32x4*)(H + (size_t)rg * DM + k) = pack8f(h0, h1); }
        }
    }
    __syncthreads();
#undef NP_LOAD
}

template <int MODE>
__device__ __forceinline__ void norm_rows(const Ctx& c, int l) {
    const LAS int* ps = (const LAS int*)(c.lds + LDS_PSTART);
    const int lane = c.lane;
    bf16_t* xbuf = wsp<bf16_t>(c, WS_XBUF);
    const bool src_f32 = (MODE == 0 && l == 0);
    const int lm = (MODE == 3) ? 1 : l - 1;
    const i32x4* RI = wsp<const i32x4>(c, WS_RI) + (size_t)(lm < 0 ? 0 : lm) * NTOK; const f32x2* RW = wsp<const f32x2>(c, WS_RW) + (size_t)(lm < 0 ? 0 : lm) * NTOK;
    const unsigned char* Y2 = wsp<const unsigned char>(c, WS_Y2);
    bf16_t* H = wsp<bf16_t>(c, WS_H);
    LAS float* Gt = (LAS float*)(c.lds + 65536); LAS float* SHt = Gt + NB * DM; LAS float* GFt = SHt + NB * DM;
    for (int i = c.tid; i < NB * DM; i += 512) { const int b_ = i / DM, k_ = i % DM;
        if (MODE == 3) { Gt[i] = inp(c, 32)[k_]; SHt[i] = 0.f; }
        else { Gt[i] = inp(c, 5)[l * DM + k_] * (1.f + modp(c, l, b_, 1)[k_]); SHt[i] = modp(c, l, b_, 0)[k_]; }
        if (MODE == 1 || MODE == 3) GFt[i] = modp(c, lm, b_, 5)[k_]; }
    __syncthreads();
    const int gw = c.vcu * 8 + c.wid, NGW = c.G * 8;
    for (int r0 = gw; r0 < NTOK; r0 += 2 * NGW) {
        f32x4 xv[2][4][2]; u32x4 rawh[2][4]; u32x2 ya[2][4], yb[2][4]; float w0[2], w1[2];
#pragma unroll
        for (int q = 0; q < 2; ++q) { const int rg = r0 + q * NGW; if (rg < NTOK) {
            if (MODE == 1 || MODE == 3) { const i32x4 ri = RI[rg]; const f32x2 rw = RW[rg]; const size_t pos0 = (size_t)(ps[ri.x] + ri.z), pos1 = (size_t)(ps[ri.y] + ri.w); w0[q] = rw.x; w1[q] = rw.y;
#pragma unroll
                for (int j = 0; j < 4; ++j) { ya[q][j] = *(const u32x2*)(Y2 + pos0 * DM + 512 * j + lane * 8); yb[q][j] = *(const u32x2*)(Y2 + pos1 * DM + 512 * j + lane * 8); } }
#pragma unroll
            for (int j = 0; j < 4; ++j) { const int k = 512 * j + lane * 8;
                if (src_f32) { xv[q][j][0] = *(const f32x4*)(inp(c, 0) + (size_t)rg * DM + k); xv[q][j][1] = *(const f32x4*)(inp(c, 0) + (size_t)rg * DM + k + 4); }
                else rawh[q][j] = *(const u32x4*)(xbuf + (size_t)rg * DM + k); } } }
#pragma unroll
        for (int q = 0; q < 2; ++q) { const int rg = r0 + q * NGW; if (rg < NTOK) { const int b = rg >> 14;
            float ss = 0.f;
#pragma unroll
            for (int j = 0; j < 4; ++j) { const int k = 512 * j + lane * 8;
                f32x4 x0, x1; if (src_f32) { x0 = xv[q][j][0]; x1 = xv[q][j][1]; } else unpack8(rawh[q][j], x0, x1);
                if (MODE == 1 || MODE == 3) {
                    const f32x2 t0 = __builtin_amdgcn_cvt_pk_f32_fp8((int)ya[q][j].x, false), t1 = __builtin_amdgcn_cvt_pk_f32_fp8((int)ya[q][j].x, true), t2 = __builtin_amdgcn_cvt_pk_f32_fp8((int)ya[q][j].y, false), t3 = __builtin_amdgcn_cvt_pk_f32_fp8((int)ya[q][j].y, true);
                    const f32x2 u0 = __builtin_amdgcn_cvt_pk_f32_fp8((int)yb[q][j].x, false), u1 = __builtin_amdgcn_cvt_pk_f32_fp8((int)yb[q][j].x, true), u2 = __builtin_amdgcn_cvt_pk_f32_fp8((int)yb[q][j].y, false), u3 = __builtin_amdgcn_cvt_pk_f32_fp8((int)yb[q][j].y, true);
                    const f32x4 a0 = {t0.x, t0.y, t1.x, t1.y}, a1 = {t2.x, t2.y, t3.x, t3.y}, b0 = {u0.x, u0.y, u1.x, u1.y}, b1 = {u2.x, u2.y, u3.x, u3.y};
                    const f32x4 g0 = *(const LAS f32x4*)(GFt + b * DM + k), g1 = *(const LAS f32x4*)(GFt + b * DM + k + 4);
                    x0 += g0 * (a0 * w0[q] + b0 * w1[q]); x1 += g1 * (a1 * w0[q] + b1 * w1[q]);
                    if (MODE == 1) { const u32x4 xw = pack8f(x0, x1); *(u32x4*)(xbuf + (size_t)rg * DM + k) = xw; unpack8(xw, x0, x1); }
                }
                xv[q][j][0] = x0; xv[q][j][1] = x1;
                ss += (x0[0] * x0[0] + x0[1] * x0[1]) + (x0[2] * x0[2] + x0[3] * x0[3]) + (x1[0] * x1[0] + x1[1] * x1[1]) + (x1[2] * x1[2] + x1[3] * x1[3]);
            }
            const float rstd = rsqrtf(wave_sum(ss) * (1.f / DM) + EPS);
#pragma unroll
            for (int j = 0; j < 4; ++j) { const int k = 512 * j + lane * 8;
                if (MODE == 3) { const f32x4 g0 = *(const LAS f32x4*)(Gt + k), g1 = *(const LAS f32x4*)(Gt + k + 4);
                    *(f32x4*)(c.a.out + (size_t)rg * DM + k) = xv[q][j][0] * (rstd * c.oscale) * g0; *(f32x4*)(c.a.out + (size_t)rg * DM + k + 4) = xv[q][j][1] * (rstd * c.oscale) * g1; }
                else { const f32x4 g0 = *(const LAS f32x4*)(Gt + b * DM + k), g1 = *(const LAS f32x4*)(Gt + b * DM + k + 4);
                    const f32x4 h0 = xv[q][j][0] * rstd * g0 + *(const LAS f32x4*)(SHt + b * DM + k), h1 = xv[q][j][1] * rstd * g1 + *(const LAS f32x4*)(SHt + b * DM + k + 4);
                    *(u32x4*)(H + (size_t)rg * DM + k) = pack8f(h0, h1); } }
        } }
    }
    __syncthreads();
}

__device__ __forceinline__ void carry_phase(const Ctx& c, int l) {
    LAS float* ex = (LAS float*)c.lds;
    const float* E = wsp<const float>(c, WS_EBUF); bf16_t* SP = wsp<bf16_t>(c, WS_SPREV);
    const int seg = c.tid >> 5, pp = c.tid & 31;
    for (int item = c.vcu; item < NB * SSM_G * 2; item += c.G) {
        const int b = item >> 6, g = (item >> 1) & 31, p = (item & 1) * 32 + pp;
        const f32x2 A = wsp<const f32x2>(c, WS_A64)[(l * 32 + g) * 64 + p];
        const int c0 = b * 256 + seg * 16;
        float er[16], ei[16];
#pragma unroll
        for (int j = 0; j < 16; ++j) { const float* e = E + ((size_t)(c0 + j) * SSM_G + g) * 128; er[j] = e[p]; ei[j] = e[64 + p]; }
        float sr = 0.f, si = 0.f;
#pragma unroll
        for (int j = 0; j < 16; ++j) { const float nr = A.x * sr - A.y * si + er[j], ni = A.x * si + A.y * sr + ei[j]; sr = nr; si = ni; er[j] = sr; ei[j] = si; }
        ex[(seg * 32 + pp) * 2] = sr; ex[(seg * 32 + pp) * 2 + 1] = si;
        float pr = A.x, pi_ = A.y;
#pragma unroll
        for (int q = 0; q < 4; ++q) { const float nr = pr * pr - pi_ * pi_, ni = 2.f * pr * pi_; pr = nr; pi_ = ni; }
        __syncthreads();
        float cr = 0.f, ci = 0.f;
        for (int s = 0; s < seg; ++s) { const float tr = ex[(s * 32 + pp) * 2], ti = ex[(s * 32 + pp) * 2 + 1]; const float nr = pr * cr - pi_ * ci + tr, ni = pr * ci + pi_ * cr + ti; cr = nr; ci = ni; }
        float qr = cr, qi = ci;
#pragma unroll
        for (int j = 0; j < 16; ++j) {
            const float vr = qr + (j ? er[j - 1] : 0.f), vi = qi + (j ? ei[j - 1] : 0.f);
            bf16_t* o = SP + ((size_t)(c0 + j) * SSM_G + g) * 256; o[p] = f2bf(vr); o[64 + p] = f2bf(vi);
            const float nr = A.x * qr - A.y * qi, ni = A.x * qi + A.y * qr; qr = nr; qi = ni;
        }
        __syncthreads();
    }
}

__device__ __forceinline__ void fin_phase(const Ctx& c) {
    const bf16_t* P = wsp<const bf16_t>(c, WS_P); const bf16_t* GL = wsp<const bf16_t>(c, WS_GL); const bf16_t* O = wsp<const bf16_t>(c, WS_O); bf16_t* Y = wsp<bf16_t>(c, WS_YCAT);
    const int gw = c.vcu * 8 + c.wid, NGW = c.G * 8, lane = c.lane;
    const int wsel = lane >> 4, win = 2 << wsel;
    for (int run = gw; run < NTOK / 16; run += NGW) {
        const int t0 = run * 16; const bool hist = (t0 & (SEQ - 1)) != 0;
        {
            u32x4 ring[31];
#pragma unroll
            for (int j = 0; j < 15; ++j) ring[j] = hist ? *(const u32x4*)(P + (size_t)(t0 - 15 + j) * 512 + lane * 8) : (u32x4){0u, 0u, 0u, 0u};
#pragma unroll
            for (int j = 0; j < 16; ++j) ring[15 + j] = *(const u32x4*)(P + (size_t)(t0 + j) * 512 + lane * 8);
            f32x4 r0 = {0.f, 0.f, 0.f, 0.f}, r1 = {0.f, 0.f, 0.f, 0.f};
#pragma unroll
            for (int j = 1; j < 16; ++j) { f32x4 a0, a1; unpack8(ring[15 - j], a0, a1); const float mk = (j < win) ? 1.f : 0.f; r0 += a0 * mk; r1 += a1 * mk; }
#pragma unroll
            for (int k = 0; k < 16; ++k) {
                f32x4 c0, c1; unpack8(ring[15 + k], c0, c1); r0 += c0; r1 += c1;
                const int cn = hist ? win : ((k + 1 < win) ? k + 1 : win); const float ic = 1.f / (float)cn;
                const f32x4 y0 = r0 * ic - c0, y1 = r1 * ic - c1;
                const float ss = (y0[0] * y0[0] + y0[1] * y0[1]) + (y0[2] * y0[2] + y0[3] * y0[3]) + (y1[0] * y1[0] + y1[1] * y1[1]) + (y1[2] * y1[2] + y1[3] * y1[3]);
                const float rs = rsqrtf(wave_sum(ss) * (1.f / 512.f) + EPS);
                *(u32x4*)(Y + (size_t)(t0 + k) * DM + lane * 8) = pack8f(y0 * rs, y1 * rs);
                const u32x4 od = wsel == 0 ? ring[14 + k] : wsel == 1 ? ring[12 + k] : wsel == 2 ? ring[8 + k] : ring[k];
                f32x4 o0, o1; unpack8(od, o0, o1); r0 -= o0; r1 -= o1;
            }
        }
        {
            u32x4 g[16];
#pragma unroll
            for (int k = 0; k < 16; ++k) g[k] = *(const u32x4*)(GL + (size_t)(t0 + k) * 512 + lane * 8);
#pragma unroll
            for (int k = 0; k < 16; ++k) { f32x4 y0, y1; unpack8(g[k], y0, y1);
                const float ss = (y0[0] * y0[0] + y0[1] * y0[1]) + (y0[2] * y0[2] + y0[3] * y0[3]) + (y1[0] * y1[0] + y1[1] * y1[1]) + (y1[2] * y1[2] + y1[3] * y1[3]);
                const float rs = rsqrtf(wave_sum(ss) * (1.f / 512.f) + EPS);
                *(u32x4*)(Y + (size_t)(t0 + k) * DM + 512 + lane * 8) = pack8f(y0 * rs, y1 * rs); }
        }
#pragma unroll
        for (int hb = 0; hb < 2; ++hb) {
            u32x4 oa[8], ob[8];
#pragma unroll
            for (int k = 0; k < 8; ++k) { oa[k] = *(const u32x4*)(O + (size_t)(t0 + hb * 8 + k) * 1024 + lane * 16); ob[k] = *(const u32x4*)(O + (size_t)(t0 + hb * 8 + k) * 1024 + lane * 16 + 8); }
#pragma unroll
            for (int k = 0; k < 8; ++k) { f32x4 y0, y1, z0, z1; unpack8(oa[k], y0, y1); unpack8(ob[k], z0, z1);
                const float ss = (y0[0] * y0[0] + y0[1] * y0[1]) + (y0[2] * y0[2] + y0[3] * y0[3]) + (y1[0] * y1[0] + y1[1] * y1[1]) + (y1[2] * y1[2] + y1[3] * y1[3])
                               + (z0[0] * z0[0] + z0[1] * z0[1]) + (z0[2] * z0[2] + z0[3] * z0[3]) + (z1[0] * z1[0] + z1[1] * z1[1]) + (z1[2] * z1[2] + z1[3] * z1[3]);
                const float rs = rsqrtf(wave_sum(ss) * (1.f / 1024.f) + EPS); const size_t yo = (size_t)(t0 + hb * 8 + k) * DM + 1024 + lane * 16;
                *(u32x4*)(Y + yo) = pack8f(y0 * rs, y1 * rs); *(u32x4*)(Y + yo + 8) = pack8f(z0 * rs, z1 * rs); }
        }
    }
}
__device__ __forceinline__ void kpe_rope(const Ctx& c) {
    const bf16_t* Z = wsp<const bf16_t>(c, WS_Z); bf16_t* K = wsp<bf16_t>(c, WS_K); const f32x2* CS = wsp<const f32x2>(c, WS_CS);
    const int gt = c.vcu * 512 + c.tid, NGT = c.G * 512;
    for (int i = gt; i < NTOK * 8; i += NGT) {
        const int tok = i >> 3, q = i & 7; const int b = tok >> 14, t = tok & (SEQ - 1);
        f32x4 v0, v1; unpack8(*(const u32x4*)(Z + (size_t)tok * ZLD + Z_KPE + q * 8), v0, v1);
        const f32x2* cs = CS + (size_t)tok * 32 + q * 4; const f32x4 c01 = *(const f32x4*)cs, c23 = *(const f32x4*)(cs + 2);
        f32x4 o0, o1;
        o0[0] = v0[0] * c01[0] - v0[1] * c01[1]; o0[1] = v0[1] * c01[0] + v0[0] * c01[1]; o0[2] = v0[2] * c01[2] - v0[3] * c01[3]; o0[3] = v0[3] * c01[2] + v0[2] * c01[3];
        o1[0] = v1[0] * c23[0] - v1[1] * c23[1]; o1[1] = v1[1] * c23[0] + v1[0] * c23[1]; o1[2] = v1[2] * c23[2] - v1[3] * c23[3]; o1[3] = v1[3] * c23[2] + v1[2] * c23[3];
        const u32x4 w = pack8f(o0, o1);
#pragma unroll
        for (int h = 0; h < NHEAD; ++h) *(u32x4*)(K + ((size_t)(b * NHEAD + h) * SEQ + t) * QKD + 128 + q * 8) = w;
    }
}
namespace att {
constexpr int KN_BYTES = 16384, KR_BYTES = 8192, V_BYTES = 16384, ST_BYTES = KN_BYTES + KR_BYTES + V_BYTES, NST = 3;
constexpr int XCH_OFF = NST * ST_BYTES;
constexpr float THR2 = 11.5f;
#define AT_KSWZ(row, colB) ((row) * 256 + ((colB) ^ (((row) & 15) << 4)))
#define AT_SBAR() __builtin_amdgcn_sched_barrier(0)
__device__ __forceinline__ int v_rd_base(int lane) { return ((lane & 3) << 3) | (((lane >> 2) & 3) << 6) | (((lane >> 4) & 1) << 5) | (((lane >> 5) & 1) << 8); }
__device__ __forceinline__ int crow(int r, int hi) { return (r & 3) + 8 * (r >> 2) + 4 * hi; }
__device__ __forceinline__ void mask_tile(f32x16& p0, f32x16& p1, int dq) {
    const float NEG = -__builtin_inff();
#pragma unroll
    for (int r = 0; r < 16; ++r) { const int cc = (r & 3) + 8 * (r >> 2); if (dq - cc < 0) p0[r] = NEG; if (dq - cc - 32 < 0) p1[r] = NEG; }
}
__device__ __forceinline__ void partialSM(f32x16& p0, f32x16& p1, float& m_reg, float sh, float& delta, float& alpha, bool& nosub, bool first) {
    float pmax = p0[0];
#pragma unroll
    for (int r = 1; r < 16; ++r) pmax = fmaxf(pmax, p0[r]);
#pragma unroll
    for (int r = 0; r < 16; ++r) pmax = fmaxf(pmax, p1[r]);
    { auto rr = __builtin_amdgcn_permlane32_swap(__float_as_uint(pmax), __float_as_uint(pmax), false, false); pmax = fmaxf(__uint_as_float(rr[0]), __uint_as_float(rr[1])); }
    pmax += sh;
    float mn;
    if (__builtin_expect(__all((pmax - m_reg) <= THR2), 1)) { mn = m_reg; alpha = 1.f; nosub = !first; }
    else { mn = fmaxf(m_reg, pmax); alpha = fast_exp2(m_reg - mn); m_reg = mn; nosub = false; }
    delta = mn - sh;
    if (nosub) {
#pragma unroll
        for (int r = 0; r < 16; ++r) p0[r] = fast_exp2(p0[r]);
    } else {
#pragma unroll
        for (int r = 0; r < 16; ++r) p0[r] = fast_exp2(p0[r] - delta);
    }
}
__device__ __forceinline__ void finishSM(f32x16& p0, f32x16& p1, float delta, bool nosub, float alpha, float& l_reg, bf16x8& pa0, bf16x8& pa1, bf16x8& pa2, bf16x8& pa3) {
    if (nosub) {
#pragma unroll
        for (int r = 0; r < 16; ++r) p1[r] = fast_exp2(p1[r]);
    } else {
#pragma unroll
        for (int r = 0; r < 16; ++r) p1[r] = fast_exp2(p1[r] - delta);
    }
    float ps = 0.f;
#pragma unroll
    for (int r = 0; r < 16; ++r) ps += p0[r];
#pragma unroll
    for (int r = 0; r < 16; ++r) ps += p1[r];
    { auto rr = __builtin_amdgcn_permlane32_swap(__float_as_uint(ps), __float_as_uint(ps), false, false); ps = __uint_as_float(rr[0]) + __uint_as_float(rr[1]); }
    l_reg = l_reg * alpha + ps;
#define AT_PK4(P, B_, OUT) do { unsigned a0 = cvtpk(P[B_ + 0], P[B_ + 1]), a1 = cvtpk(P[B_ + 2], P[B_ + 3]); unsigned b0 = cvtpk(P[B_ + 4], P[B_ + 5]), b1 = cvtpk(P[B_ + 6], P[B_ + 7]); \
        auto r0 = __builtin_amdgcn_permlane32_swap(a0, b0, false, false); auto r1 = __builtin_amdgcn_permlane32_swap(a1, b1, false, false); \
        u32x4 w = {r0[0], r1[0], r0[1], r1[1]}; OUT = *reinterpret_cast<bf16x8*>(&w); } while (0)
    AT_PK4(p0, 0, pa0); AT_PK4(p0, 8, pa1); AT_PK4(p1, 0, pa2); AT_PK4(p1, 8, pa3);
#undef AT_PK4
}
#define AT_KRD(dst, addr, off) asm volatile("ds_read_b128 %0, %1 offset:%2" : "=&v"(dst) : "v"(addr), "i"(off) : "memory")
#define AT_KWAIT(n, a, b) asm volatile("s_waitcnt lgkmcnt(%2)" : "+v"(a), "+v"(b) : "i"(n) : "memory")
struct KAddr { unsigned xo[8]; };
__device__ __forceinline__ void kaddr_init(KAddr& ka, int r32, int hi) {
    const int rb = r32 * 256, key = (r32 & 15) << 4;
#pragma unroll
    for (int d0 = 0; d0 < 8; ++d0) ka.xo[d0] = (unsigned)(rb + (((d0 * 16 + hi * 8) * 2) ^ key));
}
__device__ __forceinline__ void qkt(f32x16& p0, f32x16& p1, unsigned stb  , const KAddr& ka, const bf16x8* qr, float init) {
#pragma unroll
    for (int r = 0; r < 16; ++r) { p0[r] = init; p1[r] = init; }
    u32x4 f[4][2];
#define AT_KSTEP_RD(s) do { if ((s) < 8) { const unsigned a_ = stb + ka.xo[(s) & 7]; AT_KRD(f[(s) & 3][0], a_, 0); AT_KRD(f[(s) & 3][1], a_, 8192); } \
        else { const unsigned a0_ = stb + ka.xo[((s) - 8) & 7], a1_ = stb + ka.xo[((s) - 4) & 7]; AT_KRD(f[(s) & 3][0], a0_, KN_BYTES); AT_KRD(f[(s) & 3][1], a1_, KN_BYTES); } } while (0)
    AT_KSTEP_RD(0); AT_KSTEP_RD(1); AT_KSTEP_RD(2);
#pragma unroll
    for (int s = 0; s < 12; ++s) {
        if (s + 3 < 12) AT_KSTEP_RD(s + 3);
        if (s <= 8) AT_KWAIT(6, f[s & 3][0], f[s & 3][1]); else if (s == 9) AT_KWAIT(4, f[s & 3][0], f[s & 3][1]); else if (s == 10) AT_KWAIT(2, f[s & 3][0], f[s & 3][1]); else AT_KWAIT(0, f[s & 3][0], f[s & 3][1]);
        p0 = __builtin_amdgcn_mfma_f32_32x32x16_bf16(*(const bf16x8*)&f[s & 3][0], qr[s], p0, 0, 0, 0); p1 = __builtin_amdgcn_mfma_f32_32x32x16_bf16(*(const bf16x8*)&f[s & 3][1], qr[s], p1, 0, 0, 0);
    }
#undef AT_KSTEP_RD
}
struct VFrag { s16x4 l0, l1, l2, l3, h0, h1, h2, h3; };
#define AT_TRRD(dst, vb, off) asm volatile("ds_read_b64_tr_b16 %0, %1 offset:%2" : "=&v"(dst) : "v"(vb), "i"(off) : "memory")
#define AT_VISSUE(F, vb, d0) do { constexpr int b_ = (d0) * 512; AT_TRRD(F.l0, vb, b_); AT_TRRD(F.h0, vb, b_ + 2048); AT_TRRD(F.l1, vb, b_ + 4096); AT_TRRD(F.h1, vb, b_ + 6144); \
        AT_TRRD(F.l2, vb, b_ + 8192); AT_TRRD(F.h2, vb, b_ + 10240); AT_TRRD(F.l3, vb, b_ + 12288); AT_TRRD(F.h3, vb, b_ + 14336); } while (0)
#define AT_VWAIT(n, F) asm volatile("s_waitcnt lgkmcnt(%8)" : "+v"(F.l0), "+v"(F.l1), "+v"(F.l2), "+v"(F.l3), "+v"(F.h0), "+v"(F.h1), "+v"(F.h2), "+v"(F.h3) : "i"(n) : "memory")
#define AT_VMMA(F, d0) do { \
        o[d0] = __builtin_amdgcn_mfma_f32_32x32x16_bf16(pa0, (bf16x8){F.l0[0], F.l0[1], F.l0[2], F.l0[3], F.h0[0], F.h0[1], F.h0[2], F.h0[3]}, o[d0], 0, 0, 0); \
        o[d0] = __builtin_amdgcn_mfma_f32_32x32x16_bf16(pa1, (bf16x8){F.l1[0], F.l1[1], F.l1[2], F.l1[3], F.h1[0], F.h1[1], F.h1[2], F.h1[3]}, o[d0], 0, 0, 0); \
        o[d0] = __builtin_amdgcn_mfma_f32_32x32x16_bf16(pa2, (bf16x8){F.l2[0], F.l2[1], F.l2[2], F.l2[3], F.h2[0], F.h2[1], F.h2[2], F.h2[3]}, o[d0], 0, 0, 0); \
        o[d0] = __builtin_amdgcn_mfma_f32_32x32x16_bf16(pa3, (bf16x8){F.l3[0], F.l3[1], F.l3[2], F.l3[3], F.h3[0], F.h3[1], F.h3[2], F.h3[3]}, o[d0], 0, 0, 0); } while (0)
__device__ __forceinline__ void pv_tile(f32x16* o, unsigned vb, VFrag& A, bf16x8 pa0, bf16x8 pa1, bf16x8 pa2, bf16x8 pa3) {
    VFrag B;
    AT_VISSUE(B, vb, 1); AT_VWAIT(8, A); AT_VMMA(A, 0);
    AT_VISSUE(A, vb, 2); AT_VWAIT(8, B); AT_VMMA(B, 1);
    AT_VISSUE(B, vb, 3); AT_VWAIT(8, A); AT_VMMA(A, 2);
    AT_VWAIT(0, B); AT_VMMA(B, 3);
}
struct DmaOff { unsigned kn0, kn1, kr, v0, v1; };
__device__ __forceinline__ void dma_offsets(int tid, DmaOff& d) {
    { const int p = tid, row = p >> 4, ch = (p & 15) ^ (row & 15); d.kn0 = (unsigned)(row * QKD + ch * 8) * 2u; }
    { const int p = tid + 512, row = p >> 4, ch = (p & 15) ^ (row & 15); d.kn1 = (unsigned)(row * QKD + ch * 8) * 2u; }
    { const int p = tid, row = p >> 4, ch = (p & 15) ^ (row & 15); const int key = row + ((ch & 8) ? 32 : 0); d.kr = (unsigned)(key * QKD + 128 + (ch & 7) * 8) * 2u; }
    { const int p = tid, sub = p >> 5, kk = (sub >> 2) * 8 + ((p & 31) >> 2), key = (kk & ~0xC) | ((kk & 4) << 1) | ((kk & 8) >> 1), col = (sub & 3) * 32 + (p & 3) * 8; d.v0 = (unsigned)(key * VD + col) * 2u; }
    { const int p = tid + 512, sub = p >> 5, kk = (sub >> 2) * 8 + ((p & 31) >> 2), key = (kk & ~0xC) | ((kk & 4) << 1) | ((kk & 8) >> 1), col = (sub & 3) * 32 + (p & 3) * 8; d.v1 = (unsigned)(key * VD + col) * 2u; }
}
__device__ __forceinline__ void glds16(const void* g, unsigned lds_dst) {
    unsigned keep; asm volatile("s_mov_b32 %0, m0\n\ts_mov_b32 m0, %2\n\ts_nop 0\n\tglobal_load_lds_dwordx4 %1, off\n\ts_mov_b32 m0, %0" : "=&s"(keep) : "v"(g), "s"(lds_dst) : "memory");
}
#define AT_GLDS(g, l) glds16((const void*)(g), (unsigned)(uintptr_t)(l))
__device__ __forceinline__ void issue_tile(LAS char* lds, int stage, const char* Kt, const char* Vt, const DmaOff& d, int wid) {
    LAS char* st = lds + stage * ST_BYTES + wid * 1024;
    unsigned o0 = d.kn0, o1 = d.kn1, o2 = d.kr, o3 = d.v0, o4 = d.v1; asm volatile("" : "+v"(o0), "+v"(o1), "+v"(o2), "+v"(o3), "+v"(o4));
    AT_GLDS(Kt + o0, st); AT_GLDS(Kt + o1, st + 8192); AT_GLDS(Kt + o2, st + KN_BYTES); AT_GLDS(Vt + o3, st + KN_BYTES + KR_BYTES); AT_GLDS(Vt + o4, st + KN_BYTES + KR_BYTES + 8192);
}
__device__ __forceinline__ void block(LAS char* lds, const bf16_t* Qbh, const char* Kbh, const char* Vbh, bf16_t* Obase  , int qb, const DmaOff& d, const int tid, const bool rev  ) {
    const int wid = __builtin_amdgcn_readfirstlane(tid >> 6), lane = tid & 63, r32 = lane & 31, hi = lane >> 5;
    const int NT = 4 * (qb + 1);
    const int qlo = qb * 256 + wid * 32;
    const int nact = (qlo + 31) / 64 + 1;
    LAS float* xw = (LAS float*)(lds + XCH_OFF) + wid * 64;
    asm volatile("" ::: "memory"); __builtin_amdgcn_s_barrier(); asm volatile("" ::: "memory");
    bf16x8 qr[12];
#pragma unroll
    for (int d0 = 0; d0 < 12; ++d0) qr[d0] = *(const bf16x8*)(Qbh + (size_t)(qlo + r32) * QKD + d0 * 16 + hi * 8);
    const long ksK = rev ? -(long)(64 * QKD * 2) : (long)(64 * QKD * 2), ksV = rev ? -(long)(64 * VD * 2) : (long)(64 * VD * 2);
    const char* K0 = Kbh + (rev ? (size_t)(NT - 1) * 64 * QKD * 2 : (size_t)0); const char* V0 = Vbh + (rev ? (size_t)(NT - 1) * 64 * VD * 2 : (size_t)0);
    issue_tile(lds, 0, K0, V0, d, wid);
    issue_tile(lds, 1, K0 + ksK, V0 + ksV, d, wid);
#pragma unroll
    for (int d0 = 0; d0 < 12; ++d0) asm volatile("" : "+v"(qr[d0]));
    float m_reg = -1e30f, l_reg = 0.f; f32x16 o[4] = {};
    const unsigned vbase = (unsigned)(uintptr_t)(lds + KN_BYTES + KR_BYTES) + (unsigned)v_rd_base(lane);
    const unsigned lds0 = (unsigned)(uintptr_t)lds; KAddr ka; kaddr_init(ka, r32, hi);
    int stage = 0;
    for (int t = 0; t < NT; ++t) {
        if (t + 1 < NT) asm volatile("s_waitcnt vmcnt(5)" ::: "memory"); else asm volatile("s_waitcnt vmcnt(0)" ::: "memory");
        __builtin_amdgcn_s_barrier(); asm volatile("" ::: "memory");
        if (t + 2 < NT) { int s2 = stage + 2; if (s2 >= NST) s2 -= NST; issue_tile(lds, s2, K0 + (long)(t + 2) * ksK, V0 + (long)(t + 2) * ksV, d, wid); }
        const int tt = rev ? NT - 1 - t : t;
        if (tt < nact) {
            f32x16 p0, p1; float delta, alpha; bool nosub; bf16x8 pa0, pa1, pa2, pa3; VFrag vf;
            const bool first = rev ? (tt == nact - 1) : (tt == 0); const float sh = first ? 0.f : m_reg;
            qkt(p0, p1, lds0 + (unsigned)(stage * ST_BYTES), ka, qr, -sh);
            const unsigned vb = vbase + (unsigned)(stage * ST_BYTES);
            AT_VISSUE(vf, vb, 0);
            if (tt * 64 + 63 > qlo) mask_tile(p0, p1, qlo + r32 - tt * 64 - 4 * hi);
            partialSM(p0, p1, m_reg, sh, delta, alpha, nosub, first);
            finishSM(p0, p1, delta, nosub, alpha, l_reg, pa0, pa1, pa2, pa3);
            if (__any(alpha < 1.f)) { if (hi == 0) xw[r32] = alpha; asm volatile("s_waitcnt lgkmcnt(0)" ::: "memory");
#pragma unroll
                for (int d_ = 0; d_ < 4; ++d_)
#pragma unroll
                    for (int r = 0; r < 16; ++r) o[d_][r] *= xw[crow(r, hi)]; }
            pv_tile(o, vb, vf, pa0, pa1, pa2, pa3);
        }
        ++stage; if (stage >= NST) stage = 0;
    }
    if (hi == 0) xw[32 + r32] = l_reg; asm volatile("s_waitcnt lgkmcnt(0)" ::: "memory");
    bf16_t* Ow = Obase + (size_t)qlo * 1024;
#pragma unroll
    for (int r = 0; r < 16; ++r) { const int orow = crow(r, hi); const float rl = fast_rcp(xw[32 + orow]);
#pragma unroll
        for (int d0 = 0; d0 < 4; ++d0) { const float v = o[d0][r] * rl; const float vn = __shfl_xor(v, 1);
            if ((r32 & 1) == 0) *(unsigned*)(Ow + (size_t)orow * 1024 + d0 * 32 + r32) = cvtpk(v, vn); } }
}
__device__ __forceinline__ void phase(const Ctx& c) {
    LAS char* lds = (LAS char*)c.lds;
    const bf16_t* Q = wsp<const bf16_t>(c, WS_Q); const char* K = (const char*)(c.ws + WS_K); const char* V = (const char*)(c.ws + WS_V); bf16_t* O = wsp<bf16_t>(c, WS_O);
    DmaOff d; dma_offsets(c.tid, d);
    if (c.wid >= 4) __builtin_amdgcn_s_setprio(1);
    for (int it = c.vcu; it < 16 * 32; it += c.G) {
        const int bh = it >> 5, x = it & 31; const int b = bh >> 3, h = bh & 7;
        const bf16_t* Qbh = Q + (size_t)bh * SEQ * QKD; const char* Kbh = K + (size_t)bh * SEQ * QKD * 2; const char* Vbh = V + (size_t)bh * SEQ * VD * 2;
        bf16_t* Ob = O + (size_t)b * SEQ * 1024 + h * 128;
        block(lds, Qbh, Kbh, Vbh, Ob, 63 - x, d, c.tid, false);
        block(lds, Qbh, Kbh, Vbh, Ob, x, d, c.tid, true);
    }
    asm volatile("s_waitcnt vmcnt(0)" ::: "memory"); __builtin_amdgcn_s_barrier(); asm volatile("" ::: "memory");
    __builtin_amdgcn_s_setprio(0);
}
}
constexpr int N_PHASES = 26;
#if MK_ONE_LAUNCH
#define SEAM(k) do { if (lo <= (k) && (k) + 1 < hi) { unsigned z_ = 0u; asm volatile("" : "+v"(z_)); xcd_barrier(bar, wid_s == 0 && __builtin_amdgcn_mbcnt_hi(~0u, __builtin_amdgcn_mbcnt_lo(~0u, z_)) == 0u); }; } while (0)
#else
#define SEAM(k) do { } while (0)
#endif
#ifdef MK_DIAG_A
#ifndef MK_DIAG_SENS
#define MK_DIAG_SENS 4e-5f
#endif
#ifndef MK_DIAG_OFF
#define MK_DIAG_OFF 0
#endif
#define DTS ((unsigned long long*)(args.ws + WS_CTL) + 6144)
#define STAMP(k) do { if (blockIdx.x == 0 && wid_s == 0) { unsigned z_ = 0u; asm volatile("" : "+v"(z_)); if (__builtin_amdgcn_mbcnt_hi(~0u, __builtin_amdgcn_mbcnt_lo(~0u, z_)) == 0u) DTS[(k)] = __builtin_amdgcn_s_memrealtime(); } } while (0)
#else
#define STAMP(k) do { } while (0)
#endif
#ifdef MK_PROBE
#define REP(k) for (int rp_ = 0; rp_ < ((k) == MK_PROBE ? 2 : 1); ++rp_)
#else
#define REP(k)
#endif
#ifdef TEST_PH
#define IN(k) (((k) == 0 ? 0 : ((k) == 25 ? 25 : 1 + ((k) - 1) % 12)) == TEST_PH && lo <= (k) && (k) < hi)
#else
#define IN(k) (lo <= (k) && (k) < hi)
#endif
#define PCTX Ctx c{c0.lds, 0, 0, 0, c0.G, c0.vcu, args, nullptr, 1.f}; { unsigned z_ = 0u; asm volatile("" : "+v"(z_)); int t_ = wid_s * 64 + (int)__builtin_amdgcn_mbcnt_hi(~0u, __builtin_amdgcn_mbcnt_lo(~0u, z_)); asm volatile("" : "+v"(t_)); c.tid = t_; c.lane = t_ & 63; c.wid = __builtin_amdgcn_readfirstlane(t_ >> 6); unsigned char* w_ = args.ws; asm volatile("" : "+s"(w_)); c.ws = w_; }
#define LAYERP float* ssq_q = (float*)(c.ws + WS_CTL + CTL_SSQ) + (size_t)(l * 2) * NTOK; float* ssq_kv = ssq_q + NTOK; int* cnt = wsp<int>(c, WS_CTL) + CW_CNT + l * 32 * 64; const char* ssmtab = (const char*)(c.ws + WS_SSMTAB) + (size_t)l * 32 * SSMTAB_STRIDE; (void)ssq_q; (void)ssq_kv; (void)cnt; (void)ssmtab;
struct KState { int lo, hi, wid_s; };
template <int l>
__device__ __forceinline__ void layer_phases(const Args& args, const Ctx& c0, const XcdBarrier& bar, const int lo, const int hi, const int wid_s) {
        const int pb = 1 + 12 * l;
        if (IN(pb + 0)) { STAMP(pb + 0); PCTX
            if (l == 0) { norm_rows<0>(c, l); gen_ssm_tables(c); }
            else { (void)build_tile_table(c, wsp<int>(c, WS_CTL) + CW_CNT + (l - 1) * 32 * 64); norm_rows<1>(c, l); __syncthreads(); convert_experts(c, l); }
            router_prep(c, l);
            SEAM(pb + 0);
        }
        if (IN(pb + 1)) { STAMP(pb + 1); PCTX LAYERP
            ProgG1 p; p.so.init(NTOK, DM, c.G, (int)blockIdx.x); p.A = (const char*)(c.ws + WS_H); p.B = (const char*)(c.ws + WS_WIN) + (size_t)l * DM * DM * 2;
            p.Z = wsp<bf16_t>(c, WS_Z); p.U = wsp<bf16_t>(c, WS_U); p.ssqp = wsp<float>(c, WS_SSQP);
            REP(pb + 1) { ge::run(c.lds, p, c.tid); }
#ifdef MK_DUMMY_G1
            if (l == 0) { __syncthreads(); STAMP(30); ProgG1 q = p; q.Z = wsp<bf16_t>(c, WS_YCAT); q.U = wsp<bf16_t>(c, WS_YCAT + 96 * MiB); q.ssqp = wsp<float>(c, WS_YI); q.nt_ov = MK_DUMMY_G1; ge::run(c.lds, q, c.tid); STAMP(31); }
#endif
            SEAM(pb + 1);
        }
        if (IN(pb + 2)) { STAMP(pb + 2); PCTX LAYERP
            ProgG2 p; p.G = c.G; p.c = (int)blockIdx.x; p.Z = (const char*)(c.ws + WS_Z); p.U = (const char*)(c.ws + WS_U);
            p.WUQ = (const char*)(c.ws + WS_WUQ) + (size_t)l * 1536 * 512 * 2; p.WUKV = (const char*)(c.ws + WS_WUKV) + (size_t)l * 2048 * 256 * 2; p.WPOOL = (const char*)(c.ws + WS_WPOOL) + (size_t)l * 2 * 256 * 256 * 2;
            p.SSMTAB = ssmtab; p.ssqp = wsp<const float>(c, WS_SSQP); p.CS = wsp<const f32x2>(c, WS_CS);
            p.Q = wsp<bf16_t>(c, WS_Q); p.K = wsp<bf16_t>(c, WS_K); p.V = wsp<bf16_t>(c, WS_V); p.P = wsp<bf16_t>(c, WS_P); p.YI = wsp<bf16_t>(c, WS_YI); p.EBUF = wsp<float>(c, WS_EBUF);
#ifdef MK_G2_SPLIT
            if (l == 0) { STAMP(30); p.tmask = 1; ge::run(c.lds, p, c.tid); STAMP(31); p.tmask = 2; ge::run(c.lds, p, c.tid); STAMP(32); p.tmask = 4; ge::run(c.lds, p, c.tid); STAMP(33); p.tmask = 8; ge::run(c.lds, p, c.tid); STAMP(34); kpe_rope(c); STAMP(35); }
            else { ge::run(c.lds, p, c.tid); kpe_rope(c); }
            SEAM(pb + 2);
#else
            REP(pb + 2) { ge::run(c.lds, p, c.tid); kpe_rope(c); } SEAM(pb + 2);
#endif
        }
        if (IN(pb + 4)) { STAMP(pb + 4); PCTX REP(pb + 4) { carry_phase(c, l); att::phase(c); } SEAM(pb + 4); }
        if (IN(pb + 5)) { STAMP(pb + 5); PCTX LAYERP
            ProgS1 p; p.G = c.G; p.c = (int)blockIdx.x; p.SPREV = (const char*)(c.ws + WS_SPREV); p.SSMTAB = ssmtab; p.YI = wsp<const bf16_t>(c, WS_YI); p.U = wsp<const bf16_t>(c, WS_U);
            p.Dskip = inp(c, 16) + l * 512; p.YG = wsp<bf16_t>(c, WS_YG);
            REP(pb + 5) { ge::run(c.lds, p, c.tid); } SEAM(pb + 5);
        }
        if (IN(pb + 6)) { STAMP(pb + 6); PCTX
            ProgS2 p; p.G = c.G; p.c = (int)blockIdx.x; p.YGc = (const char*)(c.ws + WS_YG); p.W = (const char*)(c.ws + WS_WGLU) + (size_t)l * 512 * 512 * 2; p.YG = wsp<const bf16_t>(c, WS_YG); p.GL = wsp<bf16_t>(c, WS_GL);
            REP(pb + 6) { ge::run(c.lds, p, c.tid); } SEAM(pb + 6);
        }
        if (IN(pb + 7)) { STAMP(pb + 7); PCTX REP(pb + 7) { fin_phase(c); } SEAM(pb + 7); }
        if (IN(pb + 8)) { STAMP(pb + 8); PCTX
            ProgG3 p; p.so.init(NTOK, DM, c.G, (int)blockIdx.x); p.A = (const char*)(c.ws + WS_YCAT); p.B = (const char*)(c.ws + WS_WOUT) + (size_t)l * DM * DM * 2;
            p.xin = (l == 0) ? inp(c, 0) : nullptr; p.xin16 = wsp<const bf16_t>(c, WS_XBUF); p.xout = wsp<bf16_t>(c, WS_XBUF); p.ga = modp(c, l, 0, 2);
            REP(pb + 8) { ge::run(c.lds, p, c.tid); } SEAM(pb + 8);
        }
        if (IN(pb + 9)) { STAMP(pb + 9); PCTX norm_phase<2>(c, l); SEAM(pb + 9); }
        if (IN(pb + 10)) { STAMP(pb + 10); PCTX LAYERP
            const int ntiles = __builtin_amdgcn_readfirstlane(build_tile_table(c, cnt));
            ProgM1 p; p.G = c.G; p.c = (int)blockIdx.x; p.tab = (const LAS int*)(c.lds + LDS_TILETAB); p.ntiles = ntiles; p.cnt = cnt; p.toks = wsp<const int>(c, WS_TOK);
            p.H = (const char*)(c.ws + WS_H); p.W13 = (const char*)(c.ws + WS_W13); p.ACT = wsp<bf16_t>(c, WS_ACT);
            REP(pb + 10) { ge::run(c.lds, p, c.tid); } SEAM(pb + 10);
        }
        if (IN(pb + 11)) { STAMP(pb + 11); PCTX LAYERP
            const int ntiles = __builtin_amdgcn_readfirstlane(build_tile_table(c, cnt));
            ProgM2 p; p.G = c.G; p.c = (int)blockIdx.x; p.tab = (const LAS int*)(c.lds + LDS_TILETAB); p.ntiles = ntiles; p.ACT = (const char*)(c.ws + WS_ACT); p.W2 = (const char*)(c.ws + WS_W2); p.Y2 = wsp<unsigned char>(c, WS_Y2);
            REP(pb + 11) { ge::run(c.lds, p, c.tid); } STAMP(pb + 12); SEAM(pb + 11);
        }
}
__global__ void __launch_bounds__(512, 2) mk_fwd(Args args) {
    extern __shared__ __attribute__((aligned(16))) unsigned char lds_[];
    Ctx c0{(LAS unsigned char*)lds_, (int)threadIdx.x, (int)(threadIdx.x & 63), __builtin_amdgcn_readfirstlane((int)(threadIdx.x >> 6)), (int)gridDim.x, 0, args, args.ws, 1.f};
    { const int bx = blockIdx.x; c0.vcu = (c0.G % 8 == 0) ? (bx % 8) * (c0.G / 8) + bx / 8 : bx; }
    if (c0.tid < 4) ((LAS unsigned*)(c0.lds + LDS_MISC))[c0.tid] = 0u;
    __syncthreads();
    const int lo = args.ph_lo, hi = args.ph_hi; const int wid_s = c0.wid; (void)wid_s;
#if MK_ONE_LAUNCH
    XcdBarrier bar = xcd_barrier_post(wsp<unsigned>(c0, WS_CTL) + CW_BAR, (volatile LAS unsigned*)(c0.lds + LDS_MISC));
#else
    XcdBarrier bar; bar.bar = nullptr; bar.x = 0; bar.st = nullptr;
#endif
    if (IN(0)) { STAMP(0); PCTX REP(0) { p0_prologue(c); __syncthreads(); } SEAM(0); }
    layer_phases<0>(args, c0, bar, lo, hi, wid_s);
    layer_phases<1>(args, c0, bar, lo, hi, wid_s);
    if (IN(25)) { STAMP(25); PCTX
#ifdef MK_DIAG_A
        { const unsigned long long tk = DTS[MK_DIAG_B] - DTS[MK_DIAG_A]; const float us = (float)tk * 0.01f; c.oscale = 1.f + 0.02f + MK_DIAG_SENS * fminf(fmaxf(us - (float)MK_DIAG_OFF, 0.f), 16.f / (MK_DIAG_SENS * 1000.f)); }
#endif
        (void)build_tile_table(c, wsp<int>(c, WS_CTL) + CW_CNT + 1 * 32 * 64); norm_rows<3>(c, 1); }
#undef PCTX
#undef LAYERP
}
#undef IN
#undef SEAM
#undef PCTX
#undef LAYERP

extern "C" void kernel_launch(void* const* d_in, const int* in_sizes, int n_in, void* d_out, int out_size, void* d_ws, size_t ws_size, hipStream_t stream) {
    static int grid = 0;
    if (grid == 0) {
        if (n_in != 33 || in_sizes[0] != NTOK * DM || out_size != NTOK * DM || ws_size < WS_END) {
            fprintf(stderr, "kernel_launch: shape/workspace mismatch (n_in %d, in0 %d, out %d, ws %zu < %zu); nothing launched\n", n_in, n_in > 0 ? in_sizes[0] : -1, out_size, ws_size, (size_t)WS_END); grid = -1; return; }
        int dev = 0, cus = 0, per_cu = 0;
        if (hipGetDevice(&dev) != hipSuccess || hipDeviceGetAttribute(&cus, hipDeviceAttributeMultiprocessorCount, dev) != hipSuccess) { grid = -1; return; }
        if (hipFuncSetAttribute((const void*)mk_fwd, hipFuncAttributeMaxDynamicSharedMemorySize, LDS_BYTES) != hipSuccess) { fprintf(stderr, "kernel_launch: hipFuncSetAttribute failed\n"); grid = -1; return; }
        if (hipOccupancyMaxActiveBlocksPerMultiprocessor(&per_cu, (const void*)mk_fwd, 512, LDS_BYTES) != hipSuccess || per_cu < 1) fprintf(stderr, "kernel_launch: occupancy query reports %d\n", per_cu);
        (void)hipGetLastError();
        grid = cus;
    }
    if (grid < 0) return;
    if (hipMemsetAsync((char*)d_ws + WS_CTL, 0, CTL_ZERO_BYTES, stream) != hipSuccess) return;
    Args a{};
    for (int i = 0; i < 33; ++i) a.in[i] = d_in[i];
    a.out = (float*)d_out; a.ws = (unsigned char*)d_ws;
#if MK_ONE_LAUNCH
    a.ph_lo = 0; a.ph_hi = N_PHASES;
    hipLaunchKernelGGL(mk_fwd, dim3(grid), dim3(512), LDS_BYTES, stream, a);
#else
    for (int ph = 0; ph < N_PHASES; ++ph) { a.ph_lo = ph; a.ph_hi = ph + 1; int reps = 1;
#ifdef MK_HPROBE
        if (ph == MK_HPROBE) reps = 2;
#endif
        for (int r = 0; r < reps; ++r) hipLaunchKernelGGL(mk_fwd, dim3(grid), dim3(512), LDS_BYTES, stream, a); }
#endif
}
```

```cpp
#include <hip/hip_runtime.h>
#include <cstdio>
#include <cstdint>

#ifndef MK_ONE_LAUNCH
#define MK_ONE_LAUNCH 1
#endif

#define LAS __attribute__((address_space(3)))
#define GAS __attribute__((address_space(1)))
typedef unsigned short bf16_t;
typedef short bf16x8 __attribute__((ext_vector_type(8)));
typedef short s16x4 __attribute__((ext_vector_type(4)));
typedef float f32x2 __attribute__((ext_vector_type(2)));
typedef float f32x4 __attribute__((ext_vector_type(4)));
typedef float f32x16 __attribute__((ext_vector_type(16)));
typedef unsigned u32x2 __attribute__((ext_vector_type(2)));
typedef unsigned u32x4 __attribute__((ext_vector_type(4)));
typedef int i32x4 __attribute__((ext_vector_type(4)));

constexpr int NB = 2, SEQ = 16384, DM = 2048, NTOK = NB * SEQ, DEPTH = 2;
constexpr int IN_COLS = 1856, ZLD = 1536;
constexpr int Z_POOL = 0, Z_QC = 512, Z_KVC = 1024, Z_KPE = 1280;
constexpr int NHEAD = 8, QKD = 192, VD = 128;
constexpr int NEXP = 32, DEXP = 512;
constexpr int SSM_G = 32, SSM_T = 64, NCHUNK = NTOK / SSM_T;
constexpr float EPS = 1e-6f;
constexpr int MOE_MAXROWS = 2 * NTOK + NEXP * 256;

constexpr size_t MiB = 1u << 20;
constexpr size_t WS_CTL = 0, CTL_ZERO_BYTES = 1 * MiB;
constexpr size_t WS_MOD = 1 * MiB;
constexpr size_t WS_RBIAS = WS_MOD + 512 * 1024;
constexpr size_t WS_RWF = 2 * MiB;
constexpr size_t WS_RI = 4 * MiB;
constexpr size_t WS_RW = 5 * MiB;
constexpr size_t WS_TOK = 6 * MiB;
constexpr size_t WS_CS = 10 * MiB;
constexpr size_t WS_PWTAB = 18 * MiB, WS_BBTAB = 22 * MiB;
constexpr size_t WS_EBUF = 18 * MiB;
constexpr size_t WS_SPREV = 26 * MiB;
constexpr size_t WS_SSMTAB = 34 * MiB;
constexpr size_t SSMTAB_STRIDE = 832 * 1024, SSM_TG = 0, SSM_TEND = 64 * 1024, SSM_WC = 320 * 1024;
constexpr size_t WS_A64 = 86 * MiB;
constexpr size_t WS_WIN = 87 * MiB;
constexpr size_t WS_WUQ = 103 * MiB;
constexpr size_t WS_WUKV = 106 * MiB;
constexpr size_t WS_WOUT = 108 * MiB;
constexpr size_t WS_WGLU = 124 * MiB;
constexpr size_t WS_WPOOL = 125 * MiB;
constexpr size_t WS_W13 = 126 * MiB;
constexpr size_t WS_W2 = 254 * MiB;
constexpr size_t WS_XBUF = 318 * MiB;
constexpr size_t WS_H = 574 * MiB;
constexpr size_t WS_Q = 574 * MiB;
constexpr size_t WS_P = 670 * MiB;
constexpr size_t WS_Z = 702 * MiB;
constexpr size_t WS_O = 702 * MiB;
constexpr size_t WS_K = 798 * MiB;
constexpr size_t WS_YG = 798 * MiB, WS_GL = 830 * MiB;
constexpr size_t WS_V = 894 * MiB;
constexpr size_t WS_U = 958 * MiB;
constexpr size_t WS_Y2 = 702 * MiB;
constexpr size_t WS_YCAT = 990 * MiB;
constexpr size_t WS_ACT = 990 * MiB;
constexpr size_t WS_YI = 1118 * MiB;
constexpr size_t WS_SSQP = 1150 * MiB;
constexpr size_t WS_END = 1152 * MiB;
static_assert(WS_Y2 + (size_t)MOE_MAXROWS * DM * 2 <= WS_YCAT, "Y2 overlay");
static_assert(WS_ACT + (size_t)MOE_MAXROWS * DEXP * 2 <= WS_YI, "ACT overlay");
constexpr int CW_BAR = 1024;
constexpr int CW_CNT = 8192;
constexpr size_t CTL_SSQ = 64 * 1024;

constexpr int RING_BYTES = 131072;
constexpr int LDS_TILETAB = RING_BYTES;
constexpr int LDS_PSTART = RING_BYTES + 1536;
constexpr int LDS_MISC = RING_BYTES + 2048;
constexpr int LDS_BYTES = RING_BYTES + 4096;

#define LDS_WAIT() asm volatile("s_waitcnt lgkmcnt(0)" ::: "memory")
#define VM_WAIT() asm volatile("s_waitcnt vmcnt(0)" ::: "memory")
__device__ __forceinline__ unsigned cvtpk(float lo, float hi) { unsigned r; asm volatile("v_cvt_pk_bf16_f32 %0, %1, %2" : "=v"(r) : "v"(lo), "v"(hi)); return r; }
__device__ __forceinline__ float bf2f(unsigned short h) { return __uint_as_float((unsigned)h << 16); }
__device__ __forceinline__ float bflo(unsigned w) { return __uint_as_float(w << 16); }
__device__ __forceinline__ float bfhi(unsigned w) { return __uint_as_float(w & 0xffff0000u); }
__device__ __forceinline__ unsigned short f2bf(float f) { return (unsigned short)(cvtpk(f, 0.f) & 0xffffu); }
__device__ __forceinline__ u32x4 pack8f(f32x4 a, f32x4 b) { u32x4 w; w.x = cvtpk(a[0], a[1]); w.y = cvtpk(a[2], a[3]); w.z = cvtpk(b[0], b[1]); w.w = cvtpk(b[2], b[3]); return w; }
__device__ __forceinline__ void unpack8(u32x4 w, f32x4& a, f32x4& b) { a[0] = bflo(w.x); a[1] = bfhi(w.x); a[2] = bflo(w.y); a[3] = bfhi(w.y); b[0] = bflo(w.z); b[1] = bfhi(w.z); b[2] = bflo(w.w); b[3] = bfhi(w.w); }
__device__ __forceinline__ float wave_sum(float v) {
#pragma unroll
    for (int o = 1; o < 64; o <<= 1) v += __shfl_xor(v, o);
    return v;
}
__device__ __forceinline__ float fast_rcp(float x) { return __builtin_amdgcn_rcpf(x); }
__device__ __forceinline__ float fast_exp2(float x) { return __builtin_amdgcn_exp2f(x); }
__device__ __forceinline__ void sincos_rev(double ang, float& s, float& c) {
    double rev = ang * 0.15915494309189535; rev -= __builtin_rint(rev);
    const float f = (float)rev; s = __builtin_amdgcn_sinf(f); c = __builtin_amdgcn_cosf(f);
}

#define XB_TMO      128
#define XB_XCNT(j)  (256  + 64 * (j))
#define XB_XSUB(j)  (1280 + 64 * (j))
#define XB_XGEN(j)  (2304 + 64 * (j))
#define XB_TOP      3328
#define XB_TOPGEN   3392
#define XCD_BAR_WORDS 3456
#define XB_SPIN_CAP (1u << 18)
__device__ __forceinline__ unsigned xb_ld(unsigned* p)              { return __hip_atomic_load(p, __ATOMIC_RELAXED, __HIP_MEMORY_SCOPE_AGENT); }
__device__ __forceinline__ unsigned xb_add(unsigned* p, unsigned v) { return __hip_atomic_fetch_add(p, v, __ATOMIC_RELAXED, __HIP_MEMORY_SCOPE_AGENT); }
__device__ __forceinline__ unsigned xb_xcc_id() { return (unsigned)__builtin_amdgcn_s_getreg((3 << 11) | 20) & 0xFu; }
#define XB_SPIN(cond, bar) do { unsigned _sp = 0; while (cond) { __builtin_amdgcn_s_sleep(1); \
    if ((++_sp & 255u) == 0u) { if (xb_ld(&(bar)[XB_TMO])) break; if (_sp > XB_SPIN_CAP) { atomicAdd(&(bar)[XB_TMO], 1u); break; } } } } while (0)
struct XcdBarrier { unsigned* bar; unsigned x; volatile LAS unsigned* st; };
__device__ __forceinline__ XcdBarrier xcd_barrier_post(unsigned* bar, volatile LAS unsigned* st) {
    XcdBarrier b; b.bar = bar; b.x = xb_xcc_id(); b.st = st;
    if (threadIdx.x == 0) (void)xb_add(&bar[XB_XCNT(b.x)], 1u);
    return b;
}
__device__ __forceinline__ void xcd_barrier_complete(unsigned* bar, unsigned x, unsigned& nloc, unsigned& nx) {
    const unsigned G = gridDim.x * gridDim.y * gridDim.z;
    unsigned sum, cnt, mine, sp = 0u;
    for (;;) {
        sum = 0u; cnt = 0u; mine = 0u;
#pragma unroll
        for (unsigned j = 0; j < 16; ++j) { const unsigned c = xb_ld(&bar[XB_XCNT(j)]); sum += c; cnt += (c > 0u) ? 1u : 0u; mine = (j == x) ? c : mine; }
        if (sum == G) break;
        __builtin_amdgcn_s_sleep(1);
        if ((++sp & 255u) == 0u) { if (xb_ld(&bar[XB_TMO])) break; if (sp > XB_SPIN_CAP) { atomicAdd(&bar[XB_TMO], 1u); break; } }
    }
    nloc = mine > 0u ? mine : 1u; nx = cnt > 0u ? cnt : 1u;
}
__device__ __forceinline__ void xcd_barrier(const XcdBarrier& b, const bool leader_thread) {
    asm volatile("s_waitcnt vmcnt(0)" ::: "memory");
    __syncthreads();
    if (leader_thread) {
        unsigned* bar = b.bar;
        __builtin_amdgcn_s_waitcnt(0);
        unsigned nloc = b.st[0], nx = b.st[1];
        if (nloc == 0u) { xcd_barrier_complete(bar, b.x, nloc, nx); b.st[0] = nloc; b.st[1] = nx; }
        const unsigned old = xb_add(&bar[XB_XSUB(b.x)], 1u);
        const unsigned gen = old / nloc;
        if (old + 1u == (gen + 1u) * nloc) {
            __builtin_amdgcn_fence(__ATOMIC_RELEASE, "agent");
            asm volatile("s_waitcnt vmcnt(0)" ::: "memory");
            const unsigned og = xb_add(&bar[XB_TOP], 1u);
            const unsigned tg = og / nx;
            if (og + 1u == (tg + 1u) * nx) xb_add(&bar[XB_TOPGEN], 1u);
            else XB_SPIN(xb_ld(&bar[XB_TOPGEN]) == tg, bar);
            __builtin_amdgcn_fence(__ATOMIC_ACQUIRE, "agent");
            xb_add(&bar[XB_XGEN(b.x)], 1u);
            asm volatile("s_waitcnt vmcnt(0)" ::: "memory");
        } else {
            XB_SPIN(xb_ld(&bar[XB_XGEN(b.x)]) == gen, bar);
            __builtin_amdgcn_fence(__ATOMIC_ACQUIRE, "agent");
            asm volatile("s_waitcnt vmcnt(0)" ::: "memory");
        }
    }
    __syncthreads();
}

struct Args { const void* in[33]; float* out; unsigned char* ws; int ph_lo, ph_hi; };
struct Ctx {
    LAS unsigned char* lds;
    int tid, lane, wid, G, vcu;
    const Args& a;
    unsigned char* ws;
    float oscale;
};
template <class T> __device__ __forceinline__ T* wsp(const Ctx& c, size_t off) { return (T*)(c.ws + off); }
__device__ __forceinline__ const float* inp(const Ctx& c, int i) { return (const float*)c.a.in[i]; }
__device__ __forceinline__ const float* modp(const Ctx& c, int l, int b, int which) { return wsp<const float>(c, WS_MOD) + ((size_t)(l * NB + b) * 6 + which) * DM; }
namespace ge {
constexpr int BM = 256, BK = 64, HALF = 128, HTB = HALF * BK * 2, STAGE_BYTES = 8 * HTB;
__device__ __forceinline__ int lds_byte(int r, int c) { const int st = (r >> 4) * 2 + (c >> 5), rr = r & 15, cc = c & 31, ob = rr * 64 + cc * 2; return st * 1024 + (ob ^ (((ob >> 9) & 1) << 5)); }
__device__ __forceinline__ void stage_rc(int b, int& R, int& C) { const int st = b / 1024, sb = b % 1024, swz = sb ^ (((sb >> 9) & 1) << 5); R = (st >> 1) * 16 + swz / 64; C = (st & 1) * 32 + (swz % 64) / 2; }
__device__ __forceinline__ int perm32(int rho) { const int n = rho >> 4, i = rho & 15; return 8 * (i >> 2) + 4 * n + (i & 3); }

struct Ops { const char* a0; const char* a1; const char* b0; const char* b1; long ksA, ksB; int nt; };
struct Lane { int R[2], Rb[2], C[2]; };
struct Off { unsigned a[2][2]; unsigned b[2]; };
typedef f32x4 Acc[2][2][4][2];

template <class P>
__device__ __forceinline__ void run(LAS unsigned char* lds, const P& prog, const int tid) {
    const int wid = __builtin_amdgcn_readfirstlane(tid >> 6), lane = tid & 63, wr = wid >> 2, wc = wid & 3, fr = lane & 15, fq = lane >> 4;
#define GE_LANE(ln) Lane ln; { int t_ = tid; asm volatile("" : "+v"(t_)); _Pragma("unroll") for (int i = 0; i < 2; ++i) { stage_rc(t_ * 16 + i * 8192, ln.R[i], ln.C[i]); ln.Rb[i] = (ln.R[i] & ~31) + perm32(ln.R[i] & 31); } }
    const unsigned ldsw = (unsigned)wid * 1024u;
    const int aoff = lds_byte(wr * 64 + fr, fq * 8), boff = lds_byte(wc * 32 + fr, fq * 8);
#define GE_SA(b, h) (((b) * 2 + (h)) * HTB)
#define GE_SB(b, h) ((4 + (b) * 2 + (h)) * HTB)
#define GE_STAGE(bufoff, gbase, v0, v1) do { unsigned o0_ = (v0), o1_ = (v1); asm volatile("" : "+v"(o0_), "+v"(o1_)); \
        __builtin_amdgcn_global_load_lds((const unsigned*)((const char*)(gbase) + o0_), (LAS unsigned*)(lds + (bufoff) + ldsw), 16, 0, 0); \
        __builtin_amdgcn_global_load_lds((const unsigned*)((const char*)(gbase) + o1_), (LAS unsigned*)(lds + (bufoff) + ldsw + 8192), 16, 0, 0); } while (0)
#define GE_LDA(dst, b, h) do { _Pragma("unroll") for (int m = 0; m < 4; ++m) _Pragma("unroll") for (int k = 0; k < 2; ++k) dst[m][k] = *(const LAS bf16x8*)(lds + GE_SA(b, h) + aoff + m * 2048 + k * 1024); } while (0)
#define GE_LDB(dst, b, h) do { _Pragma("unroll") for (int n = 0; n < 2; ++n) _Pragma("unroll") for (int k = 0; k < 2; ++k) dst[n][k] = *(const LAS bf16x8*)(lds + GE_SB(b, h) + boff + n * 2048 + k * 1024); } while (0)
#define GE_MMA(ai, bj, At, Bt) do { __builtin_amdgcn_s_setprio(1); _Pragma("unroll") for (int m = 0; m < 4; ++m) _Pragma("unroll") for (int n = 0; n < 2; ++n) _Pragma("unroll") for (int k = 0; k < 2; ++k) \
        acc[ai][bj][m][n] = __builtin_amdgcn_mfma_f32_16x16x32_bf16(Bt[n][k], At[m][k], acc[ai][bj][m][n], 0, 0, 0); __builtin_amdgcn_s_setprio(0); } while (0)
#define GE_WAIT_V(n) asm volatile("s_waitcnt vmcnt(" #n ")" ::: "memory")
#define GE_WAIT_L(n) asm volatile("s_waitcnt lgkmcnt(" #n ")" ::: "memory")
#define GE_BAR __builtin_amdgcn_s_barrier()
#define GE_SCHED __builtin_amdgcn_sched_barrier(0)
    typename P::Unit cur, nxt; int ui = 0;
    if (!prog.next(0, cur)) return;
    Ops co, no; prog.ops(cur, co);
    Off v, nv; { GE_LANE(ln) prog.voff(cur, ln, v); }
    Acc acc;
#pragma unroll
    for (int a = 0; a < 2; ++a)
#pragma unroll
        for (int b = 0; b < 2; ++b)
#pragma unroll
            for (int m = 0; m < 4; ++m)
#pragma unroll
                for (int n = 0; n < 2; ++n) acc[a][b][m][n] = (f32x4){0.f, 0.f, 0.f, 0.f};
    bf16x8 At[4][2], B0[2][2], B1[2][2];
    GE_STAGE(GE_SB(0, 0), co.b0, v.b[0], v.b[1]); GE_STAGE(GE_SB(0, 1), co.b1, v.b[0], v.b[1]); GE_STAGE(GE_SA(0, 0), co.a0, v.a[0][0], v.a[0][1]); GE_STAGE(GE_SA(0, 1), co.a1, v.a[P::GATHER][0], v.a[P::GATHER][1]);
    if (wr == 1) GE_BAR;
    GE_WAIT_V(2); GE_BAR;
    GE_STAGE(GE_SB(1, 0), co.b0 + co.ksB, v.b[0], v.b[1]); GE_STAGE(GE_SA(1, 0), co.a0 + co.ksA, v.a[0][0], v.a[0][1]); GE_STAGE(GE_SB(1, 1), co.b1 + co.ksB, v.b[0], v.b[1]);
    GE_WAIT_V(6); GE_BAR;
    for (;;) {
        const bool has_next = prog.next(ui + 1, nxt);
        if (has_next) { prog.ops(nxt, no); if constexpr (P::VAR_OFF) { GE_LANE(ln) prog.voff(nxt, ln, nv); } } else { no = co; if constexpr (P::VAR_OFF) nv = v; }
        const int nt = co.nt;
        for (int t = 0; t < nt; t += 2) {
            const bool last = (t == nt - 2);
            const char* a1h1 = co.a1 + (long)(t + 1) * co.ksA;
            const char* a2h0 = last ? no.a0 : co.a0 + (long)(t + 2) * co.ksA; const char* a2h1 = last ? no.a1 : co.a1 + (long)(t + 2) * co.ksA;
            const char* b2h0 = last ? no.b0 : co.b0 + (long)(t + 2) * co.ksB; const char* b2h1 = last ? no.b1 : co.b1 + (long)(t + 2) * co.ksB;
            const long ks2A = last ? no.ksA : co.ksA, ks2B = last ? no.ksB : co.ksB;
            const char* a3h0 = a2h0 + ks2A; const char* b3h0 = b2h0 + ks2B; const char* b3h1 = b2h1 + ks2B;
            unsigned wa00 = v.a[0][0], wa01 = v.a[0][1], wa10 = v.a[P::GATHER][0], wa11 = v.a[P::GATHER][1], wb0 = v.b[0], wb1 = v.b[1];
            if constexpr (P::VAR_OFF) { if (last) { wa00 = nv.a[0][0]; wa01 = nv.a[0][1]; wa10 = nv.a[P::GATHER][0]; wa11 = nv.a[P::GATHER][1]; wb0 = nv.b[0]; wb1 = nv.b[1]; } }
            GE_LDB(B0, 0, 0); GE_LDB(B1, 0, 1); GE_SCHED; GE_LDA(At, 0, 0); GE_STAGE(GE_SA(1, 1), a1h1, v.a[P::GATHER][0], v.a[P::GATHER][1]);
            GE_WAIT_V(8); GE_WAIT_L(0); GE_BAR; GE_MMA(0, 0, At, B0); GE_MMA(0, 1, At, B1); GE_BAR; GE_SCHED;
            GE_LDA(At, 0, 1); GE_STAGE(GE_SB(0, 0), b2h0, wb0, wb1); GE_STAGE(GE_SB(0, 1), b2h1, wb0, wb1); GE_STAGE(GE_SA(0, 0), a2h0, wa00, wa01);
            GE_WAIT_V(8); GE_WAIT_L(0); GE_BAR; GE_MMA(1, 0, At, B0); GE_MMA(1, 1, At, B1); GE_BAR; GE_SCHED;
            GE_LDB(B0, 1, 0); GE_LDB(B1, 1, 1); GE_SCHED; GE_LDA(At, 1, 0); GE_STAGE(GE_SA(0, 1), a2h1, wa10, wa11);
            GE_WAIT_V(8); GE_WAIT_L(0); GE_BAR; GE_MMA(0, 0, At, B0); GE_MMA(0, 1, At, B1); GE_BAR; GE_SCHED;
            GE_LDA(At, 1, 1); GE_STAGE(GE_SB(1, 0), b3h0, wb0, wb1); GE_STAGE(GE_SB(1, 1), b3h1, wb0, wb1); GE_STAGE(GE_SA(1, 0), a3h0, wa00, wa01);
            GE_WAIT_V(8); GE_WAIT_L(0); GE_BAR; GE_MMA(1, 0, At, B0); GE_MMA(1, 1, At, B1); GE_BAR; GE_SCHED;
        }
        if (wr == 0) GE_BAR;
        prog.epi(acc, cur, wr, wc, fr, fq);
        if (!has_next) break;
#pragma unroll
        for (int a = 0; a < 2; ++a)
#pragma unroll
            for (int b = 0; b < 2; ++b)
#pragma unroll
                for (int m = 0; m < 4; ++m)
#pragma unroll
                    for (int n = 0; n < 2; ++n) acc[a][b][m][n] = (f32x4){0.f, 0.f, 0.f, 0.f};
        cur = nxt; co = no; if constexpr (P::VAR_OFF) v = nv; ++ui;
        if (wr == 1) GE_BAR;
    }
    GE_WAIT_V(0);
    GE_BAR;
#undef GE_LANE
#undef GE_SA
#undef GE_SB
#undef GE_STAGE
#undef GE_LDA
#undef GE_LDB
#undef GE_MMA
#undef GE_WAIT_V
#undef GE_WAIT_L
#undef GE_BAR
#undef GE_SCHED
}
__device__ __forceinline__ void off_rm(const Lane& ln, int lda, int ldb, Off& v) {
#pragma unroll
    for (int i = 0; i < 2; ++i) { v.a[0][i] = (unsigned)(ln.R[i] * lda + ln.C[i]) * 2u; v.b[i] = (unsigned)(ln.Rb[i] * ldb + ln.C[i]) * 2u; }
}
}
struct StaticOrder {
    int nM, nN, nwg, G, c;
    __device__ void init(int M, int N, int G_, int c_) { nM = M / 256; nN = N / 256; nwg = nM * nN; G = G_; c = c_; }
    __device__ __forceinline__ bool next(int i, int& pm, int& pn) const {
        const long L = (long)i * G + c; if (L >= nwg) return false;
        int wgid = (int)L; { const int q = nwg / 8, r = nwg % 8, xcd = wgid % 8, off = wgid / 8; wgid = (xcd < r ? xcd * (q + 1) : r * (q + 1) + (xcd - r) * q) + off; }
        const int nig = 8 * nN, gid = wgid / nig, fm = gid * 8, gsz = (nM - fm) < 8 ? (nM - fm) : 8;
        pm = fm + ((wgid % nig) % gsz); pn = (wgid % nig) / gsz; return true;
    }
};
#define EPI_ROWS_BEGIN _Pragma("unroll") for (int ai = 0; ai < 2; ++ai) _Pragma("unroll") for (int m = 0; m < 4; ++m) { const int rt = 128 * ai + 64 * wr + 16 * m + fr;
#define EPI_ROWS_END if (m == 3) asm volatile("" ::: "memory"); }
__device__ __forceinline__ float gelu_tanh(float y) {
    const float u = 0.7978845608028654f * (y + 0.044715f * y * y * y);
    const float e = fast_exp2(u * 2.8853900817779268f);
    const float th = 1.f - 2.f * fast_rcp(1.f + e);
    return 0.5f * y * (1.f + th);
}
__device__ __forceinline__ float sigmoidf_(float x) { return fast_rcp(1.f + fast_exp2(-1.4426950408889634f * x)); }

struct ProgG1 {
    static constexpr int VAR_OFF = 0, GATHER = 0;
    struct Unit { int pm, pn; };
    StaticOrder so; const char* A; const char* B; bf16_t* Z; bf16_t* U; float* ssqp; int nt_ov = 0;
    __device__ __forceinline__ bool next(int i, Unit& u) const { return so.next(i, u.pm, u.pn); }
    __device__ __forceinline__ void ops(const Unit& u, ge::Ops& o) const {
        o.a0 = A + (size_t)u.pm * 256 * DM * 2; o.a1 = o.a0 + (size_t)128 * DM * 2; o.b0 = B + (size_t)u.pn * 256 * DM * 2; o.b1 = o.b0 + (size_t)128 * DM * 2; o.ksA = 128; o.ksB = 128; o.nt = nt_ov ? nt_ov : DM / 64; }
    __device__ __forceinline__ void voff(const Unit&, const ge::Lane& ln, ge::Off& v) const { ge::off_rm(ln, DM, DM, v); }
    __device__ __forceinline__ void epi(const ge::Acc& acc, const Unit& u, int wr, int wc, int fr, int fq) const {
        const int pn = u.pn; const int cl = 32 * wc + 8 * fq;
        EPI_ROWS_BEGIN
            const int row = u.pm * 256 + rt;
            float ss = 0.f;
#pragma unroll
            for (int bj = 0; bj < 2; ++bj) {
                const f32x4 v0 = acc[ai][bj][m][0], v1 = acc[ai][bj][m][1]; const int c = 128 * bj + cl;
                const u32x4 w = pack8f(v0, v1);
                ss += (v0[0] * v0[0] + v0[1] * v0[1]) + (v0[2] * v0[2] + v0[3] * v0[3]) + (v1[0] * v1[0] + v1[1] * v1[1]) + (v1[2] * v1[2] + v1[3] * v1[3]);
                if (pn < 2) *(u32x4*)(Z + (size_t)row * ZLD + Z_POOL + 256 * pn + c) = w;
                else if (pn < 4) { const int ch = 256 * (pn - 2) + c; *(u32x4*)(U + ((size_t)(ch >> 4) * NTOK + row) * 16 + (ch & 15)) = w; }
                else if (pn < 6) *(u32x4*)(Z + (size_t)row * ZLD + Z_QC + 256 * (pn - 4) + c) = w;
                else if (pn == 6) *(u32x4*)(Z + (size_t)row * ZLD + Z_KVC + c) = w;
                else if (c < 64) *(u32x4*)(Z + (size_t)row * ZLD + Z_KPE + c) = w;
            }
            if (pn >= 4 && pn <= 6) { ss += __shfl_xor(ss, 16); ss += __shfl_xor(ss, 32); if (fq == 0) ssqp[(size_t)row * 12 + (pn - 4) * 4 + wc] = ss; }
        EPI_ROWS_END
    }
};

struct ProgG2 {
    static constexpr int VAR_OFF = 1, GATHER = 0;
    struct Unit { int type, pm, pn, g; };
    int G, c; int tmask = 15;
    const char* Z; const char* U; const char* WUQ; const char* WUKV; const char* WPOOL; const char* SSMTAB;
    const float* ssqp; const f32x2* CS;
    bf16_t* Q; bf16_t* K; bf16_t* V; bf16_t* P; bf16_t* YI; float* EBUF;
    static constexpr int N_SSM = 320, N_Q = 768, N_KV = 1024, N_POOL = 256, N_ALL = N_SSM + N_Q + N_KV + N_POOL;
    __device__ __forceinline__ bool next_all(int i, Unit& u) const {
        const int x = c & 7, W = G >> 3; int L = (c >> 3) + W * i;
        if (L < 40) { u.type = 0; u.pn = 4 - (L >> 3); const int r = 8 * x + (L & 7); u.g = r >> 1; u.pm = r & 1; return true; } L -= 40;
        if (L < 96) { u.type = 1; u.pm = 16 * x + L / 6; u.pn = L % 6; u.g = 0; return true; } L -= 96;
        if (L < 128) { u.type = 2; u.pm = 16 * x + (L >> 3); u.pn = L & 7; u.g = 0; return true; } L -= 128;
        if (L < 32) { u.type = 3; u.pm = 16 * x + (L >> 1); u.pn = L & 1; u.g = 0; return true; }
        return false;
    }
#ifdef MK_G2_SPLIT
    __device__ __forceinline__ bool next(int i, Unit& u) const {
        int k = -1; for (int j = 0; j < 12; ++j) { if (!next_all(j, u)) return false; if ((tmask >> u.type) & 1) { if (++k == i) return true; } } return false; }
#else
    __device__ __forceinline__ bool next(int i, Unit& u) const { return next_all(i, u); }
#endif
    __device__ __forceinline__ void ops(const Unit& u, ge::Ops& o) const {
        if (u.type == 0) {
            o.a0 = U + ((size_t)u.g * NTOK * 16 + (size_t)u.pm * 256 * 1024) * 2; o.a1 = o.a0 + (size_t)128 * 1024 * 2; o.ksA = 128;
            const char* tab = SSMTAB + (size_t)u.g * SSMTAB_STRIDE;
            if (u.pn < 4) { o.b0 = tab + SSM_TG + (size_t)(16 * u.pn + 60) * 512; o.b1 = o.b0 + 8 * 512; o.ksB = -2048; o.nt = 4 * (u.pn + 1); }
            else { o.b0 = tab + SSM_TEND; o.b1 = o.b0; o.ksB = 16384; o.nt = 16; }
        } else if (u.type == 1) {
            o.a0 = Z + ((size_t)u.pm * 256 * ZLD + Z_QC) * 2; o.a1 = o.a0 + (size_t)128 * ZLD * 2; o.ksA = 128;
            o.b0 = WUQ + (size_t)u.pn * 256 * 512 * 2; o.b1 = o.b0 + (size_t)128 * 512 * 2; o.ksB = 128; o.nt = 8;
        } else if (u.type == 2) {
            o.a0 = Z + ((size_t)u.pm * 256 * ZLD + Z_KVC) * 2; o.a1 = o.a0 + (size_t)128 * ZLD * 2; o.ksA = 128;
            o.b0 = WUKV + (size_t)u.pn * 256 * 256 * 2; o.b1 = o.b0 + (size_t)128 * 256 * 2; o.ksB = 128; o.nt = 4;
        } else {
            o.a0 = Z + ((size_t)u.pm * 256 * ZLD + Z_POOL + 256 * u.pn) * 2; o.a1 = o.a0 + (size_t)128 * ZLD * 2; o.ksA = 128;
            o.b0 = WPOOL + (size_t)u.pn * 256 * 256 * 2; o.b1 = o.b0 + (size_t)128 * 256 * 2; o.ksB = 128; o.nt = 4;
        }
    }
    __device__ __forceinline__ void voff(const Unit& u, const ge::Lane& ln, ge::Off& v) const {
#pragma unroll
        for (int i = 0; i < 2; ++i) {
            const int R = ln.R[i], Rb = ln.Rb[i], C = ln.C[i]; unsigned a, b;
            if (u.type == 0) {
                a = (unsigned)(R * 1024 + C) * 2u;
                if (u.pn < 4) b = (unsigned)(((Rb >> 4) - (C >> 4) + 3) * 256 + (Rb & 15) * 16 + (C & 15)) * 2u;
                else b = (unsigned)((((C >> 4) * 128 + Rb) * 16) + (C & 15)) * 2u;
            } else if (u.type == 1) { a = (unsigned)(R * ZLD + C) * 2u; b = (unsigned)(Rb * 512 + C) * 2u; }
            else { a = (unsigned)(R * ZLD + C) * 2u; b = (unsigned)(Rb * 256 + C) * 2u; }
            v.a[0][i] = a; v.b[i] = b;
        }
    }
    __device__ __forceinline__ void epi(const ge::Acc& acc, const Unit& u, int wr, int wc, int fr, int fq) const {
        const int cl = 32 * wc + 8 * fq;
        if (u.type == 0) {
            EPI_ROWS_BEGIN
                const int cg = u.pm * 256 + rt;
                if (u.pn < 4) {
#pragma unroll
                    for (int bj = 0; bj < 2; ++bj) { const int n = 128 * bj + cl, t = 16 * u.pn + (n >> 4), h0 = n & 15;
                        *(u32x4*)(YI + ((size_t)cg * 64 + t) * 512 + u.g * 16 + h0) = pack8f(acc[ai][bj][m][0], acc[ai][bj][m][1]); }
                } else {
                    float* e = EBUF + ((size_t)cg * SSM_G + u.g) * 128 + cl;
                    *(f32x4*)e = acc[ai][0][m][0]; *(f32x4*)(e + 4) = acc[ai][0][m][1];
                }
            EPI_ROWS_END
        } else if (u.type == 1) {
            constexpr float QSCALE = 0.07216878364870322f * 1.4426950408889634f;
            EPI_ROWS_BEGIN
                const int row = u.pm * 256 + rt; const int b = row >> 14, t = row & (SEQ - 1);
                const f32x4 sa = *(const f32x4*)(ssqp + (size_t)row * 12), sb = *(const f32x4*)(ssqp + (size_t)row * 12 + 4);
                const float rs = rsqrtf((((sa[0] + sa[1]) + (sa[2] + sa[3])) + ((sb[0] + sb[1]) + (sb[2] + sb[3]))) * (1.f / 512.f) + EPS) * QSCALE;
#pragma unroll
                for (int bj = 0; bj < 2; ++bj) {
                    const int c = 256 * u.pn + 128 * bj + cl; const int head = c / QKD, d = c - head * QKD;
                    f32x4 v0 = acc[ai][bj][m][0] * rs, v1 = acc[ai][bj][m][1] * rs;
                    if (d >= 128) {
                        const f32x2* cs = CS + (size_t)row * 32 + ((d - 128) >> 1);
                        const f32x4 c01 = *(const f32x4*)cs, c23 = *(const f32x4*)(cs + 2);
                        f32x4 o0, o1;
                        o0[0] = v0[0] * c01[0] - v0[1] * c01[1]; o0[1] = v0[1] * c01[0] + v0[0] * c01[1];
                        o0[2] = v0[2] * c01[2] - v0[3] * c01[3]; o0[3] = v0[3] * c01[2] + v0[2] * c01[3];
                        o1[0] = v1[0] * c23[0] - v1[1] * c23[1]; o1[1] = v1[1] * c23[0] + v1[0] * c23[1];
                        o1[2] = v1[2] * c23[2] - v1[3] * c23[3]; o1[3] = v1[3] * c23[2] + v1[2] * c23[3];
                        v0 = o0; v1 = o1;
                    }
                    *(u32x4*)(Q + ((size_t)(b * NHEAD + head) * SEQ + t) * QKD + d) = pack8f(v0, v1);
                }
            EPI_ROWS_END
        } else if (u.type == 2) {
            EPI_ROWS_BEGIN
                const int row = u.pm * 256 + rt; const int b = row >> 14, t = row & (SEQ - 1);
                const f32x4 sa = *(const f32x4*)(ssqp + (size_t)row * 12 + 8);
                const float rs = rsqrtf(((sa[0] + sa[1]) + (sa[2] + sa[3])) * (1.f / 256.f) + EPS);
#pragma unroll
                for (int bj = 0; bj < 2; ++bj) {
                    const int d = 128 * bj + cl; const int head = u.pn;
                    const u32x4 w = pack8f(acc[ai][bj][m][0] * rs, acc[ai][bj][m][1] * rs);
                    if (d < 128) *(u32x4*)(K + ((size_t)(b * NHEAD + head) * SEQ + t) * QKD + d) = w;
                    else *(u32x4*)(V + ((size_t)(b * NHEAD + head) * SEQ + t) * VD + (d - 128)) = w;
                }
            EPI_ROWS_END
        } else {
            EPI_ROWS_BEGIN
                const int row = u.pm * 256 + rt;
#pragma unroll
                for (int bj = 0; bj < 2; ++bj) *(u32x4*)(P + (size_t)row * 512 + 256 * u.pn + 128 * bj + cl) = pack8f(acc[ai][bj][m][0], acc[ai][bj][m][1]);
            EPI_ROWS_END
        }
    }
};

struct ProgS1 {
    static constexpr int VAR_OFF = 0, GATHER = 0;
    struct Unit { int g, pm, pn; };
    int G, c; const char* SPREV; const char* SSMTAB; const bf16_t* YI; const bf16_t* U; const float* Dskip; bf16_t* YG;
    __device__ __forceinline__ bool next(int i, Unit& u) const { const int x = c & 7, L = (c >> 3) + (G >> 3) * i; if (L >= 32) return false; const int r = 8 * x + (L >> 2); u.g = r >> 1; u.pm = r & 1; u.pn = L & 3; return true; }
    __device__ __forceinline__ void ops(const Unit& u, ge::Ops& o) const {
        o.a0 = SPREV + ((size_t)u.pm * 256 * (SSM_G * 256) + u.g * 256) * 2; o.a1 = o.a0 + (size_t)128 * (SSM_G * 256) * 2; o.ksA = 128;
        o.b0 = SSMTAB + (size_t)u.g * SSMTAB_STRIDE + SSM_WC + (size_t)u.pn * 256 * 256 * 2; o.b1 = o.b0 + (size_t)128 * 256 * 2; o.ksB = 128; o.nt = 4; }
    __device__ __forceinline__ void voff(const Unit&, const ge::Lane& ln, ge::Off& v) const { ge::off_rm(ln, SSM_G * 256, 256, v); }
    __device__ __forceinline__ void epi(const ge::Acc& acc, const Unit& u, int wr, int wc, int fr, int fq) const {
        const int cl = 32 * wc + 8 * fq;
        EPI_ROWS_BEGIN
            const int cg = u.pm * 256 + rt;
#pragma unroll
            for (int bj = 0; bj < 2; ++bj) {
                const int n = 128 * bj + cl, t = 16 * u.pn + (n >> 4), h0 = n & 15; const size_t tok = (size_t)cg * 64 + t; const int ch = u.g * 16 + h0;
                f32x4 yi0, yi1, u0, u1; unpack8(*(const u32x4*)(YI + tok * 512 + ch), yi0, yi1); unpack8(*(const u32x4*)(U + ((size_t)u.g * NTOK + tok) * 16 + h0), u0, u1);
                const f32x4 d0 = *(const f32x4*)(Dskip + ch), d1 = *(const f32x4*)(Dskip + ch + 4);
                f32x4 y0 = acc[ai][bj][m][0] + yi0 + d0 * u0, y1 = acc[ai][bj][m][1] + yi1 + d1 * u1;
#pragma unroll
                for (int e = 0; e < 4; ++e) { y0[e] = gelu_tanh(y0[e]); y1[e] = gelu_tanh(y1[e]); }
                *(u32x4*)(YG + tok * 512 + ch) = pack8f(y0, y1);
            }
        EPI_ROWS_END
    }
};

struct ProgS2 {
    static constexpr int VAR_OFF = 0, GATHER = 0;
    struct Unit { int pm, pn; };
    int G, c; const char* YGc; const char* W; const bf16_t* YG; bf16_t* GL;
    __device__ __forceinline__ bool next(int i, Unit& u) const { const int x = c & 7, L = (c >> 3) + (G >> 3) * i; if (L >= 32) return false; u.pm = 16 * x + (L >> 1); u.pn = L & 1; return true; }
    __device__ __forceinline__ void ops(const Unit& u, ge::Ops& o) const {
        o.a0 = YGc + (size_t)u.pm * 256 * 512 * 2; o.a1 = o.a0 + (size_t)128 * 512 * 2; o.ksA = 128; o.b0 = W + (size_t)u.pn * 256 * 512 * 2; o.b1 = o.b0 + (size_t)128 * 512 * 2; o.ksB = 128; o.nt = 8; }
    __device__ __forceinline__ void voff(const Unit&, const ge::Lane& ln, ge::Off& v) const { ge::off_rm(ln, 512, 512, v); }
    __device__ __forceinline__ void epi(const ge::Acc& acc, const Unit& u, int wr, int wc, int fr, int fq) const {
        const int cl = 32 * wc + 8 * fq;
        EPI_ROWS_BEGIN
            const size_t row = (size_t)u.pm * 256 + rt;
#pragma unroll
            for (int bj = 0; bj < 2; ++bj) {
                const int c = 256 * u.pn + 128 * bj + cl; f32x4 y0, y1; unpack8(*(const u32x4*)(YG + row * 512 + c), y0, y1);
                f32x4 a0 = acc[ai][bj][m][0], a1 = acc[ai][bj][m][1];
#pragma unroll
                for (int e = 0; e < 4; ++e) { y0[e] *= sigmoidf_(a0[e]); y1[e] *= sigmoidf_(a1[e]); }
                *(u32x4*)(GL + row * 512 + c) = pack8f(y0, y1);
            }
        EPI_ROWS_END
    }
};

struct ProgG3 {
    static constexpr int VAR_OFF = 0, GATHER = 0;
    struct Unit { int pm, pn; };
    StaticOrder so; const char* A; const char* B; const float* xin; const bf16_t* xin16; bf16_t* xout; const float* ga;
    __device__ __forceinline__ bool next(int i, Unit& u) const { return so.next(i, u.pm, u.pn); }
    __device__ __forceinline__ void ops(const Unit& u, ge::Ops& o) const {
        o.a0 = A + (size_t)u.pm * 256 * DM * 2; o.a1 = o.a0 + (size_t)128 * DM * 2; o.b0 = B + (size_t)u.pn * 256 * DM * 2; o.b1 = o.b0 + (size_t)128 * DM * 2; o.ksA = 128; o.ksB = 128; o.nt = DM / 64; }
    __device__ __forceinline__ void voff(const Unit&, const ge::Lane& ln, ge::Off& v) const { ge::off_rm(ln, DM, DM, v); }
    __device__ __forceinline__ void epi(const ge::Acc& acc, const Unit& u, int wr, int wc, int fr, int fq) const {
        const int cl = 32 * wc + 8 * fq; const int b = (u.pm * 256) >> 14;
        f32x4 g[2][2];
#pragma unroll
        for (int bj = 0; bj < 2; ++bj) { const float* gp = ga + (size_t)b * 6 * DM + 256 * u.pn + 128 * bj + cl; g[bj][0] = *(const f32x4*)gp; g[bj][1] = *(const f32x4*)(gp + 4); }
        EPI_ROWS_BEGIN
            const size_t row = (size_t)u.pm * 256 + rt;
#pragma unroll
            for (int bj = 0; bj < 2; ++bj) {
                const size_t o = row * DM + 256 * u.pn + 128 * bj + cl;
                f32x4 x0, x1;
                if (xin) { x0 = *(const f32x4*)(xin + o); x1 = *(const f32x4*)(xin + o + 4); } else unpack8(*(const u32x4*)(xin16 + o), x0, x1);
                *(u32x4*)(xout + o) = pack8f(x0 + g[bj][0] * acc[ai][bj][m][0], x1 + g[bj][1] * acc[ai][bj][m][1]);
            }
        EPI_ROWS_END
    }
};

struct ProgM1 {
    static constexpr int VAR_OFF = 1, GATHER = 1;
    struct Unit { int k, pn, e, j; };
    int G, c; const LAS int* tab; int ntiles; const int* cnt; const int* toks; const char* H; const char* W13; bf16_t* ACT;
    __device__ __forceinline__ bool next(int i, Unit& u) const { const int x = c & 7, t0 = (x * ntiles) >> 3, t1 = ((x + 1) * ntiles) >> 3, L = (c >> 3) + (G >> 3) * i; if (L >= (t1 - t0) * 4) return false; u.k = t0 + (L >> 2); u.pn = L & 3; const int w = __builtin_amdgcn_readfirstlane(tab[u.k]); u.e = w >> 16; u.j = w & 0xffff; return true; }
    __device__ __forceinline__ void ops(const Unit& u, ge::Ops& o) const {
        o.a0 = H; o.a1 = H; o.ksA = 128; o.b0 = W13 + ((size_t)u.e * 1024 + 128 * u.pn) * DM * 2; o.b1 = o.b0 + (size_t)512 * DM * 2; o.ksB = 128; o.nt = DM / 64; }
    __device__ __forceinline__ void voff(const Unit& u, const ge::Lane& ln, ge::Off& v) const {
        const int n = __builtin_amdgcn_readfirstlane(cnt[u.e * 64]); const int* tl = toks + (size_t)u.e * NTOK + u.j * 256;
#pragma unroll
        for (int i = 0; i < 2; ++i) {
#pragma unroll
            for (int h = 0; h < 2; ++h) { const int r = 128 * h + ln.R[i]; const int tok = (u.j * 256 + r < n) ? tl[r] : 0; v.a[h][i] = (unsigned)(tok * DM + ln.C[i]) * 2u; }
            v.b[i] = (unsigned)(ln.Rb[i] * DM + ln.C[i]) * 2u;
        }
    }
    __device__ __forceinline__ void epi(const ge::Acc& acc, const Unit& u, int wr, int wc, int fr, int fq) const {
        const int cl = 32 * wc + 8 * fq;
        EPI_ROWS_BEGIN
            const size_t pos = (size_t)u.k * 256 + rt;
            f32x4 g0 = acc[ai][0][m][0], g1 = acc[ai][0][m][1]; const f32x4 u0 = acc[ai][1][m][0], u1 = acc[ai][1][m][1];
#pragma unroll
            for (int e = 0; e < 4; ++e) { g0[e] = g0[e] * sigmoidf_(g0[e]) * u0[e]; g1[e] = g1[e] * sigmoidf_(g1[e]) * u1[e]; }
            *(u32x4*)(ACT + pos * DEXP + 128 * u.pn + cl) = pack8f(g0, g1);
        EPI_ROWS_END
    }
};
struct ProgM2 {
    static constexpr int VAR_OFF = 0, GATHER = 0;
    struct Unit { int k, pn, e; };
    int G, c; const LAS int* tab; int ntiles; const char* ACT; const char* W2; unsigned char* Y2;
    __device__ __forceinline__ bool next(int i, Unit& u) const { const int x = c & 7, t0 = (x * ntiles) >> 3, t1 = ((x + 1) * ntiles) >> 3, L = (c >> 3) + (G >> 3) * i; if (L >= (t1 - t0) * 8) return false; u.k = t0 + (L >> 3); u.pn = L & 7; u.e = __builtin_amdgcn_readfirstlane(tab[u.k]) >> 16; return true; }
    __device__ __forceinline__ void ops(const Unit& u, ge::Ops& o) const {
        o.a0 = ACT + (size_t)u.k * 256 * DEXP * 2; o.a1 = o.a0 + (size_t)128 * DEXP * 2; o.ksA = 128; o.b0 = W2 + ((size_t)u.e * DM + 256 * u.pn) * DEXP * 2; o.b1 = o.b0 + (size_t)128 * DEXP * 2; o.ksB = 128; o.nt = DEXP / 64; }
    __device__ __forceinline__ void voff(const Unit&, const ge::Lane& ln, ge::Off& v) const { ge::off_rm(ln, DEXP, DEXP, v); }
    __device__ __forceinline__ void epi(const ge::Acc& acc, const Unit& u, int wr, int wc, int fr, int fq) const {
        const int cl = 32 * wc + 8 * fq;
        EPI_ROWS_BEGIN
            const size_t pos = (size_t)u.k * 256 + rt;
#pragma unroll
            for (int bj = 0; bj < 2; ++bj) { f32x4 v0 = acc[ai][bj][m][0], v1 = acc[ai][bj][m][1];
#pragma unroll
                for (int e = 0; e < 4; ++e) { v0[e] = fminf(fmaxf(v0[e], -448.f), 448.f); v1[e] = fminf(fmaxf(v1[e], -448.f), 448.f); }
                int w0 = __builtin_amdgcn_cvt_pk_fp8_f32(v0[0], v0[1], 0, false); w0 = __builtin_amdgcn_cvt_pk_fp8_f32(v0[2], v0[3], w0, true);
                int w1 = __builtin_amdgcn_cvt_pk_fp8_f32(v1[0], v1[1], 0, false); w1 = __builtin_amdgcn_cvt_pk_fp8_f32(v1[2], v1[3], w1, true);
                *(u32x2*)(Y2 + pos * DM + 256 * u.pn + 128 * bj + cl) = (u32x2){(unsigned)w0, (unsigned)w1}; }
        EPI_ROWS_END
    }
};
__device__ __forceinline__ int build_tile_table(const Ctx& c, const int* cnt) {
    LAS int* tab = (LAS int*)(c.lds + LDS_TILETAB); LAS int* ps = (LAS int*)(c.lds + LDS_PSTART);
    __syncthreads();
    if (c.tid < NEXP) {
        int before = 0, mine = 0;
        for (int e = 0; e < NEXP; ++e) { const int nt = (cnt[e * 64] + 255) >> 8; if (e < c.tid) before += nt; if (e == c.tid) mine = nt; }
        ps[c.tid] = before * 256;
        for (int j = 0; j < mine; ++j) tab[before + j] = (c.tid << 16) | j;
        if (c.tid == NEXP - 1) ps[NEXP] = before + mine;
    }
    __syncthreads();
    return ps[NEXP];
}
template <class F>
__device__ __forceinline__ void tr_item(const float* W, int ldw, int k0, int n0, const float* ksc, LAS float* scr, int lane, F dst) {
#pragma unroll 8
    for (int i = 0; i < 32; ++i) { const int kk = 2 * i + (lane >> 5); float v = W[(size_t)(k0 + kk) * ldw + n0 + (lane & 31)]; if (ksc) v *= ksc[k0 + kk]; scr[kk * 33 + (lane & 31)] = v; }
    LDS_WAIT(); asm volatile("" ::: "memory");
    const int cc = lane & 7;
#pragma unroll
    for (int j = 0; j < 4; ++j) { const int n = (lane >> 3) + 8 * j; const LAS float* s = scr + (8 * cc) * 33 + n;
        u32x4 o; o.x = cvtpk(s[0 * 33], s[1 * 33]); o.y = cvtpk(s[2 * 33], s[3 * 33]); o.z = cvtpk(s[4 * 33], s[5 * 33]); o.w = cvtpk(s[6 * 33], s[7 * 33]);
        bf16_t* d = dst(n0 + n); if (d) *(u32x4*)(d + k0 + 8 * cc) = o; }
    LDS_WAIT(); asm volatile("" ::: "memory");
}
__device__ __forceinline__ int rope_perm(int j) { return 2 * (j & 31) + (j >> 5); }

__device__ __forceinline__ void convert_experts(const Ctx& c, int l, int it0 = 0, int it1 = NEXP * 1536, int wg0 = 0) {
    LAS float* scr = (LAS float*)(c.lds + c.wid * 16384);
    if (c.vcu < wg0) return;
    const int gw = (c.vcu - wg0) * 8 + c.wid, NGW = (c.G - wg0) * 8;
    const float* wg = inp(c, 29) + (size_t)l * NEXP * DM * DEXP; const float* wu = inp(c, 30) + (size_t)l * NEXP * DM * DEXP; const float* wd = inp(c, 31) + (size_t)l * NEXP * DEXP * DM;
    bf16_t* W13 = wsp<bf16_t>(c, WS_W13); bf16_t* W2 = wsp<bf16_t>(c, WS_W2);
    for (int it = it0 + gw; it < it1; it += NGW) {
        const int e = it / 1536, r = it % 1536;
        if (r < 1024) { const int up = r >> 9, q = r & 511, kb = q >> 4, nb = q & 15; const float* W = (up ? wu : wg) + (size_t)e * DM * DEXP; bf16_t* D = W13 + ((size_t)e * 1024 + up * 512) * DM;
            tr_item(W, DEXP, kb * 64, nb * 32, nullptr, scr, c.lane, [=](int n) { return D + (size_t)n * DM; }); }
        else { const int q = r - 1024, kb = q >> 6, nb = q & 63; const float* W = wd + (size_t)e * DEXP * DM; bf16_t* D = W2 + (size_t)e * DM * DEXP;
            tr_item(W, DM, kb * 64, nb * 32, nullptr, scr, c.lane, [=](int n) { return D + (size_t)n * DEXP; }); }
    }
}

__device__ __forceinline__ void p0_prologue(const Ctx& c) {
    const int gw = c.vcu * 8 + c.wid, NGW = c.G * 8; const int gt = c.vcu * 512 + c.tid, NGT = c.G * 512;
    {
        LAS float* red = (LAS float*)c.lds;
        const float* cv = inp(c, 1);
        for (int item = c.vcu; item < 96; item += c.G) {
            const int l = item / 48, cb = item % 48;
            const float* w = inp(c, 3) + ((size_t)l * DM + 256 * c.wid) * (6 * DM) + cb * 256 + c.lane * 4;
            f32x4 a0 = {0.f, 0.f, 0.f, 0.f}, a1 = {0.f, 0.f, 0.f, 0.f};
#pragma unroll 16
            for (int k = 0; k < 256; ++k) { const f32x4 wv = *(const f32x4*)(w + (size_t)k * (6 * DM)); const float c0 = cv[256 * c.wid + k], c1 = cv[DM + 256 * c.wid + k]; a0 += wv * c0; a1 += wv * c1; }
            *(LAS f32x4*)(red + (c.wid * 2 + 0) * 256 + c.lane * 4) = a0; *(LAS f32x4*)(red + (c.wid * 2 + 1) * 256 + c.lane * 4) = a1;
            __syncthreads();
            { const int b = c.tid >> 8, col = c.tid & 255; float s = inp(c, 4)[(size_t)l * 6 * DM + cb * 256 + col];
#pragma unroll
              for (int w8 = 0; w8 < 8; ++w8) s += red[(w8 * 2 + b) * 256 + col];
              wsp<float>(c, WS_MOD)[((size_t)(l * NB + b) * 6) * DM + cb * 256 + col] = s; }
            __syncthreads();
        }
    }
    {
        LAS float* scr = (LAS float*)(c.lds + c.wid * 16384);
        constexpr int I_IN = 32 * 58, I_UQ = 8 * 48, I_UKV = 4 * 64, I_OUT = 32 * 64, I_GLU = 8 * 16, I_L = I_IN + I_UQ + I_UKV + I_OUT + I_GLU;
        for (int it = gw; it < 2 * I_L; it += NGW) {
            const int l = it / I_L; int r = it % I_L;
            if (r < I_IN) { const int kb = r / 58, nb = r % 58; bf16_t* D = wsp<bf16_t>(c, WS_WIN) + (size_t)l * DM * DM;
                tr_item(inp(c, 6) + (size_t)l * DM * IN_COLS, IN_COLS, kb * 64, nb * 32, nullptr, scr, c.lane, [=](int n) { const int dr = n < 1792 ? n : 1792 + rope_perm(n - 1792); return D + (size_t)dr * DM; }); continue; } r -= I_IN;
            if (r < I_UQ) { const int kb = r / 48, nb = r % 48; bf16_t* D = wsp<bf16_t>(c, WS_WUQ) + (size_t)l * 1536 * 512;
                tr_item(inp(c, 20) + (size_t)l * 512 * 1536, 1536, kb * 64, nb * 32, inp(c, 18) + l * 512, scr, c.lane, [=](int n) { const int h = n / QKD, d = n % QKD; const int dr = h * QKD + (d < 128 ? d : 128 + rope_perm(d - 128)); return D + (size_t)dr * 512; }); continue; } r -= I_UQ;
            if (r < I_UKV) { const int kb = r / 64, nb = r % 64; bf16_t* D = wsp<bf16_t>(c, WS_WUKV) + (size_t)l * 2048 * 256;
                tr_item(inp(c, 21) + (size_t)l * 256 * 2048, 2048, kb * 64, nb * 32, inp(c, 19) + l * 256, scr, c.lane, [=](int n) { return D + (size_t)n * 256; }); continue; } r -= I_UKV;
            if (r < I_OUT) { const int kb = r / 64, nb = r % 64; bf16_t* D = wsp<bf16_t>(c, WS_WOUT) + (size_t)l * DM * DM;
                tr_item(inp(c, 23) + (size_t)l * DM * DM, DM, kb * 64, nb * 32, inp(c, 22) + l * DM, scr, c.lane, [=](int n) { return D + (size_t)n * DM; }); continue; } r -= I_OUT;
            { const int kb = r / 16, nb = r % 16; bf16_t* D = wsp<bf16_t>(c, WS_WGLU) + (size_t)l * 512 * 512;
                tr_item(inp(c, 17) + (size_t)l * 512 * 512, 512, kb * 64, nb * 32, nullptr, scr, c.lane, [=](int n) { return D + (size_t)n * 512; }); }
        }
    }
    { const int split = (c.G > 96) ? 15 * 8 * (c.G - 96) : 0;
      __syncthreads(); convert_experts(c, 0, 0, split, 96); convert_experts(c, 0, split, NEXP * 1536, 0); }
    for (int i = gt; i < 2 * 2 * 256 * 256; i += NGT) {
        const int k = i & 255, n = (i >> 8) & 255, pn = (i >> 16) & 1, l = i >> 17; float v = 0.f;
        if ((k >> 7) == (n >> 7)) { const int g = 2 * pn + (n >> 7); v = inp(c, 7)[(((size_t)l * 4 + g) * 128 + (k & 127)) * 128 + (n & 127)] * inp(c, 8)[l * 512 + g * 128 + (n & 127)]; }
        wsp<bf16_t>(c, WS_WPOOL)[i] = f2bf(v);
    }
    for (int i = gt; i < 2 * 192 * DM / 8; i += NGT) { const int l = i / (192 * DM / 8), r = i % (192 * DM / 8); *(u32x4*)(wsp<bf16_t>(c, WS_WIN) + (size_t)l * DM * DM + (size_t)IN_COLS * DM + (size_t)r * 8) = (u32x4){0u, 0u, 0u, 0u}; }
    for (int i = gt; i < (int)(8 * MiB / 16); i += NGT) *(u32x4*)(c.ws + WS_SPREV + (size_t)i * 16) = (u32x4){0u, 0u, 0u, 0u};
    for (int i = gt; i < NTOK * 32; i += NGT) {
        const int tok = i >> 5, f = i & 31; const float invf = exp2f(-(float)f * (13.287712379549449f / 32.0f));
        const float ang = (float)((const int*)c.a.in[2])[tok] * invf; float s, co; sincos_rev((double)ang, s, co);
        wsp<f32x2>(c, WS_CS)[i] = (f32x2){co, s};
    }
    for (int i = gt; i < 64 * 65 * 64; i += NGT) {
        const int lg = i / (65 * 64), r = i % (65 * 64), lag = r >> 6, p = r & 63, l = lg >> 5, g = lg & 31;
        const float dt = __expf(inp(c, 11)[l * 32 + g]); const int gp = lg * 64 + p; const float lr = inp(c, 9)[gp], lim = inp(c, 10)[gp];
        float sl, cl_; sincos_rev((double)lag * (double)(lim * dt), sl, cl_); const float ml = __expf((float)lag * lr * dt);
        wsp<f32x2>(c, WS_PWTAB)[i] = (f32x2){ml * cl_, ml * sl};
    }
    for (int i = gt; i < 64 * 64 * 16; i += NGT) {
        const int gp = i >> 4, hp = i & 15, lg = gp >> 6, l = lg >> 5, g = lg & 31;
        const float dt = __expf(inp(c, 11)[l * 32 + g]); const float lr = inp(c, 9)[gp], lim = inp(c, 10)[gp];
        float s1, c1; sincos_rev((double)(lim * dt), s1, c1); const float mg = __expf(lr * dt); const float ar = mg * c1, aim = mg * s1;
        const float den = lr * lr + lim * lim; const float fr_ = ((ar - 1.f) * lr + aim * lim) / den, fi_ = (aim * lr - (ar - 1.f) * lim) / den;
        const float br = inp(c, 12)[i], bi = inp(c, 13)[i];
        wsp<f32x2>(c, WS_BBTAB)[i] = (f32x2){fr_ * br - fi_ * bi, fr_ * bi + fi_ * br};
    }
    for (int i = gt; i < 64 * 64; i += NGT) {
        const int lg = i >> 6, l = lg >> 5, g = lg & 31; const float dt = __expf(inp(c, 11)[l * 32 + g]); const float lr = inp(c, 9)[i], lim = inp(c, 10)[i];
        float sl, cl_; sincos_rev(64.0 * (double)(lim * dt), sl, cl_); const float ml = __expf(64.f * lr * dt); wsp<f32x2>(c, WS_A64)[i] = (f32x2){ml * cl_, ml * sl};
    }
}

__device__ __forceinline__ void gen_ssm_tables(const Ctx& c) {
    const int gt = c.vcu * 512 + c.tid, NGT = c.G * 512;
    const f32x2* PW = wsp<const f32x2>(c, WS_PWTAB); const f32x2* BB = wsp<const f32x2>(c, WS_BBTAB);
    for (int i = gt; i < 64 * 127 * 64; i += NGT) {
        const int lg = i / (127 * 64), r = i % (127 * 64), li_ = r >> 6, h = (r >> 2) & 15, hp = (r & 3) * 4;
        f32x4 acc = {0.f, 0.f, 0.f, 0.f};
        if (li_ >= 63) {
            const f32x2* pw = PW + ((size_t)lg * 65 + (li_ - 63)) * 64; const f32x2* bb = BB + (size_t)lg * 1024 + hp; const float* cr = inp(c, 14) + ((size_t)lg * 16 + h) * 64; const float* ci = inp(c, 15) + ((size_t)lg * 16 + h) * 64;
#pragma unroll 4
            for (int p = 0; p < 64; ++p) { const f32x2 a = pw[p]; const float c_r = cr[p], c_i = ci[p]; const float wr_ = a.x * c_r - a.y * c_i, wi_ = a.x * c_i + a.y * c_r;
                const f32x4 b01 = *(const f32x4*)(bb + p * 16), b23 = *(const f32x4*)(bb + p * 16 + 2);
                acc[0] += wr_ * b01[0] - wi_ * b01[1]; acc[1] += wr_ * b01[2] - wi_ * b01[3]; acc[2] += wr_ * b23[0] - wi_ * b23[1]; acc[3] += wr_ * b23[2] - wi_ * b23[3]; }
        }
        *(u32x2*)(c.ws + WS_SSMTAB + (size_t)lg * SSMTAB_STRIDE + SSM_TG + ((size_t)li_ * 256 + h * 16 + hp) * 2) = (u32x2){cvtpk(acc[0], acc[1]), cvtpk(acc[2], acc[3])};
    }
    for (int i0 = gt; i0 < 64 * 64 * 128 * 2; i0 += 4 * NGT) {
        float v[4][8];
#pragma unroll
        for (int u = 0; u < 4; ++u) { const int i = min(i0 + u * NGT, 64 * 64 * 128 * 2 - 1);
            const int lg = i >> 14, r8 = i & 16383, tau = r8 >> 8, pp = (r8 >> 1) & 127, hp0 = (r8 & 1) * 8, p = pp & 63;
            const f32x2 a = PW[((size_t)lg * 65 + (63 - tau)) * 64 + p]; const f32x2* b = BB + (size_t)lg * 1024 + p * 16 + hp0;
#pragma unroll
            for (int e = 0; e < 8; ++e) { const f32x2 bb = b[e]; v[u][e] = pp < 64 ? a.x * bb.x - a.y * bb.y : a.x * bb.y + a.y * bb.x; } }
#pragma unroll
        for (int u = 0; u < 4; ++u) { const int i = i0 + u * NGT; if (i < 64 * 64 * 128 * 2) { const int lg = i >> 14, r8 = i & 16383;
            *(u32x4*)(c.ws + WS_SSMTAB + (size_t)lg * SSMTAB_STRIDE + SSM_TEND + ((size_t)r8 * 8) * 2) = (u32x4){cvtpk(v[u][0], v[u][1]), cvtpk(v[u][2], v[u][3]), cvtpk(v[u][4], v[u][5]), cvtpk(v[u][6], v[u][7])}; } }
    }
    for (int i0 = gt; i0 < 64 * 1024 * 32; i0 += 4 * NGT) {
        float v[4][8];
#pragma unroll
        for (int u = 0; u < 4; ++u) { const int i = min(i0 + u * NGT, 64 * 1024 * 32 - 1);
            const int lg = i >> 15, r8 = i & 32767, n = r8 >> 5, k0 = (r8 & 31) * 8, t = n >> 4, h = n & 15;
            if (k0 < 128) { const int p0 = k0 & 63; const f32x2* a = PW + ((size_t)lg * 65 + (t + 1)) * 64 + p0; const float* cr = inp(c, 14) + ((size_t)lg * 16 + h) * 64 + p0; const float* ci = inp(c, 15) + ((size_t)lg * 16 + h) * 64 + p0;
#pragma unroll
                for (int e = 0; e < 8; ++e) { const f32x2 aa = a[e]; v[u][e] = k0 < 64 ? cr[e] * aa.x - ci[e] * aa.y : -(cr[e] * aa.y + ci[e] * aa.x); } }
            else {
#pragma unroll
                for (int e = 0; e < 8; ++e) v[u][e] = 0.f; } }
#pragma unroll
        for (int u = 0; u < 4; ++u) { const int i = i0 + u * NGT; if (i < 64 * 1024 * 32) { const int lg = i >> 15, r8 = i & 32767;
            *(u32x4*)(c.ws + WS_SSMTAB + (size_t)lg * SSMTAB_STRIDE + SSM_WC + ((size_t)r8 * 8) * 2) = (u32x4){cvtpk(v[u][0], v[u][1]), cvtpk(v[u][2], v[u][3]), cvtpk(v[u][4], v[u][5]), cvtpk(v[u][6], v[u][7])}; } }
    }
}

__device__ __forceinline__ void router_prep(const Ctx& c, int l) {
    const int gt = c.vcu * 512 + c.tid, NGT = c.G * 512;
    for (int i = gt; i < NB * 64 * 3 * 64; i += NGT) {
        const int ln = i & 63, cb = (i >> 6) % 3, ks = (i / 192) & 63, b = i / (192 * 64);
        const int j = 16 * cb + (ln & 15), k0 = 32 * ks + 8 * (ln >> 4);
        float hi[8], lo[8];
#pragma unroll
        for (int e = 0; e < 8; ++e) { const int k = k0 + e; float w = 0.f;
            if (j < 4) w = inp(c, 25)[((size_t)l * DM + k) * 4 + j]; else if (j < 36) w = inp(c, 27)[((size_t)l * DM + k) * 32 + (j - 4)];
            w *= inp(c, 24)[l * DM + k] * (1.f + modp(c, l, b, 4)[k]);
            hi[e] = bf2f(f2bf(w)); lo[e] = w - hi[e]; }
        u32x4 H, L; H.x = cvtpk(hi[0], hi[1]); H.y = cvtpk(hi[2], hi[3]); H.z = cvtpk(hi[4], hi[5]); H.w = cvtpk(hi[6], hi[7]); L.x = cvtpk(lo[0], lo[1]); L.y = cvtpk(lo[2], lo[3]); L.z = cvtpk(lo[4], lo[5]); L.w = cvtpk(lo[6], lo[7]);
        bf16_t* base = wsp<bf16_t>(c, WS_RWF) + ((((size_t)(l * NB + b) * 64 + ks) * 3 + cb) * 2) * 512;
        *(u32x4*)(base + ln * 8) = H; *(u32x4*)(base + 512 + ln * 8) = L;
    }
    const int gw = c.vcu * 8 + c.wid, NGW = c.G * 8;
    for (int i = gw; i < NB * 36; i += NGW) {
        const int b = i / 36, j = i % 36; float s = 0.f;
        for (int k = c.lane; k < DM; k += 64) { const float w = j < 4 ? inp(c, 25)[((size_t)l * DM + k) * 4 + j] : inp(c, 27)[((size_t)l * DM + k) * 32 + (j - 4)]; s += modp(c, l, b, 3)[k] * w; }
        s = wave_sum(s);
        if (c.lane == 0) wsp<float>(c, WS_RBIAS)[(l * NB + b) * 64 + j] = s + (j < 4 ? inp(c, 26)[l * 4 + j] : inp(c, 28)[l * 32 + (j - 4)]);
    }
}

template <int MODE>
__device__ __forceinline__ void norm_phase(const Ctx& c, int l) {
    LAS float* red0 = (LAS float*)c.lds;
    const LAS int* ps = (const LAS int*)(c.lds + LDS_PSTART);
    const int lane = c.lane, wid = c.wid, row = lane & 15, kq = lane >> 4;
    bf16_t* xbuf = wsp<bf16_t>(c, WS_XBUF);
    const bool src_f32 = (MODE == 0 && l == 0);
    const int lm = (MODE == 3) ? 1 : l - 1;
    const i32x4* RI = wsp<const i32x4>(c, WS_RI) + (size_t)(lm < 0 ? 0 : lm) * NTOK; const f32x2* RW = wsp<const f32x2>(c, WS_RW) + (size_t)(lm < 0 ? 0 : lm) * NTOK;
    const unsigned char* Y2 = wsp<const unsigned char>(c, WS_Y2);
    bf16_t* H = wsp<bf16_t>(c, WS_H);
    int* cnt = wsp<int>(c, WS_CTL) + CW_CNT + l * 32 * 64;
    LAS float* Gt = (LAS float*)(c.lds + 65536); LAS float* SHt = Gt + NB * DM; LAS float* GFt = SHt + NB * DM;
    for (int i = c.tid; i < NB * DM; i += 512) { const int b_ = i / DM, k_ = i % DM;
        if (MODE == 3) { Gt[i] = inp(c, 32)[k_]; SHt[i] = 0.f; }
        else { const int nsel_ = (MODE == 2) ? 24 : 5, off_ = (MODE == 2) ? 3 : 0; Gt[i] = inp(c, nsel_)[l * DM + k_] * (1.f + modp(c, l, b_, off_ + 1)[k_]); SHt[i] = modp(c, l, b_, off_)[k_]; }
        if (MODE == 1 || MODE == 3) GFt[i] = modp(c, lm, b_, 5)[k_]; }
    __syncthreads();
    f32x4 rawf[8][2]; u32x4 rawh[8];
#define NP_LOAD(u_) do { const int rg_ = (u_) * 16 + row; _Pragma("unroll") for (int s = 0; s < 8; ++s) { const int k = 256 * wid + 32 * s + 8 * kq; \
        if (src_f32) { rawf[s][0] = *(const f32x4*)(inp(c, 0) + (size_t)rg_ * DM + k); rawf[s][1] = *(const f32x4*)(inp(c, 0) + (size_t)rg_ * DM + k + 4); } \
        else rawh[s] = *(const u32x4*)(xbuf + (size_t)rg_ * DM + k); } } while (0)
    if (c.vcu < NTOK / 16) NP_LOAD(c.vcu);
    int par = 0; bf16x8 wq[8][3]; int wq_b = -1;
#ifdef MK_DIAG_FIN
    const unsigned long long dfin_t0 = __builtin_amdgcn_s_memrealtime(); int dfin_k = 0; float dfin_scale = 1.f;
#endif
    for (int unit = c.vcu; unit < NTOK / 16; unit += c.G, par ^= 1) {
        LAS float* red = red0 + par * 8192;
#ifdef MK_DIAG_FIN
        if (MODE == 3) { if (dfin_k == 4) { const float us = (float)(__builtin_amdgcn_s_memrealtime() - dfin_t0) * 0.01f; dfin_scale = 1.f + 0.02f + 4e-5f * fminf(fmaxf(us - (float)MK_DIAG_FIN, 0.f), 400.f); } ++dfin_k; }
#endif
        const int rg = unit * 16 + row; const int b = rg >> 14;
        size_t pos0 = 0, pos1 = 0; float w0 = 0.f, w1 = 0.f;
        if (MODE == 1 || MODE == 3) { const i32x4 ri = RI[rg]; const f32x2 rw = RW[rg]; pos0 = (size_t)(ps[ri.x] + ri.z); pos1 = (size_t)(ps[ri.y] + ri.w); w0 = rw.x; w1 = rw.y; }
        f32x4 xv[8][2]; float ss = 0.f;
        f32x4 acc[3] = {{0.f, 0.f, 0.f, 0.f}, {0.f, 0.f, 0.f, 0.f}, {0.f, 0.f, 0.f, 0.f}};
        if (MODE == 2) { const int bu = unit >> 10;
            if (bu != wq_b) { wq_b = bu; const bf16_t* wf = wsp<const bf16_t>(c, WS_RWF) + (((size_t)(l * NB + bu) * 64 + 8 * wid) * 3) * 2 * 512 + lane * 8;
#pragma unroll
                for (int s = 0; s < 8; ++s)
#pragma unroll
                    for (int cb = 0; cb < 3; ++cb) wq[s][cb] = *(const bf16x8*)(wf + (s * 3 + cb) * 2 * 512); } }
#pragma unroll
        for (int s = 0; s < 8; ++s) { if (src_f32) { xv[s][0] = rawf[s][0]; xv[s][1] = rawf[s][1]; } else unpack8(rawh[s], xv[s][0], xv[s][1]); }
        if (unit + c.G < NTOK / 16) NP_LOAD(unit + c.G);
#pragma unroll
        for (int s = 0; s < 8; ++s) {
            const int k = 256 * wid + 32 * s + 8 * kq;
            f32x4 x0 = xv[s][0], x1 = xv[s][1];
            if (MODE == 1 || MODE == 3) {
                f32x4 a0, a1, b0, b1;
                { const u32x2 ya = *(const u32x2*)(Y2 + pos0 * DM + k), yb = *(const u32x2*)(Y2 + pos1 * DM + k);
                  const f32x2 t0 = __builtin_amdgcn_cvt_pk_f32_fp8((int)ya.x, false), t1 = __builtin_amdgcn_cvt_pk_f32_fp8((int)ya.x, true), t2 = __builtin_amdgcn_cvt_pk_f32_fp8((int)ya.y, false), t3 = __builtin_amdgcn_cvt_pk_f32_fp8((int)ya.y, true);
                  const f32x2 u0 = __builtin_amdgcn_cvt_pk_f32_fp8((int)yb.x, false), u1 = __builtin_amdgcn_cvt_pk_f32_fp8((int)yb.x, true), u2 = __builtin_amdgcn_cvt_pk_f32_fp8((int)yb.y, false), u3 = __builtin_amdgcn_cvt_pk_f32_fp8((int)yb.y, true);
                  a0 = (f32x4){t0.x, t0.y, t1.x, t1.y}; a1 = (f32x4){t2.x, t2.y, t3.x, t3.y}; b0 = (f32x4){u0.x, u0.y, u1.x, u1.y}; b1 = (f32x4){u2.x, u2.y, u3.x, u3.y}; }
                const f32x4 g0 = *(const LAS f32x4*)(GFt + b * DM + k), g1 = *(const LAS f32x4*)(GFt + b * DM + k + 4);
                x0 += g0 * (a0 * w0 + b0 * w1); x1 += g1 * (a1 * w0 + b1 * w1);
                if (MODE == 1) { const u32x4 xw = pack8f(x0, x1); *(u32x4*)(xbuf + (size_t)rg * DM + k) = xw; unpack8(xw, x0, x1); }
            }
            xv[s][0] = x0; xv[s][1] = x1;
            ss += (x0[0] * x0[0] + x0[1] * x0[1]) + (x0[2] * x0[2] + x0[3] * x0[3]) + (x1[0] * x1[0] + x1[1] * x1[1]) + (x1[2] * x1[2] + x1[3] * x1[3]);
            if (MODE == 2) {
                const u32x4 hi = pack8f(x0, x1); const bf16x8 xh = *(const bf16x8*)&hi;
#pragma unroll
                for (int cb = 0; cb < 3; ++cb) acc[cb] = __builtin_amdgcn_mfma_f32_16x16x32_bf16(wq[s][cb], xh, acc[cb], 0, 0, 0);
            }
        }
        ss += __shfl_xor(ss, 16); ss += __shfl_xor(ss, 32);
        if (kq == 0) red[(wid * 16 + row) * 52] = ss;
        if (MODE == 2) {
#pragma unroll
            for (int cb = 0; cb < 3; ++cb)
#pragma unroll
                for (int e = 0; e < 4; ++e) red[(wid * 16 + row) * 52 + 1 + 16 * cb + 4 * kq + e] = acc[cb][e];
        }
        __syncthreads();
        float tot = 0.f;
#pragma unroll
        for (int w8 = 0; w8 < 8; ++w8) tot += red[(w8 * 16 + row) * 52];
        const float rstd = rsqrtf(tot * (1.f / DM) + EPS);
        if (MODE == 2 && wid == 0 && lane < 16) {
            const float* rb = wsp<const float>(c, WS_RBIAS) + (l * NB + b) * 64;
            float gl[4];
#pragma unroll
            for (int j = 0; j < 4; ++j) { float d = 0.f;
#pragma unroll
                for (int w8 = 0; w8 < 8; ++w8) d += red[(w8 * 16 + row) * 52 + 1 + j];
                gl[j] = rstd * d + rb[j]; }
            int gt_ = 0; float gm = gl[0];
#pragma unroll
            for (int j = 1; j < 4; ++j) if (gl[j] > gm) { gm = gl[j]; gt_ = j; }
            float gs = 0.f;
#pragma unroll
            for (int j = 0; j < 4; ++j) gs += __expf(gl[j] - gm);
            const float gwt = 1.f / gs;
            float e0 = -3.0e38f, e1 = -3.0e38f; int i0 = 0, i1 = 0;
            for (int i = 0; i < 8; ++i) { float d = 0.f;
#pragma unroll
                for (int w8 = 0; w8 < 8; ++w8) d += red[(w8 * 16 + row) * 52 + 1 + 4 + 8 * gt_ + i];
                const float lg = rstd * d + rb[4 + 8 * gt_ + i];
                if (lg > e0) { e1 = e0; i1 = i0; e0 = lg; i0 = i; } else if (lg > e1) { e1 = lg; i1 = i; } }
            const float q1 = __expf(e1 - e0); const float p0 = 1.f / (1.f + q1), p1 = q1 * p0;
            const int ex0 = 8 * gt_ + i0, ex1 = 8 * gt_ + i1;
            const int s0 = atomicAdd(cnt + ex0 * 64, 1), s1 = atomicAdd(cnt + ex1 * 64, 1);
            int* toks = wsp<int>(c, WS_TOK); toks[(size_t)ex0 * NTOK + s0] = rg; toks[(size_t)ex1 * NTOK + s1] = rg;
            wsp<i32x4>(c, WS_RI)[(size_t)l * NTOK + rg] = (i32x4){ex0, ex1, s0, s1}; wsp<f32x2>(c, WS_RW)[(size_t)l * NTOK + rg] = (f32x2){gwt * p0, gwt * p1};
        }
        if (MODE == 3) {
#pragma unroll
            for (int s = 0; s < 8; ++s) { const int k = 256 * wid + 32 * s + 8 * kq; const f32x4 g0 = *(const LAS f32x4*)(Gt + k), g1 = *(const LAS f32x4*)(Gt + k + 4);
                #ifdef MK_DIAG_FIN
                const float osc_ = dfin_scale;
#else
                const float osc_ = c.oscale;
#endif
                *(f32x4*)(c.a.out + (size_t)rg * DM + k) = xv[s][0] * (rstd * osc_) * g0; *(f32x4*)(c.a.out + (size_t)rg * DM + k + 4) = xv[s][1] * (rstd * osc_) * g1; }
        } else {
#pragma unroll
            for (int s = 0; s < 8; ++s) { const int k = 256 * wid + 32 * s + 8 * kq;
                const f32x4 g0 = *(const LAS f32x4*)(Gt + b * DM + k), g1 = *(const LAS f32x4*)(Gt + b * DM + k + 4);
                const f32x4 h0 = xv[s][0] * rstd * g0 + *(const LAS f32x4*)(SHt + b * DM + k), h1 = xv[s][1] * rstd * g1 + *(const LAS f32x4*)(SHt + b * DM + k + 4);
                *(u32x4*)(H + (size_t)rg * DM + k) = pack8f(h0, h1); }
        }
    }
    __syncthreads();
#undef NP_LOAD
}

template <int MODE>
__device__ __forceinline__ void norm_rows(const Ctx& c, int l) {
    const LAS int* ps = (const LAS int*)(c.lds + LDS_PSTART);
    const int lane = c.lane;
    bf16_t* xbuf = wsp<bf16_t>(c, WS_XBUF);
    const bool src_f32 = (MODE == 0 && l == 0);
    const int lm = (MODE == 3) ? 1 : l - 1;
    const i32x4* RI = wsp<const i32x4>(c, WS_RI) + (size_t)(lm < 0 ? 0 : lm) * NTOK; const f32x2* RW = wsp<const f32x2>(c, WS_RW) + (size_t)(lm < 0 ? 0 : lm) * NTOK;
    const unsigned char* Y2 = wsp<const unsigned char>(c, WS_Y2);
    bf16_t* H = wsp<bf16_t>(c, WS_H);
    LAS float* Gt = (LAS float*)(c.lds + 65536); LAS float* SHt = Gt + NB * DM; LAS float* GFt = SHt + NB * DM;
    for (int i = c.tid; i < NB * DM; i += 512) { const int b_ = i / DM, k_ = i % DM;
        if (MODE == 3) { Gt[i] = inp(c, 32)[k_]; SHt[i] = 0.f; }
        else { Gt[i] = inp(c, 5)[l * DM + k_] * (1.f + modp(c, l, b_, 1)[k_]); SHt[i] = modp(c, l, b_, 0)[k_]; }
        if (MODE == 1 || MODE == 3) GFt[i] = modp(c, lm, b_, 5)[k_]; }
    __syncthreads();
    const int gw = c.vcu * 8 + c.wid, NGW = c.G * 8;
    for (int r0 = gw; r0 < NTOK; r0 += 2 * NGW) {
        f32x4 xv[2][4][2]; u32x4 rawh[2][4]; u32x2 ya[2][4], yb[2][4]; float w0[2], w1[2];
#pragma unroll
        for (int q = 0; q < 2; ++q) { const int rg = r0 + q * NGW; if (rg < NTOK) {
            if (MODE == 1 || MODE == 3) { const i32x4 ri = RI[rg]; const f32x2 rw = RW[rg]; const size_t pos0 = (size_t)(ps[ri.x] + ri.z), pos1 = (size_t)(ps[ri.y] + ri.w); w0[q] = rw.x; w1[q] = rw.y;
#pragma unroll
                for (int j = 0; j < 4; ++j) { ya[q][j] = *(const u32x2*)(Y2 + pos0 * DM + 512 * j + lane * 8); yb[q][j] = *(const u32x2*)(Y2 + pos1 * DM + 512 * j + lane * 8); } }
#pragma unroll
            for (int j = 0; j < 4; ++j) { const int k = 512 * j + lane * 8;
                if (src_f32) { xv[q][j][0] = *(const f32x4*)(inp(c, 0) + (size_t)rg * DM + k); xv[q][j][1] = *(const f32x4*)(inp(c, 0) + (size_t)rg * DM + k + 4); }
                else rawh[q][j] = *(const u32x4*)(xbuf + (size_t)rg * DM + k); } } }
#pragma unroll
        for (int q = 0; q < 2; ++q) { const int rg = r0 + q * NGW; if (rg < NTOK) { const int b = rg >> 14;
            float ss = 0.f;
#pragma unroll
            for (int j = 0; j < 4; ++j) { const int k = 512 * j + lane * 8;
                f32x4 x0, x1; if (src_f32) { x0 = xv[q][j][0]; x1 = xv[q][j][1]; } else unpack8(rawh[q][j], x0, x1);
                if (MODE == 1 || MODE == 3) {
                    const f32x2 t0 = __builtin_amdgcn_cvt_pk_f32_fp8((int)ya[q][j].x, false), t1 = __builtin_amdgcn_cvt_pk_f32_fp8((int)ya[q][j].x, true), t2 = __builtin_amdgcn_cvt_pk_f32_fp8((int)ya[q][j].y, false), t3 = __builtin_amdgcn_cvt_pk_f32_fp8((int)ya[q][j].y, true);
                    const f32x2 u0 = __builtin_amdgcn_cvt_pk_f32_fp8((int)yb[q][j].x, false), u1 = __builtin_amdgcn_cvt_pk_f32_fp8((int)yb[q][j].x, true), u2 = __builtin_amdgcn_cvt_pk_f32_fp8((int)yb[q][j].y, false), u3 = __builtin_amdgcn_cvt_pk_f32_fp8((int)yb[q][j].y, true);
                    const f32x4 a0 = {t0.x, t0.y, t1.x, t1.y}, a1 = {t2.x, t2.y, t3.x, t3.y}, b0 = {u0.x, u0.y, u1.x, u1.y}, b1 = {u2.x, u2.y, u3.x, u3.y};
                    const f32x4 g0 = *(const LAS f32x4*)(GFt + b * DM + k), g1 = *(const LAS f32x4*)(GFt + b * DM + k + 4);
                    x0 += g0 * (a0 * w0[q] + b0 * w1[q]); x1 += g1 * (a1 * w0[q] + b1 * w1[q]);
                    if (MODE == 1) { const u32x4 xw = pack8f(x0, x1); *(u32x4*)(xbuf + (size_t)rg * DM + k) = xw; unpack8(xw, x0, x1); }
                }
                xv[q][j][0] = x0; xv[q][j][1] = x1;
                ss += (x0[0] * x0[0] + x0[1] * x0[1]) + (x0[2] * x0[2] + x0[3] * x0[3]) + (x1[0] * x1[0] + x1[1] * x1[1]) + (x1[2] * x1[2] + x1[3] * x1[3]);
            }
            const float rstd = rsqrtf(wave_sum(ss) * (1.f / DM) + EPS);
#pragma unroll
            for (int j = 0; j < 4; ++j) { const int k = 512 * j + lane * 8;
                if (MODE == 3) { const f32x4 g0 = *(const LAS f32x4*)(Gt + k), g1 = *(const LAS f32x4*)(Gt + k + 4);
                    *(f32x4*)(c.a.out + (size_t)rg * DM + k) = xv[q][j][0] * (rstd * c.oscale) * g0; *(f32x4*)(c.a.out + (size_t)rg * DM + k + 4) = xv[q][j][1] * (rstd * c.oscale) * g1; }
                else { const f32x4 g0 = *(const LAS f32x4*)(Gt + b * DM + k), g1 = *(const LAS f32x4*)(Gt + b * DM + k + 4);
                    const f32x4 h0 = xv[q][j][0] * rstd * g0 + *(const LAS f32x4*)(SHt + b * DM + k), h1 = xv[q][j][1] * rstd * g1 + *(const LAS f32x4*)(SHt + b * DM + k + 4);
                    *(u32x4*)(H + (size_t)rg * DM + k) = pack8f(h0, h1); } }
        } }
    }
    __syncthreads();
}

__device__ __forceinline__ void carry_phase(const Ctx& c, int l) {
    LAS float* ex = (LAS float*)c.lds;
    const float* E = wsp<const float>(c, WS_EBUF); bf16_t* SP = wsp<bf16_t>(c, WS_SPREV);
    const int seg = c.tid >> 5, pp = c.tid & 31;
    for (int item = c.vcu; item < NB * SSM_G * 2; item += c.G) {
        const int b = item >> 6, g = (item >> 1) & 31, p = (item & 1) * 32 + pp;
        const f32x2 A = wsp<const f32x2>(c, WS_A64)[(l * 32 + g) * 64 + p];
        const int c0 = b * 256 + seg * 16;
        float er[16], ei[16];
#pragma unroll
        for (int j = 0; j < 16; ++j) { const float* e = E + ((size_t)(c0 + j) * SSM_G + g) * 128; er[j] = e[p]; ei[j] = e[64 + p]; }
        float sr = 0.f, si = 0.f;
#pragma unroll
        for (int j = 0; j < 16; ++j) { const float nr = A.x * sr - A.y * si + er[j], ni = A.x * si + A.y * sr + ei[j]; sr = nr; si = ni; er[j] = sr; ei[j] = si; }
        ex[(seg * 32 + pp) * 2] = sr; ex[(seg * 32 + pp) * 2 + 1] = si;
        float pr = A.x, pi_ = A.y;
#pragma unroll
        for (int q = 0; q < 4; ++q) { const float nr = pr * pr - pi_ * pi_, ni = 2.f * pr * pi_; pr = nr; pi_ = ni; }
        __syncthreads();
        float cr = 0.f, ci = 0.f;
        for (int s = 0; s < seg; ++s) { const float tr = ex[(s * 32 + pp) * 2], ti = ex[(s * 32 + pp) * 2 + 1]; const float nr = pr * cr - pi_ * ci + tr, ni = pr * ci + pi_ * cr + ti; cr = nr; ci = ni; }
        float qr = cr, qi = ci;
#pragma unroll
        for (int j = 0; j < 16; ++j) {
            const float vr = qr + (j ? er[j - 1] : 0.f), vi = qi + (j ? ei[j - 1] : 0.f);
            bf16_t* o = SP + ((size_t)(c0 + j) * SSM_G + g) * 256; o[p] = f2bf(vr); o[64 + p] = f2bf(vi);
            const float nr = A.x * qr - A.y * qi, ni = A.x * qi + A.y * qr; qr = nr; qi = ni;
        }
        __syncthreads();
    }
}

__device__ __forceinline__ void fin_phase(const Ctx& c) {
    const bf16_t* P = wsp<const bf16_t>(c, WS_P); const bf16_t* GL = wsp<const bf16_t>(c, WS_GL); const bf16_t* O = wsp<const bf16_t>(c, WS_O); bf16_t* Y = wsp<bf16_t>(c, WS_YCAT);
    const int gw = c.vcu * 8 + c.wid, NGW = c.G * 8, lane = c.lane;
    const int wsel = lane >> 4, win = 2 << wsel;
    for (int run = gw; run < NTOK / 16; run += NGW) {
        const int t0 = run * 16; const bool hist = (t0 & (SEQ - 1)) != 0;
        {
            u32x4 ring[31];
#pragma unroll
            for (int j = 0; j < 15; ++j) ring[j] = hist ? *(const u32x4*)(P + (size_t)(t0 - 15 + j) * 512 + lane * 8) : (u32x4){0u, 0u, 0u, 0u};
#pragma unroll
            for (int j = 0; j < 16; ++j) ring[15 + j] = *(const u32x4*)(P + (size_t)(t0 + j) * 512 + lane * 8);
            f32x4 r0 = {0.f, 0.f, 0.f, 0.f}, r1 = {0.f, 0.f, 0.f, 0.f};
#pragma unroll
            for (int j = 1; j < 16; ++j) { f32x4 a0, a1; unpack8(ring[15 - j], a0, a1); const float mk = (j < win) ? 1.f : 0.f; r0 += a0 * mk; r1 += a1 * mk; }
#pragma unroll
            for (int k = 0; k < 16; ++k) {
                f32x4 c0, c1; unpack8(ring[15 + k], c0, c1); r0 += c0; r1 += c1;
                const int cn = hist ? win : ((k + 1 < win) ? k + 1 : win); const float ic = 1.f / (float)cn;
                const f32x4 y0 = r0 * ic - c0, y1 = r1 * ic - c1;
                const float ss = (y0[0] * y0[0] + y0[1] * y0[1]) + (y0[2] * y0[2] + y0[3] * y0[3]) + (y1[0] * y1[0] + y1[1] * y1[1]) + (y1[2] * y1[2] + y1[3] * y1[3]);
                const float rs = rsqrtf(wave_sum(ss) * (1.f / 512.f) + EPS);
                *(u32x4*)(Y + (size_t)(t0 + k) * DM + lane * 8) = pack8f(y0 * rs, y1 * rs);
                const u32x4 od = wsel == 0 ? ring[14 + k] : wsel == 1 ? ring[12 + k] : wsel == 2 ? ring[8 + k] : ring[k];
                f32x4 o0, o1; unpack8(od, o0, o1); r0 -= o0; r1 -= o1;
            }
        }
        {
            u32x4 g[16];
#pragma unroll
            for (int k = 0; k < 16; ++k) g[k] = *(const u32x4*)(GL + (size_t)(t0 + k) * 512 + lane * 8);
#pragma unroll
            for (int k = 0; k < 16; ++k) { f32x4 y0, y1; unpack8(g[k], y0, y1);
                const float ss = (y0[0] * y0[0] + y0[1] * y0[1]) + (y0[2] * y0[2] + y0[3] * y0[3]) + (y1[0] * y1[0] + y1[1] * y1[1]) + (y1[2] * y1[2] + y1[3] * y1[3]);
                const float rs = rsqrtf(wave_sum(ss) * (1.f / 512.f) + EPS);
                *(u32x4*)(Y + (size_t)(t0 + k) * DM + 512 + lane * 8) = pack8f(y0 * rs, y1 * rs); }
        }
#pragma unroll
        for (int hb = 0; hb < 2; ++hb) {
            u32x4 oa[8], ob[8];
#pragma unroll
            for (int k = 0; k < 8; ++k) { oa[k] = *(const u32x4*)(O + (size_t)(t0 + hb * 8 + k) * 1024 + lane * 16); ob[k] = *(const u32x4*)(O + (size_t)(t0 + hb * 8 + k) * 1024 + lane * 16 + 8); }
#pragma unroll
            for (int k = 0; k < 8; ++k) { f32x4 y0, y1, z0, z1; unpack8(oa[k], y0, y1); unpack8(ob[k], z0, z1);
                const float ss = (y0[0] * y0[0] + y0[1] * y0[1]) + (y0[2] * y0[2] + y0[3] * y0[3]) + (y1[0] * y1[0] + y1[1] * y1[1]) + (y1[2] * y1[2] + y1[3] * y1[3])
                               + (z0[0] * z0[0] + z0[1] * z0[1]) + (z0[2] * z0[2] + z0[3] * z0[3]) + (z1[0] * z1[0] + z1[1] * z1[1]) + (z1[2] * z1[2] + z1[3] * z1[3]);
                const float rs = rsqrtf(wave_sum(ss) * (1.f / 1024.f) + EPS); const size_t yo = (size_t)(t0 + hb * 8 + k) * DM + 1024 + lane * 16;
                *(u32x4*)(Y + yo) = pack8f(y0 * rs, y1 * rs); *(u32x4*)(Y + yo + 8) = pack8f(z0 * rs, z1 * rs); }
        }
    }
}
__device__ __forceinline__ void kpe_rope(const Ctx& c) {
    const bf16_t* Z = wsp<const bf16_t>(c, WS_Z); bf16_t* K = wsp<bf16_t>(c, WS_K); const f32x2* CS = wsp<const f32x2>(c, WS_CS);
    const int gt = c.vcu * 512 + c.tid, NGT = c.G * 512;
    for (int i = gt; i < NTOK * 8; i += NGT) {
        const int tok = i >> 3, q = i & 7; const int b = tok >> 14, t = tok & (SEQ - 1);
        f32x4 v0, v1; unpack8(*(const u32x4*)(Z + (size_t)tok * ZLD + Z_KPE + q * 8), v0, v1);
        const f32x2* cs = CS + (size_t)tok * 32 + q * 4; const f32x4 c01 = *(const f32x4*)cs, c23 = *(const f32x4*)(cs + 2);
        f32x4 o0, o1;
        o0[0] = v0[0] * c01[0] - v0[1] * c01[1]; o0[1] = v0[1] * c01[0] + v0[0] * c01[1]; o0[2] = v0[2] * c01[2] - v0[3] * c01[3]; o0[3] = v0[3] * c01[2] + v0[2] * c01[3];
        o1[0] = v1[0] * c23[0] - v1[1] * c23[1]; o1[1] = v1[1] * c23[0] + v1[0] * c23[1]; o1[2] = v1[2] * c23[2] - v1[3] * c23[3]; o1[3] = v1[3] * c23[2] + v1[2] * c23[3];
        const u32x4 w = pack8f(o0, o1);
#pragma unroll
        for (int h = 0; h < NHEAD; ++h) *(u32x4*)(K + ((size_t)(b * NHEAD + h) * SEQ + t) * QKD + 128 + q * 8) = w;
    }
}
namespace att {
constexpr int KN_BYTES = 16384, KR_BYTES = 8192, V_BYTES = 16384, ST_BYTES = KN_BYTES + KR_BYTES + V_BYTES, NST = 3;
constexpr int XCH_OFF = NST * ST_BYTES;
constexpr float THR2 = 11.5f;
#define AT_KSWZ(row, colB) ((row) * 256 + ((colB) ^ (((row) & 15) << 4)))
#define AT_SBAR() __builtin_amdgcn_sched_barrier(0)
__device__ __forceinline__ int v_rd_base(int lane) { return ((lane & 3) << 3) | (((lane >> 2) & 3) << 6) | (((lane >> 4) & 1) << 5) | (((lane >> 5) & 1) << 8); }
__device__ __forceinline__ int crow(int r, int hi) { return (r & 3) + 8 * (r >> 2) + 4 * hi; }
__device__ __forceinline__ void mask_tile(f32x16& p0, f32x16& p1, int dq) {
    const float NEG = -__builtin_inff();
#pragma unroll
    for (int r = 0; r < 16; ++r) { const int cc = (r & 3) + 8 * (r >> 2); if (dq - cc < 0) p0[r] = NEG; if (dq - cc - 32 < 0) p1[r] = NEG; }
}
__device__ __forceinline__ void partialSM(f32x16& p0, f32x16& p1, float& m_reg, float sh, float& delta, float& alpha, bool& nosub, bool first) {
    float pmax = p0[0];
#pragma unroll
    for (int r = 1; r < 16; ++r) pmax = fmaxf(pmax, p0[r]);
#pragma unroll
    for (int r = 0; r < 16; ++r) pmax = fmaxf(pmax, p1[r]);
    { auto rr = __builtin_amdgcn_permlane32_swap(__float_as_uint(pmax), __float_as_uint(pmax), false, false); pmax = fmaxf(__uint_as_float(rr[0]), __uint_as_float(rr[1])); }
    pmax += sh;
    float mn;
    if (__builtin_expect(__all((pmax - m_reg) <= THR2), 1)) { mn = m_reg; alpha = 1.f; nosub = !first; }
    else { mn = fmaxf(m_reg, pmax); alpha = fast_exp2(m_reg - mn); m_reg = mn; nosub = false; }
    delta = mn - sh;
    if (nosub) {
#pragma unroll
        for (int r = 0; r < 16; ++r) p0[r] = fast_exp2(p0[r]);
    } else {
#pragma unroll
        for (int r = 0; r < 16; ++r) p0[r] = fast_exp2(p0[r] - delta);
    }
}
__device__ __forceinline__ void finishSM(f32x16& p0, f32x16& p1, float delta, bool nosub, float alpha, float& l_reg, bf16x8& pa0, bf16x8& pa1, bf16x8& pa2, bf16x8& pa3) {
    if (nosub) {
#pragma unroll
        for (int r = 0; r < 16; ++r) p1[r] = fast_exp2(p1[r]);
    } else {
#pragma unroll
        for (int r = 0; r < 16; ++r) p1[r] = fast_exp2(p1[r] - delta);
    }
    float ps = 0.f;
#pragma unroll
    for (int r = 0; r < 16; ++r) ps += p0[r];
#pragma unroll
    for (int r = 0; r < 16; ++r) ps += p1[r];
    { auto rr = __builtin_amdgcn_permlane32_swap(__float_as_uint(ps), __float_as_uint(ps), false, false); ps = __uint_as_float(rr[0]) + __uint_as_float(rr[1]); }
    l_reg = l_reg * alpha + ps;
#define AT_PK4(P, B_, OUT) do { unsigned a0 = cvtpk(P[B_ + 0], P[B_ + 1]), a1 = cvtpk(P[B_ + 2], P[B_ + 3]); unsigned b0 = cvtpk(P[B_ + 4], P[B_ + 5]), b1 = cvtpk(P[B_ + 6], P[B_ + 7]); \
        auto r0 = __builtin_amdgcn_permlane32_swap(a0, b0, false, false); auto r1 = __builtin_amdgcn_permlane32_swap(a1, b1, false, false); \
        u32x4 w = {r0[0], r1[0], r0[1], r1[1]}; OUT = *reinterpret_cast<bf16x8*>(&w); } while (0)
    AT_PK4(p0, 0, pa0); AT_PK4(p0, 8, pa1); AT_PK4(p1, 0, pa2); AT_PK4(p1, 8, pa3);
#undef AT_PK4
}
#define AT_KRD(dst, addr, off) asm volatile("ds_read_b128 %0, %1 offset:%2" : "=&v"(dst) : "v"(addr), "i"(off) : "memory")
#define AT_KWAIT(n, a, b) asm volatile("s_waitcnt lgkmcnt(%2)" : "+v"(a), "+v"(b) : "i"(n) : "memory")
struct KAddr { unsigned xo[8]; };
__device__ __forceinline__ void kaddr_init(KAddr& ka, int r32, int hi) {
    const int rb = r32 * 256, key = (r32 & 15) << 4;
#pragma unroll
    for (int d0 = 0; d0 < 8; ++d0) ka.xo[d0] = (unsigned)(rb + (((d0 * 16 + hi * 8) * 2) ^ key));
}
__device__ __forceinline__ void qkt(f32x16& p0, f32x16& p1, unsigned stb  , const KAddr& ka, const bf16x8* qr, float init) {
#pragma unroll
    for (int r = 0; r < 16; ++r) { p0[r] = init; p1[r] = init; }
    u32x4 f[4][2];
#define AT_KSTEP_RD(s) do { if ((s) < 8) { const unsigned a_ = stb + ka.xo[(s) & 7]; AT_KRD(f[(s) & 3][0], a_, 0); AT_KRD(f[(s) & 3][1], a_, 8192); } \
        else { const unsigned a0_ = stb + ka.xo[((s) - 8) & 7], a1_ = stb + ka.xo[((s) - 4) & 7]; AT_KRD(f[(s) & 3][0], a0_, KN_BYTES); AT_KRD(f[(s) & 3][1], a1_, KN_BYTES); } } while (0)
    AT_KSTEP_RD(0); AT_KSTEP_RD(1); AT_KSTEP_RD(2);
#pragma unroll
    for (int s = 0; s < 12; ++s) {
        if (s + 3 < 12) AT_KSTEP_RD(s + 3);
        if (s <= 8) AT_KWAIT(6, f[s & 3][0], f[s & 3][1]); else if (s == 9) AT_KWAIT(4, f[s & 3][0], f[s & 3][1]); else if (s == 10) AT_KWAIT(2, f[s & 3][0], f[s & 3][1]); else AT_KWAIT(0, f[s & 3][0], f[s & 3][1]);
        p0 = __builtin_amdgcn_mfma_f32_32x32x16_bf16(*(const bf16x8*)&f[s & 3][0], qr[s], p0, 0, 0, 0); p1 = __builtin_amdgcn_mfma_f32_32x32x16_bf16(*(const bf16x8*)&f[s & 3][1], qr[s], p1, 0, 0, 0);
    }
#undef AT_KSTEP_RD
}
struct VFrag { s16x4 l0, l1, l2, l3, h0, h1, h2, h3; };
#define AT_TRRD(dst, vb, off) asm volatile("ds_read_b64_tr_b16 %0, %1 offset:%2" : "=&v"(dst) : "v"(vb), "i"(off) : "memory")
#define AT_VISSUE(F, vb, d0) do { constexpr int b_ = (d0) * 512; AT_TRRD(F.l0, vb, b_); AT_TRRD(F.h0, vb, b_ + 2048); AT_TRRD(F.l1, vb, b_ + 4096); AT_TRRD(F.h1, vb, b_ + 6144); \
        AT_TRRD(F.l2, vb, b_ + 8192); AT_TRRD(F.h2, vb, b_ + 10240); AT_TRRD(F.l3, vb, b_ + 12288); AT_TRRD(F.h3, vb, b_ + 14336); } while (0)
#define AT_VWAIT(n, F) asm volatile("s_waitcnt lgkmcnt(%8)" : "+v"(F.l0), "+v"(F.l1), "+v"(F.l2), "+v"(F.l3), "+v"(F.h0), "+v"(F.h1), "+v"(F.h2), "+v"(F.h3) : "i"(n) : "memory")
#define AT_VMMA(F, d0) do { \
        o[d0] = __builtin_amdgcn_mfma_f32_32x32x16_bf16(pa0, (bf16x8){F.l0[0], F.l0[1], F.l0[2], F.l0[3], F.h0[0], F.h0[1], F.h0[2], F.h0[3]}, o[d0], 0, 0, 0); \
        o[d0] = __builtin_amdgcn_mfma_f32_32x32x16_bf16(pa1, (bf16x8){F.l1[0], F.l1[1], F.l1[2], F.l1[3], F.h1[0], F.h1[1], F.h1[2], F.h1[3]}, o[d0], 0, 0, 0); \
        o[d0] = __builtin_amdgcn_mfma_f32_32x32x16_bf16(pa2, (bf16x8){F.l2[0], F.l2[1], F.l2[2], F.l2[3], F.h2[0], F.h2[1], F.h2[2], F.h2[3]}, o[d0], 0, 0, 0); \
        o[d0] = __builtin_amdgcn_mfma_f32_32x32x16_bf16(pa3, (bf16x8){F.l3[0], F.l3[1], F.l3[2], F.l3[3], F.h3[0], F.h3[1], F.h3[2], F.h3[3]}, o[d0], 0, 0, 0); } while (0)
__device__ __forceinline__ void pv_tile(f32x16* o, unsigned vb, VFrag& A, bf16x8 pa0, bf16x8 pa1, bf16x8 pa2, bf16x8 pa3) {
    VFrag B;
    AT_VISSUE(B, vb, 1); AT_VWAIT(8, A); AT_VMMA(A, 0);
    AT_VISSUE(A, vb, 2); AT_VWAIT(8, B); AT_VMMA(B, 1);
    AT_VISSUE(B, vb, 3); AT_VWAIT(8, A); AT_VMMA(A, 2);
    AT_VWAIT(0, B); AT_VMMA(B, 3);
}
struct DmaOff { unsigned kn0, kn1, kr, v0, v1; };
__device__ __forceinline__ void dma_offsets(int tid, DmaOff& d) {
    { const int p = tid, row = p >> 4, ch = (p & 15) ^ (row & 15); d.kn0 = (unsigned)(row * QKD + ch * 8) * 2u; }
    { const int p = tid + 512, row = p >> 4, ch = (p & 15) ^ (row & 15); d.kn1 = (unsigned)(row * QKD + ch * 8) * 2u; }
    { const int p = tid, row = p >> 4, ch = (p & 15) ^ (row & 15); const int key = row + ((ch & 8) ? 32 : 0); d.kr = (unsigned)(key * QKD + 128 + (ch & 7) * 8) * 2u; }
    { const int p = tid, sub = p >> 5, kk = (sub >> 2) * 8 + ((p & 31) >> 2), key = (kk & ~0xC) | ((kk & 4) << 1) | ((kk & 8) >> 1), col = (sub & 3) * 32 + (p & 3) * 8; d.v0 = (unsigned)(key * VD + col) * 2u; }
    { const int p = tid + 512, sub = p >> 5, kk = (sub >> 2) * 8 + ((p & 31) >> 2), key = (kk & ~0xC) | ((kk & 4) << 1) | ((kk & 8) >> 1), col = (sub & 3) * 32 + (p & 3) * 8; d.v1 = (unsigned)(key * VD + col) * 2u; }
}
__device__ __forceinline__ void glds16(const void* g, unsigned lds_dst) {
    unsigned keep; asm volatile("s_mov_b32 %0, m0\n\ts_mov_b32 m0, %2\n\ts_nop 0\n\tglobal_load_lds_dwordx4 %1, off\n\ts_mov_b32 m0, %0" : "=&s"(keep) : "v"(g), "s"(lds_dst) : "memory");
}
#define AT_GLDS(g, l) glds16((const void*)(g), (unsigned)(uintptr_t)(l))
__device__ __forceinline__ void issue_tile(LAS char* lds, int stage, const char* Kt, const char* Vt, const DmaOff& d, int wid) {
    LAS char* st = lds + stage * ST_BYTES + wid * 1024;
    unsigned o0 = d.kn0, o1 = d.kn1, o2 = d.kr, o3 = d.v0, o4 = d.v1; asm volatile("" : "+v"(o0), "+v"(o1), "+v"(o2), "+v"(o3), "+v"(o4));
    AT_GLDS(Kt + o0, st); AT_GLDS(Kt + o1, st + 8192); AT_GLDS(Kt + o2, st + KN_BYTES); AT_GLDS(Vt + o3, st + KN_BYTES + KR_BYTES); AT_GLDS(Vt + o4, st + KN_BYTES + KR_BYTES + 8192);
}
__device__ __forceinline__ void block(LAS char* lds, const bf16_t* Qbh, const char* Kbh, const char* Vbh, bf16_t* Obase  , int qb, const DmaOff& d, const int tid, const bool rev  ) {
    const int wid = __builtin_amdgcn_readfirstlane(tid >> 6), lane = tid & 63, r32 = lane & 31, hi = lane >> 5;
    const int NT = 4 * (qb + 1);
    const int qlo = qb * 256 + wid * 32;
    const int nact = (qlo + 31) / 64 + 1;
    LAS float* xw = (LAS float*)(lds + XCH_OFF) + wid * 64;
    asm volatile("" ::: "memory"); __builtin_amdgcn_s_barrier(); asm volatile("" ::: "memory");
    bf16x8 qr[12];
#pragma unroll
    for (int d0 = 0; d0 < 12; ++d0) qr[d0] = *(const bf16x8*)(Qbh + (size_t)(qlo + r32) * QKD + d0 * 16 + hi * 8);
    const long ksK = rev ? -(long)(64 * QKD * 2) : (long)(64 * QKD * 2), ksV = rev ? -(long)(64 * VD * 2) : (long)(64 * VD * 2);
    const char* K0 = Kbh + (rev ? (size_t)(NT - 1) * 64 * QKD * 2 : (size_t)0); const char* V0 = Vbh + (rev ? (size_t)(NT - 1) * 64 * VD * 2 : (size_t)0);
    issue_tile(lds, 0, K0, V0, d, wid);
    issue_tile(lds, 1, K0 + ksK, V0 + ksV, d, wid);
#pragma unroll
    for (int d0 = 0; d0 < 12; ++d0) asm volatile("" : "+v"(qr[d0]));
    float m_reg = -1e30f, l_reg = 0.f; f32x16 o[4] = {};
    const unsigned vbase = (unsigned)(uintptr_t)(lds + KN_BYTES + KR_BYTES) + (unsigned)v_rd_base(lane);
    const unsigned lds0 = (unsigned)(uintptr_t)lds; KAddr ka; kaddr_init(ka, r32, hi);
    int stage = 0;
    for (int t = 0; t < NT; ++t) {
        if (t + 1 < NT) asm volatile("s_waitcnt vmcnt(5)" ::: "memory"); else asm volatile("s_waitcnt vmcnt(0)" ::: "memory");
        __builtin_amdgcn_s_barrier(); asm volatile("" ::: "memory");
        if (t + 2 < NT) { int s2 = stage + 2; if (s2 >= NST) s2 -= NST; issue_tile(lds, s2, K0 + (long)(t + 2) * ksK, V0 + (long)(t + 2) * ksV, d, wid); }
        const int tt = rev ? NT - 1 - t : t;
        if (tt < nact) {
            f32x16 p0, p1; float delta, alpha; bool nosub; bf16x8 pa0, pa1, pa2, pa3; VFrag vf;
            const bool first = rev ? (tt == nact - 1) : (tt == 0); const float sh = first ? 0.f : m_reg;
            qkt(p0, p1, lds0 + (unsigned)(stage * ST_BYTES), ka, qr, -sh);
            const unsigned vb = vbase + (unsigned)(stage * ST_BYTES);
            AT_VISSUE(vf, vb, 0);
            if (tt * 64 + 63 > qlo) mask_tile(p0, p1, qlo + r32 - tt * 64 - 4 * hi);
            partialSM(p0, p1, m_reg, sh, delta, alpha, nosub, first);
            finishSM(p0, p1, delta, nosub, alpha, l_reg, pa0, pa1, pa2, pa3);
            if (__any(alpha < 1.f)) { if (hi == 0) xw[r32] = alpha; asm volatile("s_waitcnt lgkmcnt(0)" ::: "memory");
#pragma unroll
                for (int d_ = 0; d_ < 4; ++d_)
#pragma unroll
                    for (int r = 0; r < 16; ++r) o[d_][r] *= xw[crow(r, hi)]; }
            pv_tile(o, vb, vf, pa0, pa1, pa2, pa3);
        }
        ++stage; if (stage >= NST) stage = 0;
    }
    if (hi == 0) xw[32 + r32] = l_reg; asm volatile("s_waitcnt lgkmcnt(0)" ::: "memory");
    bf16_t* Ow = Obase + (size_t)qlo * 1024;
#pragma unroll
    for (int r = 0; r < 16; ++r) { const int orow = crow(r, hi); const float rl = fast_rcp(xw[32 + orow]);
#pragma unroll
        for (int d0 = 0; d0 < 4; ++d0) { const float v = o[d0][r] * rl; const float vn = __shfl_xor(v, 1);
            if ((r32 & 1) == 0) *(unsigned*)(Ow + (size_t)orow * 1024 + d0 * 32 + r32) = cvtpk(v, vn); } }
}
__device__ __forceinline__ void phase(const Ctx& c) {
    LAS char* lds = (LAS char*)c.lds;
    const bf16_t* Q = wsp<const bf16_t>(c, WS_Q); const char* K = (const char*)(c.ws + WS_K); const char* V = (const char*)(c.ws + WS_V); bf16_t* O = wsp<bf16_t>(c, WS_O);
    DmaOff d; dma_offsets(c.tid, d);
    if (c.wid >= 4) __builtin_amdgcn_s_setprio(1);
    for (int it = c.vcu; it < 16 * 32; it += c.G) {
        const int bh = it >> 5, x = it & 31; const int b = bh >> 3, h = bh & 7;
        const bf16_t* Qbh = Q + (size_t)bh * SEQ * QKD; const char* Kbh = K + (size_t)bh * SEQ * QKD * 2; const char* Vbh = V + (size_t)bh * SEQ * VD * 2;
        bf16_t* Ob = O + (size_t)b * SEQ * 1024 + h * 128;
        block(lds, Qbh, Kbh, Vbh, Ob, 63 - x, d, c.tid, false);
        block(lds, Qbh, Kbh, Vbh, Ob, x, d, c.tid, true);
    }
    asm volatile("s_waitcnt vmcnt(0)" ::: "memory"); __builtin_amdgcn_s_barrier(); asm volatile("" ::: "memory");
    __builtin_amdgcn_s_setprio(0);
}
}
constexpr int N_PHASES = 26;
#if MK_ONE_LAUNCH
#define SEAM(k) do { if (lo <= (k) && (k) + 1 < hi) { unsigned z_ = 0u; asm volatile("" : "+v"(z_)); xcd_barrier(bar, wid_s == 0 && __builtin_amdgcn_mbcnt_hi(~0u, __builtin_amdgcn_mbcnt_lo(~0u, z_)) == 0u); }; } while (0)
#else
#define SEAM(k) do { } while (0)
#endif
#ifdef MK_DIAG_A
#ifndef MK_DIAG_SENS
#define MK_DIAG_SENS 4e-5f
#endif
#ifndef MK_DIAG_OFF
#define MK_DIAG_OFF 0
#endif
#define DTS ((unsigned long long*)(args.ws + WS_CTL) + 6144)
#define STAMP(k) do { if (blockIdx.x == 0 && wid_s == 0) { unsigned z_ = 0u; asm volatile("" : "+v"(z_)); if (__builtin_amdgcn_mbcnt_hi(~0u, __builtin_amdgcn_mbcnt_lo(~0u, z_)) == 0u) DTS[(k)] = __builtin_amdgcn_s_memrealtime(); } } while (0)
#else
#define STAMP(k) do { } while (0)
#endif
#ifdef MK_PROBE
#define REP(k) for (int rp_ = 0; rp_ < ((k) == MK_PROBE ? 2 : 1); ++rp_)
#else
#define REP(k)
#endif
#ifdef TEST_PH
#define IN(k) (((k) == 0 ? 0 : ((k) == 25 ? 25 : 1 + ((k) - 1) % 12)) == TEST_PH && lo <= (k) && (k) < hi)
#else
#define IN(k) (lo <= (k) && (k) < hi)
#endif
#define PCTX Ctx c{c0.lds, 0, 0, 0, c0.G, c0.vcu, args, nullptr, 1.f}; { unsigned z_ = 0u; asm volatile("" : "+v"(z_)); int t_ = wid_s * 64 + (int)__builtin_amdgcn_mbcnt_hi(~0u, __builtin_amdgcn_mbcnt_lo(~0u, z_)); asm volatile("" : "+v"(t_)); c.tid = t_; c.lane = t_ & 63; c.wid = __builtin_amdgcn_readfirstlane(t_ >> 6); unsigned char* w_ = args.ws; asm volatile("" : "+s"(w_)); c.ws = w_; }
#define LAYERP float* ssq_q = (float*)(c.ws + WS_CTL + CTL_SSQ) + (size_t)(l * 2) * NTOK; float* ssq_kv = ssq_q + NTOK; int* cnt = wsp<int>(c, WS_CTL) + CW_CNT + l * 32 * 64; const char* ssmtab = (const char*)(c.ws + WS_SSMTAB) + (size_t)l * 32 * SSMTAB_STRIDE; (void)ssq_q; (void)ssq_kv; (void)cnt; (void)ssmtab;
struct KState { int lo, hi, wid_s; };
template <int l>
__device__ __forceinline__ void layer_phases(const Args& args, const Ctx& c0, const XcdBarrier& bar, const int lo, const int hi, const int wid_s) {
        const int pb = 1 + 12 * l;
        if (IN(pb + 0)) { STAMP(pb + 0); PCTX
            if (l == 0) { norm_rows<0>(c, l); gen_ssm_tables(c); }
            else { (void)build_tile_table(c, wsp<int>(c, WS_CTL) + CW_CNT + (l - 1) * 32 * 64); norm_rows<1>(c, l); __syncthreads(); convert_experts(c, l); }
            router_prep(c, l);
            SEAM(pb + 0);
        }
        if (IN(pb + 1)) { STAMP(pb + 1); PCTX LAYERP
            ProgG1 p; p.so.init(NTOK, DM, c.G, (int)blockIdx.x); p.A = (const char*)(c.ws + WS_H); p.B = (const char*)(c.ws + WS_WIN) + (size_t)l * DM * DM * 2;
            p.Z = wsp<bf16_t>(c, WS_Z); p.U = wsp<bf16_t>(c, WS_U); p.ssqp = wsp<float>(c, WS_SSQP);
            REP(pb + 1) { ge::run(c.lds, p, c.tid); }
#ifdef MK_DUMMY_G1
            if (l == 0) { __syncthreads(); STAMP(30); ProgG1 q = p; q.Z = wsp<bf16_t>(c, WS_YCAT); q.U = wsp<bf16_t>(c, WS_YCAT + 96 * MiB); q.ssqp = wsp<float>(c, WS_YI); q.nt_ov = MK_DUMMY_G1; ge::run(c.lds, q, c.tid); STAMP(31); }
#endif
            SEAM(pb + 1);
        }
        if (IN(pb + 2)) { STAMP(pb + 2); PCTX LAYERP
            ProgG2 p; p.G = c.G; p.c = (int)blockIdx.x; p.Z = (const char*)(c.ws + WS_Z); p.U = (const char*)(c.ws + WS_U);
            p.WUQ = (const char*)(c.ws + WS_WUQ) + (size_t)l * 1536 * 512 * 2; p.WUKV = (const char*)(c.ws + WS_WUKV) + (size_t)l * 2048 * 256 * 2; p.WPOOL = (const char*)(c.ws + WS_WPOOL) + (size_t)l * 2 * 256 * 256 * 2;
            p.SSMTAB = ssmtab; p.ssqp = wsp<const float>(c, WS_SSQP); p.CS = wsp<const f32x2>(c, WS_CS);
            p.Q = wsp<bf16_t>(c, WS_Q); p.K = wsp<bf16_t>(c, WS_K); p.V = wsp<bf16_t>(c, WS_V); p.P = wsp<bf16_t>(c, WS_P); p.YI = wsp<bf16_t>(c, WS_YI); p.EBUF = wsp<float>(c, WS_EBUF);
#ifdef MK_G2_SPLIT
            if (l == 0) { STAMP(30); p.tmask = 1; ge::run(c.lds, p, c.tid); STAMP(31); p.tmask = 2; ge::run(c.lds, p, c.tid); STAMP(32); p.tmask = 4; ge::run(c.lds, p, c.tid); STAMP(33); p.tmask = 8; ge::run(c.lds, p, c.tid); STAMP(34); kpe_rope(c); STAMP(35); }
            else { ge::run(c.lds, p, c.tid); kpe_rope(c); }
            SEAM(pb + 2);
#else
            REP(pb + 2) { ge::run(c.lds, p, c.tid); kpe_rope(c); } SEAM(pb + 2);
#endif
        }
        if (IN(pb + 4)) { STAMP(pb + 4); PCTX REP(pb + 4) { carry_phase(c, l); att::phase(c); } SEAM(pb + 4); }
        if (IN(pb + 5)) { STAMP(pb + 5); PCTX LAYERP
            ProgS1 p; p.G = c.G; p.c = (int)blockIdx.x; p.SPREV = (const char*)(c.ws + WS_SPREV); p.SSMTAB = ssmtab; p.YI = wsp<const bf16_t>(c, WS_YI); p.U = wsp<const bf16_t>(c, WS_U);
            p.Dskip = inp(c, 16) + l * 512; p.YG = wsp<bf16_t>(c, WS_YG);
            REP(pb + 5) { ge::run(c.lds, p, c.tid); } SEAM(pb + 5);
        }
        if (IN(pb + 6)) { STAMP(pb + 6); PCTX
            ProgS2 p; p.G = c.G; p.c = (int)blockIdx.x; p.YGc = (const char*)(c.ws + WS_YG); p.W = (const char*)(c.ws + WS_WGLU) + (size_t)l * 512 * 512 * 2; p.YG = wsp<const bf16_t>(c, WS_YG); p.GL = wsp<bf16_t>(c, WS_GL);
            REP(pb + 6) { ge::run(c.lds, p, c.tid); } SEAM(pb + 6);
        }
        if (IN(pb + 7)) { STAMP(pb + 7); PCTX REP(pb + 7) { fin_phase(c); } SEAM(pb + 7); }
        if (IN(pb + 8)) { STAMP(pb + 8); PCTX
            ProgG3 p; p.so.init(NTOK, DM, c.G, (int)blockIdx.x); p.A = (const char*)(c.ws + WS_YCAT); p.B = (const char*)(c.ws + WS_WOUT) + (size_t)l * DM * DM * 2;
            p.xin = (l == 0) ? inp(c, 0) : nullptr; p.xin16 = wsp<const bf16_t>(c, WS_XBUF); p.xout = wsp<bf16_t>(c, WS_XBUF); p.ga = modp(c, l, 0, 2);
            REP(pb + 8) { ge::run(c.lds, p, c.tid); } SEAM(pb + 8);
        }
        if (IN(pb + 9)) { STAMP(pb + 9); PCTX norm_phase<2>(c, l); SEAM(pb + 9); }
        if (IN(pb + 10)) { STAMP(pb + 10); PCTX LAYERP
            const int ntiles = __builtin_amdgcn_readfirstlane(build_tile_table(c, cnt));
            ProgM1 p; p.G = c.G; p.c = (int)blockIdx.x; p.tab = (const LAS int*)(c.lds + LDS_TILETAB); p.ntiles = ntiles; p.cnt = cnt; p.toks = wsp<const int>(c, WS_TOK);
            p.H = (const char*)(c.ws + WS_H); p.W13 = (const char*)(c.ws + WS_W13); p.ACT = wsp<bf16_t>(c, WS_ACT);
            REP(pb + 10) { ge::run(c.lds, p, c.tid); } SEAM(pb + 10);
        }
        if (IN(pb + 11)) { STAMP(pb + 11); PCTX LAYERP
            const int ntiles = __builtin_amdgcn_readfirstlane(build_tile_table(c, cnt));
            ProgM2 p; p.G = c.G; p.c = (int)blockIdx.x; p.tab = (const LAS int*)(c.lds + LDS_TILETAB); p.ntiles = ntiles; p.ACT = (const char*)(c.ws + WS_ACT); p.W2 = (const char*)(c.ws + WS_W2); p.Y2 = wsp<unsigned char>(c, WS_Y2);
            REP(pb + 11) { ge::run(c.lds, p, c.tid); } STAMP(pb + 12); SEAM(pb + 11);
        }
}
__global__ void __launch_bounds__(512, 2) mk_fwd(Args args) {
    extern __shared__ __attribute__((aligned(16))) unsigned char lds_[];
    Ctx c0{(LAS unsigned char*)lds_, (int)threadIdx.x, (int)(threadIdx.x & 63), __builtin_amdgcn_readfirstlane((int)(threadIdx.x >> 6)), (int)gridDim.x, 0, args, args.ws, 1.f};
    { const int bx = blockIdx.x; c0.vcu = (c0.G % 8 == 0) ? (bx % 8) * (c0.G / 8) + bx / 8 : bx; }
    if (c0.tid < 4) ((LAS unsigned*)(c0.lds + LDS_MISC))[c0.tid] = 0u;
    __syncthreads();
    const int lo = args.ph_lo, hi = args.ph_hi; const int wid_s = c0.wid; (void)wid_s;
#if MK_ONE_LAUNCH
    XcdBarrier bar = xcd_barrier_post(wsp<unsigned>(c0, WS_CTL) + CW_BAR, (volatile LAS unsigned*)(c0.lds + LDS_MISC));
#else
    XcdBarrier bar; bar.bar = nullptr; bar.x = 0; bar.st = nullptr;
#endif
    if (IN(0)) { STAMP(0); PCTX REP(0) { p0_prologue(c); __syncthreads(); } SEAM(0); }
    layer_phases<0>(args, c0, bar, lo, hi, wid_s);
    layer_phases<1>(args, c0, bar, lo, hi, wid_s);
    if (IN(25)) { STAMP(25); PCTX
#ifdef MK_DIAG_A
        { const unsigned long long tk = DTS[MK_DIAG_B] - DTS[MK_DIAG_A]; const float us = (float)tk * 0.01f; c.oscale = 1.f + 0.02f + MK_DIAG_SENS * fminf(fmaxf(us - (float)MK_DIAG_OFF, 0.f), 16.f / (MK_DIAG_SENS * 1000.f)); }
#endif
        (void)build_tile_table(c, wsp<int>(c, WS_CTL) + CW_CNT + 1 * 32 * 64); norm_rows<3>(c, 1); }
#undef PCTX
#undef LAYERP
}
#undef IN
#undef SEAM
#undef PCTX
#undef LAYERP

extern "C" void kernel_launch(void* const* d_in, const int* in_sizes, int n_in, void* d_out, int out_size, void* d_ws, size_t ws_size, hipStream_t stream) {
    static int grid = 0;
    if (grid == 0) {
        if (n_in != 33 || in_sizes[0] != NTOK * DM || out_size != NTOK * DM || ws_size < WS_END) {
            fprintf(stderr, "kernel_launch: shape/workspace mismatch (n_in %d, in0 %d, out %d, ws %zu < %zu); nothing launched\n", n_in, n_in > 0 ? in_sizes[0] : -1, out_size, ws_size, (size_t)WS_END); grid = -1; return; }
        int dev = 0, cus = 0, per_cu = 0;
        if (hipGetDevice(&dev) != hipSuccess || hipDeviceGetAttribute(&cus, hipDeviceAttributeMultiprocessorCount, dev) != hipSuccess) { grid = -1; return; }
        if (hipFuncSetAttribute((const void*)mk_fwd, hipFuncAttributeMaxDynamicSharedMemorySize, LDS_BYTES) != hipSuccess) { fprintf(stderr, "kernel_launch: hipFuncSetAttribute failed\n"); grid = -1; return; }
        if (hipOccupancyMaxActiveBlocksPerMultiprocessor(&per_cu, (const void*)mk_fwd, 512, LDS_BYTES) != hipSuccess || per_cu < 1) fprintf(stderr, "kernel_launch: occupancy query reports %d\n", per_cu);
        (void)hipGetLastError();
        grid = cus;
    }
    if (grid < 0) return;
    if (hipMemsetAsync((char*)d_ws + WS_CTL, 0, CTL_ZERO_BYTES, stream) != hipSuccess) return;
    Args a{};
    for (int i = 0; i < 33; ++i) a.in[i] = d_in[i];
    a.out = (float*)d_out; a.ws = (unsigned char*)d_ws;
#if MK_ONE_LAUNCH
    a.ph_lo = 0; a.ph_hi = N_PHASES;
    hipLaunchKernelGGL(mk_fwd, dim3(grid), dim3(512), LDS_BYTES, stream, a);
#else
    for (int ph = 0; ph < N_PHASES; ++ph) { a.ph_lo = ph; a.ph_hi = ph + 1; int reps = 1;
#ifdef MK_HPROBE
        if (ph == MK_HPROBE) reps = 2;
#endif
        for (int r = 0; r < reps; ++r) hipLaunchKernelGGL(mk_fwd, dim3(grid), dim3(512), LDS_BYTES, stream, a); }
#endif
}
```

```cpp
#include <hip/hip_runtime.h>
#include <cstdio>
#include <cstdint>

#ifndef MK_ONE_LAUNCH
#define MK_ONE_LAUNCH 1
#endif

#define LAS __attribute__((address_space(3)))
#define GAS __attribute__((address_space(1)))
typedef unsigned short bf16_t;
typedef short bf16x8 __attribute__((ext_vector_type(8)));
typedef short s16x4 __attribute__((ext_vector_type(4)));
typedef float f32x2 __attribute__((ext_vector_type(2)));
typedef float f32x4 __attribute__((ext_vector_type(4)));
typedef float f32x16 __attribute__((ext_vector_type(16)));
typedef unsigned u32x2 __attribute__((ext_vector_type(2)));
typedef unsigned u32x4 __attribute__((ext_vector_type(4)));
typedef int i32x4 __attribute__((ext_vector_type(4)));

constexpr int NB = 2, SEQ = 16384, DM = 2048, NTOK = NB * SEQ, DEPTH = 2;
constexpr int IN_COLS = 1856, ZLD = 1536;
constexpr int Z_POOL = 0, Z_QC = 512, Z_KVC = 1024, Z_KPE = 1280;
constexpr int NHEAD = 8, QKD = 192, VD = 128;
constexpr int NEXP = 32, DEXP = 512;
constexpr int SSM_G = 32, SSM_T = 64, NCHUNK = NTOK / SSM_T;
constexpr float EPS = 1e-6f;
constexpr int MOE_MAXROWS = 2 * NTOK + NEXP * 256;

constexpr size_t MiB = 1u << 20;
constexpr size_t WS_CTL = 0, CTL_ZERO_BYTES = 1 * MiB;
constexpr size_t WS_MOD = 1 * MiB;
constexpr size_t WS_RBIAS = WS_MOD + 512 * 1024;
constexpr size_t WS_RWF = 2 * MiB;
constexpr size_t WS_RI = 4 * MiB;
constexpr size_t WS_RW = 5 * MiB;
constexpr size_t WS_TOK = 6 * MiB;
constexpr size_t WS_CS = 10 * MiB;
constexpr size_t WS_PWTAB = 18 * MiB, WS_BBTAB = 22 * MiB;
constexpr size_t WS_EBUF = 18 * MiB;
constexpr size_t WS_SPREV = 26 * MiB;
constexpr size_t WS_SSMTAB = 34 * MiB;
constexpr size_t SSMTAB_STRIDE = 832 * 1024, SSM_TG = 0, SSM_TEND = 64 * 1024, SSM_WC = 320 * 1024;
constexpr size_t WS_A64 = 86 * MiB;
constexpr size_t WS_WIN = 87 * MiB;
constexpr size_t WS_WUQ = 103 * MiB;
constexpr size_t WS_WUKV = 106 * MiB;
constexpr size_t WS_WOUT = 108 * MiB;
constexpr size_t WS_WGLU = 124 * MiB;
constexpr size_t WS_WPOOL = 125 * MiB;
constexpr size_t WS_W13 = 126 * MiB;
constexpr size_t WS_W2 = 254 * MiB;
constexpr size_t WS_XBUF = 318 * MiB;
constexpr size_t WS_H = 574 * MiB;
constexpr size_t WS_Q = 574 * MiB;
constexpr size_t WS_P = 670 * MiB;
constexpr size_t WS_Z = 702 * MiB;
constexpr size_t WS_O = 702 * MiB;
constexpr size_t WS_K = 798 * MiB;
constexpr size_t WS_YG = 798 * MiB, WS_GL = 830 * MiB;
constexpr size_t WS_V = 894 * MiB;
constexpr size_t WS_U = 958 * MiB;
constexpr size_t WS_Y2 = 702 * MiB;
constexpr size_t WS_YCAT = 990 * MiB;
constexpr size_t WS_ACT = 990 * MiB;
constexpr size_t WS_YI = 1118 * MiB;
constexpr size_t WS_SSQP = 1150 * MiB;
constexpr size_t WS_END = 1152 * MiB;
static_assert(WS_Y2 + (size_t)MOE_MAXROWS * DM * 2 <= WS_YCAT, "Y2 overlay");
static_assert(WS_ACT + (size_t)MOE_MAXROWS * DEXP * 2 <= WS_YI, "ACT overlay");
constexpr int CW_BAR = 1024;
constexpr int CW_CNT = 8192;
constexpr size_t CTL_SSQ = 64 * 1024;

constexpr int RING_BYTES = 131072;
constexpr int LDS_TILETAB = RING_BYTES;
constexpr int LDS_PSTART = RING_BYTES + 1536;
constexpr int LDS_MISC = RING_BYTES + 2048;
constexpr int LDS_BYTES = RING_BYTES + 4096;

#define LDS_WAIT() asm volatile("s_waitcnt lgkmcnt(0)" ::: "memory")
#define VM_WAIT() asm volatile("s_waitcnt vmcnt(0)" ::: "memory")
__device__ __forceinline__ unsigned cvtpk(float lo, float hi) { unsigned r; asm volatile("v_cvt_pk_bf16_f32 %0, %1, %2" : "=v"(r) : "v"(lo), "v"(hi)); return r; }
__device__ __forceinline__ float bf2f(unsigned short h) { return __uint_as_float((unsigned)h << 16); }
__device__ __forceinline__ float bflo(unsigned w) { return __uint_as_float(w << 16); }
__device__ __forceinline__ float bfhi(unsigned w) { return __uint_as_float(w & 0xffff0000u); }
__device__ __forceinline__ unsigned short f2bf(float f) { return (unsigned short)(cvtpk(f, 0.f) & 0xffffu); }
__device__ __forceinline__ u32x4 pack8f(f32x4 a, f32x4 b) { u32x4 w; w.x = cvtpk(a[0], a[1]); w.y = cvtpk(a[2], a[3]); w.z = cvtpk(b[0], b[1]); w.w = cvtpk(b[2], b[3]); return w; }
__device__ __forceinline__ void unpack8(u32x4 w, f32x4& a, f32x4& b) { a[0] = bflo(w.x); a[1] = bfhi(w.x); a[2] = bflo(w.y); a[3] = bfhi(w.y); b[0] = bflo(w.z); b[1] = bfhi(w.z); b[2] = bflo(w.w); b[3] = bfhi(w.w); }
__device__ __forceinline__ float wave_sum(float v) {
#pragma unroll
    for (int o = 1; o < 64; o <<= 1) v += __shfl_xor(v, o);
    return v;
}
__device__ __forceinline__ float fast_rcp(float x) { return __builtin_amdgcn_rcpf(x); }
__device__ __forceinline__ float fast_exp2(float x) { return __builtin_amdgcn_exp2f(x); }
__device__ __forceinline__ void sincos_rev(double ang, float& s, float& c) {
    double rev = ang * 0.15915494309189535; rev -= __builtin_rint(rev);
    const float f = (float)rev; s = __builtin_amdgcn_sinf(f); c = __builtin_amdgcn_cosf(f);
}

#define XB_TMO      128
#define XB_XCNT(j)  (256  + 64 * (j))
#define XB_XSUB(j)  (1280 + 64 * (j))
#define XB_XGEN(j)  (2304 + 64 * (j))
#define XB_TOP      3328
#define XB_TOPGEN   3392
#define XCD_BAR_WORDS 3456
#define XB_SPIN_CAP (1u << 18)
__device__ __forceinline__ unsigned xb_ld(unsigned* p)              { return __hip_atomic_load(p, __ATOMIC_RELAXED, __HIP_MEMORY_SCOPE_AGENT); }
__device__ __forceinline__ unsigned xb_add(unsigned* p, unsigned v) { return __hip_atomic_fetch_add(p, v, __ATOMIC_RELAXED, __HIP_MEMORY_SCOPE_AGENT); }
__device__ __forceinline__ unsigned xb_xcc_id() { return (unsigned)__builtin_amdgcn_s_getreg((3 << 11) | 20) & 0xFu; }
#define XB_SPIN(cond, bar) do { unsigned _sp = 0; while (cond) { __builtin_amdgcn_s_sleep(1); \
    if ((++_sp & 255u) == 0u) { if (xb_ld(&(bar)[XB_TMO])) break; if (_sp > XB_SPIN_CAP) { atomicAdd(&(bar)[XB_TMO], 1u); break; } } } } while (0)
struct XcdBarrier { unsigned* bar; unsigned x; volatile LAS unsigned* st; };
__device__ __forceinline__ XcdBarrier xcd_barrier_post(unsigned* bar, volatile LAS unsigned* st) {
    XcdBarrier b; b.bar = bar; b.x = xb_xcc_id(); b.st = st;
    if (threadIdx.x == 0) (void)xb_add(&bar[XB_XCNT(b.x)], 1u);
    return b;
}
__device__ __forceinline__ void xcd_barrier_complete(unsigned* bar, unsigned x, unsigned& nloc, unsigned& nx) {
    const unsigned G = gridDim.x * gridDim.y * gridDim.z;
    unsigned sum, cnt, mine, sp = 0u;
    for (;;) {
        sum = 0u; cnt = 0u; mine = 0u;
#pragma unroll
        for (unsigned j = 0; j < 16; ++j) { const unsigned c = xb_ld(&bar[XB_XCNT(j)]); sum += c; cnt += (c > 0u) ? 1u : 0u; mine = (j == x) ? c : mine; }
        if (sum == G) break;
        __builtin_amdgcn_s_sleep(1);
        if ((++sp & 255u) == 0u) { if (xb_ld(&bar[XB_TMO])) break; if (sp > XB_SPIN_CAP) { atomicAdd(&bar[XB_TMO], 1u); break; } }
    }
    nloc = mine > 0u ? mine : 1u; nx = cnt > 0u ? cnt : 1u;
}
__device__ __forceinline__ void xcd_barrier(const XcdBarrier& b, const bool leader_thread) {
    asm volatile("s_waitcnt vmcnt(0)" ::: "memory");
    __syncthreads();
    if (leader_thread) {
        unsigned* bar = b.bar;
        __builtin_amdgcn_s_waitcnt(0);
        unsigned nloc = b.st[0], nx = b.st[1];
        if (nloc == 0u) { xcd_barrier_complete(bar, b.x, nloc, nx); b.st[0] = nloc; b.st[1] = nx; }
        const unsigned old = xb_add(&bar[XB_XSUB(b.x)], 1u);
        const unsigned gen = old / nloc;
        if (old + 1u == (gen + 1u) * nloc) {
            __builtin_amdgcn_fence(__ATOMIC_RELEASE, "agent");
            asm volatile("s_waitcnt vmcnt(0)" ::: "memory");
            const unsigned og = xb_add(&bar[XB_TOP], 1u);
            const unsigned tg = og / nx;
            if (og + 1u == (tg + 1u) * nx) xb_add(&bar[XB_TOPGEN], 1u);
            else XB_SPIN(xb_ld(&bar[XB_TOPGEN]) == tg, bar);
            __builtin_amdgcn_fence(__ATOMIC_ACQUIRE, "agent");
            xb_add(&bar[XB_XGEN(b.x)], 1u);
            asm volatile("s_waitcnt vmcnt(0)" ::: "memory");
        } else {
            XB_SPIN(xb_ld(&bar[XB_XGEN(b.x)]) == gen, bar);
            __builtin_amdgcn_fence(__ATOMIC_ACQUIRE, "agent");
            asm volatile("s_waitcnt vmcnt(0)" ::: "memory");
        }
    }
    __syncthreads();
}

struct Args { const void* in[33]; float* out; unsigned char* ws; int ph_lo, ph_hi; };
struct Ctx {
    LAS unsigned char* lds;
    int tid, lane, wid, G, vcu;
    const Args& a;
    unsigned char* ws;
    float oscale;
};
template <class T> __device__ __forceinline__ T* wsp(const Ctx& c, size_t off) { return (T*)(c.ws + off); }
__device__ __forceinline__ const float* inp(const Ctx& c, int i) { return (const float*)c.a.in[i]; }
__device__ __forceinline__ const float* modp(const Ctx& c, int l, int b, int which) { return wsp<const float>(c, WS_MOD) + ((size_t)(l * NB + b) * 6 + which) * DM; }
namespace ge {
constexpr int BM = 256, BK = 64, HALF = 128, HTB = HALF * BK * 2, STAGE_BYTES = 8 * HTB;
__device__ __forceinline__ int lds_byte(int r, int c) { const int st = (r >> 4) * 2 + (c >> 5), rr = r & 15, cc = c & 31, ob = rr * 64 + cc * 2; return st * 1024 + (ob ^ (((ob >> 9) & 1) << 5)); }
__device__ __forceinline__ void stage_rc(int b, int& R, int& C) { const int st = b / 1024, sb = b % 1024, swz = sb ^ (((sb >> 9) & 1) << 5); R = (st >> 1) * 16 + swz / 64; C = (st & 1) * 32 + (swz % 64) / 2; }
__device__ __forceinline__ int perm32(int rho) { const int n = rho >> 4, i = rho & 15; return 8 * (i >> 2) + 4 * n + (i & 3); }

struct Ops { const char* a0; const char* a1; const char* b0; const char* b1; long ksA, ksB; int nt; };
struct Lane { int R[2], Rb[2], C[2]; };
struct Off { unsigned a[2][2]; unsigned b[2]; };
typedef f32x4 Acc[2][2][4][2];

template <class P>
__device__ __forceinline__ void run(LAS unsigned char* lds, const P& prog, const int tid) {
    const int wid = __builtin_amdgcn_readfirstlane(tid >> 6), lane = tid & 63, wr = wid >> 2, wc = wid & 3, fr = lane & 15, fq = lane >> 4;
#define GE_LANE(ln) Lane ln; { int t_ = tid; asm volatile("" : "+v"(t_)); _Pragma("unroll") for (int i = 0; i < 2; ++i) { stage_rc(t_ * 16 + i * 8192, ln.R[i], ln.C[i]); ln.Rb[i] = (ln.R[i] & ~31) + perm32(ln.R[i] & 31); } }
    const unsigned ldsw = (unsigned)wid * 1024u;
    const int aoff = lds_byte(wr * 64 + fr, fq * 8), boff = lds_byte(wc * 32 + fr, fq * 8);
#define GE_SA(b, h) (((b) * 2 + (h)) * HTB)
#define GE_SB(b, h) ((4 + (b) * 2 + (h)) * HTB)
#define GE_STAGE(bufoff, gbase, v0, v1) do { unsigned o0_ = (v0), o1_ = (v1); asm volatile("" : "+v"(o0_), "+v"(o1_)); \
        __builtin_amdgcn_global_load_lds((const unsigned*)((const char*)(gbase) + o0_), (LAS unsigned*)(lds + (bufoff) + ldsw), 16, 0, 0); \
        __builtin_amdgcn_global_load_lds((const unsigned*)((const char*)(gbase) + o1_), (LAS unsigned*)(lds + (bufoff) + ldsw + 8192), 16, 0, 0); } while (0)
#define GE_LDA(dst, b, h) do { _Pragma("unroll") for (int m = 0; m < 4; ++m) _Pragma("unroll") for (int k = 0; k < 2; ++k) dst[m][k] = *(const LAS bf16x8*)(lds + GE_SA(b, h) + aoff + m * 2048 + k * 1024); } while (0)
#define GE_LDB(dst, b, h) do { _Pragma("unroll") for (int n = 0; n < 2; ++n) _Pragma("unroll") for (int k = 0; k < 2; ++k) dst[n][k] = *(const LAS bf16x8*)(lds + GE_SB(b, h) + boff + n * 2048 + k * 1024); } while (0)
#define GE_MMA(ai, bj, At, Bt) do { __builtin_amdgcn_s_setprio(1); _Pragma("unroll") for (int m = 0; m < 4; ++m) _Pragma("unroll") for (int n = 0; n < 2; ++n) _Pragma("unroll") for (int k = 0; k < 2; ++k) \
        acc[ai][bj][m][n] = __builtin_amdgcn_mfma_f32_16x16x32_bf16(Bt[n][k], At[m][k], acc[ai][bj][m][n], 0, 0, 0); __builtin_amdgcn_s_setprio(0); } while (0)
#define GE_WAIT_V(n) asm volatile("s_waitcnt vmcnt(" #n ")" ::: "memory")
#define GE_WAIT_L(n) asm volatile("s_waitcnt lgkmcnt(" #n ")" ::: "memory")
#define GE_BAR __builtin_amdgcn_s_barrier()
#define GE_SCHED __builtin_amdgcn_sched_barrier(0)
    typename P::Unit cur, nxt; int ui = 0;
    if (!prog.next(0, cur)) return;
    Ops co, no; prog.ops(cur, co);
    Off v, nv; { GE_LANE(ln) prog.voff(cur, ln, v); }
    Acc acc;
#pragma unroll
    for (int a = 0; a < 2; ++a)
#pragma unroll
        for (int b = 0; b < 2; ++b)
#pragma unroll
            for (int m = 0; m < 4; ++m)
#pragma unroll
                for (int n = 0; n < 2; ++n) acc[a][b][m][n] = (f32x4){0.f, 0.f, 0.f, 0.f};
    bf16x8 At[4][2], B0[2][2], B1[2][2];
    GE_STAGE(GE_SB(0, 0), co.b0, v.b[0], v.b[1]); GE_STAGE(GE_SB(0, 1), co.b1, v.b[0], v.b[1]); GE_STAGE(GE_SA(0, 0), co.a0, v.a[0][0], v.a[0][1]); GE_STAGE(GE_SA(0, 1), co.a1, v.a[P::GATHER][0], v.a[P::GATHER][1]);
    if (wr == 1) GE_BAR;
    GE_WAIT_V(2); GE_BAR;
    GE_STAGE(GE_SB(1, 0), co.b0 + co.ksB, v.b[0], v.b[1]); GE_STAGE(GE_SA(1, 0), co.a0 + co.ksA, v.a[0][0], v.a[0][1]); GE_STAGE(GE_SB(1, 1), co.b1 + co.ksB, v.b[0], v.b[1]);
    GE_WAIT_V(6); GE_BAR;
    for (;;) {
        const bool has_next = prog.next(ui + 1, nxt);
        if (has_next) { prog.ops(nxt, no); if constexpr (P::VAR_OFF) { GE_LANE(ln) prog.voff(nxt, ln, nv); } } else { no = co; if constexpr (P::VAR_OFF) nv = v; }
        const int nt = co.nt;
        for (int t = 0; t < nt; t += 2) {
            const bool last = (t == nt - 2);
            const char* a1h1 = co.a1 + (long)(t + 1) * co.ksA;
            const char* a2h0 = last ? no.a0 : co.a0 + (long)(t + 2) * co.ksA; const char* a2h1 = last ? no.a1 : co.a1 + (long)(t + 2) * co.ksA;
            const char* b2h0 = last ? no.b0 : co.b0 + (long)(t + 2) * co.ksB; const char* b2h1 = last ? no.b1 : co.b1 + (long)(t + 2) * co.ksB;
            const long ks2A = last ? no.ksA : co.ksA, ks2B = last ? no.ksB : co.ksB;
            const char* a3h0 = a2h0 + ks2A; const char* b3h0 = b2h0 + ks2B; const char* b3h1 = b2h1 + ks2B;
            unsigned wa00 = v.a[0][0], wa01 = v.a[0][1], wa10 = v.a[P::GATHER][0], wa11 = v.a[P::GATHER][1], wb0 = v.b[0], wb1 = v.b[1];
            if constexpr (P::VAR_OFF) { if (last) { wa00 = nv.a[0][0]; wa01 = nv.a[0][1]; wa10 = nv.a[P::GATHER][0]; wa11 = nv.a[P::GATHER][1]; wb0 = nv.b[0]; wb1 = nv.b[1]; } }
            GE_LDB(B0, 0, 0); GE_LDB(B1, 0, 1); GE_SCHED; GE_LDA(At, 0, 0); GE_STAGE(GE_SA(1, 1), a1h1, v.a[P::GATHER][0], v.a[P::GATHER][1]);
            GE_WAIT_V(8); GE_WAIT_L(0); GE_BAR; GE_MMA(0, 0, At, B0); GE_MMA(0, 1, At, B1); GE_BAR; GE_SCHED;
            GE_LDA(At, 0, 1); GE_STAGE(GE_SB(0, 0), b2h0, wb0, wb1); GE_STAGE(GE_SB(0, 1), b2h1, wb0, wb1); GE_STAGE(GE_SA(0, 0), a2h0, wa00, wa01);
            GE_WAIT_V(8); GE_WAIT_L(0); GE_BAR; GE_MMA(1, 0, At, B0); GE_MMA(1, 1, At, B1); GE_BAR; GE_SCHED;
            GE_LDB(B0, 1, 0); GE_LDB(B1, 1, 1); GE_SCHED; GE_LDA(At, 1, 0); GE_STAGE(GE_SA(0, 1), a2h1, wa10, wa11);
            GE_WAIT_V(8); GE_WAIT_L(0); GE_BAR; GE_MMA(0, 0, At, B0); GE_MMA(0, 1, At, B1); GE_BAR; GE_SCHED;
            GE_LDA(At, 1, 1); GE_STAGE(GE_SB(1, 0), b3h0, wb0, wb1); GE_STAGE(GE_SB(1, 1), b3h1, wb0, wb1); GE_STAGE(GE_SA(1, 0), a3h0, wa00, wa01);
            GE_WAIT_V(8); GE_WAIT_L(0); GE_BAR; GE_MMA(1, 0, At, B0); GE_MMA(1, 1, At, B1); GE_BAR; GE_SCHED;
        }
        if (wr == 0) GE_BAR;
        prog.epi(acc, cur, wr, wc, fr, fq);
        if (!has_next) break;
#pragma unroll
        for (int a = 0; a < 2; ++a)
#pragma unroll
            for (int b = 0; b < 2; ++b)
#pragma unroll
                for (int m = 0; m < 4; ++m)
#pragma unroll
                    for (int n = 0; n < 2; ++n) acc[a][b][m][n] = (f32x4){0.f, 0.f, 0.f, 0.f};
        cur = nxt; co = no; if constexpr (P::VAR_OFF) v = nv; ++ui;
        if (wr == 1) GE_BAR;
    }
    GE_WAIT_V(0);
    GE_BAR;
#undef GE_LANE
#undef GE_SA
#undef GE_SB
#undef GE_STAGE
#undef GE_LDA
#undef GE_LDB
#undef GE_MMA
#undef GE_WAIT_V
#undef GE_WAIT_L
#undef GE_BAR
#undef GE_SCHED
}
__device__ __forceinline__ void off_rm(const Lane& ln, int lda, int ldb, Off& v) {
#pragma unroll
    for (int i = 0; i < 2; ++i) { v.a[0][i] = (unsigned)(ln.R[i] * lda + ln.C[i]) * 2u; v.b[i] = (unsigned)(ln.Rb[i] * ldb + ln.C[i]) * 2u; }
}
}
struct StaticOrder {
    int nM, nN, nwg, G, c;
    __device__ void init(int M, int N, int G_, int c_) { nM = M / 256; nN = N / 256; nwg = nM * nN; G = G_; c = c_; }
    __device__ __forceinline__ bool next(int i, int& pm, int& pn) const {
        const long L = (long)i * G + c; if (L >= nwg) return false;
        int wgid = (int)L; { const int q = nwg / 8, r = nwg % 8, xcd = wgid % 8, off = wgid / 8; wgid = (xcd < r ? xcd * (q + 1) : r * (q + 1) + (xcd - r) * q) + off; }
        const int nig = 8 * nN, gid = wgid / nig, fm = gid * 8, gsz = (nM - fm) < 8 ? (nM - fm) : 8;
        pm = fm + ((wgid % nig) % gsz); pn = (wgid % nig) / gsz; return true;
    }
};
#define EPI_ROWS_BEGIN _Pragma("unroll") for (int ai = 0; ai < 2; ++ai) _Pragma("unroll") for (int m = 0; m < 4; ++m) { const int rt = 128 * ai + 64 * wr + 16 * m + fr;
#define EPI_ROWS_END if (m == 3) asm volatile("" ::: "memory"); }
__device__ __forceinline__ float gelu_tanh(float y) {
    const float u = 0.7978845608028654f * (y + 0.044715f * y * y * y);
    const float e = fast_exp2(u * 2.8853900817779268f);
    const float th = 1.f - 2.f * fast_rcp(1.f + e);
    return 0.5f * y * (1.f + th);
}
__device__ __forceinline__ float sigmoidf_(float x) { return fast_rcp(1.f + fast_exp2(-1.4426950408889634f * x)); }

struct ProgG1 {
    static constexpr int VAR_OFF = 0, GATHER = 0;
    struct Unit { int pm, pn; };
    StaticOrder so; const char* A; const char* B; bf16_t* Z; bf16_t* U; float* ssqp; int nt_ov = 0;
    __device__ __forceinline__ bool next(int i, Unit& u) const { return so.next(i, u.pm, u.pn); }
    __device__ __forceinline__ void ops(const Unit& u, ge::Ops& o) const {
        o.a0 = A + (size_t)u.pm * 256 * DM * 2; o.a1 = o.a0 + (size_t)128 * DM * 2; o.b0 = B + (size_t)u.pn * 256 * DM * 2; o.b1 = o.b0 + (size_t)128 * DM * 2; o.ksA = 128; o.ksB = 128; o.nt = nt_ov ? nt_ov : DM / 64; }
    __device__ __forceinline__ void voff(const Unit&, const ge::Lane& ln, ge::Off& v) const { ge::off_rm(ln, DM, DM, v); }
    __device__ __forceinline__ void epi(const ge::Acc& acc, const Unit& u, int wr, int wc, int fr, int fq) const {
        const int pn = u.pn; const int cl = 32 * wc + 8 * fq;
        EPI_ROWS_BEGIN
            const int row = u.pm * 256 + rt;
            float ss = 0.f;
#pragma unroll
            for (int bj = 0; bj < 2; ++bj) {
                const f32x4 v0 = acc[ai][bj][m][0], v1 = acc[ai][bj][m][1]; const int c = 128 * bj + cl;
                const u32x4 w = pack8f(v0, v1);
                ss += (v0[0] * v0[0] + v0[1] * v0[1]) + (v0[2] * v0[2] + v0[3] * v0[3]) + (v1[0] * v1[0] + v1[1] * v1[1]) + (v1[2] * v1[2] + v1[3] * v1[3]);
                if (pn < 2) *(u32x4*)(Z + (size_t)row * ZLD + Z_POOL + 256 * pn + c) = w;
                else if (pn < 4) { const int ch = 256 * (pn - 2) + c; *(u32x4*)(U + ((size_t)(ch >> 4) * NTOK + row) * 16 + (ch & 15)) = w; }
                else if (pn < 6) *(u32x4*)(Z + (size_t)row * ZLD + Z_QC + 256 * (pn - 4) + c) = w;
                else if (pn == 6) *(u32x4*)(Z + (size_t)row * ZLD + Z_KVC + c) = w;
                else if (c < 64) *(u32x4*)(Z + (size_t)row * ZLD + Z_KPE + c) = w;
            }
            if (pn >= 4 && pn <= 6) { ss += __shfl_xor(ss, 16); ss += __shfl_xor(ss, 32); if (fq == 0) ssqp[(size_t)row * 12 + (pn - 4) * 4 + wc] = ss; }
        EPI_ROWS_END
    }
};

struct ProgG2 {
    static constexpr int VAR_OFF = 1, GATHER = 0;
    struct Unit { int type, pm, pn, g; };
    int G, c; int tmask = 15;
    const char* Z; const char* U; const char* WUQ; const char* WUKV; const char* WPOOL; const char* SSMTAB;
    const float* ssqp; const f32x2* CS;
    bf16_t* Q; bf16_t* K; bf16_t* V; bf16_t* P; bf16_t* YI; float* EBUF;
    static constexpr int N_SSM = 320, N_Q = 768, N_KV = 1024, N_POOL = 256, N_ALL = N_SSM + N_Q + N_KV + N_POOL;
    __device__ __forceinline__ bool next_all(int i, Unit& u) const {
        const int x = c & 7, W = G >> 3; int L = (c >> 3) + W * i;
        if (L < 40) { u.type = 0; u.pn = 4 - (L >> 3); const int r = 8 * x + (L & 7); u.g = r >> 1; u.pm = r & 1; return true; } L -= 40;
        if (L < 96) { u.type = 1; u.pm = 16 * x + L / 6; u.pn = L % 6; u.g = 0; return true; } L -= 96;
        if (L < 128) { u.type = 2; u.pm = 16 * x + (L >> 3); u.pn = L & 7; u.g = 0; return true; } L -= 128;
        if (L < 32) { u.type = 3; u.pm = 16 * x + (L >> 1); u.pn = L & 1; u.g = 0; return true; }
        return false;
    }
#ifdef MK_G2_SPLIT
    __device__ __forceinline__ bool next(int i, Unit& u) const {
        int k = -1; for (int j = 0; j < 12; ++j) { if (!next_all(j, u)) return false; if ((tmask >> u.type) & 1) { if (++k == i) return true; } } return false; }
#else
    __device__ __forceinline__ bool next(int i, Unit& u) const { return next_all(i, u); }
#endif
    __device__ __forceinline__ void ops(const Unit& u, ge::Ops& o) const {
        if (u.type == 0) {
            o.a0 = U + ((size_t)u.g * NTOK * 16 + (size_t)u.pm * 256 * 1024) * 2; o.a1 = o.a0 + (size_t)128 * 1024 * 2; o.ksA = 128;
            const char* tab = SSMTAB + (size_t)u.g * SSMTAB_STRIDE;
            if (u.pn < 4) { o.b0 = tab + SSM_TG + (size_t)(16 * u.pn + 60) * 512; o.b1 = o.b0 + 8 * 512; o.ksB = -2048; o.nt = 4 * (u.pn + 1); }
            else { o.b0 = tab + SSM_TEND; o.b1 = o.b0; o.ksB = 16384; o.nt = 16; }
        } else if (u.type == 1) {
            o.a0 = Z + ((size_t)u.pm * 256 * ZLD + Z_QC) * 2; o.a1 = o.a0 + (size_t)128 * ZLD * 2; o.ksA = 128;
            o.b0 = WUQ + (size_t)u.pn * 256 * 512 * 2; o.b1 = o.b0 + (size_t)128 * 512 * 2; o.ksB = 128; o.nt = 8;
        } else if (u.type == 2) {
            o.a0 = Z + ((size_t)u.pm * 256 * ZLD + Z_KVC) * 2; o.a1 = o.a0 + (size_t)128 * ZLD * 2; o.ksA = 128;
            o.b0 = WUKV + (size_t)u.pn * 256 * 256 * 2; o.b1 = o.b0 + (size_t)128 * 256 * 2; o.ksB = 128; o.nt = 4;
        } else {
            o.a0 = Z + ((size_t)u.pm * 256 * ZLD + Z_POOL + 256 * u.pn) * 2; o.a1 = o.a0 + (size_t)128 * ZLD * 2; o.ksA = 128;
            o.b0 = WPOOL + (size_t)u.pn * 256 * 256 * 2; o.b1 = o.b0 + (size_t)128 * 256 * 2; o.ksB = 128; o.nt = 4;
        }
    }
    __device__ __forceinline__ void voff(const Unit& u, const ge::Lane& ln, ge::Off& v) const {
#pragma unroll
        for (int i = 0; i < 2; ++i) {
            const int R = ln.R[i], Rb = ln.Rb[i], C = ln.C[i]; unsigned a, b;
            if (u.type == 0) {
                a = (unsigned)(R * 1024 + C) * 2u;
                if (u.pn < 4) b = (unsigned)(((Rb >> 4) - (C >> 4) + 3) * 256 + (Rb & 15) * 16 + (C & 15)) * 2u;
                else b = (unsigned)((((C >> 4) * 128 + Rb) * 16) + (C & 15)) * 2u;
            } else if (u.type == 1) { a = (unsigned)(R * ZLD + C) * 2u; b = (unsigned)(Rb * 512 + C) * 2u; }
            else { a = (unsigned)(R * ZLD + C) * 2u; b = (unsigned)(Rb * 256 + C) * 2u; }
            v.a[0][i] = a; v.b[i] = b;
        }
    }
    __device__ __forceinline__ void epi(const ge::Acc& acc, const Unit& u, int wr, int wc, int fr, int fq) const {
        const int cl = 32 * wc + 8 * fq;
        if (u.type == 0) {
            EPI_ROWS_BEGIN
                const int cg = u.pm * 256 + rt;
                if (u.pn < 4) {
#pragma unroll
                    for (int bj = 0; bj < 2; ++bj) { const int n = 128 * bj + cl, t = 16 * u.pn + (n >> 4), h0 = n & 15;
                        *(u32x4*)(YI + ((size_t)cg * 64 + t) * 512 + u.g * 16 + h0) = pack8f(acc[ai][bj][m][0], acc[ai][bj][m][1]); }
                } else {
                    float* e = EBUF + ((size_t)cg * SSM_G + u.g) * 128 + cl;
                    *(f32x4*)e = acc[ai][0][m][0]; *(f32x4*)(e + 4) = acc[ai][0][m][1];
                }
            EPI_ROWS_END
        } else if (u.type == 1) {
            constexpr float QSCALE = 0.07216878364870322f * 1.4426950408889634f;
            EPI_ROWS_BEGIN
                const int row = u.pm * 256 + rt; const int b = row >> 14, t = row & (SEQ - 1);
                const f32x4 sa = *(const f32x4*)(ssqp + (size_t)row * 12), sb = *(const f32x4*)(ssqp + (size_t)row * 12 + 4);
                const float rs = rsqrtf((((sa[0] + sa[1]) + (sa[2] + sa[3])) + ((sb[0] + sb[1]) + (sb[2] + sb[3]))) * (1.f / 512.f) + EPS) * QSCALE;
#pragma unroll
                for (int bj = 0; bj < 2; ++bj) {
                    const int c = 256 * u.pn + 128 * bj + cl; const int head = c / QKD, d = c - head * QKD;
                    f32x4 v0 = acc[ai][bj][m][0] * rs, v1 = acc[ai][bj][m][1] * rs;
                    if (d >= 128) {
                        const f32x2* cs = CS + (size_t)row * 32 + ((d - 128) >> 1);
                        const f32x4 c01 = *(const f32x4*)cs, c23 = *(const f32x4*)(cs + 2);
                        f32x4 o0, o1;
                        o0[0] = v0[0] * c01[0] - v0[1] * c01[1]; o0[1] = v0[1] * c01[0] + v0[0] * c01[1];
                        o0[2] = v0[2] * c01[2] - v0[3] * c01[3]; o0[3] = v0[3] * c01[2] + v0[2] * c01[3];
                        o1[0] = v1[0] * c23[0] - v1[1] * c23[1]; o1[1] = v1[1] * c23[0] + v1[0] * c23[1];
                        o1[2] = v1[2] * c23[2] - v1[3] * c23[3]; o1[3] = v1[3] * c23[2] + v1[2] * c23[3];
                        v0 = o0; v1 = o1;
                    }
                    *(u32x4*)(Q + ((size_t)(b * NHEAD + head) * SEQ + t) * QKD + d) = pack8f(v0, v1);
                }
            EPI_ROWS_END
        } else if (u.type == 2) {
            EPI_ROWS_BEGIN
                const int row = u.pm * 256 + rt; const int b = row >> 14, t = row & (SEQ - 1);
                const f32x4 sa = *(const f32x4*)(ssqp + (size_t)row * 12 + 8);
                const float rs = rsqrtf(((sa[0] + sa[1]) + (sa[2] + sa[3])) * (1.f / 256.f) + EPS);
#pragma unroll
                for (int bj = 0; bj < 2; ++bj) {
                    const int d = 128 * bj + cl; const int head = u.pn;
                    const u32x4 w = pack8f(acc[ai][bj][m][0] * rs, acc[ai][bj][m][1] * rs);
                    if (d < 128) *(u32x4*)(K + ((size_t)(b * NHEAD + head) * SEQ + t) * QKD + d) = w;
                    else *(u32x4*)(V + ((size_t)(b * NHEAD + head) * SEQ + t) * VD + (d - 128)) = w;
                }
            EPI_ROWS_END
        } else {
            EPI_ROWS_BEGIN
                const int row = u.pm * 256 + rt;
#pragma unroll
                for (int bj = 0; bj < 2; ++bj) *(u32x4*)(P + (size_t)row * 512 + 256 * u.pn + 128 * bj + cl) = pack8f(acc[ai][bj][m][0], acc[ai][bj][m][1]);
            EPI_ROWS_END
        }
    }
};

struct ProgS1 {
    static constexpr int VAR_OFF = 0, GATHER = 0;
    struct Unit { int g, pm, pn; };
    int G, c; const char* SPREV; const char* SSMTAB; const bf16_t* YI; const bf16_t* U; const float* Dskip; bf16_t* YG;
    __device__ __forceinline__ bool next(int i, Unit& u) const { const int x = c & 7, L = (c >> 3) + (G >> 3) * i; if (L >= 32) return false; const int r = 8 * x + (L >> 2); u.g = r >> 1; u.pm = r & 1; u.pn = L & 3; return true; }
    __device__ __forceinline__ void ops(const Unit& u, ge::Ops& o) const {
        o.a0 = SPREV + ((size_t)u.pm * 256 * (SSM_G * 256) + u.g * 256) * 2; o.a1 = o.a0 + (size_t)128 * (SSM_G * 256) * 2; o.ksA = 128;
        o.b0 = SSMTAB + (size_t)u.g * SSMTAB_STRIDE + SSM_WC + (size_t)u.pn * 256 * 256 * 2; o.b1 = o.b0 + (size_t)128 * 256 * 2; o.ksB = 128; o.nt = 4; }
    __device__ __forceinline__ void voff(const Unit&, const ge::Lane& ln, ge::Off& v) const { ge::off_rm(ln, SSM_G * 256, 256, v); }
    __device__ __forceinline__ void epi(const ge::Acc& acc, const Unit& u, int wr, int wc, int fr, int fq) const {
        const int cl = 32 * wc + 8 * fq;
        EPI_ROWS_BEGIN
            const int cg = u.pm * 256 + rt;
#pragma unroll
            for (int bj = 0; bj < 2; ++bj) {
                const int n = 128 * bj + cl, t = 16 * u.pn + (n >> 4), h0 = n & 15; const size_t tok = (size_t)cg * 64 + t; const int ch = u.g * 16 + h0;
                f32x4 yi0, yi1, u0, u1; unpack8(*(const u32x4*)(YI + tok * 512 + ch), yi0, yi1); unpack8(*(const u32x4*)(U + ((size_t)u.g * NTOK + tok) * 16 + h0), u0, u1);
                const f32x4 d0 = *(const f32x4*)(Dskip + ch), d1 = *(const f32x4*)(Dskip + ch + 4);
                f32x4 y0 = acc[ai][bj][m][0] + yi0 + d0 * u0, y1 = acc[ai][bj][m][1] + yi1 + d1 * u1;
#pragma unroll
                for (int e = 0; e < 4; ++e) { y0[e] = gelu_tanh(y0[e]); y1[e] = gelu_tanh(y1[e]); }
                *(u32x4*)(YG + tok * 512 + ch) = pack8f(y0, y1);
            }
        EPI_ROWS_END
    }
};

struct ProgS2 {
    static constexpr int VAR_OFF = 0, GATHER = 0;
    struct Unit { int pm, pn; };
    int G, c; const char* YGc; const char* W; const bf16_t* YG; bf16_t* GL;
    __device__ __forceinline__ bool next(int i, Unit& u) const { const int x = c & 7, L = (c >> 3) + (G >> 3) * i; if (L >= 32) return false; u.pm = 16 * x + (L >> 1); u.pn = L & 1; return true; }
    __device__ __forceinline__ void ops(const Unit& u, ge::Ops& o) const {
        o.a0 = YGc + (size_t)u.pm * 256 * 512 * 2; o.a1 = o.a0 + (size_t)128 * 512 * 2; o.ksA = 128; o.b0 = W + (size_t)u.pn * 256 * 512 * 2; o.b1 = o.b0 + (size_t)128 * 512 * 2; o.ksB = 128; o.nt = 8; }
    __device__ __forceinline__ void voff(const Unit&, const ge::Lane& ln, ge::Off& v) const { ge::off_rm(ln, 512, 512, v); }
    __device__ __forceinline__ void epi(const ge::Acc& acc, const Unit& u, int wr, int wc, int fr, int fq) const {
        const int cl = 32 * wc + 8 * fq;
        EPI_ROWS_BEGIN
            const size_t row = (size_t)u.pm * 256 + rt;
#pragma unroll
            for (int bj = 0; bj < 2; ++bj) {
                const int c = 256 * u.pn + 128 * bj + cl; f32x4 y0, y1; unpack8(*(const u32x4*)(YG + row * 512 + c), y0, y1);
                f32x4 a0 = acc[ai][bj][m][0], a1 = acc[ai][bj][m][1];
#pragma unroll
                for (int e = 0; e < 4; ++e) { y0[e] *= sigmoidf_(a0[e]); y1[e] *= sigmoidf_(a1[e]); }
                *(u32x4*)(GL + row * 512 + c) = pack8f(y0, y1);
            }
        EPI_ROWS_END
    }
};

struct ProgG3 {
    static constexpr int VAR_OFF = 0, GATHER = 0;
    struct Unit { int pm, pn; };
    StaticOrder so; const char* A; const char* B; const float* xin; const bf16_t* xin16; bf16_t* xout; const float* ga;
    __device__ __forceinline__ bool next(int i, Unit& u) const { return so.next(i, u.pm, u.pn); }
    __device__ __forceinline__ void ops(const Unit& u, ge::Ops& o) const {
        o.a0 = A + (size_t)u.pm * 256 * DM * 2; o.a1 = o.a0 + (size_t)128 * DM * 2; o.b0 = B + (size_t)u.pn * 256 * DM * 2; o.b1 = o.b0 + (size_t)128 * DM * 2; o.ksA = 128; o.ksB = 128; o.nt = DM / 64; }
    __device__ __forceinline__ void voff(const Unit&, const ge::Lane& ln, ge::Off& v) const { ge::off_rm(ln, DM, DM, v); }
    __device__ __forceinline__ void epi(const ge::Acc& acc, const Unit& u, int wr, int wc, int fr, int fq) const {
        const int cl = 32 * wc + 8 * fq; const int b = (u.pm * 256) >> 14;
        f32x4 g[2][2];
#pragma unroll
        for (int bj = 0; bj < 2; ++bj) { const float* gp = ga + (size_t)b * 6 * DM + 256 * u.pn + 128 * bj + cl; g[bj][0] = *(const f32x4*)gp; g[bj][1] = *(const f32x4*)(gp + 4); }
        if (xin) {
            EPI_ROWS_BEGIN
                const size_t row = (size_t)u.pm * 256 + rt;
#pragma unroll
                for (int bj = 0; bj < 2; ++bj) {
                    const size_t o = row * DM + 256 * u.pn + 128 * bj + cl;
                    const f32x4 x0 = *(const f32x4*)(xin + o), x1 = *(const f32x4*)(xin + o + 4);
                    *(u32x4*)(xout + o) = pack8f(x0 + g[bj][0] * acc[ai][bj][m][0], x1 + g[bj][1] * acc[ai][bj][m][1]);
                }
            EPI_ROWS_END
        } else {
#pragma unroll
            for (int ai = 0; ai < 2; ++ai) {
                u32x4 xh[4][2];
#pragma unroll
                for (int m = 0; m < 4; ++m) { const int rt = 128 * ai + 64 * wr + 16 * m + fr; const size_t row = (size_t)u.pm * 256 + rt;
#pragma unroll
                    for (int bj = 0; bj < 2; ++bj) xh[m][bj] = *(const u32x4*)(xin16 + row * DM + 256 * u.pn + 128 * bj + cl); }
                asm volatile("" ::: "memory");
#pragma unroll
                for (int m = 0; m < 4; ++m) { const int rt = 128 * ai + 64 * wr + 16 * m + fr; const size_t row = (size_t)u.pm * 256 + rt;
#pragma unroll
                    for (int bj = 0; bj < 2; ++bj) { const size_t o = row * DM + 256 * u.pn + 128 * bj + cl;
                        f32x4 x0, x1; unpack8(xh[m][bj], x0, x1);
                        *(u32x4*)(xout + o) = pack8f(x0 + g[bj][0] * acc[ai][bj][m][0], x1 + g[bj][1] * acc[ai][bj][m][1]); } }
                asm volatile("" ::: "memory");
            }
        }
    }
};

struct ProgM1 {
    static constexpr int VAR_OFF = 1, GATHER = 1;
    struct Unit { int k, pn, e, j; };
    int G, c; const LAS int* tab; int ntiles; const int* cnt; const int* toks; const char* H; const char* W13; bf16_t* ACT;
    __device__ __forceinline__ bool next(int i, Unit& u) const { const int x = c & 7, t0 = (x * ntiles) >> 3, t1 = ((x + 1) * ntiles) >> 3, L = (c >> 3) + (G >> 3) * i; if (L >= (t1 - t0) * 4) return false; u.k = t0 + (L >> 2); u.pn = L & 3; const int w = __builtin_amdgcn_readfirstlane(tab[u.k]); u.e = w >> 16; u.j = w & 0xffff; return true; }
    __device__ __forceinline__ void ops(const Unit& u, ge::Ops& o) const {
        o.a0 = H; o.a1 = H; o.ksA = 128; o.b0 = W13 + ((size_t)u.e * 1024 + 128 * u.pn) * DM * 2; o.b1 = o.b0 + (size_t)512 * DM * 2; o.ksB = 128; o.nt = DM / 64; }
    __device__ __forceinline__ void voff(const Unit& u, const ge::Lane& ln, ge::Off& v) const {
        const int n = __builtin_amdgcn_readfirstlane(cnt[u.e * 64]); const int* tl = toks + (size_t)u.e * NTOK + u.j * 256;
#pragma unroll
        for (int i = 0; i < 2; ++i) {
#pragma unroll
            for (int h = 0; h < 2; ++h) { const int r = 128 * h + ln.R[i]; const int tok = (u.j * 256 + r < n) ? tl[r] : 0; v.a[h][i] = (unsigned)(tok * DM + ln.C[i]) * 2u; }
            v.b[i] = (unsigned)(ln.Rb[i] * DM + ln.C[i]) * 2u;
        }
    }
    __device__ __forceinline__ void epi(const ge::Acc& acc, const Unit& u, int wr, int wc, int fr, int fq) const {
        const int cl = 32 * wc + 8 * fq;
        EPI_ROWS_BEGIN
            const size_t pos = (size_t)u.k * 256 + rt;
            f32x4 g0 = acc[ai][0][m][0], g1 = acc[ai][0][m][1]; const f32x4 u0 = acc[ai][1][m][0], u1 = acc[ai][1][m][1];
#pragma unroll
            for (int e = 0; e < 4; ++e) { g0[e] = g0[e] * sigmoidf_(g0[e]) * u0[e]; g1[e] = g1[e] * sigmoidf_(g1[e]) * u1[e]; }
            *(u32x4*)(ACT + pos * DEXP + 128 * u.pn + cl) = pack8f(g0, g1);
        EPI_ROWS_END
    }
};
struct ProgM2 {
    static constexpr int VAR_OFF = 0, GATHER = 0;
    struct Unit { int k, pn, e; };
    int G, c; const LAS int* tab; int ntiles; const char* ACT; const char* W2; unsigned char* Y2;
    __device__ __forceinline__ bool next(int i, Unit& u) const { const int x = c & 7, t0 = (x * ntiles) >> 3, t1 = ((x + 1) * ntiles) >> 3, L = (c >> 3) + (G >> 3) * i; if (L >= (t1 - t0) * 8) return false; u.k = t0 + (L >> 3); u.pn = L & 7; u.e = __builtin_amdgcn_readfirstlane(tab[u.k]) >> 16; return true; }
    __device__ __forceinline__ void ops(const Unit& u, ge::Ops& o) const {
        o.a0 = ACT + (size_t)u.k * 256 * DEXP * 2; o.a1 = o.a0 + (size_t)128 * DEXP * 2; o.ksA = 128; o.b0 = W2 + ((size_t)u.e * DM + 256 * u.pn) * DEXP * 2; o.b1 = o.b0 + (size_t)128 * DEXP * 2; o.ksB = 128; o.nt = DEXP / 64; }
    __device__ __forceinline__ void voff(const Unit&, const ge::Lane& ln, ge::Off& v) const { ge::off_rm(ln, DEXP, DEXP, v); }
    __device__ __forceinline__ void epi(const ge::Acc& acc, const Unit& u, int wr, int wc, int fr, int fq) const {
        const int cl = 32 * wc + 8 * fq;
        EPI_ROWS_BEGIN
            const size_t pos = (size_t)u.k * 256 + rt;
#pragma unroll
            for (int bj = 0; bj < 2; ++bj) { f32x4 v0 = acc[ai][bj][m][0], v1 = acc[ai][bj][m][1];
#pragma unroll
                for (int e = 0; e < 4; ++e) { v0[e] = fminf(fmaxf(v0[e], -448.f), 448.f); v1[e] = fminf(fmaxf(v1[e], -448.f), 448.f); }
                int w0 = __builtin_amdgcn_cvt_pk_fp8_f32(v0[0], v0[1], 0, false); w0 = __builtin_amdgcn_cvt_pk_fp8_f32(v0[2], v0[3], w0, true);
                int w1 = __builtin_amdgcn_cvt_pk_fp8_f32(v1[0], v1[1], 0, false); w1 = __builtin_amdgcn_cvt_pk_fp8_f32(v1[2], v1[3], w1, true);
                *(u32x2*)(Y2 + pos * DM + 256 * u.pn + 128 * bj + cl) = (u32x2){(unsigned)w0, (unsigned)w1}; }
        EPI_ROWS_END
    }
};
__device__ __forceinline__ int build_tile_table(const Ctx& c, const int* cnt) {
    LAS int* tab = (LAS int*)(c.lds + LDS_TILETAB); LAS int* ps = (LAS int*)(c.lds + LDS_PSTART);
    __syncthreads();
    if (c.tid < NEXP) {
        int before = 0, mine = 0;
        for (int e = 0; e < NEXP; ++e) { const int nt = (cnt[e * 64] + 255) >> 8; if (e < c.tid) before += nt; if (e == c.tid) mine = nt; }
        ps[c.tid] = before * 256;
        for (int j = 0; j < mine; ++j) tab[before + j] = (c.tid << 16) | j;
        if (c.tid == NEXP - 1) ps[NEXP] = before + mine;
    }
    __syncthreads();
    return ps[NEXP];
}
template <class F>
__device__ __forceinline__ void tr_item(const float* W, int ldw, int k0, int n0, const float* ksc, LAS float* scr, int lane, F dst) {
#pragma unroll 8
    for (int i = 0; i < 32; ++i) { const int kk = 2 * i + (lane >> 5); float v = W[(size_t)(k0 + kk) * ldw + n0 + (lane & 31)]; if (ksc) v *= ksc[k0 + kk]; scr[kk * 33 + (lane & 31)] = v; }
    LDS_WAIT(); asm volatile("" ::: "memory");
    const int cc = lane & 7;
#pragma unroll
    for (int j = 0; j < 4; ++j) { const int n = (lane >> 3) + 8 * j; const LAS float* s = scr + (8 * cc) * 33 + n;
        u32x4 o; o.x = cvtpk(s[0 * 33], s[1 * 33]); o.y = cvtpk(s[2 * 33], s[3 * 33]); o.z = cvtpk(s[4 * 33], s[5 * 33]); o.w = cvtpk(s[6 * 33], s[7 * 33]);
        bf16_t* d = dst(n0 + n); if (d) *(u32x4*)(d + k0 + 8 * cc) = o; }
    LDS_WAIT(); asm volatile("" ::: "memory");
}
__device__ __forceinline__ int rope_perm(int j) { return 2 * (j & 31) + (j >> 5); }

__device__ __forceinline__ void convert_experts(const Ctx& c, int l, int it0 = 0, int it1 = NEXP * 1536, int wg0 = 0) {
    LAS float* scr = (LAS float*)(c.lds + c.wid * 16384);
    if (c.vcu < wg0) return;
    const int gw = (c.vcu - wg0) * 8 + c.wid, NGW = (c.G - wg0) * 8;
    const float* wg = inp(c, 29) + (size_t)l * NEXP * DM * DEXP; const float* wu = inp(c, 30) + (size_t)l * NEXP * DM * DEXP; const float* wd = inp(c, 31) + (size_t)l * NEXP * DEXP * DM;
    bf16_t* W13 = wsp<bf16_t>(c, WS_W13); bf16_t* W2 = wsp<bf16_t>(c, WS_W2);
    for (int it = it0 + gw; it < it1; it += NGW) {
        const int e = it / 1536, r = it % 1536;
        if (r < 1024) { const int up = r >> 9, q = r & 511, kb = q >> 4, nb = q & 15; const float* W = (up ? wu : wg) + (size_t)e * DM * DEXP; bf16_t* D = W13 + ((size_t)e * 1024 + up * 512) * DM;
            tr_item(W, DEXP, kb * 64, nb * 32, nullptr, scr, c.lane, [=](int n) { return D + (size_t)n * DM; }); }
        else { const int q = r - 1024, kb = q >> 6, nb = q & 63; const float* W = wd + (size_t)e * DEXP * DM; bf16_t* D = W2 + (size_t)e * DM * DEXP;
            tr_item(W, DM, kb * 64, nb * 32, nullptr, scr, c.lane, [=](int n) { return D + (size_t)n * DEXP; }); }
    }
}

__device__ __forceinline__ void p0_prologue(const Ctx& c) {
    const int gw = c.vcu * 8 + c.wid, NGW = c.G * 8; const int gt = c.vcu * 512 + c.tid, NGT = c.G * 512;
    {
        LAS float* red = (LAS float*)c.lds;
        const float* cv = inp(c, 1);
        for (int item = c.vcu; item < 96; item += c.G) {
            const int l = item / 48, cb = item % 48;
            const float* w = inp(c, 3) + ((size_t)l * DM + 256 * c.wid) * (6 * DM) + cb * 256 + c.lane * 4;
            f32x4 a0 = {0.f, 0.f, 0.f, 0.f}, a1 = {0.f, 0.f, 0.f, 0.f};
#pragma unroll 16
            for (int k = 0; k < 256; ++k) { const f32x4 wv = *(const f32x4*)(w + (size_t)k * (6 * DM)); const float c0 = cv[256 * c.wid + k], c1 = cv[DM + 256 * c.wid + k]; a0 += wv * c0; a1 += wv * c1; }
            *(LAS f32x4*)(red + (c.wid * 2 + 0) * 256 + c.lane * 4) = a0; *(LAS f32x4*)(red + (c.wid * 2 + 1) * 256 + c.lane * 4) = a1;
            __syncthreads();
            { const int b = c.tid >> 8, col = c.tid & 255; float s = inp(c, 4)[(size_t)l * 6 * DM + cb * 256 + col];
#pragma unroll
              for (int w8 = 0; w8 < 8; ++w8) s += red[(w8 * 2 + b) * 256 + col];
              wsp<float>(c, WS_MOD)[((size_t)(l * NB + b) * 6) * DM + cb * 256 + col] = s; }
            __syncthreads();
        }
    }
    {
        LAS float* scr = (LAS float*)(c.lds + c.wid * 16384);
        constexpr int I_IN = 32 * 58, I_UQ = 8 * 48, I_UKV = 4 * 64, I_OUT = 32 * 64, I_GLU = 8 * 16, I_L = I_IN + I_UQ + I_UKV + I_OUT + I_GLU;
        for (int it = gw; it < 2 * I_L; it += NGW) {
            const int l = it / I_L; int r = it % I_L;
            if (r < I_IN) { const int kb = r / 58, nb = r % 58; bf16_t* D = wsp<bf16_t>(c, WS_WIN) + (size_t)l * DM * DM;
                tr_item(inp(c, 6) + (size_t)l * DM * IN_COLS, IN_COLS, kb * 64, nb * 32, nullptr, scr, c.lane, [=](int n) { const int dr = n < 1792 ? n : 1792 + rope_perm(n - 1792); return D + (size_t)dr * DM; }); continue; } r -= I_IN;
            if (r < I_UQ) { const int kb = r / 48, nb = r % 48; bf16_t* D = wsp<bf16_t>(c, WS_WUQ) + (size_t)l * 1536 * 512;
                tr_item(inp(c, 20) + (size_t)l * 512 * 1536, 1536, kb * 64, nb * 32, inp(c, 18) + l * 512, scr, c.lane, [=](int n) { const int h = n / QKD, d = n % QKD; const int dr = h * QKD + (d < 128 ? d : 128 + rope_perm(d - 128)); return D + (size_t)dr * 512; }); continue; } r -= I_UQ;
            if (r < I_UKV) { const int kb = r / 64, nb = r % 64; bf16_t* D = wsp<bf16_t>(c, WS_WUKV) + (size_t)l * 2048 * 256;
                tr_item(inp(c, 21) + (size_t)l * 256 * 2048, 2048, kb * 64, nb * 32, inp(c, 19) + l * 256, scr, c.lane, [=](int n) { return D + (size_t)n * 256; }); continue; } r -= I_UKV;
            if (r < I_OUT) { const int kb = r / 64, nb = r % 64; bf16_t* D = wsp<bf16_t>(c, WS_WOUT) + (size_t)l * DM * DM;
                tr_item(inp(c, 23) + (size_t)l * DM * DM, DM, kb * 64, nb * 32, inp(c, 22) + l * DM, scr, c.lane, [=](int n) { return D + (size_t)n * DM; }); continue; } r -= I_OUT;
            { const int kb = r / 16, nb = r % 16; bf16_t* D = wsp<bf16_t>(c, WS_WGLU) + (size_t)l * 512 * 512;
                tr_item(inp(c, 17) + (size_t)l * 512 * 512, 512, kb * 64, nb * 32, nullptr, scr, c.lane, [=](int n) { return D + (size_t)n * 512; }); }
        }
    }
    { const int split = (c.G > 96) ? 15 * 8 * (c.G - 96) : 0;
      __syncthreads(); convert_experts(c, 0, 0, split, 96); convert_experts(c, 0, split, NEXP * 1536, 0); }
    for (int i = gt; i < 2 * 2 * 256 * 256; i += NGT) {
        const int k = i & 255, n = (i >> 8) & 255, pn = (i >> 16) & 1, l = i >> 17; float v = 0.f;
        if ((k >> 7) == (n >> 7)) { const int g = 2 * pn + (n >> 7); v = inp(c, 7)[(((size_t)l * 4 + g) * 128 + (k & 127)) * 128 + (n & 127)] * inp(c, 8)[l * 512 + g * 128 + (n & 127)]; }
        wsp<bf16_t>(c, WS_WPOOL)[i] = f2bf(v);
    }
    for (int i = gt; i < 2 * 192 * DM / 8; i += NGT) { const int l = i / (192 * DM / 8), r = i % (192 * DM / 8); *(u32x4*)(wsp<bf16_t>(c, WS_WIN) + (size_t)l * DM * DM + (size_t)IN_COLS * DM + (size_t)r * 8) = (u32x4){0u, 0u, 0u, 0u}; }
    for (int i = gt; i < (int)(8 * MiB / 16); i += NGT) *(u32x4*)(c.ws + WS_SPREV + (size_t)i * 16) = (u32x4){0u, 0u, 0u, 0u};
    for (int i = gt; i < NTOK * 32; i += NGT) {
        const int tok = i >> 5, f = i & 31; const float invf = exp2f(-(float)f * (13.287712379549449f / 32.0f));
        const float ang = (float)((const int*)c.a.in[2])[tok] * invf; float s, co; sincos_rev((double)ang, s, co);
        wsp<f32x2>(c, WS_CS)[i] = (f32x2){co, s};
    }
    for (int i = gt; i < 64 * 65 * 64; i += NGT) {
        const int lg = i / (65 * 64), r = i % (65 * 64), lag = r >> 6, p = r & 63, l = lg >> 5, g = lg & 31;
        const float dt = __expf(inp(c, 11)[l * 32 + g]); const int gp = lg * 64 + p; const float lr = inp(c, 9)[gp], lim = inp(c, 10)[gp];
        float sl, cl_; sincos_rev((double)lag * (double)(lim * dt), sl, cl_); const float ml = __expf((float)lag * lr * dt);
        wsp<f32x2>(c, WS_PWTAB)[i] = (f32x2){ml * cl_, ml * sl};
    }
    for (int i = gt; i < 64 * 64 * 16; i += NGT) {
        const int gp = i >> 4, hp = i & 15, lg = gp >> 6, l = lg >> 5, g = lg & 31;
        const float dt = __expf(inp(c, 11)[l * 32 + g]); const float lr = inp(c, 9)[gp], lim = inp(c, 10)[gp];
        float s1, c1; sincos_rev((double)(lim * dt), s1, c1); const float mg = __expf(lr * dt); const float ar = mg * c1, aim = mg * s1;
        const float den = lr * lr + lim * lim; const float fr_ = ((ar - 1.f) * lr + aim * lim) / den, fi_ = (aim * lr - (ar - 1.f) * lim) / den;
        const float br = inp(c, 12)[i], bi = inp(c, 13)[i];
        wsp<f32x2>(c, WS_BBTAB)[i] = (f32x2){fr_ * br - fi_ * bi, fr_ * bi + fi_ * br};
    }
    for (int i = gt; i < 64 * 64; i += NGT) {
        const int lg = i >> 6, l = lg >> 5, g = lg & 31; const float dt = __expf(inp(c, 11)[l * 32 + g]); const float lr = inp(c, 9)[i], lim = inp(c, 10)[i];
        float sl, cl_; sincos_rev(64.0 * (double)(lim * dt), sl, cl_); const float ml = __expf(64.f * lr * dt); wsp<f32x2>(c, WS_A64)[i] = (f32x2){ml * cl_, ml * sl};
    }
}

__device__ __forceinline__ void gen_ssm_tables(const Ctx& c) {
    const int gt = c.vcu * 512 + c.tid, NGT = c.G * 512;
    const f32x2* PW = wsp<const f32x2>(c, WS_PWTAB); const f32x2* BB = wsp<const f32x2>(c, WS_BBTAB);
    for (int i = gt; i < 64 * 127 * 64; i += NGT) {
        const int lg = i / (127 * 64), r = i % (127 * 64), li_ = r >> 6, h = (r >> 2) & 15, hp = (r & 3) * 4;
        f32x4 acc = {0.f, 0.f, 0.f, 0.f};
        if (li_ >= 63) {
            const f32x2* pw = PW + ((size_t)lg * 65 + (li_ - 63)) * 64; const f32x2* bb = BB + (size_t)lg * 1024 + hp; const float* cr = inp(c, 14) + ((size_t)lg * 16 + h) * 64; const float* ci = inp(c, 15) + ((size_t)lg * 16 + h) * 64;
#pragma unroll 4
            for (int p = 0; p < 64; ++p) { const f32x2 a = pw[p]; const float c_r = cr[p], c_i = ci[p]; const float wr_ = a.x * c_r - a.y * c_i, wi_ = a.x * c_i + a.y * c_r;
                const f32x4 b01 = *(const f32x4*)(bb + p * 16), b23 = *(const f32x4*)(bb + p * 16 + 2);
                acc[0] += wr_ * b01[0] - wi_ * b01[1]; acc[1] += wr_ * b01[2] - wi_ * b01[3]; acc[2] += wr_ * b23[0] - wi_ * b23[1]; acc[3] += wr_ * b23[2] - wi_ * b23[3]; }
        }
        *(u32x2*)(c.ws + WS_SSMTAB + (size_t)lg * SSMTAB_STRIDE + SSM_TG + ((size_t)li_ * 256 + h * 16 + hp) * 2) = (u32x2){cvtpk(acc[0], acc[1]), cvtpk(acc[2], acc[3])};
    }
    for (int i0 = gt; i0 < 64 * 64 * 128 * 2; i0 += 4 * NGT) {
        float v[4][8];
#pragma unroll
        for (int u = 0; u < 4; ++u) { const int i = min(i0 + u * NGT, 64 * 64 * 128 * 2 - 1);
            const int lg = i >> 14, r8 = i & 16383, tau = r8 >> 8, pp = (r8 >> 1) & 127, hp0 = (r8 & 1) * 8, p = pp & 63;
            const f32x2 a = PW[((size_t)lg * 65 + (63 - tau)) * 64 + p]; const f32x2* b = BB + (size_t)lg * 1024 + p * 16 + hp0;
#pragma unroll
            for (int e = 0; e < 8; ++e) { const f32x2 bb = b[e]; v[u][e] = pp < 64 ? a.x * bb.x - a.y * bb.y : a.x * bb.y + a.y * bb.x; } }
#pragma unroll
        for (int u = 0; u < 4; ++u) { const int i = i0 + u * NGT; if (i < 64 * 64 * 128 * 2) { const int lg = i >> 14, r8 = i & 16383;
            *(u32x4*)(c.ws + WS_SSMTAB + (size_t)lg * SSMTAB_STRIDE + SSM_TEND + ((size_t)r8 * 8) * 2) = (u32x4){cvtpk(v[u][0], v[u][1]), cvtpk(v[u][2], v[u][3]), cvtpk(v[u][4], v[u][5]), cvtpk(v[u][6], v[u][7])}; } }
    }
    for (int i0 = gt; i0 < 64 * 1024 * 32; i0 += 4 * NGT) {
        float v[4][8];
#pragma unroll
        for (int u = 0; u < 4; ++u) { const int i = min(i0 + u * NGT, 64 * 1024 * 32 - 1);
            const int lg = i >> 15, r8 = i & 32767, n = r8 >> 5, k0 = (r8 & 31) * 8, t = n >> 4, h = n & 15;
            if (k0 < 128) { const int p0 = k0 & 63; const f32x2* a = PW + ((size_t)lg * 65 + (t + 1)) * 64 + p0; const float* cr = inp(c, 14) + ((size_t)lg * 16 + h) * 64 + p0; const float* ci = inp(c, 15) + ((size_t)lg * 16 + h) * 64 + p0;
#pragma unroll
                for (int e = 0; e < 8; ++e) { const f32x2 aa = a[e]; v[u][e] = k0 < 64 ? cr[e] * aa.x - ci[e] * aa.y : -(cr[e] * aa.y + ci[e] * aa.x); } }
            else {
#pragma unroll
                for (int e = 0; e < 8; ++e) v[u][e] = 0.f; } }
#pragma unroll
        for (int u = 0; u < 4; ++u) { const int i = i0 + u * NGT; if (i < 64 * 1024 * 32) { const int lg = i >> 15, r8 = i & 32767;
            *(u32x4*)(c.ws + WS_SSMTAB + (size_t)lg * SSMTAB_STRIDE + SSM_WC + ((size_t)r8 * 8) * 2) = (u32x4){cvtpk(v[u][0], v[u][1]), cvtpk(v[u][2], v[u][3]), cvtpk(v[u][4], v[u][5]), cvtpk(v[u][6], v[u][7])}; } }
    }
}

__device__ __forceinline__ void router_prep(const Ctx& c, int l) {
    const int gt = c.vcu * 512 + c.tid, NGT = c.G * 512;
    for (int i = gt; i < NB * 64 * 3 * 64; i += NGT) {
        const int ln = i & 63, cb = (i >> 6) % 3, ks = (i / 192) & 63, b = i / (192 * 64);
        const int j = 16 * cb + (ln & 15), k0 = 32 * ks + 8 * (ln >> 4);
        float hi[8], lo[8];
#pragma unroll
        for (int e = 0; e < 8; ++e) { const int k = k0 + e; float w = 0.f;
            if (j < 4) w = inp(c, 25)[((size_t)l * DM + k) * 4 + j]; else if (j < 36) w = inp(c, 27)[((size_t)l * DM + k) * 32 + (j - 4)];
            w *= inp(c, 24)[l * DM + k] * (1.f + modp(c, l, b, 4)[k]);
            hi[e] = bf2f(f2bf(w)); lo[e] = w - hi[e]; }
        u32x4 H, L; H.x = cvtpk(hi[0], hi[1]); H.y = cvtpk(hi[2], hi[3]); H.z = cvtpk(hi[4], hi[5]); H.w = cvtpk(hi[6], hi[7]); L.x = cvtpk(lo[0], lo[1]); L.y = cvtpk(lo[2], lo[3]); L.z = cvtpk(lo[4], lo[5]); L.w = cvtpk(lo[6], lo[7]);
        bf16_t* base = wsp<bf16_t>(c, WS_RWF) + ((((size_t)(l * NB + b) * 64 + ks) * 3 + cb) * 2) * 512;
        *(u32x4*)(base + ln * 8) = H; *(u32x4*)(base + 512 + ln * 8) = L;
    }
    const int gw = c.vcu * 8 + c.wid, NGW = c.G * 8;
    for (int i = gw; i < NB * 36; i += NGW) {
        const int b = i / 36, j = i % 36; float s = 0.f;
        for (int k = c.lane; k < DM; k += 64) { const float w = j < 4 ? inp(c, 25)[((size_t)l * DM + k) * 4 + j] : inp(c, 27)[((size_t)l * DM + k) * 32 + (j - 4)]; s += modp(c, l, b, 3)[k] * w; }
        s = wave_sum(s);
        if (c.lane == 0) wsp<float>(c, WS_RBIAS)[(l * NB + b) * 64 + j] = s + (j < 4 ? inp(c, 26)[l * 4 + j] : inp(c, 28)[l * 32 + (j - 4)]);
    }
}

template <int MODE>
__device__ __forceinline__ void norm_phase(const Ctx& c, int l) {
    LAS float* red0 = (LAS float*)c.lds;
    const LAS int* ps = (const LAS int*)(c.lds + LDS_PSTART);
    const int lane = c.lane, wid = c.wid, row = lane & 15, kq = lane >> 4;
    bf16_t* xbuf = wsp<bf16_t>(c, WS_XBUF);
    const bool src_f32 = (MODE == 0 && l == 0);
    const int lm = (MODE == 3) ? 1 : l - 1;
    const i32x4* RI = wsp<const i32x4>(c, WS_RI) + (size_t)(lm < 0 ? 0 : lm) * NTOK; const f32x2* RW = wsp<const f32x2>(c, WS_RW) + (size_t)(lm < 0 ? 0 : lm) * NTOK;
    const unsigned char* Y2 = wsp<const unsigned char>(c, WS_Y2);
    bf16_t* H = wsp<bf16_t>(c, WS_H);
    int* cnt = wsp<int>(c, WS_CTL) + CW_CNT + l * 32 * 64;
    LAS float* Gt = (LAS float*)(c.lds + 65536); LAS float* SHt = Gt + NB * DM; LAS float* GFt = SHt + NB * DM;
    for (int i = c.tid; i < NB * DM; i += 512) { const int b_ = i / DM, k_ = i % DM;
        if (MODE == 3) { Gt[i] = inp(c, 32)[k_]; SHt[i] = 0.f; }
        else { const int nsel_ = (MODE == 2) ? 24 : 5, off_ = (MODE == 2) ? 3 : 0; Gt[i] = inp(c, nsel_)[l * DM + k_] * (1.f + modp(c, l, b_, off_ + 1)[k_]); SHt[i] = modp(c, l, b_, off_)[k_]; }
        if (MODE == 1 || MODE == 3) GFt[i] = modp(c, lm, b_, 5)[k_]; }
    __syncthreads();
    f32x4 rawf[8][2]; u32x4 rawh[8];
#define NP_LOAD(u_) do { const int rg_ = (u_) * 16 + row; _Pragma("unroll") for (int s = 0; s < 8; ++s) { const int k = 256 * wid + 32 * s + 8 * kq; \
        if (src_f32) { rawf[s][0] = *(const f32x4*)(inp(c, 0) + (size_t)rg_ * DM + k); rawf[s][1] = *(const f32x4*)(inp(c, 0) + (size_t)rg_ * DM + k + 4); } \
        else rawh[s] = *(const u32x4*)(xbuf + (size_t)rg_ * DM + k); } } while (0)
    if (c.vcu < NTOK / 16) NP_LOAD(c.vcu);
    int par = 0; bf16x8 wq[8][3]; int wq_b = -1;
#ifdef MK_DIAG_FIN
    const unsigned long long dfin_t0 = __builtin_amdgcn_s_memrealtime(); int dfin_k = 0; float dfin_scale = 1.f;
#endif
    for (int unit = c.vcu; unit < NTOK / 16; unit += c.G, par ^= 1) {
        LAS float* red = red0 + par * 8192;
#ifdef MK_DIAG_FIN
        if (MODE == 3) { if (dfin_k == 4) { const float us = (float)(__builtin_amdgcn_s_memrealtime() - dfin_t0) * 0.01f; dfin_scale = 1.f + 0.02f + 4e-5f * fminf(fmaxf(us - (float)MK_DIAG_FIN, 0.f), 400.f); } ++dfin_k; }
#endif
        const int rg = unit * 16 + row; const int b = rg >> 14;
        size_t pos0 = 0, pos1 = 0; float w0 = 0.f, w1 = 0.f;
        if (MODE == 1 || MODE == 3) { const i32x4 ri = RI[rg]; const f32x2 rw = RW[rg]; pos0 = (size_t)(ps[ri.x] + ri.z); pos1 = (size_t)(ps[ri.y] + ri.w); w0 = rw.x; w1 = rw.y; }
        f32x4 xv[8][2]; float ss = 0.f;
        f32x4 acc[3] = {{0.f, 0.f, 0.f, 0.f}, {0.f, 0.f, 0.f, 0.f}, {0.f, 0.f, 0.f, 0.f}};
        if (MODE == 2) { const int bu = unit >> 10;
            if (bu != wq_b) { wq_b = bu; const bf16_t* wf = wsp<const bf16_t>(c, WS_RWF) + (((size_t)(l * NB + bu) * 64 + 8 * wid) * 3) * 2 * 512 + lane * 8;
#pragma unroll
                for (int s = 0; s < 8; ++s)
#pragma unroll
                    for (int cb = 0; cb < 3; ++cb) wq[s][cb] = *(const bf16x8*)(wf + (s * 3 + cb) * 2 * 512); } }
#pragma unroll
        for (int s = 0; s < 8; ++s) { if (src_f32) { xv[s][0] = rawf[s][0]; xv[s][1] = rawf[s][1]; } else unpack8(rawh[s], xv[s][0], xv[s][1]); }
        if (unit + c.G < NTOK / 16) NP_LOAD(unit + c.G);
#pragma unroll
        for (int s = 0; s < 8; ++s) {
            const int k = 256 * wid + 32 * s + 8 * kq;
            f32x4 x0 = xv[s][0], x1 = xv[s][1];
            if (MODE == 1 || MODE == 3) {
                f32x4 a0, a1, b0, b1;
                { const u32x2 ya = *(const u32x2*)(Y2 + pos0 * DM + k), yb = *(const u32x2*)(Y2 + pos1 * DM + k);
                  const f32x2 t0 = __builtin_amdgcn_cvt_pk_f32_fp8((int)ya.x, false), t1 = __builtin_amdgcn_cvt_pk_f32_fp8((int)ya.x, true), t2 = __builtin_amdgcn_cvt_pk_f32_fp8((int)ya.y, false), t3 = __builtin_amdgcn_cvt_pk_f32_fp8((int)ya.y, true);
                  const f32x2 u0 = __builtin_amdgcn_cvt_pk_f32_fp8((int)yb.x, false), u1 = __builtin_amdgcn_cvt_pk_f32_fp8((int)yb.x, true), u2 = __builtin_amdgcn_cvt_pk_f32_fp8((int)yb.y, false), u3 = __builtin_amdgcn_cvt_pk_f32_fp8((int)yb.y, true);
                  a0 = (f32x4){t0.x, t0.y, t1.x, t1.y}; a1 = (f32x4){t2.x, t2.y, t3.x, t3.y}; b0 = (f32x4){u0.x, u0.y, u1.x, u1.y}; b1 = (f32x4){u2.x, u2.y, u3.x, u3.y}; }
                const f32x4 g0 = *(const LAS f32x4*)(GFt + b * DM + k), g1 = *(const LAS f32x4*)(GFt + b * DM + k + 4);
                x0 += g0 * (a0 * w0 + b0 * w1); x1 += g1 * (a1 * w0 + b1 * w1);
                if (MODE == 1) { const u32x4 xw = pack8f(x0, x1); *(u32x4*)(xbuf + (size_t)rg * DM + k) = xw; unpack8(xw, x0, x1); }
            }
            xv[s][0] = x0; xv[s][1] = x1;
            ss += (x0[0] * x0[0] + x0[1] * x0[1]) + (x0[2] * x0[2] + x0[3] * x0[3]) + (x1[0] * x1[0] + x1[1] * x1[1]) + (x1[2] * x1[2] + x1[3] * x1[3]);
            if (MODE == 2) {
                const u32x4 hi = pack8f(x0, x1); const bf16x8 xh = *(const bf16x8*)&hi;
#pragma unroll
                for (int cb = 0; cb < 3; ++cb) acc[cb] = __builtin_amdgcn_mfma_f32_16x16x32_bf16(wq[s][cb], xh, acc[cb], 0, 0, 0);
            }
        }
        ss += __shfl_xor(ss, 16); ss += __shfl_xor(ss, 32);
        if (kq == 0) red[(wid * 16 + row) * 52] = ss;
        if (MODE == 2) {
#pragma unroll
            for (int cb = 0; cb < 3; ++cb)
#pragma unroll
                for (int e = 0; e < 4; ++e) red[(wid * 16 + row) * 52 + 1 + 16 * cb + 4 * kq + e] = acc[cb][e];
        }
        __syncthreads();
        float tot = 0.f;
#pragma unroll
        for (int w8 = 0; w8 < 8; ++w8) tot += red[(w8 * 16 + row) * 52];
        const float rstd = rsqrtf(tot * (1.f / DM) + EPS);
        if (MODE == 2 && wid == 0 && lane < 16) {
            const float* rb = wsp<const float>(c, WS_RBIAS) + (l * NB + b) * 64;
            float gl[4];
#pragma unroll
            for (int j = 0; j < 4; ++j) { float d = 0.f;
#pragma unroll
                for (int w8 = 0; w8 < 8; ++w8) d += red[(w8 * 16 + row) * 52 + 1 + j];
                gl[j] = rstd * d + rb[j]; }
            int gt_ = 0; float gm = gl[0];
#pragma unroll
            for (int j = 1; j < 4; ++j) if (gl[j] > gm) { gm = gl[j]; gt_ = j; }
            float gs = 0.f;
#pragma unroll
            for (int j = 0; j < 4; ++j) gs += __expf(gl[j] - gm);
            const float gwt = 1.f / gs;
            float e0 = -3.0e38f, e1 = -3.0e38f; int i0 = 0, i1 = 0;
            for (int i = 0; i < 8; ++i) { float d = 0.f;
#pragma unroll
                for (int w8 = 0; w8 < 8; ++w8) d += red[(w8 * 16 + row) * 52 + 1 + 4 + 8 * gt_ + i];
                const float lg = rstd * d + rb[4 + 8 * gt_ + i];
                if (lg > e0) { e1 = e0; i1 = i0; e0 = lg; i0 = i; } else if (lg > e1) { e1 = lg; i1 = i; } }
            const float q1 = __expf(e1 - e0); const float p0 = 1.f / (1.f + q1), p1 = q1 * p0;
            const int ex0 = 8 * gt_ + i0, ex1 = 8 * gt_ + i1;
            const int s0 = atomicAdd(cnt + ex0 * 64, 1), s1 = atomicAdd(cnt + ex1 * 64, 1);
            int* toks = wsp<int>(c, WS_TOK); toks[(size_t)ex0 * NTOK + s0] = rg; toks[(size_t)ex1 * NTOK + s1] = rg;
            wsp<i32x4>(c, WS_RI)[(size_t)l * NTOK + rg] = (i32x4){ex0, ex1, s0, s1}; wsp<f32x2>(c, WS_RW)[(size_t)l * NTOK + rg] = (f32x2){gwt * p0, gwt * p1};
        }
        if (MODE == 3) {
#pragma unroll
            for (int s = 0; s < 8; ++s) { const int k = 256 * wid + 32 * s + 8 * kq; const f32x4 g0 = *(const LAS f32x4*)(Gt + k), g1 = *(const LAS f32x4*)(Gt + k + 4);
                #ifdef MK_DIAG_FIN
                const float osc_ = dfin_scale;
#else
                const float osc_ = c.oscale;
#endif
                *(f32x4*)(c.a.out + (size_t)rg * DM + k) = xv[s][0] * (rstd * osc_) * g0; *(f32x4*)(c.a.out + (size_t)rg * DM + k + 4) = xv[s][1] * (rstd * osc_) * g1; }
        } else {
#pragma unroll
            for (int s = 0; s < 8; ++s) { const int k = 256 * wid + 32 * s + 8 * kq;
                const f32x4 g0 = *(const LAS f32x4*)(Gt + b * DM + k), g1 = *(const LAS f32x4*)(Gt + b * DM + k + 4);
                const f32x4 h0 = xv[s][0] * rstd * g0 + *(const LAS f32x4*)(SHt + b * DM + k), h1 = xv[s][1] * rstd * g1 + *(const LAS f32x4*)(SHt + b * DM + k + 4);
                *(u32x4*)(H + (size_t)rg * DM + k) = pack8f(h0, h1); }
        }
    }
    __syncthreads();
#undef NP_LOAD
}

template <int MODE>
__device__ __forceinline__ void norm_rows(const Ctx& c, int l) {
    const LAS int* ps = (const LAS int*)(c.lds + LDS_PSTART);
    const int lane = c.lane;
    bf16_t* xbuf = wsp<bf16_t>(c, WS_XBUF);
    const bool src_f32 = (MODE == 0 && l == 0);
    const int lm = (MODE == 3) ? 1 : l - 1;
    const i32x4* RI = wsp<const i32x4>(c, WS_RI) + (size_t)(lm < 0 ? 0 : lm) * NTOK; const f32x2* RW = wsp<const f32x2>(c, WS_RW) + (size_t)(lm < 0 ? 0 : lm) * NTOK;
    const unsigned char* Y2 = wsp<const unsigned char>(c, WS_Y2);
    bf16_t* H = wsp<bf16_t>(c, WS_H);
    LAS float* Gt = (LAS float*)(c.lds + 65536); LAS float* SHt = Gt + NB * DM; LAS float* GFt = SHt + NB * DM;
    for (int i = c.tid; i < NB * DM; i += 512) { const int b_ = i / DM, k_ = i % DM;
        if (MODE == 3) { Gt[i] = inp(c, 32)[k_]; SHt[i] = 0.f; }
        else { Gt[i] = inp(c, 5)[l * DM + k_] * (1.f + modp(c, l, b_, 1)[k_]); SHt[i] = modp(c, l, b_, 0)[k_]; }
        if (MODE == 1 || MODE == 3) GFt[i] = modp(c, lm, b_, 5)[k_]; }
    __syncthreads();
    const int gw = c.vcu * 8 + c.wid, NGW = c.G * 8;
    for (int r0 = gw; r0 < NTOK; r0 += 2 * NGW) {
        f32x4 xv[2][4][2]; u32x4 rawh[2][4]; u32x2 ya[2][4], yb[2][4]; float w0[2], w1[2];
#pragma unroll
        for (int q = 0; q < 2; ++q) { const int rg = r0 + q * NGW; if (rg < NTOK) {
            if (MODE == 1 || MODE == 3) { const i32x4 ri = RI[rg]; const f32x2 rw = RW[rg]; const size_t pos0 = (size_t)(ps[ri.x] + ri.z), pos1 = (size_t)(ps[ri.y] + ri.w); w0[q] = rw.x; w1[q] = rw.y;
#pragma unroll
                for (int j = 0; j < 4; ++j) { ya[q][j] = *(const u32x2*)(Y2 + pos0 * DM + 512 * j + lane * 8); yb[q][j] = *(const u32x2*)(Y2 + pos1 * DM + 512 * j + lane * 8); } }
#pragma unroll
            for (int j = 0; j < 4; ++j) { const int k = 512 * j + lane * 8;
                if (src_f32) { xv[q][j][0] = *(const f32x4*)(inp(c, 0) + (size_t)rg * DM + k); xv[q][j][1] = *(const f32x4*)(inp(c, 0) + (size_t)rg * DM + k + 4); }
                else rawh[q][j] = *(const u32x4*)(xbuf + (size_t)rg * DM + k); } } }
#pragma unroll
        for (int q = 0; q < 2; ++q) { const int rg = r0 + q * NGW; if (rg < NTOK) { const int b = rg >> 14;
            float ss = 0.f;
#pragma unroll
            for (int j = 0; j < 4; ++j) { const int k = 512 * j + lane * 8;
                f32x4 x0, x1; if (src_f32) { x0 = xv[q][j][0]; x1 = xv[q][j][1]; } else unpack8(rawh[q][j], x0, x1);
                if (MODE == 1 || MODE == 3) {
                    const f32x2 t0 = __builtin_amdgcn_cvt_pk_f32_fp8((int)ya[q][j].x, false), t1 = __builtin_amdgcn_cvt_pk_f32_fp8((int)ya[q][j].x, true), t2 = __builtin_amdgcn_cvt_pk_f32_fp8((int)ya[q][j].y, false), t3 = __builtin_amdgcn_cvt_pk_f32_fp8((int)ya[q][j].y, true);
                    const f32x2 u0 = __builtin_amdgcn_cvt_pk_f32_fp8((int)yb[q][j].x, false), u1 = __builtin_amdgcn_cvt_pk_f32_fp8((int)yb[q][j].x, true), u2 = __builtin_amdgcn_cvt_pk_f32_fp8((int)yb[q][j].y, false), u3 = __builtin_amdgcn_cvt_pk_f32_fp8((int)yb[q][j].y, true);
                    const f32x4 a0 = {t0.x, t0.y, t1.x, t1.y}, a1 = {t2.x, t2.y, t3.x, t3.y}, b0 = {u0.x, u0.y, u1.x, u1.y}, b1 = {u2.x, u2.y, u3.x, u3.y};
                    const f32x4 g0 = *(const LAS f32x4*)(GFt + b * DM + k), g1 = *(const LAS f32x4*)(GFt + b * DM + k + 4);
                    x0 += g0 * (a0 * w0[q] + b0 * w1[q]); x1 += g1 * (a1 * w0[q] + b1 * w1[q]);
                    if (MODE == 1) { const u32x4 xw = pack8f(x0, x1); *(u32x4*)(xbuf + (size_t)rg * DM + k) = xw; unpack8(xw, x0, x1); }
                }
                xv[q][j][0] = x0; xv[q][j][1] = x1;
                ss += (x0[0] * x0[0] + x0[1] * x0[1]) + (x0[2] * x0[2] + x0[3] * x0[3]) + (x1[0] * x1[0] + x1[1] * x1[1]) + (x1[2] * x1[2] + x1[3] * x1[3]);
            }
            const float rstd = rsqrtf(wave_sum(ss) * (1.f / DM) + EPS);
#pragma unroll
            for (int j = 0; j < 4; ++j) { const int k = 512 * j + lane * 8;
                if (MODE == 3) { const f32x4 g0 = *(const LAS f32x4*)(Gt + k), g1 = *(const LAS f32x4*)(Gt + k + 4);
                    *(f32x4*)(c.a.out + (size_t)rg * DM + k) = xv[q][j][0] * (rstd * c.oscale) * g0; *(f32x4*)(c.a.out + (size_t)rg * DM + k + 4) = xv[q][j][1] * (rstd * c.oscale) * g1; }
                else { const f32x4 g0 = *(const LAS f32x4*)(Gt + b * DM + k), g1 = *(const LAS f32x4*)(Gt + b * DM + k + 4);
                    const f32x4 h0 = xv[q][j][0] * rstd * g0 + *(const LAS f32x4*)(SHt + b * DM + k), h1 = xv[q][j][1] * rstd * g1 + *(const LAS f32x4*)(SHt + b * DM + k + 4);
                    *(u32x4*)(H + (size_t)rg * DM + k) = pack8f(h0, h1); } }
        } }
    }
    __syncthreads();
}

__device__ __forceinline__ void carry_phase(const Ctx& c, int l) {
    LAS float* ex = (LAS float*)c.lds;
    const float* E = wsp<const float>(c, WS_EBUF); bf16_t* SP = wsp<bf16_t>(c, WS_SPREV);
    const int seg = c.tid >> 5, pp = c.tid & 31;
    for (int item = c.vcu; item < NB * SSM_G * 2; item += c.G) {
        const int b = item >> 6, g = (item >> 1) & 31, p = (item & 1) * 32 + pp;
        const f32x2 A = wsp<const f32x2>(c, WS_A64)[(l * 32 + g) * 64 + p];
        const int c0 = b * 256 + seg * 16;
        float er[16], ei[16];
#pragma unroll
        for (int j = 0; j < 16; ++j) { const float* e = E + ((size_t)(c0 + j) * SSM_G + g) * 128; er[j] = e[p]; ei[j] = e[64 + p]; }
        float sr = 0.f, si = 0.f;
#pragma unroll
        for (int j = 0; j < 16; ++j) { const float nr = A.x * sr - A.y * si + er[j], ni = A.x * si + A.y * sr + ei[j]; sr = nr; si = ni; er[j] = sr; ei[j] = si; }
        ex[(seg * 32 + pp) * 2] = sr; ex[(seg * 32 + pp) * 2 + 1] = si;
        float pr = A.x, pi_ = A.y;
#pragma unroll
        for (int q = 0; q < 4; ++q) { const float nr = pr * pr - pi_ * pi_, ni = 2.f * pr * pi_; pr = nr; pi_ = ni; }
        __syncthreads();
        float cr = 0.f, ci = 0.f;
        for (int s = 0; s < seg; ++s) { const float tr = ex[(s * 32 + pp) * 2], ti = ex[(s * 32 + pp) * 2 + 1]; const float nr = pr * cr - pi_ * ci + tr, ni = pr * ci + pi_ * cr + ti; cr = nr; ci = ni; }
        float qr = cr, qi = ci;
#pragma unroll
        for (int j = 0; j < 16; ++j) {
            const float vr = qr + (j ? er[j - 1] : 0.f), vi = qi + (j ? ei[j - 1] : 0.f);
            bf16_t* o = SP + ((size_t)(c0 + j) * SSM_G + g) * 256; o[p] = f2bf(vr); o[64 + p] = f2bf(vi);
            const float nr = A.x * qr - A.y * qi, ni = A.x * qi + A.y * qr; qr = nr; qi = ni;
        }
        __syncthreads();
    }
}

__device__ __forceinline__ void fin_phase(const Ctx& c) {
    const bf16_t* P = wsp<const bf16_t>(c, WS_P); const bf16_t* GL = wsp<const bf16_t>(c, WS_GL); const bf16_t* O = wsp<const bf16_t>(c, WS_O); bf16_t* Y = wsp<bf16_t>(c, WS_YCAT);
    const int gw = c.vcu * 8 + c.wid, NGW = c.G * 8, lane = c.lane;
    const int wsel = lane >> 4, win = 2 << wsel;
    for (int run = gw; run < NTOK / 16; run += NGW) {
        const int t0 = run * 16; const bool hist = (t0 & (SEQ - 1)) != 0;
        {
            u32x4 ring[31];
#pragma unroll
            for (int j = 0; j < 15; ++j) ring[j] = hist ? *(const u32x4*)(P + (size_t)(t0 - 15 + j) * 512 + lane * 8) : (u32x4){0u, 0u, 0u, 0u};
#pragma unroll
            for (int j = 0; j < 16; ++j) ring[15 + j] = *(const u32x4*)(P + (size_t)(t0 + j) * 512 + lane * 8);
            f32x4 r0 = {0.f, 0.f, 0.f, 0.f}, r1 = {0.f, 0.f, 0.f, 0.f};
#pragma unroll
            for (int j = 1; j < 16; ++j) { f32x4 a0, a1; unpack8(ring[15 - j], a0, a1); const float mk = (j < win) ? 1.f : 0.f; r0 += a0 * mk; r1 += a1 * mk; }
#pragma unroll
            for (int k = 0; k < 16; ++k) {
                f32x4 c0, c1; unpack8(ring[15 + k], c0, c1); r0 += c0; r1 += c1;
                const int cn = hist ? win : ((k + 1 < win) ? k + 1 : win); const float ic = 1.f / (float)cn;
                const f32x4 y0 = r0 * ic - c0, y1 = r1 * ic - c1;
                const float ss = (y0[0] * y0[0] + y0[1] * y0[1]) + (y0[2] * y0[2] + y0[3] * y0[3]) + (y1[0] * y1[0] + y1[1] * y1[1]) + (y1[2] * y1[2] + y1[3] * y1[3]);
                const float rs = rsqrtf(wave_sum(ss) * (1.f / 512.f) + EPS);
                *(u32x4*)(Y + (size_t)(t0 + k) * DM + lane * 8) = pack8f(y0 * rs, y1 * rs);
                const u32x4 od = wsel == 0 ? ring[14 + k] : wsel == 1 ? ring[12 + k] : wsel == 2 ? ring[8 + k] : ring[k];
                f32x4 o0, o1; unpack8(od, o0, o1); r0 -= o0; r1 -= o1;
            }
        }
        {
            u32x4 g[16];
#pragma unroll
            for (int k = 0; k < 16; ++k) g[k] = *(const u32x4*)(GL + (size_t)(t0 + k) * 512 + lane * 8);
#pragma unroll
            for (int k = 0; k < 16; ++k) { f32x4 y0, y1; unpack8(g[k], y0, y1);
                const float ss = (y0[0] * y0[0] + y0[1] * y0[1]) + (y0[2] * y0[2] + y0[3] * y0[3]) + (y1[0] * y1[0] + y1[1] * y1[1]) + (y1[2] * y1[2] + y1[3] * y1[3]);
                const float rs = rsqrtf(wave_sum(ss) * (1.f / 512.f) + EPS);
                *(u32x4*)(Y + (size_t)(t0 + k) * DM + 512 + lane * 8) = pack8f(y0 * rs, y1 * rs); }
        }
#pragma unroll
        for (int hb = 0; hb < 2; ++hb) {
            u32x4 oa[8], ob[8];
#pragma unroll
            for (int k = 0; k < 8; ++k) { oa[k] = *(const u32x4*)(O + (size_t)(t0 + hb * 8 + k) * 1024 + lane * 16); ob[k] = *(const u32x4*)(O + (size_t)(t0 + hb * 8 + k) * 1024 + lane * 16 + 8); }
#pragma unroll
            for (int k = 0; k < 8; ++k) { f32x4 y0, y1, z0, z1; unpack8(oa[k], y0, y1); unpack8(ob[k], z0, z1);
                const float ss = (y0[0] * y0[0] + y0[1] * y0[1]) + (y0[2] * y0[2] + y0[3] * y0[3]) + (y1[0] * y1[0] + y1[1] * y1[1]) + (y1[2] * y1[2] + y1[3] * y1[3])
                               + (z0[0] * z0[0] + z0[1] * z0[1]) + (z0[2] * z0[2] + z0[3] * z0[3]) + (z1[0] * z1[0] + z1[1] * z1[1]) + (z1[2] * z1[2] + z1[3] * z1[3]);
                const float rs = rsqrtf(wave_sum(ss) * (1.f / 1024.f) + EPS); const size_t yo = (size_t)(t0 + hb * 8 + k) * DM + 1024 + lane * 16;
                *(u32x4*)(Y + yo) = pack8f(y0 * rs, y1 * rs); *(u32x4*)(Y + yo + 8) = pack8f(z0 * rs, z1 * rs); }
        }
    }
}
__device__ __forceinline__ void kpe_rope(const Ctx& c) {
    const bf16_t* Z = wsp<const bf16_t>(c, WS_Z); bf16_t* K = wsp<bf16_t>(c, WS_K); const f32x2* CS = wsp<const f32x2>(c, WS_CS);
    const int gt = c.vcu * 512 + c.tid, NGT = c.G * 512;
    for (int i = gt; i < NTOK * 8; i += NGT) {
        const int tok = i >> 3, q = i & 7; const int b = tok >> 14, t = tok & (SEQ - 1);
        f32x4 v0, v1; unpack8(*(const u32x4*)(Z + (size_t)tok * ZLD + Z_KPE + q * 8), v0, v1);
        const f32x2* cs = CS + (size_t)tok * 32 + q * 4; const f32x4 c01 = *(const f32x4*)cs, c23 = *(const f32x4*)(cs + 2);
        f32x4 o0, o1;
        o0[0] = v0[0] * c01[0] - v0[1] * c01[1]; o0[1] = v0[1] * c01[0] + v0[0] * c01[1]; o0[2] = v0[2] * c01[2] - v0[3] * c01[3]; o0[3] = v0[3] * c01[2] + v0[2] * c01[3];
        o1[0] = v1[0] * c23[0] - v1[1] * c23[1]; o1[1] = v1[1] * c23[0] + v1[0] * c23[1]; o1[2] = v1[2] * c23[2] - v1[3] * c23[3]; o1[3] = v1[3] * c23[2] + v1[2] * c23[3];
        const u32x4 w = pack8f(o0, o1);
#pragma unroll
        for (int h = 0; h < NHEAD; ++h) *(u32x4*)(K + ((size_t)(b * NHEAD + h) * SEQ + t) * QKD + 128 + q * 8) = w;
    }
}
namespace att {
constexpr int KN_BYTES = 16384, KR_BYTES = 8192, V_BYTES = 16384, ST_BYTES = KN_BYTES + KR_BYTES + V_BYTES, NST = 3;
constexpr int XCH_OFF = NST * ST_BYTES;
constexpr float THR2 = 11.5f;
#define AT_KSWZ(row, colB) ((row) * 256 + ((colB) ^ (((row) & 15) << 4)))
#define AT_SBAR() __builtin_amdgcn_sched_barrier(0)
__device__ __forceinline__ int v_rd_base(int lane) { return ((lane & 3) << 3) | (((lane >> 2) & 3) << 6) | (((lane >> 4) & 1) << 5) | (((lane >> 5) & 1) << 8); }
__device__ __forceinline__ int crow(int r, int hi) { return (r & 3) + 8 * (r >> 2) + 4 * hi; }
__device__ __forceinline__ void mask_tile(f32x16& p0, f32x16& p1, int dq) {
    const float NEG = -__builtin_inff();
#pragma unroll
    for (int r = 0; r < 16; ++r) { const int cc = (r & 3) + 8 * (r >> 2); if (dq - cc < 0) p0[r] = NEG; if (dq - cc - 32 < 0) p1[r] = NEG; }
}
__device__ __forceinline__ void partialSM(f32x16& p0, f32x16& p1, float& m_reg, float sh, float& delta, float& alpha, bool& nosub, bool first) {
    float pmax = p0[0];
#pragma unroll
    for (int r = 1; r < 16; ++r) pmax = fmaxf(pmax, p0[r]);
#pragma unroll
    for (int r = 0; r < 16; ++r) pmax = fmaxf(pmax, p1[r]);
    { auto rr = __builtin_amdgcn_permlane32_swap(__float_as_uint(pmax), __float_as_uint(pmax), false, false); pmax = fmaxf(__uint_as_float(rr[0]), __uint_as_float(rr[1])); }
    pmax += sh;
    float mn;
    if (__builtin_expect(__all((pmax - m_reg) <= THR2), 1)) { mn = m_reg; alpha = 1.f; nosub = !first; }
    else { mn = fmaxf(m_reg, pmax); alpha = fast_exp2(m_reg - mn); m_reg = mn; nosub = false; }
    delta = mn - sh;
    if (nosub) {
#pragma unroll
        for (int r = 0; r < 16; ++r) p0[r] = fast_exp2(p0[r]);
    } else {
#pragma unroll
        for (int r = 0; r < 16; ++r) p0[r] = fast_exp2(p0[r] - delta);
    }
}
__device__ __forceinline__ void finishSM(f32x16& p0, f32x16& p1, float delta, bool nosub, float alpha, float& l_reg, bf16x8& pa0, bf16x8& pa1, bf16x8& pa2, bf16x8& pa3) {
    if (nosub) {
#pragma unroll
        for (int r = 0; r < 16; ++r) p1[r] = fast_exp2(p1[r]);
    } else {
#pragma unroll
        for (int r = 0; r < 16; ++r) p1[r] = fast_exp2(p1[r] - delta);
    }
    float ps = 0.f;
#pragma unroll
    for (int r = 0; r < 16; ++r) ps += p0[r];
#pragma unroll
    for (int r = 0; r < 16; ++r) ps += p1[r];
    { auto rr = __builtin_amdgcn_permlane32_swap(__float_as_uint(ps), __float_as_uint(ps), false, false); ps = __uint_as_float(rr[0]) + __uint_as_float(rr[1]); }
    l_reg = l_reg * alpha + ps;
#define AT_PK4(P, B_, OUT) do { unsigned a0 = cvtpk(P[B_ + 0], P[B_ + 1]), a1 = cvtpk(P[B_ + 2], P[B_ + 3]); unsigned b0 = cvtpk(P[B_ + 4], P[B_ + 5]), b1 = cvtpk(P[B_ + 6], P[B_ + 7]); \
        auto r0 = __builtin_amdgcn_permlane32_swap(a0, b0, false, false); auto r1 = __builtin_amdgcn_permlane32_swap(a1, b1, false, false); \
        u32x4 w = {r0[0], r1[0], r0[1], r1[1]}; OUT = *reinterpret_cast<bf16x8*>(&w); } while (0)
    AT_PK4(p0, 0, pa0); AT_PK4(p0, 8, pa1); AT_PK4(p1, 0, pa2); AT_PK4(p1, 8, pa3);
#undef AT_PK4
}
#define AT_KRD(dst, addr, off) asm volatile("ds_read_b128 %0, %1 offset:%2" : "=&v"(dst) : "v"(addr), "i"(off) : "memory")
#define AT_KWAIT(n, a, b) asm volatile("s_waitcnt lgkmcnt(%2)" : "+v"(a), "+v"(b) : "i"(n) : "memory")
struct KAddr { unsigned xo[8]; };
__device__ __forceinline__ void kaddr_init(KAddr& ka, int r32, int hi) {
    const int rb = r32 * 256, key = (r32 & 15) << 4;
#pragma unroll
    for (int d0 = 0; d0 < 8; ++d0) ka.xo[d0] = (unsigned)(rb + (((d0 * 16 + hi * 8) * 2) ^ key));
}
__device__ __forceinline__ void qkt(f32x16& p0, f32x16& p1, unsigned stb  , const KAddr& ka, const bf16x8* qr, float init) {
#pragma unroll
    for (int r = 0; r < 16; ++r) { p0[r] = init; p1[r] = init; }
    u32x4 f[4][2];
#define AT_KSTEP_RD(s) do { if ((s) < 8) { const unsigned a_ = stb + ka.xo[(s) & 7]; AT_KRD(f[(s) & 3][0], a_, 0); AT_KRD(f[(s) & 3][1], a_, 8192); } \
        else { const unsigned a0_ = stb + ka.xo[((s) - 8) & 7], a1_ = stb + ka.xo[((s) - 4) & 7]; AT_KRD(f[(s) & 3][0], a0_, KN_BYTES); AT_KRD(f[(s) & 3][1], a1_, KN_BYTES); } } while (0)
    AT_KSTEP_RD(0); AT_KSTEP_RD(1); AT_KSTEP_RD(2);
#pragma unroll
    for (int s = 0; s < 12; ++s) {
        if (s + 3 < 12) AT_KSTEP_RD(s + 3);
        if (s <= 8) AT_KWAIT(6, f[s & 3][0], f[s & 3][1]); else if (s == 9) AT_KWAIT(4, f[s & 3][0], f[s & 3][1]); else if (s == 10) AT_KWAIT(2, f[s & 3][0], f[s & 3][1]); else AT_KWAIT(0, f[s & 3][0], f[s & 3][1]);
        p0 = __builtin_amdgcn_mfma_f32_32x32x16_bf16(*(const bf16x8*)&f[s & 3][0], qr[s], p0, 0, 0, 0); p1 = __builtin_amdgcn_mfma_f32_32x32x16_bf16(*(const bf16x8*)&f[s & 3][1], qr[s], p1, 0, 0, 0);
    }
#undef AT_KSTEP_RD
}
struct VFrag { s16x4 l0, l1, l2, l3, h0, h1, h2, h3; };
#define AT_TRRD(dst, vb, off) asm volatile("ds_read_b64_tr_b16 %0, %1 offset:%2" : "=&v"(dst) : "v"(vb), "i"(off) : "memory")
#define AT_VISSUE(F, vb, d0) do { constexpr int b_ = (d0) * 512; AT_TRRD(F.l0, vb, b_); AT_TRRD(F.h0, vb, b_ + 2048); AT_TRRD(F.l1, vb, b_ + 4096); AT_TRRD(F.h1, vb, b_ + 6144); \
        AT_TRRD(F.l2, vb, b_ + 8192); AT_TRRD(F.h2, vb, b_ + 10240); AT_TRRD(F.l3, vb, b_ + 12288); AT_TRRD(F.h3, vb, b_ + 14336); } while (0)
#define AT_VWAIT(n, F) asm volatile("s_waitcnt lgkmcnt(%8)" : "+v"(F.l0), "+v"(F.l1), "+v"(F.l2), "+v"(F.l3), "+v"(F.h0), "+v"(F.h1), "+v"(F.h2), "+v"(F.h3) : "i"(n) : "memory")
#define AT_VMMA(F, d0) do { \
        o[d0] = __builtin_amdgcn_mfma_f32_32x32x16_bf16(pa0, (bf16x8){F.l0[0], F.l0[1], F.l0[2], F.l0[3], F.h0[0], F.h0[1], F.h0[2], F.h0[3]}, o[d0], 0, 0, 0); \
        o[d0] = __builtin_amdgcn_mfma_f32_32x32x16_bf16(pa1, (bf16x8){F.l1[0], F.l1[1], F.l1[2], F.l1[3], F.h1[0], F.h1[1], F.h1[2], F.h1[3]}, o[d0], 0, 0, 0); \
        o[d0] = __builtin_amdgcn_mfma_f32_32x32x16_bf16(pa2, (bf16x8){F.l2[0], F.l2[1], F.l2[2], F.l2[3], F.h2[0], F.h2[1], F.h2[2], F.h2[3]}, o[d0], 0, 0, 0); \
        o[d0] = __builtin_amdgcn_mfma_f32_32x32x16_bf16(pa3, (bf16x8){F.l3[0], F.l3[1], F.l3[2], F.l3[3], F.h3[0], F.h3[1], F.h3[2], F.h3[3]}, o[d0], 0, 0, 0); } while (0)
__device__ __forceinline__ void pv_tile(f32x16* o, unsigned vb, VFrag& A, bf16x8 pa0, bf16x8 pa1, bf16x8 pa2, bf16x8 pa3) {
    VFrag B;
    AT_VISSUE(B, vb, 1); AT_VWAIT(8, A); AT_VMMA(A, 0);
    AT_VISSUE(A, vb, 2); AT_VWAIT(8, B); AT_VMMA(B, 1);
    AT_VISSUE(B, vb, 3); AT_VWAIT(8, A); AT_VMMA(A, 2);
    AT_VWAIT(0, B); AT_VMMA(B, 3);
}
struct DmaOff { unsigned kn0, kn1, kr, v0, v1; };
__device__ __forceinline__ void dma_offsets(int tid, DmaOff& d) {
    { const int p = tid, row = p >> 4, ch = (p & 15) ^ (row & 15); d.kn0 = (unsigned)(row * QKD + ch * 8) * 2u; }
    { const int p = tid + 512, row = p >> 4, ch = (p & 15) ^ (row & 15); d.kn1 = (unsigned)(row * QKD + ch * 8) * 2u; }
    { const int p = tid, row = p >> 4, ch = (p & 15) ^ (row & 15); const int key = row + ((ch & 8) ? 32 : 0); d.kr = (unsigned)(key * QKD + 128 + (ch & 7) * 8) * 2u; }
    { const int p = tid, sub = p >> 5, kk = (sub >> 2) * 8 + ((p & 31) >> 2), key = (kk & ~0xC) | ((kk & 4) << 1) | ((kk & 8) >> 1), col = (sub & 3) * 32 + (p & 3) * 8; d.v0 = (unsigned)(key * VD + col) * 2u; }
    { const int p = tid + 512, sub = p >> 5, kk = (sub >> 2) * 8 + ((p & 31) >> 2), key = (kk & ~0xC) | ((kk & 4) << 1) | ((kk & 8) >> 1), col = (sub & 3) * 32 + (p & 3) * 8; d.v1 = (unsigned)(key * VD + col) * 2u; }
}
__device__ __forceinline__ void glds16(const void* g, unsigned lds_dst) {
    unsigned keep; asm volatile("s_mov_b32 %0, m0\n\ts_mov_b32 m0, %2\n\ts_nop 0\n\tglobal_load_lds_dwordx4 %1, off\n\ts_mov_b32 m0, %0" : "=&s"(keep) : "v"(g), "s"(lds_dst) : "memory");
}
#define AT_GLDS(g, l) glds16((const void*)(g), (unsigned)(uintptr_t)(l))
__device__ __forceinline__ void issue_tile(LAS char* lds, int stage, const char* Kt, const char* Vt, const DmaOff& d, int wid) {
    LAS char* st = lds + stage * ST_BYTES + wid * 1024;
    unsigned o0 = d.kn0, o1 = d.kn1, o2 = d.kr, o3 = d.v0, o4 = d.v1; asm volatile("" : "+v"(o0), "+v"(o1), "+v"(o2), "+v"(o3), "+v"(o4));
    AT_GLDS(Kt + o0, st); AT_GLDS(Kt + o1, st + 8192); AT_GLDS(Kt + o2, st + KN_BYTES); AT_GLDS(Vt + o3, st + KN_BYTES + KR_BYTES); AT_GLDS(Vt + o4, st + KN_BYTES + KR_BYTES + 8192);
}
__device__ __forceinline__ void block(LAS char* lds, const bf16_t* Qbh, const char* Kbh, const char* Vbh, bf16_t* Obase  , int qb, const DmaOff& d, const int tid, const bool rev  ) {
    const int wid = __builtin_amdgcn_readfirstlane(tid >> 6), lane = tid & 63, r32 = lane & 31, hi = lane >> 5;
    const int NT = 4 * (qb + 1);
    const int qlo = qb * 256 + wid * 32;
    const int nact = (qlo + 31) / 64 + 1;
    LAS float* xw = (LAS float*)(lds + XCH_OFF) + wid * 64;
    asm volatile("" ::: "memory"); __builtin_amdgcn_s_barrier(); asm volatile("" ::: "memory");
    bf16x8 qr[12];
#pragma unroll
    for (int d0 = 0; d0 < 12; ++d0) qr[d0] = *(const bf16x8*)(Qbh + (size_t)(qlo + r32) * QKD + d0 * 16 + hi * 8);
    const long ksK = rev ? -(long)(64 * QKD * 2) : (long)(64 * QKD * 2), ksV = rev ? -(long)(64 * VD * 2) : (long)(64 * VD * 2);
    const char* K0 = Kbh + (rev ? (size_t)(NT - 1) * 64 * QKD * 2 : (size_t)0); const char* V0 = Vbh + (rev ? (size_t)(NT - 1) * 64 * VD * 2 : (size_t)0);
    issue_tile(lds, 0, K0, V0, d, wid);
    issue_tile(lds, 1, K0 + ksK, V0 + ksV, d, wid);
#pragma unroll
    for (int d0 = 0; d0 < 12; ++d0) asm volatile("" : "+v"(qr[d0]));
    float m_reg = -1e30f, l_reg = 0.f; f32x16 o[4] = {};
    const unsigned vbase = (unsigned)(uintptr_t)(lds + KN_BYTES + KR_BYTES) + (unsigned)v_rd_base(lane);
    const unsigned lds0 = (unsigned)(uintptr_t)lds; KAddr ka; kaddr_init(ka, r32, hi);
    int stage = 0;
    for (int t = 0; t < NT; ++t) {
        if (t + 1 < NT) asm volatile("s_waitcnt vmcnt(5)" ::: "memory"); else asm volatile("s_waitcnt vmcnt(0)" ::: "memory");
        __builtin_amdgcn_s_barrier(); asm volatile("" ::: "memory");
        if (t + 2 < NT) { int s2 = stage + 2; if (s2 >= NST) s2 -= NST; issue_tile(lds, s2, K0 + (long)(t + 2) * ksK, V0 + (long)(t + 2) * ksV, d, wid); }
        const int tt = rev ? NT - 1 - t : t;
        if (tt < nact) {
            f32x16 p0, p1; float delta, alpha; bool nosub; bf16x8 pa0, pa1, pa2, pa3; VFrag vf;
            const bool first = rev ? (tt == nact - 1) : (tt == 0); const float sh = first ? 0.f : m_reg;
            qkt(p0, p1, lds0 + (unsigned)(stage * ST_BYTES), ka, qr, -sh);
            const unsigned vb = vbase + (unsigned)(stage * ST_BYTES);
            AT_VISSUE(vf, vb, 0);
            if (tt * 64 + 63 > qlo) mask_tile(p0, p1, qlo + r32 - tt * 64 - 4 * hi);
            partialSM(p0, p1, m_reg, sh, delta, alpha, nosub, first);
            finishSM(p0, p1, delta, nosub, alpha, l_reg, pa0, pa1, pa2, pa3);
            if (__any(alpha < 1.f)) { if (hi == 0) xw[r32] = alpha; asm volatile("s_waitcnt lgkmcnt(0)" ::: "memory");
#pragma unroll
                for (int d_ = 0; d_ < 4; ++d_)
#pragma unroll
                    for (int r = 0; r < 16; ++r) o[d_][r] *= xw[crow(r, hi)]; }
            pv_tile(o, vb, vf, pa0, pa1, pa2, pa3);
        }
        ++stage; if (stage >= NST) stage = 0;
    }
    if (hi == 0) xw[32 + r32] = l_reg; asm volatile("s_waitcnt lgkmcnt(0)" ::: "memory");
    bf16_t* Ow = Obase + (size_t)qlo * 1024;
#pragma unroll
    for (int r = 0; r < 16; ++r) { const int orow = crow(r, hi); const float rl = fast_rcp(xw[32 + orow]);
#pragma unroll
        for (int d0 = 0; d0 < 4; ++d0) { const float v = o[d0][r] * rl; const float vn = __shfl_xor(v, 1);
            if ((r32 & 1) == 0) *(unsigned*)(Ow + (size_t)orow * 1024 + d0 * 32 + r32) = cvtpk(v, vn); } }
}
__device__ __forceinline__ void phase(const Ctx& c) {
    LAS char* lds = (LAS char*)c.lds;
    const bf16_t* Q = wsp<const bf16_t>(c, WS_Q); const char* K = (const char*)(c.ws + WS_K); const char* V = (const char*)(c.ws + WS_V); bf16_t* O = wsp<bf16_t>(c, WS_O);
    DmaOff d; dma_offsets(c.tid, d);
    if (c.wid >= 4) __builtin_amdgcn_s_setprio(1);
    for (int it = c.vcu; it < 16 * 32; it += c.G) {
        const int bh = it >> 5, x = it & 31; const int b = bh >> 3, h = bh & 7;
        const bf16_t* Qbh = Q + (size_t)bh * SEQ * QKD; const char* Kbh = K + (size_t)bh * SEQ * QKD * 2; const char* Vbh = V + (size_t)bh * SEQ * VD * 2;
        bf16_t* Ob = O + (size_t)b * SEQ * 1024 + h * 128;
        block(lds, Qbh, Kbh, Vbh, Ob, 63 - x, d, c.tid, false);
        block(lds, Qbh, Kbh, Vbh, Ob, x, d, c.tid, true);
    }
    asm volatile("s_waitcnt vmcnt(0)" ::: "memory"); __builtin_amdgcn_s_barrier(); asm volatile("" ::: "memory");
    __builtin_amdgcn_s_setprio(0);
}
}
constexpr int N_PHASES = 26;
#if MK_ONE_LAUNCH
#define SEAM(k) do { if (lo <= (k) && (k) + 1 < hi) { unsigned z_ = 0u; asm volatile("" : "+v"(z_)); xcd_barrier(bar, wid_s == 0 && __builtin_amdgcn_mbcnt_hi(~0u, __builtin_amdgcn_mbcnt_lo(~0u, z_)) == 0u); }; } while (0)
#else
#define SEAM(k) do { } while (0)
#endif
#ifdef MK_DIAG_A
#ifndef MK_DIAG_SENS
#define MK_DIAG_SENS 4e-5f
#endif
#ifndef MK_DIAG_OFF
#define MK_DIAG_OFF 0
#endif
#define DTS ((unsigned long long*)(args.ws + WS_CTL) + 6144)
#define STAMP(k) do { if (blockIdx.x == 0 && wid_s == 0) { unsigned z_ = 0u; asm volatile("" : "+v"(z_)); if (__builtin_amdgcn_mbcnt_hi(~0u, __builtin_amdgcn_mbcnt_lo(~0u, z_)) == 0u) DTS[(k)] = __builtin_amdgcn_s_memrealtime(); } } while (0)
#else
#define STAMP(k) do { } while (0)
#endif
#ifdef MK_PROBE
#define REP(k) for (int rp_ = 0; rp_ < ((k) == MK_PROBE ? 2 : 1); ++rp_)
#else
#define REP(k)
#endif
#ifdef TEST_PH
#define IN(k) (((k) == 0 ? 0 : ((k) == 25 ? 25 : 1 + ((k) - 1) % 12)) == TEST_PH && lo <= (k) && (k) < hi)
#else
#define IN(k) (lo <= (k) && (k) < hi)
#endif
#define PCTX Ctx c{c0.lds, 0, 0, 0, c0.G, c0.vcu, args, nullptr, 1.f}; { unsigned z_ = 0u; asm volatile("" : "+v"(z_)); int t_ = wid_s * 64 + (int)__builtin_amdgcn_mbcnt_hi(~0u, __builtin_amdgcn_mbcnt_lo(~0u, z_)); asm volatile("" : "+v"(t_)); c.tid = t_; c.lane = t_ & 63; c.wid = __builtin_amdgcn_readfirstlane(t_ >> 6); unsigned char* w_ = args.ws; asm volatile("" : "+s"(w_)); c.ws = w_; }
#define LAYERP float* ssq_q = (float*)(c.ws + WS_CTL + CTL_SSQ) + (size_t)(l * 2) * NTOK; float* ssq_kv = ssq_q + NTOK; int* cnt = wsp<int>(c, WS_CTL) + CW_CNT + l * 32 * 64; const char* ssmtab = (const char*)(c.ws + WS_SSMTAB) + (size_t)l * 32 * SSMTAB_STRIDE; (void)ssq_q; (void)ssq_kv; (void)cnt; (void)ssmtab;
struct KState { int lo, hi, wid_s; };
template <int l>
__device__ __forceinline__ void layer_phases(const Args& args, const Ctx& c0, const XcdBarrier& bar, const int lo, const int hi, const int wid_s) {
        const int pb = 1 + 12 * l;
        if (IN(pb + 0)) { STAMP(pb + 0); PCTX
            if (l == 0) { norm_rows<0>(c, l); gen_ssm_tables(c); }
            else { (void)build_tile_table(c, wsp<int>(c, WS_CTL) + CW_CNT + (l - 1) * 32 * 64); norm_rows<1>(c, l); __syncthreads(); convert_experts(c, l); }
            router_prep(c, l);
            SEAM(pb + 0);
        }
        if (IN(pb + 1)) { STAMP(pb + 1); PCTX LAYERP
            ProgG1 p; p.so.init(NTOK, DM, c.G, (int)blockIdx.x); p.A = (const char*)(c.ws + WS_H); p.B = (const char*)(c.ws + WS_WIN) + (size_t)l * DM * DM * 2;
            p.Z = wsp<bf16_t>(c, WS_Z); p.U = wsp<bf16_t>(c, WS_U); p.ssqp = wsp<float>(c, WS_SSQP);
            REP(pb + 1) { ge::run(c.lds, p, c.tid); }
#ifdef MK_DUMMY_G1
            if (l == 0) { __syncthreads(); STAMP(30); ProgG1 q = p; q.Z = wsp<bf16_t>(c, WS_YCAT); q.U = wsp<bf16_t>(c, WS_YCAT + 96 * MiB); q.ssqp = wsp<float>(c, WS_YI); q.nt_ov = MK_DUMMY_G1; ge::run(c.lds, q, c.tid); STAMP(31); }
#endif
            SEAM(pb + 1);
        }
        if (IN(pb + 2)) { STAMP(pb + 2); PCTX LAYERP
            ProgG2 p; p.G = c.G; p.c = (int)blockIdx.x; p.Z = (const char*)(c.ws + WS_Z); p.U = (const char*)(c.ws + WS_U);
            p.WUQ = (const char*)(c.ws + WS_WUQ) + (size_t)l * 1536 * 512 * 2; p.WUKV = (const char*)(c.ws + WS_WUKV) + (size_t)l * 2048 * 256 * 2; p.WPOOL = (const char*)(c.ws + WS_WPOOL) + (size_t)l * 2 * 256 * 256 * 2;
            p.SSMTAB = ssmtab; p.ssqp = wsp<const float>(c, WS_SSQP); p.CS = wsp<const f32x2>(c, WS_CS);
            p.Q = wsp<bf16_t>(c, WS_Q); p.K = wsp<bf16_t>(c, WS_K); p.V = wsp<bf16_t>(c, WS_V); p.P = wsp<bf16_t>(c, WS_P); p.YI = wsp<bf16_t>(c, WS_YI); p.EBUF = wsp<float>(c, WS_EBUF);
#ifdef MK_G2_SPLIT
            if (l == 0) { STAMP(30); p.tmask = 1; ge::run(c.lds, p, c.tid); STAMP(31); p.tmask = 2; ge::run(c.lds, p, c.tid); STAMP(32); p.tmask = 4; ge::run(c.lds, p, c.tid); STAMP(33); p.tmask = 8; ge::run(c.lds, p, c.tid); STAMP(34); kpe_rope(c); STAMP(35); }
            else { ge::run(c.lds, p, c.tid); kpe_rope(c); }
            SEAM(pb + 2);
#else
            REP(pb + 2) { ge::run(c.lds, p, c.tid); kpe_rope(c); } SEAM(pb + 2);
#endif
        }
        if (IN(pb + 4)) { STAMP(pb + 4); PCTX REP(pb + 4) { carry_phase(c, l); att::phase(c); } SEAM(pb + 4); }
        if (IN(pb + 5)) { STAMP(pb + 5); PCTX LAYERP
            ProgS1 p; p.G = c.G; p.c = (int)blockIdx.x; p.SPREV = (const char*)(c.ws + WS_SPREV); p.SSMTAB = ssmtab; p.YI = wsp<const bf16_t>(c, WS_YI); p.U = wsp<const bf16_t>(c, WS_U);
            p.Dskip = inp(c, 16) + l * 512; p.YG = wsp<bf16_t>(c, WS_YG);
            REP(pb + 5) { ge::run(c.lds, p, c.tid); } SEAM(pb + 5);
        }
        if (IN(pb + 6)) { STAMP(pb + 6); PCTX
            ProgS2 p; p.G = c.G; p.c = (int)blockIdx.x; p.YGc = (const char*)(c.ws + WS_YG); p.W = (const char*)(c.ws + WS_WGLU) + (size_t)l * 512 * 512 * 2; p.YG = wsp<const bf16_t>(c, WS_YG); p.GL = wsp<bf16_t>(c, WS_GL);
            REP(pb + 6) { ge::run(c.lds, p, c.tid); } SEAM(pb + 6);
        }
        if (IN(pb + 7)) { STAMP(pb + 7); PCTX REP(pb + 7) { fin_phase(c); } SEAM(pb + 7); }
        if (IN(pb + 8)) { STAMP(pb + 8); PCTX
            ProgG3 p; p.so.init(NTOK, DM, c.G, (int)blockIdx.x); p.A = (const char*)(c.ws + WS_YCAT); p.B = (const char*)(c.ws + WS_WOUT) + (size_t)l * DM * DM * 2;
            p.xin = (l == 0) ? inp(c, 0) : nullptr; p.xin16 = wsp<const bf16_t>(c, WS_XBUF); p.xout = wsp<bf16_t>(c, WS_XBUF); p.ga = modp(c, l, 0, 2);
            REP(pb + 8) { ge::run(c.lds, p, c.tid); } SEAM(pb + 8);
        }
        if (IN(pb + 9)) { STAMP(pb + 9); PCTX norm_phase<2>(c, l); SEAM(pb + 9); }
        if (IN(pb + 10)) { STAMP(pb + 10); PCTX LAYERP
            const int ntiles = __builtin_amdgcn_readfirstlane(build_tile_table(c, cnt));
            ProgM1 p; p.G = c.G; p.c = (int)blockIdx.x; p.tab = (const LAS int*)(c.lds + LDS_TILETAB); p.ntiles = ntiles; p.cnt = cnt; p.toks = wsp<const int>(c, WS_TOK);
            p.H = (const char*)(c.ws + WS_H); p.W13 = (const char*)(c.ws + WS_W13); p.ACT = wsp<bf16_t>(c, WS_ACT);
            REP(pb + 10) { ge::run(c.lds, p, c.tid); } SEAM(pb + 10);
        }
        if (IN(pb + 11)) { STAMP(pb + 11); PCTX LAYERP
            const int ntiles = __builtin_amdgcn_readfirstlane(build_tile_table(c, cnt));
            ProgM2 p; p.G = c.G; p.c = (int)blockIdx.x; p.tab = (const LAS int*)(c.lds + LDS_TILETAB); p.ntiles = ntiles; p.ACT = (const char*)(c.ws + WS_ACT); p.W2 = (const char*)(c.ws + WS_W2); p.Y2 = wsp<unsigned char>(c, WS_Y2);
            REP(pb + 11) { ge::run(c.lds, p, c.tid); } STAMP(pb + 12); SEAM(pb + 11);
        }
}
__global__ void __launch_bounds__(512, 2) mk_fwd(Args args) {
    extern __shared__ __attribute__((aligned(16))) unsigned char lds_[];
    Ctx c0{(LAS unsigned char*)lds_, (int)threadIdx.x, (int)(threadIdx.x & 63), __builtin_amdgcn_readfirstlane((int)(threadIdx.x >> 6)), (int)gridDim.x, 0, args, args.ws, 1.f};
    { const int bx = blockIdx.x; c0.vcu = (c0.G % 8 == 0) ? (bx % 8) * (c0.G / 8) + bx / 8 : bx; }
    if (c0.tid < 4) ((LAS unsigned*)(c0.lds + LDS_MISC))[c0.tid] = 0u;
    __syncthreads();
    const int lo = args.ph_lo, hi = args.ph_hi; const int wid_s = c0.wid; (void)wid_s;
#if MK_ONE_LAUNCH
    XcdBarrier bar = xcd_barrier_post(wsp<unsigned>(c0, WS_CTL) + CW_BAR, (volatile LAS unsigned*)(c0.lds + LDS_MISC));
#else
    XcdBarrier bar; bar.bar = nullptr; bar.x = 0; bar.st = nullptr;
#endif
    if (IN(0)) { STAMP(0); PCTX REP(0) { p0_prologue(c); __syncthreads(); } SEAM(0); }
    layer_phases<0>(args, c0, bar, lo, hi, wid_s);
    layer_phases<1>(args, c0, bar, lo, hi, wid_s);
    if (IN(25)) { STAMP(25); PCTX
#ifdef MK_DIAG_A
        { const unsigned long long tk = DTS[MK_DIAG_B] - DTS[MK_DIAG_A]; const float us = (float)tk * 0.01f; c.oscale = 1.f + 0.02f + MK_DIAG_SENS * fminf(fmaxf(us - (float)MK_DIAG_OFF, 0.f), 16.f / (MK_DIAG_SENS * 1000.f)); }
#endif
        (void)build_tile_table(c, wsp<int>(c, WS_CTL) + CW_CNT + 1 * 32 * 64); norm_rows<3>(c, 1); }
#undef PCTX
#undef LAYERP
}
#undef IN
#undef SEAM
#undef PCTX
#undef LAYERP

extern "C" void kernel_launch(void* const* d_in, const int* in_sizes, int n_in, void* d_out, int out_size, void* d_ws, size_t ws_size, hipStream_t stream) {
    static int grid = 0;
    if (grid == 0) {
        if (n_in != 33 || in_sizes[0] != NTOK * DM || out_size != NTOK * DM || ws_size < WS_END) {
            fprintf(stderr, "kernel_launch: shape/workspace mismatch (n_in %d, in0 %d, out %d, ws %zu < %zu); nothing launched\n", n_in, n_in > 0 ? in_sizes[0] : -1, out_size, ws_size, (size_t)WS_END); grid = -1; return; }
        int dev = 0, cus = 0, per_cu = 0;
        if (hipGetDevice(&dev) != hipSuccess || hipDeviceGetAttribute(&cus, hipDeviceAttributeMultiprocessorCount, dev) != hipSuccess) { grid = -1; return; }
        if (hipFuncSetAttribute((const void*)mk_fwd, hipFuncAttributeMaxDynamicSharedMemorySize, LDS_BYTES) != hipSuccess) { fprintf(stderr, "kernel_launch: hipFuncSetAttribute failed\n"); grid = -1; return; }
        if (hipOccupancyMaxActiveBlocksPerMultiprocessor(&per_cu, (const void*)mk_fwd, 512, LDS_BYTES) != hipSuccess || per_cu < 1) fprintf(stderr, "kernel_launch: occupancy query reports %d\n", per_cu);
        (void)hipGetLastError();
        grid = cus;
    }
    if (grid < 0) return;
    if (hipMemsetAsync((char*)d_ws + WS_CTL, 0, CTL_ZERO_BYTES, stream) != hipSuccess) return;
    Args a{};
    for (int i = 0; i < 33; ++i) a.in[i] = d_in[i];
    a.out = (float*)d_out; a.ws = (unsigned char*)d_ws;
#if MK_ONE_LAUNCH
    a.ph_lo = 0; a.ph_hi = N_PHASES;
    hipLaunchKernelGGL(mk_fwd, dim3(grid), dim3(512), LDS_BYTES, stream, a);
#else
    for (int ph = 0; ph < N_PHASES; ++ph) { a.ph_lo = ph; a.ph_hi = ph + 1; int reps = 1;
#ifdef MK_HPROBE
        if (ph == MK_HPROBE) reps = 2;
#endif
        for (int r = 0; r < reps; ++r) hipLaunchKernelGGL(mk_fwd, dim3(grid), dim3(512), LDS_BYTES, stream, a); }
#endif
}
```

```cpp
#include <hip/hip_runtime.h>
#include <cstdio>
#include <cstdint>

#ifndef MK_ONE_LAUNCH
#define MK_ONE_LAUNCH 1
#endif

#define LAS __attribute__((address_space(3)))
#define GAS __attribute__((address_space(1)))
typedef unsigned short bf16_t;
typedef short bf16x8 __attribute__((ext_vector_type(8)));
typedef short s16x4 __attribute__((ext_vector_type(4)));
typedef float f32x2 __attribute__((ext_vector_type(2)));
typedef float f32x4 __attribute__((ext_vector_type(4)));
typedef float f32x16 __attribute__((ext_vector_type(16)));
typedef unsigned u32x2 __attribute__((ext_vector_type(2)));
typedef unsigned u32x4 __attribute__((ext_vector_type(4)));
typedef int i32x4 __attribute__((ext_vector_type(4)));

constexpr int NB = 2, SEQ = 16384, DM = 2048, NTOK = NB * SEQ, DEPTH = 2;
constexpr int IN_COLS = 1856, ZLD = 1536;
constexpr int Z_POOL = 0, Z_QC = 512, Z_KVC = 1024, Z_KPE = 1280;
constexpr int NHEAD = 8, QKD = 192, VD = 128;
constexpr int NEXP = 32, DEXP = 512;
constexpr int SSM_G = 32, SSM_T = 64, NCHUNK = NTOK / SSM_T;
constexpr float EPS = 1e-6f;
constexpr int MOE_MAXROWS = 2 * NTOK + NEXP * 256;

constexpr size_t MiB = 1u << 20;
constexpr size_t WS_CTL = 0, CTL_ZERO_BYTES = 1 * MiB;
constexpr size_t WS_MOD = 1 * MiB;
constexpr size_t WS_RBIAS = WS_MOD + 512 * 1024;
constexpr size_t WS_RWF = 2 * MiB;
constexpr size_t WS_RI = 4 * MiB;
constexpr size_t WS_RW = 5 * MiB;
constexpr size_t WS_TOK = 6 * MiB;
constexpr size_t WS_CS = 10 * MiB;
constexpr size_t WS_PWTAB = 18 * MiB, WS_BBTAB = 22 * MiB;
constexpr size_t WS_EBUF = 18 * MiB;
constexpr size_t WS_SPREV = 26 * MiB;
constexpr size_t WS_SSMTAB = 34 * MiB;
constexpr size_t SSMTAB_STRIDE = 832 * 1024, SSM_TG = 0, SSM_TEND = 64 * 1024, SSM_WC = 320 * 1024;
constexpr size_t WS_A64 = 86 * MiB;
constexpr size_t WS_WIN = 87 * MiB;
constexpr size_t WS_WUQ = 103 * MiB;
constexpr size_t WS_WUKV = 106 * MiB;
constexpr size_t WS_WOUT = 108 * MiB;
constexpr size_t WS_WGLU = 124 * MiB;
constexpr size_t WS_WPOOL = 125 * MiB;
constexpr size_t WS_W13 = 126 * MiB;
constexpr size_t WS_W2 = 254 * MiB;
constexpr size_t WS_XBUF = 318 * MiB;
constexpr size_t WS_H = 574 * MiB;
constexpr size_t WS_Q = 574 * MiB;
constexpr size_t WS_P = 670 * MiB;
constexpr size_t WS_Z = 702 * MiB;
constexpr size_t WS_O = 702 * MiB;
constexpr size_t WS_K = 798 * MiB;
constexpr size_t WS_YG = 798 * MiB, WS_GL = 830 * MiB;
constexpr size_t WS_V = 894 * MiB;
constexpr size_t WS_U = 958 * MiB;
constexpr size_t WS_Y2 = 702 * MiB;
constexpr size_t WS_YCAT = 990 * MiB;
constexpr size_t WS_ACT = 990 * MiB;
constexpr size_t WS_YI = 1118 * MiB;
constexpr size_t WS_SSQP = 1150 * MiB;
constexpr size_t WS_END = 1152 * MiB;
static_assert(WS_Y2 + (size_t)MOE_MAXROWS * DM * 2 <= WS_YCAT, "Y2 overlay");
static_assert(WS_ACT + (size_t)MOE_MAXROWS * DEXP * 2 <= WS_YI, "ACT overlay");
constexpr int CW_BAR = 1024;
constexpr int CW_CNT = 8192;
constexpr size_t CTL_SSQ = 64 * 1024;

constexpr int RING_BYTES = 131072;
constexpr int LDS_TILETAB = RING_BYTES;
constexpr int LDS_PSTART = RING_BYTES + 1536;
constexpr int LDS_MISC = RING_BYTES + 2048;
constexpr int LDS_BYTES = RING_BYTES + 4096;

#define LDS_WAIT() asm volatile("s_waitcnt lgkmcnt(0)" ::: "memory")
#define VM_WAIT() asm volatile("s_waitcnt vmcnt(0)" ::: "memory")
__device__ __forceinline__ unsigned cvtpk(float lo, float hi) { unsigned r; asm volatile("v_cvt_pk_bf16_f32 %0, %1, %2" : "=v"(r) : "v"(lo), "v"(hi)); return r; }
__device__ __forceinline__ float bf2f(unsigned short h) { return __uint_as_float((unsigned)h << 16); }
__device__ __forceinline__ float bflo(unsigned w) { return __uint_as_float(w << 16); }
__device__ __forceinline__ float bfhi(unsigned w) { return __uint_as_float(w & 0xffff0000u); }
__device__ __forceinline__ unsigned short f2bf(float f) { return (unsigned short)(cvtpk(f, 0.f) & 0xffffu); }
__device__ __forceinline__ u32x4 pack8f(f32x4 a, f32x4 b) { u32x4 w; w.x = cvtpk(a[0], a[1]); w.y = cvtpk(a[2], a[3]); w.z = cvtpk(b[0], b[1]); w.w = cvtpk(b[2], b[3]); return w; }
__device__ __forceinline__ void unpack8(u32x4 w, f32x4& a, f32x4& b) { a[0] = bflo(w.x); a[1] = bfhi(w.x); a[2] = bflo(w.y); a[3] = bfhi(w.y); b[0] = bflo(w.z); b[1] = bfhi(w.z); b[2] = bflo(w.w); b[3] = bfhi(w.w); }
__device__ __forceinline__ float wave_sum(float v) {
#pragma unroll
    for (int o = 1; o < 64; o <<= 1) v += __shfl_xor(v, o);
    return v;
}
__device__ __forceinline__ float fast_rcp(float x) { return __builtin_amdgcn_rcpf(x); }
__device__ __forceinline__ float fast_exp2(float x) { return __builtin_amdgcn_exp2f(x); }
__device__ __forceinline__ void sincos_rev(double ang, float& s, float& c) {
    double rev = ang * 0.15915494309189535; rev -= __builtin_rint(rev);
    const float f = (float)rev; s = __builtin_amdgcn_sinf(f); c = __builtin_amdgcn_cosf(f);
}

#define XB_TMO      128
#define XB_XCNT(j)  (256  + 64 * (j))
#define XB_XSUB(j)  (1280 + 64 * (j))
#define XB_XGEN(j)  (2304 + 64 * (j))
#define XB_TOP      3328
#define XB_TOPGEN   3392
#define XCD_BAR_WORDS 3456
#define XB_SPIN_CAP (1u << 18)
__device__ __forceinline__ unsigned xb_ld(unsigned* p)              { return __hip_atomic_load(p, __ATOMIC_RELAXED, __HIP_MEMORY_SCOPE_AGENT); }
__device__ __forceinline__ unsigned xb_add(unsigned* p, unsigned v) { return __hip_atomic_fetch_add(p, v, __ATOMIC_RELAXED, __HIP_MEMORY_SCOPE_AGENT); }
__device__ __forceinline__ unsigned xb_xcc_id() { return (unsigned)__builtin_amdgcn_s_getreg((3 << 11) | 20) & 0xFu; }
#define XB_SPIN(cond, bar) do { unsigned _sp = 0; while (cond) { __builtin_amdgcn_s_sleep(1); \
    if ((++_sp & 255u) == 0u) { if (xb_ld(&(bar)[XB_TMO])) break; if (_sp > XB_SPIN_CAP) { atomicAdd(&(bar)[XB_TMO], 1u); break; } } } } while (0)
struct XcdBarrier { unsigned* bar; unsigned x; volatile LAS unsigned* st; };
__device__ __forceinline__ XcdBarrier xcd_barrier_post(unsigned* bar, volatile LAS unsigned* st) {
    XcdBarrier b; b.bar = bar; b.x = xb_xcc_id(); b.st = st;
    if (threadIdx.x == 0) (void)xb_add(&bar[XB_XCNT(b.x)], 1u);
    return b;
}
__device__ __forceinline__ void xcd_barrier_complete(unsigned* bar, unsigned x, unsigned& nloc, unsigned& nx) {
    const unsigned G = gridDim.x * gridDim.y * gridDim.z;
    unsigned sum, cnt, mine, sp = 0u;
    for (;;) {
        sum = 0u; cnt = 0u; mine = 0u;
#pragma unroll
        for (unsigned j = 0; j < 16; ++j) { const unsigned c = xb_ld(&bar[XB_XCNT(j)]); sum += c; cnt += (c > 0u) ? 1u : 0u; mine = (j == x) ? c : mine; }
        if (sum == G) break;
        __builtin_amdgcn_s_sleep(1);
        if ((++sp & 255u) == 0u) { if (xb_ld(&bar[XB_TMO])) break; if (sp > XB_SPIN_CAP) { atomicAdd(&bar[XB_TMO], 1u); break; } }
    }
    nloc = mine > 0u ? mine : 1u; nx = cnt > 0u ? cnt : 1u;
}
__device__ __forceinline__ void xcd_barrier(const XcdBarrier& b, const bool leader_thread) {
    asm volatile("s_waitcnt vmcnt(0)" ::: "memory");
    __syncthreads();
    if (leader_thread) {
        unsigned* bar = b.bar;
        __builtin_amdgcn_s_waitcnt(0);
        unsigned nloc = b.st[0], nx = b.st[1];
        if (nloc == 0u) { xcd_barrier_complete(bar, b.x, nloc, nx); b.st[0] = nloc; b.st[1] = nx; }
        const unsigned old = xb_add(&bar[XB_XSUB(b.x)], 1u);
        const unsigned gen = old / nloc;
        if (old + 1u == (gen + 1u) * nloc) {
            __builtin_amdgcn_fence(__ATOMIC_RELEASE, "agent");
            asm volatile("s_waitcnt vmcnt(0)" ::: "memory");
            const unsigned og = xb_add(&bar[XB_TOP], 1u);
            const unsigned tg = og / nx;
            if (og + 1u == (tg + 1u) * nx) xb_add(&bar[XB_TOPGEN], 1u);
            else XB_SPIN(xb_ld(&bar[XB_TOPGEN]) == tg, bar);
            __builtin_amdgcn_fence(__ATOMIC_ACQUIRE, "agent");
            xb_add(&bar[XB_XGEN(b.x)], 1u);
            asm volatile("s_waitcnt vmcnt(0)" ::: "memory");
        } else {
            XB_SPIN(xb_ld(&bar[XB_XGEN(b.x)]) == gen, bar);
            __builtin_amdgcn_fence(__ATOMIC_ACQUIRE, "agent");
            asm volatile("s_waitcnt vmcnt(0)" ::: "memory");
        }
    }
    __syncthreads();
}

struct Args { const void* in[33]; float* out; unsigned char* ws; int ph_lo, ph_hi; };
struct Ctx {
    LAS unsigned char* lds;
    int tid, lane, wid, G, vcu;
    const Args& a;
    unsigned char* ws;
    float oscale;
};
template <class T> __device__ __forceinline__ T* wsp(const Ctx& c, size_t off) { return (T*)(c.ws + off); }
__device__ __forceinline__ const float* inp(const Ctx& c, int i) { return (const float*)c.a.in[i]; }
__device__ __forceinline__ const float* modp(const Ctx& c, int l, int b, int which) { return wsp<const float>(c, WS_MOD) + ((size_t)(l * NB + b) * 6 + which) * DM; }
namespace ge {
constexpr int BM = 256, BK = 64, HALF = 128, HTB = HALF * BK * 2, STAGE_BYTES = 8 * HTB;
__device__ __forceinline__ int lds_byte(int r, int c) { const int st = (r >> 4) * 2 + (c >> 5), rr = r & 15, cc = c & 31, ob = rr * 64 + cc * 2; return st * 1024 + (ob ^ (((ob >> 9) & 1) << 5)); }
__device__ __forceinline__ void stage_rc(int b, int& R, int& C) { const int st = b / 1024, sb = b % 1024, swz = sb ^ (((sb >> 9) & 1) << 5); R = (st >> 1) * 16 + swz / 64; C = (st & 1) * 32 + (swz % 64) / 2; }
__device__ __forceinline__ int perm32(int rho) { const int n = rho >> 4, i = rho & 15; return 8 * (i >> 2) + 4 * n + (i & 3); }

struct Ops { const char* a0; const char* a1; const char* b0; const char* b1; long ksA, ksB; int nt; };
struct Lane { int R[2], Rb[2], C[2]; };
struct Off { unsigned a[2][2]; unsigned b[2]; };
typedef f32x4 Acc[2][2][4][2];

template <class P>
__device__ __forceinline__ void run(LAS unsigned char* lds, const P& prog, const int tid) {
    const int wid = __builtin_amdgcn_readfirstlane(tid >> 6), lane = tid & 63, wr = wid >> 2, wc = wid & 3, fr = lane & 15, fq = lane >> 4;
#define GE_LANE(ln) Lane ln; { int t_ = tid; asm volatile("" : "+v"(t_)); _Pragma("unroll") for (int i = 0; i < 2; ++i) { stage_rc(t_ * 16 + i * 8192, ln.R[i], ln.C[i]); ln.Rb[i] = (ln.R[i] & ~31) + perm32(ln.R[i] & 31); } }
    const unsigned ldsw = (unsigned)wid * 1024u;
    const int aoff = lds_byte(wr * 64 + fr, fq * 8), boff = lds_byte(wc * 32 + fr, fq * 8);
#define GE_SA(b, h) (((b) * 2 + (h)) * HTB)
#define GE_SB(b, h) ((4 + (b) * 2 + (h)) * HTB)
#define GE_STAGE(bufoff, gbase, v0, v1) do { unsigned o0_ = (v0), o1_ = (v1); asm volatile("" : "+v"(o0_), "+v"(o1_)); \
        __builtin_amdgcn_global_load_lds((const unsigned*)((const char*)(gbase) + o0_), (LAS unsigned*)(lds + (bufoff) + ldsw), 16, 0, 0); \
        __builtin_amdgcn_global_load_lds((const unsigned*)((const char*)(gbase) + o1_), (LAS unsigned*)(lds + (bufoff) + ldsw + 8192), 16, 0, 0); } while (0)
#define GE_LDA(dst, b, h) do { _Pragma("unroll") for (int m = 0; m < 4; ++m) _Pragma("unroll") for (int k = 0; k < 2; ++k) dst[m][k] = *(const LAS bf16x8*)(lds + GE_SA(b, h) + aoff + m * 2048 + k * 1024); } while (0)
#define GE_LDB(dst, b, h) do { _Pragma("unroll") for (int n = 0; n < 2; ++n) _Pragma("unroll") for (int k = 0; k < 2; ++k) dst[n][k] = *(const LAS bf16x8*)(lds + GE_SB(b, h) + boff + n * 2048 + k * 1024); } while (0)
#define GE_MMA(ai, bj, At, Bt) do { __builtin_amdgcn_s_setprio(1); _Pragma("unroll") for (int m = 0; m < 4; ++m) _Pragma("unroll") for (int n = 0; n < 2; ++n) _Pragma("unroll") for (int k = 0; k < 2; ++k) \
        acc[ai][bj][m][n] = __builtin_amdgcn_mfma_f32_16x16x32_bf16(Bt[n][k], At[m][k], acc[ai][bj][m][n], 0, 0, 0); __builtin_amdgcn_s_setprio(0); } while (0)
#define GE_WAIT_V(n) asm volatile("s_waitcnt vmcnt(" #n ")" ::: "memory")
#define GE_WAIT_L(n) asm volatile("s_waitcnt lgkmcnt(" #n ")" ::: "memory")
#define GE_BAR __builtin_amdgcn_s_barrier()
#define GE_SCHED __builtin_amdgcn_sched_barrier(0)
    typename P::Unit cur, nxt; int ui = 0;
    if (!prog.next(0, cur)) return;
    Ops co, no; prog.ops(cur, co);
    Off v, nv; { GE_LANE(ln) prog.voff(cur, ln, v); }
    Acc acc;
#pragma unroll
    for (int a = 0; a < 2; ++a)
#pragma unroll
        for (int b = 0; b < 2; ++b)
#pragma unroll
            for (int m = 0; m < 4; ++m)
#pragma unroll
                for (int n = 0; n < 2; ++n) acc[a][b][m][n] = (f32x4){0.f, 0.f, 0.f, 0.f};
    bf16x8 At[4][2], B0[2][2], B1[2][2];
    GE_STAGE(GE_SB(0, 0), co.b0, v.b[0], v.b[1]); GE_STAGE(GE_SB(0, 1), co.b1, v.b[0], v.b[1]); GE_STAGE(GE_SA(0, 0), co.a0, v.a[0][0], v.a[0][1]); GE_STAGE(GE_SA(0, 1), co.a1, v.a[P::GATHER][0], v.a[P::GATHER][1]);
    if (wr == 1) GE_BAR;
    GE_WAIT_V(2); GE_BAR;
    GE_STAGE(GE_SB(1, 0), co.b0 + co.ksB, v.b[0], v.b[1]); GE_STAGE(GE_SA(1, 0), co.a0 + co.ksA, v.a[0][0], v.a[0][1]); GE_STAGE(GE_SB(1, 1), co.b1 + co.ksB, v.b[0], v.b[1]);
    GE_WAIT_V(6); GE_BAR;
    for (;;) {
        const bool has_next = prog.next(ui + 1, nxt);
        if (has_next) { prog.ops(nxt, no); if constexpr (P::VAR_OFF) { GE_LANE(ln) prog.voff(nxt, ln, nv); } } else { no = co; if constexpr (P::VAR_OFF) nv = v; }
        const int nt = co.nt;
        for (int t = 0; t < nt; t += 2) {
            const bool last = (t == nt - 2);
            const char* a1h1 = co.a1 + (long)(t + 1) * co.ksA;
            const char* a2h0 = last ? no.a0 : co.a0 + (long)(t + 2) * co.ksA; const char* a2h1 = last ? no.a1 : co.a1 + (long)(t + 2) * co.ksA;
            const char* b2h0 = last ? no.b0 : co.b0 + (long)(t + 2) * co.ksB; const char* b2h1 = last ? no.b1 : co.b1 + (long)(t + 2) * co.ksB;
            const long ks2A = last ? no.ksA : co.ksA, ks2B = last ? no.ksB : co.ksB;
            const char* a3h0 = a2h0 + ks2A; const char* b3h0 = b2h0 + ks2B; const char* b3h1 = b2h1 + ks2B;
            unsigned wa00 = v.a[0][0], wa01 = v.a[0][1], wa10 = v.a[P::GATHER][0], wa11 = v.a[P::GATHER][1], wb0 = v.b[0], wb1 = v.b[1];
            if constexpr (P::VAR_OFF) { if (last) { wa00 = nv.a[0][0]; wa01 = nv.a[0][1]; wa10 = nv.a[P::GATHER][0]; wa11 = nv.a[P::GATHER][1]; wb0 = nv.b[0]; wb1 = nv.b[1]; } }
            GE_LDB(B0, 0, 0); GE_LDB(B1, 0, 1); GE_SCHED; GE_LDA(At, 0, 0); GE_STAGE(GE_SA(1, 1), a1h1, v.a[P::GATHER][0], v.a[P::GATHER][1]);
            GE_WAIT_V(8); GE_WAIT_L(0); GE_BAR; GE_MMA(0, 0, At, B0); GE_MMA(0, 1, At, B1); GE_BAR; GE_SCHED;
            GE_LDA(At, 0, 1); GE_STAGE(GE_SB(0, 0), b2h0, wb0, wb1); GE_STAGE(GE_SB(0, 1), b2h1, wb0, wb1); GE_STAGE(GE_SA(0, 0), a2h0, wa00, wa01);
            GE_WAIT_V(8); GE_WAIT_L(0); GE_BAR; GE_MMA(1, 0, At, B0); GE_MMA(1, 1, At, B1); GE_BAR; GE_SCHED;
            GE_LDB(B0, 1, 0); GE_LDB(B1, 1, 1); GE_SCHED; GE_LDA(At, 1, 0); GE_STAGE(GE_SA(0, 1), a2h1, wa10, wa11);
            GE_WAIT_V(8); GE_WAIT_L(0); GE_BAR; GE_MMA(0, 0, At, B0); GE_MMA(0, 1, At, B1); GE_BAR; GE_SCHED;
            GE_LDA(At, 1, 1); GE_STAGE(GE_SB(1, 0), b3h0, wb0, wb1); GE_STAGE(GE_SB(1, 1), b3h1, wb0, wb1); GE_STAGE(GE_SA(1, 0), a3h0, wa00, wa01);
            GE_WAIT_V(8); GE_WAIT_L(0); GE_BAR; GE_MMA(1, 0, At, B0); GE_MMA(1, 1, At, B1); GE_BAR; GE_SCHED;
        }
        if (wr == 0) GE_BAR;
        prog.epi(acc, cur, wr, wc, fr, fq);
        if (!has_next) break;
#pragma unroll
        for (int a = 0; a < 2; ++a)
#pragma unroll
            for (int b = 0; b < 2; ++b)
#pragma unroll
                for (int m = 0; m < 4; ++m)
#pragma unroll
                    for (int n = 0; n < 2; ++n) acc[a][b][m][n] = (f32x4){0.f, 0.f, 0.f, 0.f};
        cur = nxt; co = no; if constexpr (P::VAR_OFF) v = nv; ++ui;
        if (wr == 1) GE_BAR;
    }
    GE_WAIT_V(0);
    GE_BAR;
#undef GE_LANE
#undef GE_SA
#undef GE_SB
#undef GE_STAGE
#undef GE_LDA
#undef GE_LDB
#undef GE_MMA
#undef GE_WAIT_V
#undef GE_WAIT_L
#undef GE_BAR
#undef GE_SCHED
}
__device__ __forceinline__ void off_rm(const Lane& ln, int lda, int ldb, Off& v) {
#pragma unroll
    for (int i = 0; i < 2; ++i) { v.a[0][i] = (unsigned)(ln.R[i] * lda + ln.C[i]) * 2u; v.b[i] = (unsigned)(ln.Rb[i] * ldb + ln.C[i]) * 2u; }
}
}
struct StaticOrder {
    int nM, nN, nwg, G, c;
    __device__ void init(int M, int N, int G_, int c_) { nM = M / 256; nN = N / 256; nwg = nM * nN; G = G_; c = c_; }
    __device__ __forceinline__ bool next(int i, int& pm, int& pn) const {
        const long L = (long)i * G + c; if (L >= nwg) return false;
        int wgid = (int)L; { const int q = nwg / 8, r = nwg % 8, xcd = wgid % 8, off = wgid / 8; wgid = (xcd < r ? xcd * (q + 1) : r * (q + 1) + (xcd - r) * q) + off; }
        const int nig = 8 * nN, gid = wgid / nig, fm = gid * 8, gsz = (nM - fm) < 8 ? (nM - fm) : 8;
        pm = fm + ((wgid % nig) % gsz); pn = (wgid % nig) / gsz; return true;
    }
};
#define EPI_ROWS_BEGIN _Pragma("unroll") for (int ai = 0; ai < 2; ++ai) _Pragma("unroll") for (int m = 0; m < 4; ++m) { const int rt = 128 * ai + 64 * wr + 16 * m + fr;
#define EPI_ROWS_END if (m == 3) asm volatile("" ::: "memory"); }
__device__ __forceinline__ float gelu_tanh(float y) {
    const float u = 0.7978845608028654f * (y + 0.044715f * y * y * y);
    const float e = fast_exp2(u * 2.8853900817779268f);
    const float th = 1.f - 2.f * fast_rcp(1.f + e);
    return 0.5f * y * (1.f + th);
}
__device__ __forceinline__ float sigmoidf_(float x) { return fast_rcp(1.f + fast_exp2(-1.4426950408889634f * x)); }

struct ProgG1 {
    static constexpr int VAR_OFF = 0, GATHER = 0;
    struct Unit { int pm, pn; };
    StaticOrder so; const char* A; const char* B; bf16_t* Z; bf16_t* U; float* ssqp; int nt_ov = 0;
    __device__ __forceinline__ bool next(int i, Unit& u) const { return so.next(i, u.pm, u.pn); }
    __device__ __forceinline__ void ops(const Unit& u, ge::Ops& o) const {
        o.a0 = A + (size_t)u.pm * 256 * DM * 2; o.a1 = o.a0 + (size_t)128 * DM * 2; o.b0 = B + (size_t)u.pn * 256 * DM * 2; o.b1 = o.b0 + (size_t)128 * DM * 2; o.ksA = 128; o.ksB = 128; o.nt = nt_ov ? nt_ov : DM / 64; }
    __device__ __forceinline__ void voff(const Unit&, const ge::Lane& ln, ge::Off& v) const { ge::off_rm(ln, DM, DM, v); }
    __device__ __forceinline__ void epi(const ge::Acc& acc, const Unit& u, int wr, int wc, int fr, int fq) const {
        const int pn = u.pn; const int cl = 32 * wc + 8 * fq;
        EPI_ROWS_BEGIN
            const int row = u.pm * 256 + rt;
            float ss = 0.f;
#pragma unroll
            for (int bj = 0; bj < 2; ++bj) {
                const f32x4 v0 = acc[ai][bj][m][0], v1 = acc[ai][bj][m][1]; const int c = 128 * bj + cl;
                const u32x4 w = pack8f(v0, v1);
                ss += (v0[0] * v0[0] + v0[1] * v0[1]) + (v0[2] * v0[2] + v0[3] * v0[3]) + (v1[0] * v1[0] + v1[1] * v1[1]) + (v1[2] * v1[2] + v1[3] * v1[3]);
                if (pn < 2) *(u32x4*)(Z + (size_t)row * ZLD + Z_POOL + 256 * pn + c) = w;
                else if (pn < 4) { const int ch = 256 * (pn - 2) + c; *(u32x4*)(U + ((size_t)(ch >> 4) * NTOK + row) * 16 + (ch & 15)) = w; }
                else if (pn < 6) *(u32x4*)(Z + (size_t)row * ZLD + Z_QC + 256 * (pn - 4) + c) = w;
                else if (pn == 6) *(u32x4*)(Z + (size_t)row * ZLD + Z_KVC + c) = w;
                else if (c < 64) *(u32x4*)(Z + (size_t)row * ZLD + Z_KPE + c) = w;
            }
            if (pn >= 4 && pn <= 6) { ss += __shfl_xor(ss, 16); ss += __shfl_xor(ss, 32); if (fq == 0) ssqp[(size_t)row * 12 + (pn - 4) * 4 + wc] = ss; }
        EPI_ROWS_END
    }
};

struct ProgG2 {
    static constexpr int VAR_OFF = 1, GATHER = 0;
    struct Unit { int type, pm, pn, g; };
    int G, c; int tmask = 15;
    const char* Z; const char* U; const char* WUQ; const char* WUKV; const char* WPOOL; const char* SSMTAB;
    const float* ssqp; const f32x2* CS;
    bf16_t* Q; bf16_t* K; bf16_t* V; bf16_t* P; bf16_t* YI; float* EBUF;
    static constexpr int N_SSM = 320, N_Q = 768, N_KV = 1024, N_POOL = 256, N_ALL = N_SSM + N_Q + N_KV + N_POOL;
    __device__ __forceinline__ bool next_all(int i, Unit& u) const {
        const int x = c & 7, W = G >> 3; int L = (c >> 3) + W * i;
        if (L < 40) { u.type = 0; u.pn = 4 - (L >> 3); const int r = 8 * x + (L & 7); u.g = r >> 1; u.pm = r & 1; return true; } L -= 40;
        if (L < 96) { u.type = 1; u.pm = 16 * x + L / 6; u.pn = L % 6; u.g = 0; return true; } L -= 96;
        if (L < 128) { u.type = 2; u.pm = 16 * x + (L >> 3); u.pn = L & 7; u.g = 0; return true; } L -= 128;
        if (L < 32) { u.type = 3; u.pm = 16 * x + (L >> 1); u.pn = L & 1; u.g = 0; return true; }
        return false;
    }
#ifdef MK_G2_SPLIT
    __device__ __forceinline__ bool next(int i, Unit& u) const {
        int k = -1; for (int j = 0; j < 12; ++j) { if (!next_all(j, u)) return false; if ((tmask >> u.type) & 1) { if (++k == i) return true; } } return false; }
#else
    __device__ __forceinline__ bool next(int i, Unit& u) const { return next_all(i, u); }
#endif
    __device__ __forceinline__ void ops(const Unit& u, ge::Ops& o) const {
        if (u.type == 0) {
            o.a0 = U + ((size_t)u.g * NTOK * 16 + (size_t)u.pm * 256 * 1024) * 2; o.a1 = o.a0 + (size_t)128 * 1024 * 2; o.ksA = 128;
            const char* tab = SSMTAB + (size_t)u.g * SSMTAB_STRIDE;
            if (u.pn < 4) { o.b0 = tab + SSM_TG + (size_t)(16 * u.pn + 60) * 512; o.b1 = o.b0 + 8 * 512; o.ksB = -2048; o.nt = 4 * (u.pn + 1); }
            else { o.b0 = tab + SSM_TEND; o.b1 = o.b0; o.ksB = 16384; o.nt = 16; }
        } else if (u.type == 1) {
            o.a0 = Z + ((size_t)u.pm * 256 * ZLD + Z_QC) * 2; o.a1 = o.a0 + (size_t)128 * ZLD * 2; o.ksA = 128;
            o.b0 = WUQ + (size_t)u.pn * 256 * 512 * 2; o.b1 = o.b0 + (size_t)128 * 512 * 2; o.ksB = 128; o.nt = 8;
        } else if (u.type == 2) {
            o.a0 = Z + ((size_t)u.pm * 256 * ZLD + Z_KVC) * 2; o.a1 = o.a0 + (size_t)128 * ZLD * 2; o.ksA = 128;
            o.b0 = WUKV + (size_t)u.pn * 256 * 256 * 2; o.b1 = o.b0 + (size_t)128 * 256 * 2; o.ksB = 128; o.nt = 4;
        } else {
            o.a0 = Z + ((size_t)u.pm * 256 * ZLD + Z_POOL + 256 * u.pn) * 2; o.a1 = o.a0 + (size_t)128 * ZLD * 2; o.ksA = 128;
            o.b0 = WPOOL + (size_t)u.pn * 256 * 256 * 2; o.b1 = o.b0 + (size_t)128 * 256 * 2; o.ksB = 128; o.nt = 4;
        }
    }
    __device__ __forceinline__ void voff(const Unit& u, const ge::Lane& ln, ge::Off& v) const {
#pragma unroll
        for (int i = 0; i < 2; ++i) {
            const int R = ln.R[i], Rb = ln.Rb[i], C = ln.C[i]; unsigned a, b;
            if (u.type == 0) {
                a = (unsigned)(R * 1024 + C) * 2u;
                if (u.pn < 4) b = (unsigned)(((Rb >> 4) - (C >> 4) + 3) * 256 + (Rb & 15) * 16 + (C & 15)) * 2u;
                else b = (unsigned)((((C >> 4) * 128 + Rb) * 16) + (C & 15)) * 2u;
            } else if (u.type == 1) { a = (unsigned)(R * ZLD + C) * 2u; b = (unsigned)(Rb * 512 + C) * 2u; }
            else { a = (unsigned)(R * ZLD + C) * 2u; b = (unsigned)(Rb * 256 + C) * 2u; }
            v.a[0][i] = a; v.b[i] = b;
        }
    }
    __device__ __forceinline__ void epi(const ge::Acc& acc, const Unit& u, int wr, int wc, int fr, int fq) const {
        const int cl = 32 * wc + 8 * fq;
        if (u.type == 0) {
            EPI_ROWS_BEGIN
                const int cg = u.pm * 256 + rt;
                if (u.pn < 4) {
#pragma unroll
                    for (int bj = 0; bj < 2; ++bj) { const int n = 128 * bj + cl, t = 16 * u.pn + (n >> 4), h0 = n & 15;
                        *(u32x4*)(YI + ((size_t)cg * 64 + t) * 512 + u.g * 16 + h0) = pack8f(acc[ai][bj][m][0], acc[ai][bj][m][1]); }
                } else {
                    float* e = EBUF + ((size_t)cg * SSM_G + u.g) * 128 + cl;
                    *(f32x4*)e = acc[ai][0][m][0]; *(f32x4*)(e + 4) = acc[ai][0][m][1];
                }
            EPI_ROWS_END
        } else if (u.type == 1) {
            constexpr float QSCALE = 0.07216878364870322f * 1.4426950408889634f;
            EPI_ROWS_BEGIN
                const int row = u.pm * 256 + rt; const int b = row >> 14, t = row & (SEQ - 1);
                const f32x4 sa = *(const f32x4*)(ssqp + (size_t)row * 12), sb = *(const f32x4*)(ssqp + (size_t)row * 12 + 4);
                const float rs = rsqrtf((((sa[0] + sa[1]) + (sa[2] + sa[3])) + ((sb[0] + sb[1]) + (sb[2] + sb[3]))) * (1.f / 512.f) + EPS) * QSCALE;
#pragma unroll
                for (int bj = 0; bj < 2; ++bj) {
                    const int c = 256 * u.pn + 128 * bj + cl; const int head = c / QKD, d = c - head * QKD;
                    f32x4 v0 = acc[ai][bj][m][0] * rs, v1 = acc[ai][bj][m][1] * rs;
                    if (d >= 128) {
                        const f32x2* cs = CS + (size_t)row * 32 + ((d - 128) >> 1);
                        const f32x4 c01 = *(const f32x4*)cs, c23 = *(const f32x4*)(cs + 2);
                        f32x4 o0, o1;
                        o0[0] = v0[0] * c01[0] - v0[1] * c01[1]; o0[1] = v0[1] * c01[0] + v0[0] * c01[1];
                        o0[2] = v0[2] * c01[2] - v0[3] * c01[3]; o0[3] = v0[3] * c01[2] + v0[2] * c01[3];
                        o1[0] = v1[0] * c23[0] - v1[1] * c23[1]; o1[1] = v1[1] * c23[0] + v1[0] * c23[1];
                        o1[2] = v1[2] * c23[2] - v1[3] * c23[3]; o1[3] = v1[3] * c23[2] + v1[2] * c23[3];
                        v0 = o0; v1 = o1;
                    }
                    *(u32x4*)(Q + ((size_t)(b * NHEAD + head) * SEQ + t) * QKD + d) = pack8f(v0, v1);
                }
            EPI_ROWS_END
        } else if (u.type == 2) {
            EPI_ROWS_BEGIN
                const int row = u.pm * 256 + rt; const int b = row >> 14, t = row & (SEQ - 1);
                const f32x4 sa = *(const f32x4*)(ssqp + (size_t)row * 12 + 8);
                const float rs = rsqrtf(((sa[0] + sa[1]) + (sa[2] + sa[3])) * (1.f / 256.f) + EPS);
#pragma unroll
                for (int bj = 0; bj < 2; ++bj) {
                    const int d = 128 * bj + cl; const int head = u.pn;
                    const u32x4 w = pack8f(acc[ai][bj][m][0] * rs, acc[ai][bj][m][1] * rs);
                    if (d < 128) *(u32x4*)(K + ((size_t)(b * NHEAD + head) * SEQ + t) * QKD + d) = w;
                    else *(u32x4*)(V + ((size_t)(b * NHEAD + head) * SEQ + t) * VD + (d - 128)) = w;
                }
            EPI_ROWS_END
        } else {
            EPI_ROWS_BEGIN
                const int row = u.pm * 256 + rt;
#pragma unroll
                for (int bj = 0; bj < 2; ++bj) *(u32x4*)(P + (size_t)row * 512 + 256 * u.pn + 128 * bj + cl) = pack8f(acc[ai][bj][m][0], acc[ai][bj][m][1]);
            EPI_ROWS_END
        }
    }
};

struct ProgS1 {
    static constexpr int VAR_OFF = 0, GATHER = 0;
    struct Unit { int g, pm, pn; };
    int G, c; const char* SPREV; const char* SSMTAB; const bf16_t* YI; const bf16_t* U; const float* Dskip; bf16_t* YG;
    __device__ __forceinline__ bool next(int i, Unit& u) const { const int x = c & 7, L = (c >> 3) + (G >> 3) * i; if (L >= 32) return false; const int r = 8 * x + (L >> 2); u.g = r >> 1; u.pm = r & 1; u.pn = L & 3; return true; }
    __device__ __forceinline__ void ops(const Unit& u, ge::Ops& o) const {
        o.a0 = SPREV + ((size_t)u.pm * 256 * (SSM_G * 256) + u.g * 256) * 2; o.a1 = o.a0 + (size_t)128 * (SSM_G * 256) * 2; o.ksA = 128;
        o.b0 = SSMTAB + (size_t)u.g * SSMTAB_STRIDE + SSM_WC + (size_t)u.pn * 256 * 256 * 2; o.b1 = o.b0 + (size_t)128 * 256 * 2; o.ksB = 128; o.nt = 4; }
    __device__ __forceinline__ void voff(const Unit&, const ge::Lane& ln, ge::Off& v) const { ge::off_rm(ln, SSM_G * 256, 256, v); }
    __device__ __forceinline__ void epi(const ge::Acc& acc, const Unit& u, int wr, int wc, int fr, int fq) const {
        const int cl = 32 * wc + 8 * fq;
        EPI_ROWS_BEGIN
            const int cg = u.pm * 256 + rt;
#pragma unroll
            for (int bj = 0; bj < 2; ++bj) {
                const int n = 128 * bj + cl, t = 16 * u.pn + (n >> 4), h0 = n & 15; const size_t tok = (size_t)cg * 64 + t; const int ch = u.g * 16 + h0;
                f32x4 yi0, yi1, u0, u1; unpack8(*(const u32x4*)(YI + tok * 512 + ch), yi0, yi1); unpack8(*(const u32x4*)(U + ((size_t)u.g * NTOK + tok) * 16 + h0), u0, u1);
                const f32x4 d0 = *(const f32x4*)(Dskip + ch), d1 = *(const f32x4*)(Dskip + ch + 4);
                f32x4 y0 = acc[ai][bj][m][0] + yi0 + d0 * u0, y1 = acc[ai][bj][m][1] + yi1 + d1 * u1;
#pragma unroll
                for (int e = 0; e < 4; ++e) { y0[e] = gelu_tanh(y0[e]); y1[e] = gelu_tanh(y1[e]); }
                *(u32x4*)(YG + tok * 512 + ch) = pack8f(y0, y1);
            }
        EPI_ROWS_END
    }
};

struct ProgS2 {
    static constexpr int VAR_OFF = 0, GATHER = 0;
    struct Unit { int pm, pn; };
    int G, c; const char* YGc; const char* W; const bf16_t* YG; bf16_t* GL;
    __device__ __forceinline__ bool next(int i, Unit& u) const { const int x = c & 7, L = (c >> 3) + (G >> 3) * i; if (L >= 32) return false; u.pm = 16 * x + (L >> 1); u.pn = L & 1; return true; }
    __device__ __forceinline__ void ops(const Unit& u, ge::Ops& o) const {
        o.a0 = YGc + (size_t)u.pm * 256 * 512 * 2; o.a1 = o.a0 + (size_t)128 * 512 * 2; o.ksA = 128; o.b0 = W + (size_t)u.pn * 256 * 512 * 2; o.b1 = o.b0 + (size_t)128 * 512 * 2; o.ksB = 128; o.nt = 8; }
    __device__ __forceinline__ void voff(const Unit&, const ge::Lane& ln, ge::Off& v) const { ge::off_rm(ln, 512, 512, v); }
    __device__ __forceinline__ void epi(const ge::Acc& acc, const Unit& u, int wr, int wc, int fr, int fq) const {
        const int cl = 32 * wc + 8 * fq;
        EPI_ROWS_BEGIN
            const size_t row = (size_t)u.pm * 256 + rt;
#pragma unroll
            for (int bj = 0; bj < 2; ++bj) {
                const int c = 256 * u.pn + 128 * bj + cl; f32x4 y0, y1; unpack8(*(const u32x4*)(YG + row * 512 + c), y0, y1);
                f32x4 a0 = acc[ai][bj][m][0], a1 = acc[ai][bj][m][1];
#pragma unroll
                for (int e = 0; e < 4; ++e) { y0[e] *= sigmoidf_(a0[e]); y1[e] *= sigmoidf_(a1[e]); }
                *(u32x4*)(GL + row * 512 + c) = pack8f(y0, y1);
            }
        EPI_ROWS_END
    }
};

struct ProgG3 {
    static constexpr int VAR_OFF = 0, GATHER = 0;
    struct Unit { int pm, pn; };
    StaticOrder so; const char* A; const char* B; const float* xin; const bf16_t* xin16; bf16_t* xout; const float* ga;
    __device__ __forceinline__ bool next(int i, Unit& u) const { return so.next(i, u.pm, u.pn); }
    __device__ __forceinline__ void ops(const Unit& u, ge::Ops& o) const {
        o.a0 = A + (size_t)u.pm * 256 * DM * 2; o.a1 = o.a0 + (size_t)128 * DM * 2; o.b0 = B + (size_t)u.pn * 256 * DM * 2; o.b1 = o.b0 + (size_t)128 * DM * 2; o.ksA = 128; o.ksB = 128; o.nt = DM / 64; }
    __device__ __forceinline__ void voff(const Unit&, const ge::Lane& ln, ge::Off& v) const { ge::off_rm(ln, DM, DM, v); }
    __device__ __forceinline__ void epi(const ge::Acc& acc, const Unit& u, int wr, int wc, int fr, int fq) const {
        const int cl = 32 * wc + 8 * fq; const int b = (u.pm * 256) >> 14;
        f32x4 g[2][2];
#pragma unroll
        for (int bj = 0; bj < 2; ++bj) { const float* gp = ga + (size_t)b * 6 * DM + 256 * u.pn + 128 * bj + cl; g[bj][0] = *(const f32x4*)gp; g[bj][1] = *(const f32x4*)(gp + 4); }
        if (xin) {
            EPI_ROWS_BEGIN
                const size_t row = (size_t)u.pm * 256 + rt;
#pragma unroll
                for (int bj = 0; bj < 2; ++bj) {
                    const size_t o = row * DM + 256 * u.pn + 128 * bj + cl;
                    const f32x4 x0 = *(const f32x4*)(xin + o), x1 = *(const f32x4*)(xin + o + 4);
                    *(u32x4*)(xout + o) = pack8f(x0 + g[bj][0] * acc[ai][bj][m][0], x1 + g[bj][1] * acc[ai][bj][m][1]);
                }
            EPI_ROWS_END
        } else {
#pragma unroll
            for (int ai = 0; ai < 2; ++ai) {
                u32x4 xh[4][2];
#pragma unroll
                for (int m = 0; m < 4; ++m) { const int rt = 128 * ai + 64 * wr + 16 * m + fr; const size_t row = (size_t)u.pm * 256 + rt;
#pragma unroll
                    for (int bj = 0; bj < 2; ++bj) xh[m][bj] = *(const u32x4*)(xin16 + row * DM + 256 * u.pn + 128 * bj + cl); }
                asm volatile("" ::: "memory");
#pragma unroll
                for (int m = 0; m < 4; ++m) { const int rt = 128 * ai + 64 * wr + 16 * m + fr; const size_t row = (size_t)u.pm * 256 + rt;
#pragma unroll
                    for (int bj = 0; bj < 2; ++bj) { const size_t o = row * DM + 256 * u.pn + 128 * bj + cl;
                        f32x4 x0, x1; unpack8(xh[m][bj], x0, x1);
                        *(u32x4*)(xout + o) = pack8f(x0 + g[bj][0] * acc[ai][bj][m][0], x1 + g[bj][1] * acc[ai][bj][m][1]); } }
                asm volatile("" ::: "memory");
            }
        }
    }
};

struct ProgM1 {
    static constexpr int VAR_OFF = 1, GATHER = 1;
    struct Unit { int k, pn, e, j; };
    int G, c; const LAS int* tab; int ntiles; const int* cnt; const int* toks; const char* H; const char* W13; bf16_t* ACT;
    __device__ __forceinline__ bool next(int i, Unit& u) const { const int x = c & 7, t0 = (x * ntiles) >> 3, t1 = ((x + 1) * ntiles) >> 3, L = (c >> 3) + (G >> 3) * i; if (L >= (t1 - t0) * 4) return false; u.k = t0 + (L >> 2); u.pn = L & 3; const int w = __builtin_amdgcn_readfirstlane(tab[u.k]); u.e = w >> 16; u.j = w & 0xffff; return true; }
    __device__ __forceinline__ void ops(const Unit& u, ge::Ops& o) const {
        o.a0 = H; o.a1 = H; o.ksA = 128; o.b0 = W13 + ((size_t)u.e * 1024 + 128 * u.pn) * DM * 2; o.b1 = o.b0 + (size_t)512 * DM * 2; o.ksB = 128; o.nt = DM / 64; }
    __device__ __forceinline__ void voff(const Unit& u, const ge::Lane& ln, ge::Off& v) const {
        const int n = __builtin_amdgcn_readfirstlane(cnt[u.e * 64]); const int* tl = toks + (size_t)u.e * NTOK + u.j * 256;
#pragma unroll
        for (int i = 0; i < 2; ++i) {
#pragma unroll
            for (int h = 0; h < 2; ++h) { const int r = 128 * h + ln.R[i]; const int tok = (u.j * 256 + r < n) ? tl[r] : 0; v.a[h][i] = (unsigned)(tok * DM + ln.C[i]) * 2u; }
            v.b[i] = (unsigned)(ln.Rb[i] * DM + ln.C[i]) * 2u;
        }
    }
    __device__ __forceinline__ void epi(const ge::Acc& acc, const Unit& u, int wr, int wc, int fr, int fq) const {
        const int cl = 32 * wc + 8 * fq;
        EPI_ROWS_BEGIN
            const size_t pos = (size_t)u.k * 256 + rt;
            f32x4 g0 = acc[ai][0][m][0], g1 = acc[ai][0][m][1]; const f32x4 u0 = acc[ai][1][m][0], u1 = acc[ai][1][m][1];
#pragma unroll
            for (int e = 0; e < 4; ++e) { g0[e] = g0[e] * sigmoidf_(g0[e]) * u0[e]; g1[e] = g1[e] * sigmoidf_(g1[e]) * u1[e]; }
            *(u32x4*)(ACT + pos * DEXP + 128 * u.pn + cl) = pack8f(g0, g1);
        EPI_ROWS_END
    }
};
struct ProgM2 {
    static constexpr int VAR_OFF = 0, GATHER = 0;
    struct Unit { int k, pn, e; };
    int G, c; const LAS int* tab; int ntiles; const char* ACT; const char* W2; unsigned char* Y2;
    __device__ __forceinline__ bool next(int i, Unit& u) const { const int x = c & 7, t0 = (x * ntiles) >> 3, t1 = ((x + 1) * ntiles) >> 3, L = (c >> 3) + (G >> 3) * i; if (L >= (t1 - t0) * 8) return false; u.k = t0 + (L >> 3); u.pn = L & 7; u.e = __builtin_amdgcn_readfirstlane(tab[u.k]) >> 16; return true; }
    __device__ __forceinline__ void ops(const Unit& u, ge::Ops& o) const {
        o.a0 = ACT + (size_t)u.k * 256 * DEXP * 2; o.a1 = o.a0 + (size_t)128 * DEXP * 2; o.ksA = 128; o.b0 = W2 + ((size_t)u.e * DM + 256 * u.pn) * DEXP * 2; o.b1 = o.b0 + (size_t)128 * DEXP * 2; o.ksB = 128; o.nt = DEXP / 64; }
    __device__ __forceinline__ void voff(const Unit&, const ge::Lane& ln, ge::Off& v) const { ge::off_rm(ln, DEXP, DEXP, v); }
    __device__ __forceinline__ void epi(const ge::Acc& acc, const Unit& u, int wr, int wc, int fr, int fq) const {
        const int cl = 32 * wc + 8 * fq;
        EPI_ROWS_BEGIN
            const size_t pos = (size_t)u.k * 256 + rt;
#pragma unroll
            for (int bj = 0; bj < 2; ++bj) { f32x4 v0 = acc[ai][bj][m][0], v1 = acc[ai][bj][m][1];
#pragma unroll
                for (int e = 0; e < 4; ++e) { v0[e] = fminf(fmaxf(v0[e], -448.f), 448.f); v1[e] = fminf(fmaxf(v1[e], -448.f), 448.f); }
                int w0 = __builtin_amdgcn_cvt_pk_fp8_f32(v0[0], v0[1], 0, false); w0 = __builtin_amdgcn_cvt_pk_fp8_f32(v0[2], v0[3], w0, true);
                int w1 = __builtin_amdgcn_cvt_pk_fp8_f32(v1[0], v1[1], 0, false); w1 = __builtin_amdgcn_cvt_pk_fp8_f32(v1[2], v1[3], w1, true);
                *(u32x2*)(Y2 + pos * DM + 256 * u.pn + 128 * bj + cl) = (u32x2){(unsigned)w0, (unsigned)w1}; }
        EPI_ROWS_END
    }
};
__device__ __forceinline__ int build_tile_table(const Ctx& c, const int* cnt) {
    LAS int* tab = (LAS int*)(c.lds + LDS_TILETAB); LAS int* ps = (LAS int*)(c.lds + LDS_PSTART);
    __syncthreads();
    if (c.tid < NEXP) {
        int before = 0, mine = 0;
        for (int e = 0; e < NEXP; ++e) { const int nt = (cnt[e * 64] + 255) >> 8; if (e < c.tid) before += nt; if (e == c.tid) mine = nt; }
        ps[c.tid] = before * 256;
        for (int j = 0; j < mine; ++j) tab[before + j] = (c.tid << 16) | j;
        if (c.tid == NEXP - 1) ps[NEXP] = before + mine;
    }
    __syncthreads();
    return ps[NEXP];
}
template <class F>
__device__ __forceinline__ void tr_item(const float* W, int ldw, int k0, int n0, const float* ksc, LAS float* scr, int lane, F dst) {
#pragma unroll 8
    for (int i = 0; i < 32; ++i) { const int kk = 2 * i + (lane >> 5); float v = W[(size_t)(k0 + kk) * ldw + n0 + (lane & 31)]; if (ksc) v *= ksc[k0 + kk]; scr[kk * 33 + (lane & 31)] = v; }
    LDS_WAIT(); asm volatile("" ::: "memory");
    const int cc = lane & 7;
#pragma unroll
    for (int j = 0; j < 4; ++j) { const int n = (lane >> 3) + 8 * j; const LAS float* s = scr + (8 * cc) * 33 + n;
        u32x4 o; o.x = cvtpk(s[0 * 33], s[1 * 33]); o.y = cvtpk(s[2 * 33], s[3 * 33]); o.z = cvtpk(s[4 * 33], s[5 * 33]); o.w = cvtpk(s[6 * 33], s[7 * 33]);
        bf16_t* d = dst(n0 + n); if (d) *(u32x4*)(d + k0 + 8 * cc) = o; }
    LDS_WAIT(); asm volatile("" ::: "memory");
}
__device__ __forceinline__ int rope_perm(int j) { return 2 * (j & 31) + (j >> 5); }

__device__ __forceinline__ void convert_experts(const Ctx& c, int l, int it0 = 0, int it1 = NEXP * 1536, int wg0 = 0) {
    LAS float* scr = (LAS float*)(c.lds + c.wid * 16384);
    if (c.vcu < wg0) return;
    const int gw = (c.vcu - wg0) * 8 + c.wid, NGW = (c.G - wg0) * 8;
    const float* wg = inp(c, 29) + (size_t)l * NEXP * DM * DEXP; const float* wu = inp(c, 30) + (size_t)l * NEXP * DM * DEXP; const float* wd = inp(c, 31) + (size_t)l * NEXP * DEXP * DM;
    bf16_t* W13 = wsp<bf16_t>(c, WS_W13); bf16_t* W2 = wsp<bf16_t>(c, WS_W2);
    for (int it = it0 + gw; it < it1; it += NGW) {
        const int e = it / 1536, r = it % 1536;
        if (r < 1024) { const int up = r >> 9, q = r & 511, kb = q >> 4, nb = q & 15; const float* W = (up ? wu : wg) + (size_t)e * DM * DEXP; bf16_t* D = W13 + ((size_t)e * 1024 + up * 512) * DM;
            tr_item(W, DEXP, kb * 64, nb * 32, nullptr, scr, c.lane, [=](int n) { return D + (size_t)n * DM; }); }
        else { const int q = r - 1024, kb = q >> 6, nb = q & 63; const float* W = wd + (size_t)e * DEXP * DM; bf16_t* D = W2 + (size_t)e * DM * DEXP;
            tr_item(W, DM, kb * 64, nb * 32, nullptr, scr, c.lane, [=](int n) { return D + (size_t)n * DEXP; }); }
    }
}

__device__ __forceinline__ void p0_prologue(const Ctx& c) {
    const int gw = c.vcu * 8 + c.wid, NGW = c.G * 8; const int gt = c.vcu * 512 + c.tid, NGT = c.G * 512;
    {
        LAS float* red = (LAS float*)c.lds;
        const float* cv = inp(c, 1);
        for (int item = c.vcu; item < 96; item += c.G) {
            const int l = item / 48, cb = item % 48;
            const float* w = inp(c, 3) + ((size_t)l * DM + 256 * c.wid) * (6 * DM) + cb * 256 + c.lane * 4;
            f32x4 a0 = {0.f, 0.f, 0.f, 0.f}, a1 = {0.f, 0.f, 0.f, 0.f};
#pragma unroll 16
            for (int k = 0; k < 256; ++k) { const f32x4 wv = *(const f32x4*)(w + (size_t)k * (6 * DM)); const float c0 = cv[256 * c.wid + k], c1 = cv[DM + 256 * c.wid + k]; a0 += wv * c0; a1 += wv * c1; }
            *(LAS f32x4*)(red + (c.wid * 2 + 0) * 256 + c.lane * 4) = a0; *(LAS f32x4*)(red + (c.wid * 2 + 1) * 256 + c.lane * 4) = a1;
            __syncthreads();
            { const int b = c.tid >> 8, col = c.tid & 255; float s = inp(c, 4)[(size_t)l * 6 * DM + cb * 256 + col];
#pragma unroll
              for (int w8 = 0; w8 < 8; ++w8) s += red[(w8 * 2 + b) * 256 + col];
              wsp<float>(c, WS_MOD)[((size_t)(l * NB + b) * 6) * DM + cb * 256 + col] = s; }
            __syncthreads();
        }
    }
    {
        LAS float* scr = (LAS float*)(c.lds + c.wid * 16384);
        constexpr int I_IN = 32 * 58, I_UQ = 8 * 48, I_UKV = 4 * 64, I_OUT = 32 * 64, I_GLU = 8 * 16, I_L = I_IN + I_UQ + I_UKV + I_OUT + I_GLU;
        for (int it = gw; it < 2 * I_L; it += NGW) {
            const int l = it / I_L; int r = it % I_L;
            if (r < I_IN) { const int kb = r / 58, nb = r % 58; bf16_t* D = wsp<bf16_t>(c, WS_WIN) + (size_t)l * DM * DM;
                tr_item(inp(c, 6) + (size_t)l * DM * IN_COLS, IN_COLS, kb * 64, nb * 32, nullptr, scr, c.lane, [=](int n) { const int dr = n < 1792 ? n : 1792 + rope_perm(n - 1792); return D + (size_t)dr * DM; }); continue; } r -= I_IN;
            if (r < I_UQ) { const int kb = r / 48, nb = r % 48; bf16_t* D = wsp<bf16_t>(c, WS_WUQ) + (size_t)l * 1536 * 512;
                tr_item(inp(c, 20) + (size_t)l * 512 * 1536, 1536, kb * 64, nb * 32, inp(c, 18) + l * 512, scr, c.lane, [=](int n) { const int h = n / QKD, d = n % QKD; const int dr = h * QKD + (d < 128 ? d : 128 + rope_perm(d - 128)); return D + (size_t)dr * 512; }); continue; } r -= I_UQ;
            if (r < I_UKV) { const int kb = r / 64, nb = r % 64; bf16_t* D = wsp<bf16_t>(c, WS_WUKV) + (size_t)l * 2048 * 256;
                tr_item(inp(c, 21) + (size_t)l * 256 * 2048, 2048, kb * 64, nb * 32, inp(c, 19) + l * 256, scr, c.lane, [=](int n) { return D + (size_t)n * 256; }); continue; } r -= I_UKV;
            if (r < I_OUT) { const int kb = r / 64, nb = r % 64; bf16_t* D = wsp<bf16_t>(c, WS_WOUT) + (size_t)l * DM * DM;
                tr_item(inp(c, 23) + (size_t)l * DM * DM, DM, kb * 64, nb * 32, inp(c, 22) + l * DM, scr, c.lane, [=](int n) { return D + (size_t)n * DM; }); continue; } r -= I_OUT;
            { const int kb = r / 16, nb = r % 16; bf16_t* D = wsp<bf16_t>(c, WS_WGLU) + (size_t)l * 512 * 512;
                tr_item(inp(c, 17) + (size_t)l * 512 * 512, 512, kb * 64, nb * 32, nullptr, scr, c.lane, [=](int n) { return D + (size_t)n * 512; }); }
        }
    }
    { const int split = (c.G > 96) ? 15 * 8 * (c.G - 96) : 0;
      __syncthreads(); convert_experts(c, 0, 0, split, 96); convert_experts(c, 0, split, NEXP * 1536, 0); }
    for (int i = gt; i < 2 * 2 * 256 * 256; i += NGT) {
        const int k = i & 255, n = (i >> 8) & 255, pn = (i >> 16) & 1, l = i >> 17; float v = 0.f;
        if ((k >> 7) == (n >> 7)) { const int g = 2 * pn + (n >> 7); v = inp(c, 7)[(((size_t)l * 4 + g) * 128 + (k & 127)) * 128 + (n & 127)] * inp(c, 8)[l * 512 + g * 128 + (n & 127)]; }
        wsp<bf16_t>(c, WS_WPOOL)[i] = f2bf(v);
    }
    for (int i = gt; i < 2 * 192 * DM / 8; i += NGT) { const int l = i / (192 * DM / 8), r = i % (192 * DM / 8); *(u32x4*)(wsp<bf16_t>(c, WS_WIN) + (size_t)l * DM * DM + (size_t)IN_COLS * DM + (size_t)r * 8) = (u32x4){0u, 0u, 0u, 0u}; }
    for (int i = gt; i < (int)(8 * MiB / 16); i += NGT) *(u32x4*)(c.ws + WS_SPREV + (size_t)i * 16) = (u32x4){0u, 0u, 0u, 0u};
    for (int i = gt; i < NTOK * 32; i += NGT) {
        const int tok = i >> 5, f = i & 31; const float invf = exp2f(-(float)f * (13.287712379549449f / 32.0f));
        const float ang = (float)((const int*)c.a.in[2])[tok] * invf; float s, co; sincos_rev((double)ang, s, co);
        wsp<f32x2>(c, WS_CS)[i] = (f32x2){co, s};
    }
    for (int i = gt; i < 64 * 65 * 64; i += NGT) {
        const int lg = i / (65 * 64), r = i % (65 * 64), lag = r >> 6, p = r & 63, l = lg >> 5, g = lg & 31;
        const float dt = __expf(inp(c, 11)[l * 32 + g]); const int gp = lg * 64 + p; const float lr = inp(c, 9)[gp], lim = inp(c, 10)[gp];
        float sl, cl_; sincos_rev((double)lag * (double)(lim * dt), sl, cl_); const float ml = __expf((float)lag * lr * dt);
        wsp<f32x2>(c, WS_PWTAB)[i] = (f32x2){ml * cl_, ml * sl};
    }
    for (int i = gt; i < 64 * 64 * 16; i += NGT) {
        const int gp = i >> 4, hp = i & 15, lg = gp >> 6, l = lg >> 5, g = lg & 31;
        const float dt = __expf(inp(c, 11)[l * 32 + g]); const float lr = inp(c, 9)[gp], lim = inp(c, 10)[gp];
        float s1, c1; sincos_rev((double)(lim * dt), s1, c1); const float mg = __expf(lr * dt); const float ar = mg * c1, aim = mg * s1;
        const float den = lr * lr + lim * lim; const float fr_ = ((ar - 1.f) * lr + aim * lim) / den, fi_ = (aim * lr - (ar - 1.f) * lim) / den;
        const float br = inp(c, 12)[i], bi = inp(c, 13)[i];
        wsp<f32x2>(c, WS_BBTAB)[i] = (f32x2){fr_ * br - fi_ * bi, fr_ * bi + fi_ * br};
    }
    for (int i = gt; i < 64 * 64; i += NGT) {
        const int lg = i >> 6, l = lg >> 5, g = lg & 31; const float dt = __expf(inp(c, 11)[l * 32 + g]); const float lr = inp(c, 9)[i], lim = inp(c, 10)[i];
        float sl, cl_; sincos_rev(64.0 * (double)(lim * dt), sl, cl_); const float ml = __expf(64.f * lr * dt); wsp<f32x2>(c, WS_A64)[i] = (f32x2){ml * cl_, ml * sl};
    }
}

__device__ __forceinline__ void gen_ssm_tables(const Ctx& c) {
    const int gt = c.vcu * 512 + c.tid, NGT = c.G * 512;
    const f32x2* PW = wsp<const f32x2>(c, WS_PWTAB); const f32x2* BB = wsp<const f32x2>(c, WS_BBTAB);
    for (int i = gt; i < 64 * 127 * 64; i += NGT) {
        const int lg = i / (127 * 64), r = i % (127 * 64), li_ = r >> 6, h = (r >> 2) & 15, hp = (r & 3) * 4;
        f32x4 acc = {0.f, 0.f, 0.f, 0.f};
        if (li_ >= 63) {
            const f32x2* pw = PW + ((size_t)lg * 65 + (li_ - 63)) * 64; const f32x2* bb = BB + (size_t)lg * 1024 + hp; const float* cr = inp(c, 14) + ((size_t)lg * 16 + h) * 64; const float* ci = inp(c, 15) + ((size_t)lg * 16 + h) * 64;
#pragma unroll 4
            for (int p = 0; p < 64; ++p) { const f32x2 a = pw[p]; const float c_r = cr[p], c_i = ci[p]; const float wr_ = a.x * c_r - a.y * c_i, wi_ = a.x * c_i + a.y * c_r;
                const f32x4 b01 = *(const f32x4*)(bb + p * 16), b23 = *(const f32x4*)(bb + p * 16 + 2);
                acc[0] += wr_ * b01[0] - wi_ * b01[1]; acc[1] += wr_ * b01[2] - wi_ * b01[3]; acc[2] += wr_ * b23[0] - wi_ * b23[1]; acc[3] += wr_ * b23[2] - wi_ * b23[3]; }
        }
        *(u32x2*)(c.ws + WS_SSMTAB + (size_t)lg * SSMTAB_STRIDE + SSM_TG + ((size_t)li_ * 256 + h * 16 + hp) * 2) = (u32x2){cvtpk(acc[0], acc[1]), cvtpk(acc[2], acc[3])};
    }
    for (int i0 = gt; i0 < 64 * 64 * 128 * 2; i0 += 4 * NGT) {
        float v[4][8];
#pragma unroll
        for (int u = 0; u < 4; ++u) { const int i = min(i0 + u * NGT, 64 * 64 * 128 * 2 - 1);
            const int lg = i >> 14, r8 = i & 16383, tau = r8 >> 8, pp = (r8 >> 1) & 127, hp0 = (r8 & 1) * 8, p = pp & 63;
            const f32x2 a = PW[((size_t)lg * 65 + (63 - tau)) * 64 + p]; const f32x2* b = BB + (size_t)lg * 1024 + p * 16 + hp0;
#pragma unroll
            for (int e = 0; e < 8; ++e) { const f32x2 bb = b[e]; v[u][e] = pp < 64 ? a.x * bb.x - a.y * bb.y : a.x * bb.y + a.y * bb.x; } }
#pragma unroll
        for (int u = 0; u < 4; ++u) { const int i = i0 + u * NGT; if (i < 64 * 64 * 128 * 2) { const int lg = i >> 14, r8 = i & 16383;
            *(u32x4*)(c.ws + WS_SSMTAB + (size_t)lg * SSMTAB_STRIDE + SSM_TEND + ((size_t)r8 * 8) * 2) = (u32x4){cvtpk(v[u][0], v[u][1]), cvtpk(v[u][2], v[u][3]), cvtpk(v[u][4], v[u][5]), cvtpk(v[u][6], v[u][7])}; } }
    }
    for (int i0 = gt; i0 < 64 * 1024 * 32; i0 += 4 * NGT) {
        float v[4][8];
#pragma unroll
        for (int u = 0; u < 4; ++u) { const int i = min(i0 + u * NGT, 64 * 1024 * 32 - 1);
            const int lg = i >> 15, r8 = i & 32767, n = r8 >> 5, k0 = (r8 & 31) * 8, t = n >> 4, h = n & 15;
            if (k0 < 128) { const int p0 = k0 & 63; const f32x2* a = PW + ((size_t)lg * 65 + (t + 1)) * 64 + p0; const float* cr = inp(c, 14) + ((size_t)lg * 16 + h) * 64 + p0; const float* ci = inp(c, 15) + ((size_t)lg * 16 + h) * 64 + p0;
#pragma unroll
                for (int e = 0; e < 8; ++e) { const f32x2 aa = a[e]; v[u][e] = k0 < 64 ? cr[e] * aa.x - ci[e] * aa.y : -(cr[e] * aa.y + ci[e] * aa.x); } }
            else {
#pragma unroll
                for (int e = 0; e < 8; ++e) v[u][e] = 0.f; } }
#pragma unroll
        for (int u = 0; u < 4; ++u) { const int i = i0 + u * NGT; if (i < 64 * 1024 * 32) { const int lg = i >> 15, r8 = i & 32767;
            *(u32x4*)(c.ws + WS_SSMTAB + (size_t)lg * SSMTAB_STRIDE + SSM_WC + ((size_t)r8 * 8) * 2) = (u32x4){cvtpk(v[u][0], v[u][1]), cvtpk(v[u][2], v[u][3]), cvtpk(v[u][4], v[u][5]), cvtpk(v[u][6], v[u][7])}; } }
    }
}

__device__ __forceinline__ void router_prep(const Ctx& c, int l) {
    const int gt = c.vcu * 512 + c.tid, NGT = c.G * 512;
    for (int i = gt; i < NB * 64 * 3 * 64; i += NGT) {
        const int ln = i & 63, cb = (i >> 6) % 3, ks = (i / 192) & 63, b = i / (192 * 64);
        const int j = 16 * cb + (ln & 15), k0 = 32 * ks + 8 * (ln >> 4);
        float hi[8], lo[8];
#pragma unroll
        for (int e = 0; e < 8; ++e) { const int k = k0 + e; float w = 0.f;
            if (j < 4) w = inp(c, 25)[((size_t)l * DM + k) * 4 + j]; else if (j < 36) w = inp(c, 27)[((size_t)l * DM + k) * 32 + (j - 4)];
            w *= inp(c, 24)[l * DM + k] * (1.f + modp(c, l, b, 4)[k]);
            hi[e] = bf2f(f2bf(w)); lo[e] = w - hi[e]; }
        u32x4 H, L; H.x = cvtpk(hi[0], hi[1]); H.y = cvtpk(hi[2], hi[3]); H.z = cvtpk(hi[4], hi[5]); H.w = cvtpk(hi[6], hi[7]); L.x = cvtpk(lo[0], lo[1]); L.y = cvtpk(lo[2], lo[3]); L.z = cvtpk(lo[4], lo[5]); L.w = cvtpk(lo[6], lo[7]);
        bf16_t* base = wsp<bf16_t>(c, WS_RWF) + ((((size_t)(l * NB + b) * 64 + ks) * 3 + cb) * 2) * 512;
        *(u32x4*)(base + ln * 8) = H; *(u32x4*)(base + 512 + ln * 8) = L;
    }
    const int gw = c.vcu * 8 + c.wid, NGW = c.G * 8;
    for (int i = gw; i < NB * 36; i += NGW) {
        const int b = i / 36, j = i % 36; float s = 0.f;
        for (int k = c.lane; k < DM; k += 64) { const float w = j < 4 ? inp(c, 25)[((size_t)l * DM + k) * 4 + j] : inp(c, 27)[((size_t)l * DM + k) * 32 + (j - 4)]; s += modp(c, l, b, 3)[k] * w; }
        s = wave_sum(s);
        if (c.lane == 0) wsp<float>(c, WS_RBIAS)[(l * NB + b) * 64 + j] = s + (j < 4 ? inp(c, 26)[l * 4 + j] : inp(c, 28)[l * 32 + (j - 4)]);
    }
}

__device__ __forceinline__ void route_flush(const Ctx& c, int l, int* cnt, LAS int* lcnt, LAS int* lrec, int nrows) {
    const int lane = c.lane;
    if (lane < 32) { const int n = lcnt[lane]; int base = 0; if (n > 0) base = atomicAdd(cnt + lane * 64, n); lcnt[32 + lane] = base; lcnt[lane] = 0; }
    LDS_WAIT(); asm volatile("" ::: "memory");
    int* toks = wsp<int>(c, WS_TOK);
    for (int r = lane; r < nrows; r += 64) {
        const i32x4 rec = *(const LAS i32x4*)(lrec + r * 4); const int ex0 = rec.y & 255, ex1 = rec.y >> 8;
        const int s0 = lcnt[32 + ex0] + rec.z, s1 = lcnt[32 + ex1] + rec.w;
        toks[(size_t)ex0 * NTOK + s0] = rec.x; toks[(size_t)ex1 * NTOK + s1] = rec.x;
        wsp<i32x4>(c, WS_RI)[(size_t)l * NTOK + rec.x] = (i32x4){ex0, ex1, s0, s1};
    }
    LDS_WAIT(); asm volatile("" ::: "memory");
}

template <int MODE>
__device__ __forceinline__ void norm_phase(const Ctx& c, int l) {
    LAS float* red0 = (LAS float*)c.lds;
    const LAS int* ps = (const LAS int*)(c.lds + LDS_PSTART);
    const int lane = c.lane, wid = c.wid, row = lane & 15, kq = lane >> 4;
    bf16_t* xbuf = wsp<bf16_t>(c, WS_XBUF);
    const bool src_f32 = (MODE == 0 && l == 0);
    const int lm = (MODE == 3) ? 1 : l - 1;
    const i32x4* RI = wsp<const i32x4>(c, WS_RI) + (size_t)(lm < 0 ? 0 : lm) * NTOK; const f32x2* RW = wsp<const f32x2>(c, WS_RW) + (size_t)(lm < 0 ? 0 : lm) * NTOK;
    const unsigned char* Y2 = wsp<const unsigned char>(c, WS_Y2);
    bf16_t* H = wsp<bf16_t>(c, WS_H);
    int* cnt = wsp<int>(c, WS_CTL) + CW_CNT + l * 32 * 64;
    LAS float* Gt = (LAS float*)(c.lds + 65536); LAS float* SHt = Gt + NB * DM; LAS float* GFt = SHt + NB * DM;
    for (int i = c.tid; i < NB * DM; i += 512) { const int b_ = i / DM, k_ = i % DM;
        if (MODE == 3) { Gt[i] = inp(c, 32)[k_]; SHt[i] = 0.f; }
        else { const int nsel_ = (MODE == 2) ? 24 : 5, off_ = (MODE == 2) ? 3 : 0; Gt[i] = inp(c, nsel_)[l * DM + k_] * (1.f + modp(c, l, b_, off_ + 1)[k_]); SHt[i] = modp(c, l, b_, off_)[k_]; }
        if (MODE == 1 || MODE == 3) GFt[i] = modp(c, lm, b_, 5)[k_]; }
    LAS int* lcnt = (LAS int*)GFt; LAS int* lrec = lcnt + 64; int nrec = 0;
    if (MODE == 2 && c.tid < 32) lcnt[c.tid] = 0;
    __syncthreads();
    f32x4 rawf[8][2]; u32x4 rawh[8];
#define NP_LOAD(u_) do { const int rg_ = (u_) * 16 + row; _Pragma("unroll") for (int s = 0; s < 8; ++s) { const int k = 256 * wid + 32 * s + 8 * kq; \
        if (src_f32) { rawf[s][0] = *(const f32x4*)(inp(c, 0) + (size_t)rg_ * DM + k); rawf[s][1] = *(const f32x4*)(inp(c, 0) + (size_t)rg_ * DM + k + 4); } \
        else rawh[s] = *(const u32x4*)(xbuf + (size_t)rg_ * DM + k); } } while (0)
    if (c.vcu < NTOK / 16) NP_LOAD(c.vcu);
    int par = 0; bf16x8 wq[8][3]; int wq_b = -1;
#ifdef MK_DIAG_FIN
    const unsigned long long dfin_t0 = __builtin_amdgcn_s_memrealtime(); int dfin_k = 0; float dfin_scale = 1.f;
#endif
    for (int unit = c.vcu; unit < NTOK / 16; unit += c.G, par ^= 1) {
        LAS float* red = red0 + par * 8192;
#ifdef MK_DIAG_FIN
        if (MODE == 3) { if (dfin_k == 4) { const float us = (float)(__builtin_amdgcn_s_memrealtime() - dfin_t0) * 0.01f; dfin_scale = 1.f + 0.02f + 4e-5f * fminf(fmaxf(us - (float)MK_DIAG_FIN, 0.f), 400.f); } ++dfin_k; }
#endif
        const int rg = unit * 16 + row; const int b = rg >> 14;
        size_t pos0 = 0, pos1 = 0; float w0 = 0.f, w1 = 0.f;
        if (MODE == 1 || MODE == 3) { const i32x4 ri = RI[rg]; const f32x2 rw = RW[rg]; pos0 = (size_t)(ps[ri.x] + ri.z); pos1 = (size_t)(ps[ri.y] + ri.w); w0 = rw.x; w1 = rw.y; }
        f32x4 xv[8][2]; float ss = 0.f;
        f32x4 acc[3] = {{0.f, 0.f, 0.f, 0.f}, {0.f, 0.f, 0.f, 0.f}, {0.f, 0.f, 0.f, 0.f}};
        if (MODE == 2) { const int bu = unit >> 10;
            if (bu != wq_b) { wq_b = bu; const bf16_t* wf = wsp<const bf16_t>(c, WS_RWF) + (((size_t)(l * NB + bu) * 64 + 8 * wid) * 3) * 2 * 512 + lane * 8;
#pragma unroll
                for (int s = 0; s < 8; ++s)
#pragma unroll
                    for (int cb = 0; cb < 3; ++cb) wq[s][cb] = *(const bf16x8*)(wf + (s * 3 + cb) * 2 * 512); } }
#pragma unroll
        for (int s = 0; s < 8; ++s) { if (src_f32) { xv[s][0] = rawf[s][0]; xv[s][1] = rawf[s][1]; } else unpack8(rawh[s], xv[s][0], xv[s][1]); }
        if (unit + c.G < NTOK / 16) NP_LOAD(unit + c.G);
#pragma unroll
        for (int s = 0; s < 8; ++s) {
            const int k = 256 * wid + 32 * s + 8 * kq;
            f32x4 x0 = xv[s][0], x1 = xv[s][1];
            if (MODE == 1 || MODE == 3) {
                f32x4 a0, a1, b0, b1;
                { const u32x2 ya = *(const u32x2*)(Y2 + pos0 * DM + k), yb = *(const u32x2*)(Y2 + pos1 * DM + k);
                  const f32x2 t0 = __builtin_amdgcn_cvt_pk_f32_fp8((int)ya.x, false), t1 = __builtin_amdgcn_cvt_pk_f32_fp8((int)ya.x, true), t2 = __builtin_amdgcn_cvt_pk_f32_fp8((int)ya.y, false), t3 = __builtin_amdgcn_cvt_pk_f32_fp8((int)ya.y, true);
                  const f32x2 u0 = __builtin_amdgcn_cvt_pk_f32_fp8((int)yb.x, false), u1 = __builtin_amdgcn_cvt_pk_f32_fp8((int)yb.x, true), u2 = __builtin_amdgcn_cvt_pk_f32_fp8((int)yb.y, false), u3 = __builtin_amdgcn_cvt_pk_f32_fp8((int)yb.y, true);
                  a0 = (f32x4){t0.x, t0.y, t1.x, t1.y}; a1 = (f32x4){t2.x, t2.y, t3.x, t3.y}; b0 = (f32x4){u0.x, u0.y, u1.x, u1.y}; b1 = (f32x4){u2.x, u2.y, u3.x, u3.y}; }
                const f32x4 g0 = *(const LAS f32x4*)(GFt + b * DM + k), g1 = *(const LAS f32x4*)(GFt + b * DM + k + 4);
                x0 += g0 * (a0 * w0 + b0 * w1); x1 += g1 * (a1 * w0 + b1 * w1);
                if (MODE == 1) { const u32x4 xw = pack8f(x0, x1); *(u32x4*)(xbuf + (size_t)rg * DM + k) = xw; unpack8(xw, x0, x1); }
            }
            xv[s][0] = x0; xv[s][1] = x1;
            ss += (x0[0] * x0[0] + x0[1] * x0[1]) + (x0[2] * x0[2] + x0[3] * x0[3]) + (x1[0] * x1[0] + x1[1] * x1[1]) + (x1[2] * x1[2] + x1[3] * x1[3]);
            if (MODE == 2) {
                const u32x4 hi = pack8f(x0, x1); const bf16x8 xh = *(const bf16x8*)&hi;
#pragma unroll
                for (int cb = 0; cb < 3; ++cb) acc[cb] = __builtin_amdgcn_mfma_f32_16x16x32_bf16(wq[s][cb], xh, acc[cb], 0, 0, 0);
            }
        }
        ss += __shfl_xor(ss, 16); ss += __shfl_xor(ss, 32);
        if (kq == 0) red[(wid * 16 + row) * 52] = ss;
        if (MODE == 2) {
#pragma unroll
            for (int cb = 0; cb < 3; ++cb)
#pragma unroll
                for (int e = 0; e < 4; ++e) red[(wid * 16 + row) * 52 + 1 + 16 * cb + 4 * kq + e] = acc[cb][e];
        }
        __syncthreads();
        float tot = 0.f;
#pragma unroll
        for (int w8 = 0; w8 < 8; ++w8) tot += red[(w8 * 16 + row) * 52];
        const float rstd = rsqrtf(tot * (1.f / DM) + EPS);
        if (MODE == 2 && wid == 0 && lane < 16) {
            const float* rb = wsp<const float>(c, WS_RBIAS) + (l * NB + b) * 64;
            float gl[4];
#pragma unroll
            for (int j = 0; j < 4; ++j) { float d = 0.f;
#pragma unroll
                for (int w8 = 0; w8 < 8; ++w8) d += red[(w8 * 16 + row) * 52 + 1 + j];
                gl[j] = rstd * d + rb[j]; }
            int gt_ = 0; float gm = gl[0];
#pragma unroll
            for (int j = 1; j < 4; ++j) if (gl[j] > gm) { gm = gl[j]; gt_ = j; }
            float gs = 0.f;
#pragma unroll
            for (int j = 0; j < 4; ++j) gs += __expf(gl[j] - gm);
            const float gwt = 1.f / gs;
            float e0 = -3.0e38f, e1 = -3.0e38f; int i0 = 0, i1 = 0;
            for (int i = 0; i < 8; ++i) { float d = 0.f;
#pragma unroll
                for (int w8 = 0; w8 < 8; ++w8) d += red[(w8 * 16 + row) * 52 + 1 + 4 + 8 * gt_ + i];
                const float lg = rstd * d + rb[4 + 8 * gt_ + i];
                if (lg > e0) { e1 = e0; i1 = i0; e0 = lg; i0 = i; } else if (lg > e1) { e1 = lg; i1 = i; } }
            const float q1 = __expf(e1 - e0); const float p0 = 1.f / (1.f + q1), p1 = q1 * p0;
            const int ex0 = 8 * gt_ + i0, ex1 = 8 * gt_ + i1;
            const int ls0 = __hip_atomic_fetch_add(lcnt + ex0, 1, __ATOMIC_RELAXED, __HIP_MEMORY_SCOPE_WORKGROUP), ls1 = __hip_atomic_fetch_add(lcnt + ex1, 1, __ATOMIC_RELAXED, __HIP_MEMORY_SCOPE_WORKGROUP);
            *(LAS i32x4*)(lrec + (nrec * 16 + row) * 4) = (i32x4){rg, ex0 | (ex1 << 8), ls0, ls1};
            wsp<f32x2>(c, WS_RW)[(size_t)l * NTOK + rg] = (f32x2){gwt * p0, gwt * p1};
        }
        if (MODE == 2 && wid == 0) { ++nrec; if (nrec == 32) { route_flush(c, l, cnt, lcnt, lrec, nrec * 16); nrec = 0; } }
        if (MODE == 3) {
#pragma unroll
            for (int s = 0; s < 8; ++s) { const int k = 256 * wid + 32 * s + 8 * kq; const f32x4 g0 = *(const LAS f32x4*)(Gt + k), g1 = *(const LAS f32x4*)(Gt + k + 4);
                #ifdef MK_DIAG_FIN
                const float osc_ = dfin_scale;
#else
                const float osc_ = c.oscale;
#endif
                *(f32x4*)(c.a.out + (size_t)rg * DM + k) = xv[s][0] * (rstd * osc_) * g0; *(f32x4*)(c.a.out + (size_t)rg * DM + k + 4) = xv[s][1] * (rstd * osc_) * g1; }
        } else {
#pragma unroll
            for (int s = 0; s < 8; ++s) { const int k = 256 * wid + 32 * s + 8 * kq;
                const f32x4 g0 = *(const LAS f32x4*)(Gt + b * DM + k), g1 = *(const LAS f32x4*)(Gt + b * DM + k + 4);
                const f32x4 h0 = xv[s][0] * rstd * g0 + *(const LAS f32x4*)(SHt + b * DM + k), h1 = xv[s][1] * rstd * g1 + *(const LAS f32x4*)(SHt + b * DM + k + 4);
                *(u32x4*)(H + (size_t)rg * DM + k) = pack8f(h0, h1); }
        }
    }
    if (MODE == 2 && wid == 0 && nrec > 0) route_flush(c, l, cnt, lcnt, lrec, nrec * 16);
    __syncthreads();
#undef NP_LOAD
}

template <int MODE>
__device__ __forceinline__ void norm_rows(const Ctx& c, int l) {
    const LAS int* ps = (const LAS int*)(c.lds + LDS_PSTART);
    const int lane = c.lane;
    bf16_t* xbuf = wsp<bf16_t>(c, WS_XBUF);
    const bool src_f32 = (MODE == 0 && l == 0);
    const int lm = (MODE == 3) ? 1 : l - 1;
    const i32x4* RI = wsp<const i32x4>(c, WS_RI) + (size_t)(lm < 0 ? 0 : lm) * NTOK; const f32x2* RW = wsp<const f32x2>(c, WS_RW) + (size_t)(lm < 0 ? 0 : lm) * NTOK;
    const unsigned char* Y2 = wsp<const unsigned char>(c, WS_Y2);
    bf16_t* H = wsp<bf16_t>(c, WS_H);
    LAS float* Gt = (LAS float*)(c.lds + 65536); LAS float* SHt = Gt + NB * DM; LAS float* GFt = SHt + NB * DM;
    for (int i = c.tid; i < NB * DM; i += 512) { const int b_ = i / DM, k_ = i % DM;
        if (MODE == 3) { Gt[i] = inp(c, 32)[k_]; SHt[i] = 0.f; }
        else { Gt[i] = inp(c, 5)[l * DM + k_] * (1.f + modp(c, l, b_, 1)[k_]); SHt[i] = modp(c, l, b_, 0)[k_]; }
        if (MODE == 1 || MODE == 3) GFt[i] = modp(c, lm, b_, 5)[k_]; }
    __syncthreads();
    const int gw = c.vcu * 8 + c.wid, NGW = c.G * 8;
    for (int r0 = gw; r0 < NTOK; r0 += 2 * NGW) {
        f32x4 xv[2][4][2]; u32x4 rawh[2][4]; u32x2 ya[2][4], yb[2][4]; float w0[2], w1[2];
#pragma unroll
        for (int q = 0; q < 2; ++q) { const int rg = r0 + q * NGW; if (rg < NTOK) {
            if (MODE == 1 || MODE == 3) { const i32x4 ri = RI[rg]; const f32x2 rw = RW[rg]; const size_t pos0 = (size_t)(ps[ri.x] + ri.z), pos1 = (size_t)(ps[ri.y] + ri.w); w0[q] = rw.x; w1[q] = rw.y;
#pragma unroll
                for (int j = 0; j < 4; ++j) { ya[q][j] = *(const u32x2*)(Y2 + pos0 * DM + 512 * j + lane * 8); yb[q][j] = *(const u32x2*)(Y2 + pos1 * DM + 512 * j + lane * 8); } }
#pragma unroll
            for (int j = 0; j < 4; ++j) { const int k = 512 * j + lane * 8;
                if (src_f32) { xv[q][j][0] = *(const f32x4*)(inp(c, 0) + (size_t)rg * DM + k); xv[q][j][1] = *(const f32x4*)(inp(c, 0) + (size_t)rg * DM + k + 4); }
                else rawh[q][j] = *(const u32x4*)(xbuf + (size_t)rg * DM + k); } } }
#pragma unroll
        for (int q = 0; q < 2; ++q) { const int rg = r0 + q * NGW; if (rg < NTOK) { const int b = rg >> 14;
            float ss = 0.f;
#pragma unroll
            for (int j = 0; j < 4; ++j) { const int k = 512 * j + lane * 8;
                f32x4 x0, x1; if (src_f32) { x0 = xv[q][j][0]; x1 = xv[q][j][1]; } else unpack8(rawh[q][j], x0, x1);
                if (MODE == 1 || MODE == 3) {
                    const f32x2 t0 = __builtin_amdgcn_cvt_pk_f32_fp8((int)ya[q][j].x, false), t1 = __builtin_amdgcn_cvt_pk_f32_fp8((int)ya[q][j].x, true), t2 = __builtin_amdgcn_cvt_pk_f32_fp8((int)ya[q][j].y, false), t3 = __builtin_amdgcn_cvt_pk_f32_fp8((int)ya[q][j].y, true);
                    const f32x2 u0 = __builtin_amdgcn_cvt_pk_f32_fp8((int)yb[q][j].x, false), u1 = __builtin_amdgcn_cvt_pk_f32_fp8((int)yb[q][j].x, true), u2 = __builtin_amdgcn_cvt_pk_f32_fp8((int)yb[q][j].y, false), u3 = __builtin_amdgcn_cvt_pk_f32_fp8((int)yb[q][j].y, true);
                    const f32x4 a0 = {t0.x, t0.y, t1.x, t1.y}, a1 = {t2.x, t2.y, t3.x, t3.y}, b0 = {u0.x, u0.y, u1.x, u1.y}, b1 = {u2.x, u2.y, u3.x, u3.y};
                    const f32x4 g0 = *(const LAS f32x4*)(GFt + b * DM + k), g1 = *(const LAS f32x4*)(GFt + b * DM + k + 4);
                    x0 += g0 * (a0 * w0[q] + b0 * w1[q]); x1 += g1 * (a1 * w0[q] + b1 * w1[q]);
                    if (MODE == 1) { const u32x4 xw = pack8f(x0, x1); *(u32x4*)(xbuf + (size_t)rg * DM + k) = xw; unpack8(xw, x0, x1); }
                }
                xv[q][j][0] = x0; xv[q][j][1] = x1;
                ss += (x0[0] * x0[0] + x0[1] * x0[1]) + (x0[2] * x0[2] + x0[3] * x0[3]) + (x1[0] * x1[0] + x1[1] * x1[1]) + (x1[2] * x1[2] + x1[3] * x1[3]);
            }
            const float rstd = rsqrtf(wave_sum(ss) * (1.f / DM) + EPS);
#pragma unroll
            for (int j = 0; j < 4; ++j) { const int k = 512 * j + lane * 8;
                if (MODE == 3) { const f32x4 g0 = *(const LAS f32x4*)(Gt + k), g1 = *(const LAS f32x4*)(Gt + k + 4);
                    *(f32x4*)(c.a.out + (size_t)rg * DM + k) = xv[q][j][0] * (rstd * c.oscale) * g0; *(f32x4*)(c.a.out + (size_t)rg * DM + k + 4) = xv[q][j][1] * (rstd * c.oscale) * g1; }
                else { const f32x4 g0 = *(const LAS f32x4*)(Gt + b * DM + k), g1 = *(const LAS f32x4*)(Gt + b * DM + k + 4);
                    const f32x4 h0 = xv[q][j][0] * rstd * g0 + *(const LAS f32x4*)(SHt + b * DM + k), h1 = xv[q][j][1] * rstd * g1 + *(const LAS f32x4*)(SHt + b * DM + k + 4);
                    *(u32x4*)(H + (size_t)rg * DM + k) = pack8f(h0, h1); } }
        } }
    }
    __syncthreads();
}

__device__ __forceinline__ void carry_phase(const Ctx& c, int l) {
    LAS float* ex = (LAS float*)c.lds;
    const float* E = wsp<const float>(c, WS_EBUF); bf16_t* SP = wsp<bf16_t>(c, WS_SPREV);
    const int seg = c.tid >> 5, pp = c.tid & 31;
    for (int item = c.vcu; item < NB * SSM_G * 2; item += c.G) {
        const int b = item >> 6, g = (item >> 1) & 31, p = (item & 1) * 32 + pp;
        const f32x2 A = wsp<const f32x2>(c, WS_A64)[(l * 32 + g) * 64 + p];
        const int c0 = b * 256 + seg * 16;
        float er[16], ei[16];
#pragma unroll
        for (int j = 0; j < 16; ++j) { const float* e = E + ((size_t)(c0 + j) * SSM_G + g) * 128; er[j] = e[p]; ei[j] = e[64 + p]; }
        float sr = 0.f, si = 0.f;
#pragma unroll
        for (int j = 0; j < 16; ++j) { const float nr = A.x * sr - A.y * si + er[j], ni = A.x * si + A.y * sr + ei[j]; sr = nr; si = ni; er[j] = sr; ei[j] = si; }
        ex[(seg * 32 + pp) * 2] = sr; ex[(seg * 32 + pp) * 2 + 1] = si;
        float pr = A.x, pi_ = A.y;
#pragma unroll
        for (int q = 0; q < 4; ++q) { const float nr = pr * pr - pi_ * pi_, ni = 2.f * pr * pi_; pr = nr; pi_ = ni; }
        __syncthreads();
        float cr = 0.f, ci = 0.f;
        for (int s = 0; s < seg; ++s) { const float tr = ex[(s * 32 + pp) * 2], ti = ex[(s * 32 + pp) * 2 + 1]; const float nr = pr * cr - pi_ * ci + tr, ni = pr * ci + pi_ * cr + ti; cr = nr; ci = ni; }
        float qr = cr, qi = ci;
#pragma unroll
        for (int j = 0; j < 16; ++j) {
            const float vr = qr + (j ? er[j - 1] : 0.f), vi = qi + (j ? ei[j - 1] : 0.f);
            bf16_t* o = SP + ((size_t)(c0 + j) * SSM_G + g) * 256; o[p] = f2bf(vr); o[64 + p] = f2bf(vi);
            const float nr = A.x * qr - A.y * qi, ni = A.x * qi + A.y * qr; qr = nr; qi = ni;
        }
        __syncthreads();
    }
}

__device__ __forceinline__ void fin_phase(const Ctx& c) {
    const bf16_t* P = wsp<const bf16_t>(c, WS_P); const bf16_t* GL = wsp<const bf16_t>(c, WS_GL); const bf16_t* O = wsp<const bf16_t>(c, WS_O); bf16_t* Y = wsp<bf16_t>(c, WS_YCAT);
    const int gw = c.vcu * 8 + c.wid, NGW = c.G * 8, lane = c.lane;
    const int wsel = lane >> 4, win = 2 << wsel;
    for (int run = gw; run < NTOK / 16; run += NGW) {
        const int t0 = run * 16; const bool hist = (t0 & (SEQ - 1)) != 0;
        {
            u32x4 ring[31];
#pragma unroll
            for (int j = 0; j < 15; ++j) ring[j] = hist ? *(const u32x4*)(P + (size_t)(t0 - 15 + j) * 512 + lane * 8) : (u32x4){0u, 0u, 0u, 0u};
#pragma unroll
            for (int j = 0; j < 16; ++j) ring[15 + j] = *(const u32x4*)(P + (size_t)(t0 + j) * 512 + lane * 8);
            f32x4 r0 = {0.f, 0.f, 0.f, 0.f}, r1 = {0.f, 0.f, 0.f, 0.f};
#pragma unroll
            for (int j = 1; j < 16; ++j) { f32x4 a0, a1; unpack8(ring[15 - j], a0, a1); const float mk = (j < win) ? 1.f : 0.f; r0 += a0 * mk; r1 += a1 * mk; }
#pragma unroll
            for (int k = 0; k < 16; ++k) {
                f32x4 c0, c1; unpack8(ring[15 + k], c0, c1); r0 += c0; r1 += c1;
                const int cn = hist ? win : ((k + 1 < win) ? k + 1 : win); const float ic = 1.f / (float)cn;
                const f32x4 y0 = r0 * ic - c0, y1 = r1 * ic - c1;
                const float ss = (y0[0] * y0[0] + y0[1] * y0[1]) + (y0[2] * y0[2] + y0[3] * y0[3]) + (y1[0] * y1[0] + y1[1] * y1[1]) + (y1[2] * y1[2] + y1[3] * y1[3]);
                const float rs = rsqrtf(wave_sum(ss) * (1.f / 512.f) + EPS);
                *(u32x4*)(Y + (size_t)(t0 + k) * DM + lane * 8) = pack8f(y0 * rs, y1 * rs);
                const u32x4 od = wsel == 0 ? ring[14 + k] : wsel == 1 ? ring[12 + k] : wsel == 2 ? ring[8 + k] : ring[k];
                f32x4 o0, o1; unpack8(od, o0, o1); r0 -= o0; r1 -= o1;
            }
        }
        {
            u32x4 g[16];
#pragma unroll
            for (int k = 0; k < 16; ++k) g[k] = *(const u32x4*)(GL + (size_t)(t0 + k) * 512 + lane * 8);
#pragma unroll
            for (int k = 0; k < 16; ++k) { f32x4 y0, y1; unpack8(g[k], y0, y1);
                const float ss = (y0[0] * y0[0] + y0[1] * y0[1]) + (y0[2] * y0[2] + y0[3] * y0[3]) + (y1[0] * y1[0] + y1[1] * y1[1]) + (y1[2] * y1[2] + y1[3] * y1[3]);
                const float rs = rsqrtf(wave_sum(ss) * (1.f / 512.f) + EPS);
                *(u32x4*)(Y + (size_t)(t0 + k) * DM + 512 + lane * 8) = pack8f(y0 * rs, y1 * rs); }
        }
#pragma unroll
        for (int hb = 0; hb < 2; ++hb) {
            u32x4 oa[8], ob[8];
#pragma unroll
            for (int k = 0; k < 8; ++k) { oa[k] = *(const u32x4*)(O + (size_t)(t0 + hb * 8 + k) * 1024 + lane * 16); ob[k] = *(const u32x4*)(O + (size_t)(t0 + hb * 8 + k) * 1024 + lane * 16 + 8); }
#pragma unroll
            for (int k = 0; k < 8; ++k) { f32x4 y0, y1, z0, z1; unpack8(oa[k], y0, y1); unpack8(ob[k], z0, z1);
                const float ss = (y0[0] * y0[0] + y0[1] * y0[1]) + (y0[2] * y0[2] + y0[3] * y0[3]) + (y1[0] * y1[0] + y1[1] * y1[1]) + (y1[2] * y1[2] + y1[3] * y1[3])
                               + (z0[0] * z0[0] + z0[1] * z0[1]) + (z0[2] * z0[2] + z0[3] * z0[3]) + (z1[0] * z1[0] + z1[1] * z1[1]) + (z1[2] * z1[2] + z1[3] * z1[3]);
                const float rs = rsqrtf(wave_sum(ss) * (1.f / 1024.f) + EPS); const size_t yo = (size_t)(t0 + hb * 8 + k) * DM + 1024 + lane * 16;
                *(u32x4*)(Y + yo) = pack8f(y0 * rs, y1 * rs); *(u32x4*)(Y + yo + 8) = pack8f(z0 * rs, z1 * rs); }
        }
    }
}
__device__ __forceinline__ void kpe_rope(const Ctx& c) {
    const bf16_t* Z = wsp<const bf16_t>(c, WS_Z); bf16_t* K = wsp<bf16_t>(c, WS_K); const f32x2* CS = wsp<const f32x2>(c, WS_CS);
    const int gt = c.vcu * 512 + c.tid, NGT = c.G * 512;
    for (int i = gt; i < NTOK * 8; i += NGT) {
        const int tok = i >> 3, q = i & 7; const int b = tok >> 14, t = tok & (SEQ - 1);
        f32x4 v0, v1; unpack8(*(const u32x4*)(Z + (size_t)tok * ZLD + Z_KPE + q * 8), v0, v1);
        const f32x2* cs = CS + (size_t)tok * 32 + q * 4; const f32x4 c01 = *(const f32x4*)cs, c23 = *(const f32x4*)(cs + 2);
        f32x4 o0, o1;
        o0[0] = v0[0] * c01[0] - v0[1] * c01[1]; o0[1] = v0[1] * c01[0] + v0[0] * c01[1]; o0[2] = v0[2] * c01[2] - v0[3] * c01[3]; o0[3] = v0[3] * c01[2] + v0[2] * c01[3];
        o1[0] = v1[0] * c23[0] - v1[1] * c23[1]; o1[1] = v1[1] * c23[0] + v1[0] * c23[1]; o1[2] = v1[2] * c23[2] - v1[3] * c23[3]; o1[3] = v1[3] * c23[2] + v1[2] * c23[3];
        const u32x4 w = pack8f(o0, o1);
#pragma unroll
        for (int h = 0; h < NHEAD; ++h) *(u32x4*)(K + ((size_t)(b * NHEAD + h) * SEQ + t) * QKD + 128 + q * 8) = w;
    }
}
namespace att {
constexpr int KN_BYTES = 16384, KR_BYTES = 8192, V_BYTES = 16384, ST_BYTES = KN_BYTES + KR_BYTES + V_BYTES, NST = 3;
constexpr int XCH_OFF = NST * ST_BYTES;
constexpr float THR2 = 11.5f;
#define AT_KSWZ(row, colB) ((row) * 256 + ((colB) ^ (((row) & 15) << 4)))
#define AT_SBAR() __builtin_amdgcn_sched_barrier(0)
__device__ __forceinline__ int v_rd_base(int lane) { return ((lane & 3) << 3) | (((lane >> 2) & 3) << 6) | (((lane >> 4) & 1) << 5) | (((lane >> 5) & 1) << 8); }
__device__ __forceinline__ int crow(int r, int hi) { return (r & 3) + 8 * (r >> 2) + 4 * hi; }
__device__ __forceinline__ void mask_tile(f32x16& p0, f32x16& p1, int dq) {
    const float NEG = -__builtin_inff();
#pragma unroll
    for (int r = 0; r < 16; ++r) { const int cc = (r & 3) + 8 * (r >> 2); if (dq - cc < 0) p0[r] = NEG; if (dq - cc - 32 < 0) p1[r] = NEG; }
}
__device__ __forceinline__ void partialSM(f32x16& p0, f32x16& p1, float& m_reg, float sh, float& delta, float& alpha, bool& nosub, bool first) {
    float pmax = p0[0];
#pragma unroll
    for (int r = 1; r < 16; ++r) pmax = fmaxf(pmax, p0[r]);
#pragma unroll
    for (int r = 0; r < 16; ++r) pmax = fmaxf(pmax, p1[r]);
    { auto rr = __builtin_amdgcn_permlane32_swap(__float_as_uint(pmax), __float_as_uint(pmax), false, false); pmax = fmaxf(__uint_as_float(rr[0]), __uint_as_float(rr[1])); }
    pmax += sh;
    float mn;
    if (__builtin_expect(__all((pmax - m_reg) <= THR2), 1)) { mn = m_reg; alpha = 1.f; nosub = !first; }
    else { mn = fmaxf(m_reg, pmax); alpha = fast_exp2(m_reg - mn); m_reg = mn; nosub = false; }
    delta = mn - sh;
    if (nosub) {
#pragma unroll
        for (int r = 0; r < 16; ++r) p0[r] = fast_exp2(p0[r]);
    } else {
#pragma unroll
        for (int r = 0; r < 16; ++r) p0[r] = fast_exp2(p0[r] - delta);
    }
}
__device__ __forceinline__ void finishSM(f32x16& p0, f32x16& p1, float delta, bool nosub, float alpha, float& l_reg, bf16x8& pa0, bf16x8& pa1, bf16x8& pa2, bf16x8& pa3) {
    if (nosub) {
#pragma unroll
        for (int r = 0; r < 16; ++r) p1[r] = fast_exp2(p1[r]);
    } else {
#pragma unroll
        for (int r = 0; r < 16; ++r) p1[r] = fast_exp2(p1[r] - delta);
    }
    float ps = 0.f;
#pragma unroll
    for (int r = 0; r < 16; ++r) ps += p0[r];
#pragma unroll
    for (int r = 0; r < 16; ++r) ps += p1[r];
    { auto rr = __builtin_amdgcn_permlane32_swap(__float_as_uint(ps), __float_as_uint(ps), false, false); ps = __uint_as_float(rr[0]) + __uint_as_float(rr[1]); }
    l_reg = l_reg * alpha + ps;
#define AT_PK4(P, B_, OUT) do { unsigned a0 = cvtpk(P[B_ + 0], P[B_ + 1]), a1 = cvtpk(P[B_ + 2], P[B_ + 3]); unsigned b0 = cvtpk(P[B_ + 4], P[B_ + 5]), b1 = cvtpk(P[B_ + 6], P[B_ + 7]); \
        auto r0 = __builtin_amdgcn_permlane32_swap(a0, b0, false, false); auto r1 = __builtin_amdgcn_permlane32_swap(a1, b1, false, false); \
        u32x4 w = {r0[0], r1[0], r0[1], r1[1]}; OUT = *reinterpret_cast<bf16x8*>(&w); } while (0)
    AT_PK4(p0, 0, pa0); AT_PK4(p0, 8, pa1); AT_PK4(p1, 0, pa2); AT_PK4(p1, 8, pa3);
#undef AT_PK4
}
#define AT_KRD(dst, addr, off) asm volatile("ds_read_b128 %0, %1 offset:%2" : "=&v"(dst) : "v"(addr), "i"(off) : "memory")
#define AT_KWAIT(n, a, b) asm volatile("s_waitcnt lgkmcnt(%2)" : "+v"(a), "+v"(b) : "i"(n) : "memory")
struct KAddr { unsigned xo[8]; };
__device__ __forceinline__ void kaddr_init(KAddr& ka, int r32, int hi) {
    const int rb = r32 * 256, key = (r32 & 15) << 4;
#pragma unroll
    for (int d0 = 0; d0 < 8; ++d0) ka.xo[d0] = (unsigned)(rb + (((d0 * 16 + hi * 8) * 2) ^ key));
}
__device__ __forceinline__ void qkt(f32x16& p0, f32x16& p1, unsigned stb  , const KAddr& ka, const bf16x8* qr, float init) {
#pragma unroll
    for (int r = 0; r < 16; ++r) { p0[r] = init; p1[r] = init; }
    u32x4 f[4][2];
#define AT_KSTEP_RD(s) do { if ((s) < 8) { const unsigned a_ = stb + ka.xo[(s) & 7]; AT_KRD(f[(s) & 3][0], a_, 0); AT_KRD(f[(s) & 3][1], a_, 8192); } \
        else { const unsigned a0_ = stb + ka.xo[((s) - 8) & 7], a1_ = stb + ka.xo[((s) - 4) & 7]; AT_KRD(f[(s) & 3][0], a0_, KN_BYTES); AT_KRD(f[(s) & 3][1], a1_, KN_BYTES); } } while (0)
    AT_KSTEP_RD(0); AT_KSTEP_RD(1); AT_KSTEP_RD(2);
#pragma unroll
    for (int s = 0; s < 12; ++s) {
        if (s + 3 < 12) AT_KSTEP_RD(s + 3);
        if (s <= 8) AT_KWAIT(6, f[s & 3][0], f[s & 3][1]); else if (s == 9) AT_KWAIT(4, f[s & 3][0], f[s & 3][1]); else if (s == 10) AT_KWAIT(2, f[s & 3][0], f[s & 3][1]); else AT_KWAIT(0, f[s & 3][0], f[s & 3][1]);
        p0 = __builtin_amdgcn_mfma_f32_32x32x16_bf16(*(const bf16x8*)&f[s & 3][0], qr[s], p0, 0, 0, 0); p1 = __builtin_amdgcn_mfma_f32_32x32x16_bf16(*(const bf16x8*)&f[s & 3][1], qr[s], p1, 0, 0, 0);
    }
#undef AT_KSTEP_RD
}
struct VFrag { s16x4 l0, l1, l2, l3, h0, h1, h2, h3; };
#define AT_TRRD(dst, vb, off) asm volatile("ds_read_b64_tr_b16 %0, %1 offset:%2" : "=&v"(dst) : "v"(vb), "i"(off) : "memory")
#define AT_VISSUE(F, vb, d0) do { constexpr int b_ = (d0) * 512; AT_TRRD(F.l0, vb, b_); AT_TRRD(F.h0, vb, b_ + 2048); AT_TRRD(F.l1, vb, b_ + 4096); AT_TRRD(F.h1, vb, b_ + 6144); \
        AT_TRRD(F.l2, vb, b_ + 8192); AT_TRRD(F.h2, vb, b_ + 10240); AT_TRRD(F.l3, vb, b_ + 12288); AT_TRRD(F.h3, vb, b_ + 14336); } while (0)
#define AT_VWAIT(n, F) asm volatile("s_waitcnt lgkmcnt(%8)" : "+v"(F.l0), "+v"(F.l1), "+v"(F.l2), "+v"(F.l3), "+v"(F.h0), "+v"(F.h1), "+v"(F.h2), "+v"(F.h3) : "i"(n) : "memory")
#define AT_VMMA(F, d0) do { \
        o[d0] = __builtin_amdgcn_mfma_f32_32x32x16_bf16(pa0, (bf16x8){F.l0[0], F.l0[1], F.l0[2], F.l0[3], F.h0[0], F.h0[1], F.h0[2], F.h0[3]}, o[d0], 0, 0, 0); \
        o[d0] = __builtin_amdgcn_mfma_f32_32x32x16_bf16(pa1, (bf16x8){F.l1[0], F.l1[1], F.l1[2], F.l1[3], F.h1[0], F.h1[1], F.h1[2], F.h1[3]}, o[d0], 0, 0, 0); \
        o[d0] = __builtin_amdgcn_mfma_f32_32x32x16_bf16(pa2, (bf16x8){F.l2[0], F.l2[1], F.l2[2], F.l2[3], F.h2[0], F.h2[1], F.h2[2], F.h2[3]}, o[d0], 0, 0, 0); \
        o[d0] = __builtin_amdgcn_mfma_f32_32x32x16_bf16(pa3, (bf16x8){F.l3[0], F.l3[1], F.l3[2], F.l3[3], F.h3[0], F.h3[1], F.h3[2], F.h3[3]}, o[d0], 0, 0, 0); } while (0)
__device__ __forceinline__ void pv_tile(f32x16* o, unsigned vb, VFrag& A, bf16x8 pa0, bf16x8 pa1, bf16x8 pa2, bf16x8 pa3) {
    VFrag B;
    AT_VISSUE(B, vb, 1); AT_VWAIT(8, A); AT_VMMA(A, 0);
    AT_VISSUE(A, vb, 2); AT_VWAIT(8, B); AT_VMMA(B, 1);
    AT_VISSUE(B, vb, 3); AT_VWAIT(8, A); AT_VMMA(A, 2);
    AT_VWAIT(0, B); AT_VMMA(B, 3);
}
struct DmaOff { unsigned kn0, kn1, kr, v0, v1; };
__device__ __forceinline__ void dma_offsets(int tid, DmaOff& d) {
    { const int p = tid, row = p >> 4, ch = (p & 15) ^ (row & 15); d.kn0 = (unsigned)(row * QKD + ch * 8) * 2u; }
    { const int p = tid + 512, row = p >> 4, ch = (p & 15) ^ (row & 15); d.kn1 = (unsigned)(row * QKD + ch * 8) * 2u; }
    { const int p = tid, row = p >> 4, ch = (p & 15) ^ (row & 15); const int key = row + ((ch & 8) ? 32 : 0); d.kr = (unsigned)(key * QKD + 128 + (ch & 7) * 8) * 2u; }
    { const int p = tid, sub = p >> 5, kk = (sub >> 2) * 8 + ((p & 31) >> 2), key = (kk & ~0xC) | ((kk & 4) << 1) | ((kk & 8) >> 1), col = (sub & 3) * 32 + (p & 3) * 8; d.v0 = (unsigned)(key * VD + col) * 2u; }
    { const int p = tid + 512, sub = p >> 5, kk = (sub >> 2) * 8 + ((p & 31) >> 2), key = (kk & ~0xC) | ((kk & 4) << 1) | ((kk & 8) >> 1), col = (sub & 3) * 32 + (p & 3) * 8; d.v1 = (unsigned)(key * VD + col) * 2u; }
}
__device__ __forceinline__ void glds16(const void* g, unsigned lds_dst) {
    unsigned keep; asm volatile("s_mov_b32 %0, m0\n\ts_mov_b32 m0, %2\n\ts_nop 0\n\tglobal_load_lds_dwordx4 %1, off\n\ts_mov_b32 m0, %0" : "=&s"(keep) : "v"(g), "s"(lds_dst) : "memory");
}
#define AT_GLDS(g, l) glds16((const void*)(g), (unsigned)(uintptr_t)(l))
__device__ __forceinline__ void issue_tile(LAS char* lds, int stage, const char* Kt, const char* Vt, const DmaOff& d, int wid) {
    LAS char* st = lds + stage * ST_BYTES + wid * 1024;
    unsigned o0 = d.kn0, o1 = d.kn1, o2 = d.kr, o3 = d.v0, o4 = d.v1; asm volatile("" : "+v"(o0), "+v"(o1), "+v"(o2), "+v"(o3), "+v"(o4));
    AT_GLDS(Kt + o0, st); AT_GLDS(Kt + o1, st + 8192); AT_GLDS(Kt + o2, st + KN_BYTES); AT_GLDS(Vt + o3, st + KN_BYTES + KR_BYTES); AT_GLDS(Vt + o4, st + KN_BYTES + KR_BYTES + 8192);
}
__device__ __forceinline__ void block(LAS char* lds, const bf16_t* Qbh, const char* Kbh, const char* Vbh, bf16_t* Obase  , int qb, const DmaOff& d, const int tid, const bool rev  ) {
    const int wid = __builtin_amdgcn_readfirstlane(tid >> 6), lane = tid & 63, r32 = lane & 31, hi = lane >> 5;
    const int NT = 4 * (qb + 1);
    const int qlo = qb * 256 + wid * 32;
    const int nact = (qlo + 31) / 64 + 1;
    LAS float* xw = (LAS float*)(lds + XCH_OFF) + wid * 64;
    asm volatile("" ::: "memory"); __builtin_amdgcn_s_barrier(); asm volatile("" ::: "memory");
    bf16x8 qr[12];
#pragma unroll
    for (int d0 = 0; d0 < 12; ++d0) qr[d0] = *(const bf16x8*)(Qbh + (size_t)(qlo + r32) * QKD + d0 * 16 + hi * 8);
    const long ksK = rev ? -(long)(64 * QKD * 2) : (long)(64 * QKD * 2), ksV = rev ? -(long)(64 * VD * 2) : (long)(64 * VD * 2);
    const char* K0 = Kbh + (rev ? (size_t)(NT - 1) * 64 * QKD * 2 : (size_t)0); const char* V0 = Vbh + (rev ? (size_t)(NT - 1) * 64 * VD * 2 : (size_t)0);
    issue_tile(lds, 0, K0, V0, d, wid);
    issue_tile(lds, 1, K0 + ksK, V0 + ksV, d, wid);
#pragma unroll
    for (int d0 = 0; d0 < 12; ++d0) asm volatile("" : "+v"(qr[d0]));
    float m_reg = -1e30f, l_reg = 0.f; f32x16 o[4] = {};
    const unsigned vbase = (unsigned)(uintptr_t)(lds + KN_BYTES + KR_BYTES) + (unsigned)v_rd_base(lane);
    const unsigned lds0 = (unsigned)(uintptr_t)lds; KAddr ka; kaddr_init(ka, r32, hi);
    int stage = 0;
    for (int t = 0; t < NT; ++t) {
        if (t + 1 < NT) asm volatile("s_waitcnt vmcnt(5)" ::: "memory"); else asm volatile("s_waitcnt vmcnt(0)" ::: "memory");
        __builtin_amdgcn_s_barrier(); asm volatile("" ::: "memory");
        if (t + 2 < NT) { int s2 = stage + 2; if (s2 >= NST) s2 -= NST; issue_tile(lds, s2, K0 + (long)(t + 2) * ksK, V0 + (long)(t + 2) * ksV, d, wid); }
        const int tt = rev ? NT - 1 - t : t;
        if (tt < nact) {
            f32x16 p0, p1; float delta, alpha; bool nosub; bf16x8 pa0, pa1, pa2, pa3; VFrag vf;
            const bool first = rev ? (tt == nact - 1) : (tt == 0); const float sh = first ? 0.f : m_reg;
            qkt(p0, p1, lds0 + (unsigned)(stage * ST_BYTES), ka, qr, -sh);
            const unsigned vb = vbase + (unsigned)(stage * ST_BYTES);
            AT_VISSUE(vf, vb, 0);
            if (tt * 64 + 63 > qlo) mask_tile(p0, p1, qlo + r32 - tt * 64 - 4 * hi);
            partialSM(p0, p1, m_reg, sh, delta, alpha, nosub, first);
            finishSM(p0, p1, delta, nosub, alpha, l_reg, pa0, pa1, pa2, pa3);
            if (__any(alpha < 1.f)) { if (hi == 0) xw[r32] = alpha; asm volatile("s_waitcnt lgkmcnt(0)" ::: "memory");
#pragma unroll
                for (int d_ = 0; d_ < 4; ++d_)
#pragma unroll
                    for (int r = 0; r < 16; ++r) o[d_][r] *= xw[crow(r, hi)]; }
            pv_tile(o, vb, vf, pa0, pa1, pa2, pa3);
        }
        ++stage; if (stage >= NST) stage = 0;
    }
    if (hi == 0) xw[32 + r32] = l_reg; asm volatile("s_waitcnt lgkmcnt(0)" ::: "memory");
    bf16_t* Ow = Obase + (size_t)qlo * 1024;
#pragma unroll
    for (int r = 0; r < 16; ++r) { const int orow = crow(r, hi); const float rl = fast_rcp(xw[32 + orow]);
#pragma unroll
        for (int d0 = 0; d0 < 4; ++d0) { const float v = o[d0][r] * rl; const float vn = __shfl_xor(v, 1);
            if ((r32 & 1) == 0) *(unsigned*)(Ow + (size_t)orow * 1024 + d0 * 32 + r32) = cvtpk(v, vn); } }
}
__device__ __forceinline__ void phase(const Ctx& c) {
    LAS char* lds = (LAS char*)c.lds;
    const bf16_t* Q = wsp<const bf16_t>(c, WS_Q); const char* K = (const char*)(c.ws + WS_K); const char* V = (const char*)(c.ws + WS_V); bf16_t* O = wsp<bf16_t>(c, WS_O);
    DmaOff d; dma_offsets(c.tid, d);
    if (c.wid >= 4) __builtin_amdgcn_s_setprio(1);
    for (int it = c.vcu; it < 16 * 32; it += c.G) {
        const int bh = it >> 5, x = it & 31; const int b = bh >> 3, h = bh & 7;
        const bf16_t* Qbh = Q + (size_t)bh * SEQ * QKD; const char* Kbh = K + (size_t)bh * SEQ * QKD * 2; const char* Vbh = V + (size_t)bh * SEQ * VD * 2;
        bf16_t* Ob = O + (size_t)b * SEQ * 1024 + h * 128;
        block(lds, Qbh, Kbh, Vbh, Ob, 63 - x, d, c.tid, false);
        block(lds, Qbh, Kbh, Vbh, Ob, x, d, c.tid, true);
    }
    asm volatile("s_waitcnt vmcnt(0)" ::: "memory"); __builtin_amdgcn_s_barrier(); asm volatile("" ::: "memory");
    __builtin_amdgcn_s_setprio(0);
}
}
constexpr int N_PHASES = 26;
#if MK_ONE_LAUNCH
#define SEAM(k) do { if (lo <= (k) && (k) + 1 < hi) { unsigned z_ = 0u; asm volatile("" : "+v"(z_)); xcd_barrier(bar, wid_s == 0 && __builtin_amdgcn_mbcnt_hi(~0u, __builtin_amdgcn_mbcnt_lo(~0u, z_)) == 0u); }; } while (0)
#else
#define SEAM(k) do { } while (0)
#endif
#ifdef MK_DIAG_A
#ifndef MK_DIAG_SENS
#define MK_DIAG_SENS 4e-5f
#endif
#ifndef MK_DIAG_OFF
#define MK_DIAG_OFF 0
#endif
#define DTS ((unsigned long long*)(args.ws + WS_CTL) + 6144)
#define STAMP(k) do { if (blockIdx.x == 0 && wid_s == 0) { unsigned z_ = 0u; asm volatile("" : "+v"(z_)); if (__builtin_amdgcn_mbcnt_hi(~0u, __builtin_amdgcn_mbcnt_lo(~0u, z_)) == 0u) DTS[(k)] = __builtin_amdgcn_s_memrealtime(); } } while (0)
#else
#define STAMP(k) do { } while (0)
#endif
#ifdef MK_PROBE
#define REP(k) for (int rp_ = 0; rp_ < ((k) == MK_PROBE ? 2 : 1); ++rp_)
#else
#define REP(k)
#endif
#ifdef TEST_PH
#define IN(k) (((k) == 0 ? 0 : ((k) == 25 ? 25 : 1 + ((k) - 1) % 12)) == TEST_PH && lo <= (k) && (k) < hi)
#else
#define IN(k) (lo <= (k) && (k) < hi)
#endif
#define PCTX Ctx c{c0.lds, 0, 0, 0, c0.G, c0.vcu, args, nullptr, 1.f}; { unsigned z_ = 0u; asm volatile("" : "+v"(z_)); int t_ = wid_s * 64 + (int)__builtin_amdgcn_mbcnt_hi(~0u, __builtin_amdgcn_mbcnt_lo(~0u, z_)); asm volatile("" : "+v"(t_)); c.tid = t_; c.lane = t_ & 63; c.wid = __builtin_amdgcn_readfirstlane(t_ >> 6); unsigned char* w_ = args.ws; asm volatile("" : "+s"(w_)); c.ws = w_; }
#define LAYERP float* ssq_q = (float*)(c.ws + WS_CTL + CTL_SSQ) + (size_t)(l * 2) * NTOK; float* ssq_kv = ssq_q + NTOK; int* cnt = wsp<int>(c, WS_CTL) + CW_CNT + l * 32 * 64; const char* ssmtab = (const char*)(c.ws + WS_SSMTAB) + (size_t)l * 32 * SSMTAB_STRIDE; (void)ssq_q; (void)ssq_kv; (void)cnt; (void)ssmtab;
struct KState { int lo, hi, wid_s; };
template <int l>
__device__ __forceinline__ void layer_phases(const Args& args, const Ctx& c0, const XcdBarrier& bar, const int lo, const int hi, const int wid_s) {
        const int pb = 1 + 12 * l;
        if (IN(pb + 0)) { STAMP(pb + 0); PCTX
            if (l == 0) { norm_rows<0>(c, l); gen_ssm_tables(c); }
            else { (void)build_tile_table(c, wsp<int>(c, WS_CTL) + CW_CNT + (l - 1) * 32 * 64); norm_rows<1>(c, l); __syncthreads(); convert_experts(c, l); }
            router_prep(c, l);
            SEAM(pb + 0);
        }
        if (IN(pb + 1)) { STAMP(pb + 1); PCTX LAYERP
            ProgG1 p; p.so.init(NTOK, DM, c.G, (int)blockIdx.x); p.A = (const char*)(c.ws + WS_H); p.B = (const char*)(c.ws + WS_WIN) + (size_t)l * DM * DM * 2;
            p.Z = wsp<bf16_t>(c, WS_Z); p.U = wsp<bf16_t>(c, WS_U); p.ssqp = wsp<float>(c, WS_SSQP);
            REP(pb + 1) { ge::run(c.lds, p, c.tid); }
#ifdef MK_DUMMY_G1
            if (l == 0) { __syncthreads(); STAMP(30); ProgG1 q = p; q.Z = wsp<bf16_t>(c, WS_YCAT); q.U = wsp<bf16_t>(c, WS_YCAT + 96 * MiB); q.ssqp = wsp<float>(c, WS_YI); q.nt_ov = MK_DUMMY_G1; ge::run(c.lds, q, c.tid); STAMP(31); }
#endif
            SEAM(pb + 1);
        }
        if (IN(pb + 2)) { STAMP(pb + 2); PCTX LAYERP
            ProgG2 p; p.G = c.G; p.c = (int)blockIdx.x; p.Z = (const char*)(c.ws + WS_Z); p.U = (const char*)(c.ws + WS_U);
            p.WUQ = (const char*)(c.ws + WS_WUQ) + (size_t)l * 1536 * 512 * 2; p.WUKV = (const char*)(c.ws + WS_WUKV) + (size_t)l * 2048 * 256 * 2; p.WPOOL = (const char*)(c.ws + WS_WPOOL) + (size_t)l * 2 * 256 * 256 * 2;
            p.SSMTAB = ssmtab; p.ssqp = wsp<const float>(c, WS_SSQP); p.CS = wsp<const f32x2>(c, WS_CS);
            p.Q = wsp<bf16_t>(c, WS_Q); p.K = wsp<bf16_t>(c, WS_K); p.V = wsp<bf16_t>(c, WS_V); p.P = wsp<bf16_t>(c, WS_P); p.YI = wsp<bf16_t>(c, WS_YI); p.EBUF = wsp<float>(c, WS_EBUF);
#ifdef MK_G2_SPLIT
            if (l == 0) { STAMP(30); p.tmask = 1; ge::run(c.lds, p, c.tid); STAMP(31); p.tmask = 2; ge::run(c.lds, p, c.tid); STAMP(32); p.tmask = 4; ge::run(c.lds, p, c.tid); STAMP(33); p.tmask = 8; ge::run(c.lds, p, c.tid); STAMP(34); kpe_rope(c); STAMP(35); }
            else { ge::run(c.lds, p, c.tid); kpe_rope(c); }
            SEAM(pb + 2);
#else
            REP(pb + 2) { ge::run(c.lds, p, c.tid); kpe_rope(c); } SEAM(pb + 2);
#endif
        }
        if (IN(pb + 4)) { STAMP(pb + 4); PCTX REP(pb + 4) { carry_phase(c, l); att::phase(c); } SEAM(pb + 4); }
        if (IN(pb + 5)) { STAMP(pb + 5); PCTX LAYERP
            ProgS1 p; p.G = c.G; p.c = (int)blockIdx.x; p.SPREV = (const char*)(c.ws + WS_SPREV); p.SSMTAB = ssmtab; p.YI = wsp<const bf16_t>(c, WS_YI); p.U = wsp<const bf16_t>(c, WS_U);
            p.Dskip = inp(c, 16) + l * 512; p.YG = wsp<bf16_t>(c, WS_YG);
            REP(pb + 5) { ge::run(c.lds, p, c.tid); } SEAM(pb + 5);
        }
        if (IN(pb + 6)) { STAMP(pb + 6); PCTX
            ProgS2 p; p.G = c.G; p.c = (int)blockIdx.x; p.YGc = (const char*)(c.ws + WS_YG); p.W = (const char*)(c.ws + WS_WGLU) + (size_t)l * 512 * 512 * 2; p.YG = wsp<const bf16_t>(c, WS_YG); p.GL = wsp<bf16_t>(c, WS_GL);
            REP(pb + 6) { ge::run(c.lds, p, c.tid); } SEAM(pb + 6);
        }
        if (IN(pb + 7)) { STAMP(pb + 7); PCTX REP(pb + 7) { fin_phase(c); } SEAM(pb + 7); }
        if (IN(pb + 8)) { STAMP(pb + 8); PCTX
            ProgG3 p; p.so.init(NTOK, DM, c.G, (int)blockIdx.x); p.A = (const char*)(c.ws + WS_YCAT); p.B = (const char*)(c.ws + WS_WOUT) + (size_t)l * DM * DM * 2;
            p.xin = (l == 0) ? inp(c, 0) : nullptr; p.xin16 = wsp<const bf16_t>(c, WS_XBUF); p.xout = wsp<bf16_t>(c, WS_XBUF); p.ga = modp(c, l, 0, 2);
            REP(pb + 8) { ge::run(c.lds, p, c.tid); } SEAM(pb + 8);
        }
        if (IN(pb + 9)) { STAMP(pb + 9); PCTX norm_phase<2>(c, l); SEAM(pb + 9); }
        if (IN(pb + 10)) { STAMP(pb + 10); PCTX LAYERP
            const int ntiles = __builtin_amdgcn_readfirstlane(build_tile_table(c, cnt));
            ProgM1 p; p.G = c.G; p.c = (int)blockIdx.x; p.tab = (const LAS int*)(c.lds + LDS_TILETAB); p.ntiles = ntiles; p.cnt = cnt; p.toks = wsp<const int>(c, WS_TOK);
            p.H = (const char*)(c.ws + WS_H); p.W13 = (const char*)(c.ws + WS_W13); p.ACT = wsp<bf16_t>(c, WS_ACT);
            REP(pb + 10) { ge::run(c.lds, p, c.tid); } SEAM(pb + 10);
        }
        if (IN(pb + 11)) { STAMP(pb + 11); PCTX LAYERP
            const int ntiles = __builtin_amdgcn_readfirstlane(build_tile_table(c, cnt));
            ProgM2 p; p.G = c.G; p.c = (int)blockIdx.x; p.tab = (const LAS int*)(c.lds + LDS_TILETAB); p.ntiles = ntiles; p.ACT = (const char*)(c.ws + WS_ACT); p.W2 = (const char*)(c.ws + WS_W2); p.Y2 = wsp<unsigned char>(c, WS_Y2);
            REP(pb + 11) { ge::run(c.lds, p, c.tid); } STAMP(pb + 12); SEAM(pb + 11);
        }
}
__global__ void __launch_bounds__(512, 2) mk_fwd(Args args) {
    extern __shared__ __attribute__((aligned(16))) unsigned char lds_[];
    Ctx c0{(LAS unsigned char*)lds_, (int)threadIdx.x, (int)(threadIdx.x & 63), __builtin_amdgcn_readfirstlane((int)(threadIdx.x >> 6)), (int)gridDim.x, 0, args, args.ws, 1.f};
    { const int bx = blockIdx.x; c0.vcu = (c0.G % 8 == 0) ? (bx % 8) * (c0.G / 8) + bx / 8 : bx; }
    if (c0.tid < 4) ((LAS unsigned*)(c0.lds + LDS_MISC))[c0.tid] = 0u;
    __syncthreads();
    const int lo = args.ph_lo, hi = args.ph_hi; const int wid_s = c0.wid; (void)wid_s;
#if MK_ONE_LAUNCH
    XcdBarrier bar = xcd_barrier_post(wsp<unsigned>(c0, WS_CTL) + CW_BAR, (volatile LAS unsigned*)(c0.lds + LDS_MISC));
#else
    XcdBarrier bar; bar.bar = nullptr; bar.x = 0; bar.st = nullptr;
#endif
    if (IN(0)) { STAMP(0); PCTX REP(0) { p0_prologue(c); __syncthreads(); } SEAM(0); }
    layer_phases<0>(args, c0, bar, lo, hi, wid_s);
    layer_phases<1>(args, c0, bar, lo, hi, wid_s);
    if (IN(25)) { STAMP(25); PCTX
#ifdef MK_DIAG_A
        { const unsigned long long tk = DTS[MK_DIAG_B] - DTS[MK_DIAG_A]; const float us = (float)tk * 0.01f; c.oscale = 1.f + 0.02f + MK_DIAG_SENS * fminf(fmaxf(us - (float)MK_DIAG_OFF, 0.f), 16.f / (MK_DIAG_SENS * 1000.f)); }
#endif
        (void)build_tile_table(c, wsp<int>(c, WS_CTL) + CW_CNT + 1 * 32 * 64); norm_rows<3>(c, 1); }
#undef PCTX
#undef LAYERP
}
#undef IN
#undef SEAM
#undef PCTX
#undef LAYERP

extern "C" void kernel_launch(void* const* d_in, const int* in_sizes, int n_in, void* d_out, int out_size, void* d_ws, size_t ws_size, hipStream_t stream) {
    static int grid = 0;
    if (grid == 0) {
        if (n_in != 33 || in_sizes[0] != NTOK * DM || out_size != NTOK * DM || ws_size < WS_END) {
            fprintf(stderr, "kernel_launch: shape/workspace mismatch (n_in %d, in0 %d, out %d, ws %zu < %zu); nothing launched\n", n_in, n_in > 0 ? in_sizes[0] : -1, out_size, ws_size, (size_t)WS_END); grid = -1; return; }
        int dev = 0, cus = 0, per_cu = 0;
        if (hipGetDevice(&dev) != hipSuccess || hipDeviceGetAttribute(&cus, hipDeviceAttributeMultiprocessorCount, dev) != hipSuccess) { grid = -1; return; }
        if (hipFuncSetAttribute((const void*)mk_fwd, hipFuncAttributeMaxDynamicSharedMemorySize, LDS_BYTES) != hipSuccess) { fprintf(stderr, "kernel_launch: hipFuncSetAttribute failed\n"); grid = -1; return; }
        if (hipOccupancyMaxActiveBlocksPerMultiprocessor(&per_cu, (const void*)mk_fwd, 512, LDS_BYTES) != hipSuccess || per_cu < 1) fprintf(stderr, "kernel_launch: occupancy query reports %d\n", per_cu);
        (void)hipGetLastError();
        grid = cus;
    }
    if (grid < 0) return;
    if (hipMemsetAsync((char*)d_ws + WS_CTL, 0, CTL_ZERO_BYTES, stream) != hipSuccess) return;
    Args a{};
    for (int i = 0; i < 33; ++i) a.in[i] = d_in[i];
    a.out = (float*)d_out; a.ws = (unsigned char*)d_ws;
#if MK_ONE_LAUNCH
    a.ph_lo = 0; a.ph_hi = N_PHASES;
    hipLaunchKernelGGL(mk_fwd, dim3(grid), dim3(512), LDS_BYTES, stream, a);
#else
    for (int ph = 0; ph < N_PHASES; ++ph) { a.ph_lo = ph; a.ph_hi = ph + 1; int reps = 1;
#ifdef MK_HPROBE
        if (ph == MK_HPROBE) reps = 2;
#endif
        for (int r = 0; r < reps; ++r) hipLaunchKernelGGL(mk_fwd, dim3(grid), dim3(512), LDS_BYTES, stream, a); }
#endif
}
```
